# Optimizing an MI355X kernel written in HIP

```python
import jax, jax.numpy as jnp
from jax import lax

D_MODEL = 1024
BATCH = 4
SEQ = 8192
DEPTH = 1
DEC_BATCH = 32
DEC_SEQ = 16
PAST_LEN = 4096

CHUNK = 64
CONV_CH = 512
CONV_WIDTH = 31
N_HEADS = 8
N_KV_HEADS = 2
HEAD_DIM = 64
Q_PER_KV = N_HEADS // N_KV_HEADS
ATTN_WIDTH = N_HEADS * HEAD_DIM
KV_WIDTH = N_KV_HEADS * HEAD_DIM
MIX_WIDTH = CONV_CH + ATTN_WIDTH
IN_COLS = 2 * CONV_CH + ATTN_WIDTH + 2 * KV_WIDTH
SPLITS = [CONV_CH, 2 * CONV_CH, 2 * CONV_CH + ATTN_WIDTH, 2 * CONV_CH + ATTN_WIDTH + KV_WIDTH]
WINDOW = 128
WINDOW_CHUNKS = WINDOW // CHUNK
ROPE_DIM = HEAD_DIM // 4
ROPE_THETA = 500000.0
D_FF = 2816
EPS = 1e-6

kernel_name = "hymba_conformer_swa_sink_stream_step"


def rms_norm(x, g):
    xf = x.astype(jnp.float32)
    y = xf * lax.rsqrt(jnp.mean(xf * xf, axis=-1, keepdims=True) + EPS)
    return (y * g.astype(jnp.float32)).astype(x.dtype)


def layer_norm(x, g, b):
    xf = x.astype(jnp.float32)
    mu = jnp.mean(xf, axis=-1, keepdims=True)
    xc = xf - mu
    y = xc * lax.rsqrt(jnp.mean(xc * xc, axis=-1, keepdims=True) + EPS)
    return (y * g.astype(jnp.float32) + b.astype(jnp.float32)).astype(x.dtype)


def swiglu_ffn(x, g, w_up, w_down):
    a, b = jnp.split(rms_norm(x, g) @ w_up, 2, axis=-1)
    return (jax.nn.silu(a) * b) @ w_down


def partial_rope(x, pos):
    half = ROPE_DIM // 2
    inv = jnp.power(jnp.float32(ROPE_THETA), -jnp.arange(half, dtype=jnp.float32) / half)
    ang = pos.astype(jnp.float32)[:, None] * inv[None, :]
    cos = jnp.cos(ang)[:, None, :]
    sin = jnp.sin(ang)[:, None, :]
    xf = x.astype(jnp.float32)
    x1, x2 = xf[..., :half], xf[..., half:ROPE_DIM]
    out = jnp.concatenate([x1 * cos - x2 * sin, x2 * cos + x1 * sin, xf[..., ROPE_DIM:]], axis=-1)
    return out.astype(x.dtype)


def sink_attend(q, k, v, key_valid, sinks):
    s = jnp.einsum('bnqhgd,bnkhd->bnhgqk', q, k, preferred_element_type=jnp.float32) * (HEAD_DIM ** -0.5)
    if key_valid is not None:
        s = jnp.where(key_valid[None, :, None, None, None, :], s, -jnp.inf)
    sink = jnp.broadcast_to(sinks.astype(jnp.float32).reshape(1, 1, N_KV_HEADS, Q_PER_KV, 1, 1), s.shape[:-1] + (1,))
    p = jax.nn.softmax(jnp.concatenate([s, sink], axis=-1), axis=-1)[..., :-1]
    return jnp.einsum('bnhgqk,bnkhd->bnqhgd', p.astype(v.dtype), v)


def banded_window_attention(q, k, v, sinks):
    B, T = q.shape[:2]
    n_c = T // CHUNK
    qb = q.reshape(B, n_c, CHUNK, N_KV_HEADS, Q_PER_KV, HEAD_DIM)

    def band(t):
        tc = t.reshape(B, n_c, CHUNK, N_KV_HEADS, HEAD_DIM)
        tp = jnp.pad(tc, ((0, 0), (WINDOW_CHUNKS, 0), (0, 0), (0, 0), (0, 0)))
        return jnp.concatenate([tp[:, j:j + n_c] for j in range(WINDOW_CHUNKS + 1)], axis=2)

    kb, vb = band(k), band(v)
    key_chunk = jnp.arange(n_c)[:, None] - WINDOW_CHUNKS + jnp.arange(WINDOW_CHUNKS + 1)[None, :]
    valid = jnp.repeat(key_chunk >= 0, CHUNK, axis=1)
    o = sink_attend(qb, kb, vb, valid, sinks)
    return o.reshape(B, T, ATTN_WIDTH)


def conv_tail(u_hist, w_dw, b_dw, g_cn, b_cn):
    y = lax.conv_general_dilated(u_hist, w_dw[:, None, :], window_strides=(1,), padding='VALID',
                                 dimension_numbers=('NWC', 'WIO', 'NWC'), feature_group_count=CONV_CH)
    return jax.nn.silu(layer_norm(y + b_dw, g_cn, b_cn))


def encoder_layer(x, pos, conv_prev, k_prev, v_prev, g_ff1, w_ff1_in, w_ff1_out, g_mix, w_in, g_q, g_k,
                  sinks, w_dw, b_dw, g_cn, b_cn, w_out, g_ff2, w_ff2_in, w_ff2_out):
    B, T, _ = x.shape
    x = x + 0.5 * swiglu_ffn(x, g_ff1, w_ff1_in, w_ff1_out)
    z = rms_norm(x, g_mix) @ w_in
    cv, cg, q, k, v = jnp.split(z, SPLITS, axis=-1)
    u = cv * jax.nn.sigmoid(cg)
    if conv_prev is None:
        conv_prev = jnp.zeros((B, CONV_WIDTH - 1, CONV_CH), u.dtype)
    u_hist = jnp.concatenate([conv_prev, u], axis=1)
    c_out = conv_tail(u_hist, w_dw, b_dw, g_cn, b_cn)
    new_conv = u_hist[:, -(CONV_WIDTH - 1):]
    q = partial_rope(rms_norm(q.reshape(B, T, N_HEADS, HEAD_DIM), g_q), pos)
    k = partial_rope(rms_norm(k.reshape(B, T, N_KV_HEADS, HEAD_DIM), g_k), pos)
    v = v.reshape(B, T, N_KV_HEADS, HEAD_DIM)
    if k_prev is None:
        a_out = banded_window_attention(q, k, v, sinks)
        k_all, v_all = k, v
    else:
        k_all = jnp.concatenate([k_prev, k], axis=1)
        v_all = jnp.concatenate([v_prev, v], axis=1)
        qs = q.reshape(B, 1, T, N_KV_HEADS, Q_PER_KV, HEAD_DIM)
        a_out = sink_attend(qs, k_all[:, None], v_all[:, None], None, sinks).reshape(B, T, ATTN_WIDTH)
    x = x + jnp.concatenate([c_out, a_out], axis=-1) @ w_out
    x = x + 0.5 * swiglu_ffn(x, g_ff2, w_ff2_in, w_ff2_out)
    return x, new_conv, k_all[:, -WINDOW:], v_all[:, -WINDOW:]


def setup_inputs(seed: int = 0) -> dict:
    key = jax.random.key(seed)
    ks = jax.random.split(key, 24)
    f32 = jnp.float32
    nrm = lambda k, shape, s: jax.random.normal(k, shape, f32) * s
    L = DEPTH
    return {
        "x_prompt": nrm(ks[0], (BATCH, SEQ, D_MODEL), 1.0),
        "x_sample": nrm(ks[1], (DEC_BATCH, DEC_SEQ, D_MODEL), 1.0),
        "state_conv": nrm(ks[2], (L, DEC_BATCH, CONV_WIDTH - 1, CONV_CH), 0.5),
        "cache_k_win": nrm(ks[3], (L, DEC_BATCH, WINDOW, N_KV_HEADS, HEAD_DIM), 1.0),
        "cache_v_win": nrm(ks[4], (L, DEC_BATCH, WINDOW, N_KV_HEADS, HEAD_DIM), 1.0),
        "g_ff1": 1.0 + nrm(ks[5], (L, D_MODEL), 0.02),
        "w_ff1_in": nrm(ks[6], (L, D_MODEL, 2 * D_FF), D_MODEL ** -0.5),
        "w_ff1_out": nrm(ks[7], (L, D_FF, D_MODEL), D_FF ** -0.5),
        "g_mix": 1.0 + nrm(ks[8], (L, D_MODEL), 0.02),
        "w_in": nrm(ks[9], (L, D_MODEL, IN_COLS), D_MODEL ** -0.5),
        "g_q": 1.0 + nrm(ks[10], (L, HEAD_DIM), 0.02),
        "g_k": 1.0 + nrm(ks[11], (L, HEAD_DIM), 0.02),
        "sinks": nrm(ks[12], (L, N_HEADS), 0.5),
        "w_dw": nrm(ks[13], (L, CONV_WIDTH, CONV_CH), CONV_WIDTH ** -0.5),
        "b_dw": nrm(ks[14], (L, CONV_CH), 0.02),
        "g_cn": 1.0 + nrm(ks[15], (L, CONV_CH), 0.02),
        "b_cn": nrm(ks[16], (L, CONV_CH), 0.02),
        "w_out": nrm(ks[17], (L, MIX_WIDTH, D_MODEL), MIX_WIDTH ** -0.5),
        "g_ff2": 1.0 + nrm(ks[18], (L, D_MODEL), 0.02),
        "w_ff2_in": nrm(ks[19], (L, D_MODEL, 2 * D_FF), D_MODEL ** -0.5),
        "w_ff2_out": nrm(ks[20], (L, D_FF, D_MODEL), D_FF ** -0.5),
    }


def reference(x_prompt, x_sample, state_conv, cache_k_win, cache_v_win, g_ff1, w_ff1_in, w_ff1_out,
              g_mix, w_in, g_q, g_k, sinks, w_dw, b_dw, g_cn, b_cn, w_out, g_ff2, w_ff2_in, w_ff2_out):
    pos_p = jnp.arange(x_prompt.shape[1], dtype=jnp.int32)
    pos_s = PAST_LEN + jnp.arange(x_sample.shape[1], dtype=jnp.int32)
    hp, hs = x_prompt, x_sample
    cp_l, kp_l, vp_l, cs_l, kss_l, vs_l = [], [], [], [], [], []
    for l in range(DEPTH):
        w = (g_ff1[l], w_ff1_in[l], w_ff1_out[l], g_mix[l], w_in[l], g_q[l], g_k[l], sinks[l], w_dw[l],
             b_dw[l], g_cn[l], b_cn[l], w_out[l], g_ff2[l], w_ff2_in[l], w_ff2_out[l])
        hp, cp, kp, vp = encoder_layer(hp, pos_p, None, None, None, *w)
        hs, cs, kss, vs = encoder_layer(hs, pos_s, state_conv[l], cache_k_win[l], cache_v_win[l], *w)
        cp_l.append(cp); kp_l.append(kp); vp_l.append(vp)
        cs_l.append(cs); kss_l.append(kss); vs_l.append(vs)
    conv_state_prompt = jnp.stack(cp_l)
    k_win_prompt = jnp.stack(kp_l)
    v_win_prompt = jnp.stack(vp_l)
    conv_state_sample = jnp.stack(cs_l)
    k_win_sample = jnp.stack(kss_l)
    v_win_sample = jnp.stack(vs_l)
    return (hp, hs, conv_state_prompt, k_win_prompt, v_win_prompt, conv_state_sample, k_win_sample, v_win_sample)
```

```cpp
#include <hip/hip_runtime.h>
#include <cstdio>
#include <cstdint>
#include <cmath>

#define LAS __attribute__((address_space(3)))
typedef unsigned short bf16_t;
typedef short bf16x8 __attribute__((ext_vector_type(8)));
typedef float f32x4 __attribute__((ext_vector_type(4)));
typedef float f32x2 __attribute__((ext_vector_type(2)));
typedef unsigned u32x4 __attribute__((ext_vector_type(4)));
typedef unsigned u32x2 __attribute__((ext_vector_type(2)));

constexpr int D = 1024, TP = 8192, NBP = 4, NBS = 32, TS = 16, MP = NBP * TP, MS = NBS * TS, M = MP + MS;
constexpr int FF = 2816, NUP = 2 * FF, NIN = 1792, CC = 512, HD = 64, PAST = 4096;
constexpr int CW = 31, HIST = CW - 1, WIN = 128;
constexpr int KSROWS = 160;
constexpr int USROWS = HIST + TS;
constexpr float EPS = 1e-6f;
constexpr float LOG2E = 1.4426950408889634f;
constexpr float QSCALE = 0.125f * LOG2E;

constexpr size_t O_YP = 0, O_YS = (size_t)MP * D, O_CSP = O_YS + (size_t)MS * D, O_KWP = O_CSP + (size_t)NBP * HIST * CC,
                 O_VWP = O_KWP + (size_t)NBP * WIN * 128, O_CSS = O_VWP + (size_t)NBP * WIN * 128, O_KWS = O_CSS + (size_t)NBS * HIST * CC,
                 O_VWS = O_KWS + (size_t)NBS * WIN * 128, O_END = O_VWS + (size_t)NBS * WIN * 128;

constexpr size_t al(size_t x) { return (x + 4095) & ~(size_t)4095; }
constexpr size_t WS_CTL = 0;
constexpr size_t WS_W1T = 1u << 20;
constexpr size_t WS_W2T = WS_W1T + al((size_t)NUP * D * 2);
constexpr size_t WS_WINT = WS_W2T + al((size_t)D * FF * 2);
constexpr size_t WS_WOT = WS_WINT + al((size_t)NIN * D * 2);
constexpr size_t WS_W3T = WS_WOT + al((size_t)D * D * 2);
constexpr size_t WS_W4T = WS_W3T + al((size_t)NUP * D * 2);
constexpr size_t WS_ROPE = WS_W4T + al((size_t)D * FF * 2);
constexpr size_t WS_SSQ0 = WS_ROPE + al((size_t)TP * 8 * 8);
constexpr size_t WS_SSQ1 = WS_SSQ0 + al((size_t)M * 16 * 4);
constexpr size_t WS_SSQ2 = WS_SSQ1 + al((size_t)M * 16 * 4);
constexpr size_t WS_KS = WS_SSQ2 + al((size_t)M * 16 * 4);
constexpr size_t WS_VTS = WS_KS + al((size_t)NBS * KSROWS * 128 * 2);
constexpr size_t WS_US = WS_VTS + al((size_t)NBS * 128 * KSROWS * 2);
constexpr size_t WS_AB = WS_US + al((size_t)NBS * USROWS * CC * 2);
constexpr size_t WS_X1 = WS_AB + al((size_t)M * D * 2);
constexpr size_t WS_ACT = WS_X1 + al((size_t)M * D * 4);
constexpr size_t WS_END = WS_ACT + al((size_t)M * FF * 2);
constexpr size_t WS_UP = WS_ACT;
constexpr size_t WS_Q = WS_UP + al((size_t)MP * CC * 2);
constexpr size_t WS_KP = WS_Q + al((size_t)M * 512 * 2);
constexpr size_t WS_VTP = WS_KP + al((size_t)MP * 128 * 2);
constexpr size_t WS_MIX = WS_VTP + al((size_t)MP * 128 * 2);
static_assert(WS_MIX + (size_t)M * D * 2 <= WS_END, "overlay fits");

constexpr int LDS_BYTES = 147456;

__device__ __forceinline__ unsigned cvt_pk_bf16(float lo, float hi) { unsigned r; asm volatile("v_cvt_pk_bf16_f32 %0, %1, %2" : "=v"(r) : "v"(lo), "v"(hi)); return r; }
__device__ __forceinline__ float bf2f(bf16_t h) { return __uint_as_float((unsigned)h << 16); }
__device__ __forceinline__ bf16_t f2bf(float f) { return (bf16_t)(cvt_pk_bf16(f, 0.f) & 0xffffu); }
__device__ __forceinline__ float silu_f(float a) { return a * __builtin_amdgcn_rcpf(1.0f + __builtin_amdgcn_exp2f(-a * LOG2E)); }
__device__ __forceinline__ float sigmoid_f(float a) { return __builtin_amdgcn_rcpf(1.0f + __builtin_amdgcn_exp2f(-a * LOG2E)); }
__device__ __forceinline__ float sum_rows4(float x) {
    float a = x, b = x;
    asm volatile("s_nop 1\n\tv_permlane16_swap_b32 %0, %1" : "+v"(a), "+v"(b));
    float t = a + b; a = t; b = t;
    asm volatile("s_nop 1\n\tv_permlane32_swap_b32 %0, %1" : "+v"(a), "+v"(b));
    return a + b;
}
__device__ __forceinline__ float max_rows4(float x) {
    float a = x, b = x;
    asm volatile("s_nop 1\n\tv_permlane16_swap_b32 %0, %1" : "+v"(a), "+v"(b));
    float t = fmaxf(a, b); a = t; b = t;
    asm volatile("s_nop 1\n\tv_permlane32_swap_b32 %0, %1" : "+v"(a), "+v"(b));
    return fmaxf(a, b);
}
__device__ __forceinline__ float wave_sum(float v) {
#pragma unroll
    for (int o = 1; o < 64; o <<= 1) v += __shfl_xor(v, o);
    return v;
}
__device__ __forceinline__ float dpp_row_sum(float v) {
    v += __builtin_bit_cast(float, __builtin_amdgcn_update_dpp(0, __builtin_bit_cast(int, v), 0xB1, 0xF, 0xF, true));
    v += __builtin_bit_cast(float, __builtin_amdgcn_update_dpp(0, __builtin_bit_cast(int, v), 0x4E, 0xF, 0xF, true));
    v += __builtin_bit_cast(float, __builtin_amdgcn_update_dpp(0, __builtin_bit_cast(int, v), 0x124, 0xF, 0xF, true));
    v += __builtin_bit_cast(float, __builtin_amdgcn_update_dpp(0, __builtin_bit_cast(int, v), 0x128, 0xF, 0xF, true));
    return v;
}
__device__ __forceinline__ void wave_sum2(float& a, float& b) {
    a = dpp_row_sum(a); b = dpp_row_sum(b);
    a = sum_rows4(a); b = sum_rows4(b);
}
__device__ __forceinline__ float row_rstd(const float* ssq, int r) {
    const f32x4* p = (const f32x4*)(ssq + (size_t)r * 16);
    const f32x4 a = p[0], b = p[1], c = p[2], d = p[3];
    const f32x4 s = (a + b) + (c + d);
    return rsqrtf(((s.x + s.y) + (s.z + s.w)) * (1.0f / D) + EPS);
}

namespace pg8 {
constexpr int BM = 256, BK = 64, HALF = 128, HTB = HALF * BK * 2, STAGE_BYTES = 8 * HTB, NXCD = 8, WGM = 8;
__host__ __device__ __forceinline__ int lds_byte(int r, int c) { const int st = (r >> 4) * 2 + (c >> 5), rr = r & 15, cc = c & 31, ob = rr * 64 + cc * 2; return st * 1024 + (ob ^ (((ob >> 9) & 1) << 5)); }
__host__ __device__ __forceinline__ void stage_rc(int b, int& R, int& C) { const int st = b / 1024, sb = b % 1024, swz = sb ^ (((sb >> 9) & 1) << 5); R = (st >> 1) * 16 + swz / 64; C = (st & 1) * 32 + (swz % 64) / 2; }
__host__ __device__ __forceinline__ int perm32(int rho) { const int n = rho >> 4, i = rho & 15; return 8 * (i >> 2) + 4 * n + (i & 3); }

struct Unit { int pm, pn; };
struct Gemm { const bf16_t* A; const bf16_t* Bt; int M, N, K; };

struct StaticOrder {
    int nM, nN, nwg, G, c;
    __host__ __device__ void init(int M_, int N_, int G_, int c_) { nM = M_ / BM; nN = N_ / BM; nwg = nM * nN; G = G_; c = c_; }
    __host__ __device__ bool next(int i, Unit& u) const {
        const long L = (long)i * G + c; if (L >= nwg) return false;
        int wgid = (int)L; { const int q = nwg / NXCD, r = nwg % NXCD, xcd = wgid % NXCD, off = wgid / NXCD; wgid = (xcd < r ? xcd * (q + 1) : r * (q + 1) + (xcd - r) * q) + off; }
        const int nig = WGM * nN, gid = wgid / nig, fm = gid * WGM, gsz = (nM - fm) < WGM ? (nM - fm) : WGM;
        u.pm = fm + ((wgid % nig) % gsz); u.pn = (wgid % nig) / gsz; return true;
    }
    __device__ __forceinline__ void a_ready(const Unit&) const {}
    __device__ __forceinline__ void done(const Unit&) const {}
};

template <class Epi, class Sched, bool ALIGN_EPI, bool SP2>
__device__ __forceinline__ void gemm_phase(LAS unsigned char* lds, const Gemm g, const Sched& S, const Epi& E) {
    int tid = threadIdx.x; asm volatile("" : "+v"(tid));
    const int wid = __builtin_amdgcn_readfirstlane(tid >> 6), lane = tid & 63, wr = wid >> 2, wc = wid & 3, fr = lane & 15, fq = lane >> 4;
    const int K = g.K, nt = K / BK;
    unsigned voffA[2], voffB[2];
#pragma unroll
    for (int i = 0; i < 2; ++i) { int R, C; stage_rc(tid * 16 + i * 8192, R, C); const int Rb = Epi::PERM ? ((R & ~31) + perm32(R & 31)) : R;
        voffA[i] = (unsigned)(R * K + C) * 2u; voffB[i] = (unsigned)(Rb * K + C) * 2u; }
    const size_t kstep = (size_t)(BK * 2);
    const size_t hstep = (size_t)HALF * K * 2;
    const size_t tstep = 2 * hstep;
    const unsigned ldsw = (unsigned)wid * 1024u;
    const int aoff = lds_byte(wr * 64 + fr, fq * 8), boff = lds_byte(wc * 32 + fr, fq * 8);
#define PG8_SA(b, h) (((b) * 2 + (h)) * HTB)
#define PG8_SB(b, h) ((4 + (b) * 2 + (h)) * HTB)
#define PG8_STAGE(bufoff, gbase, voff) do { _Pragma("unroll") for (int _i = 0; _i < 2; ++_i) \
        __builtin_amdgcn_global_load_lds((const unsigned*)((const char*)(gbase) + (voff)[_i]), (LAS unsigned*)(lds + (bufoff) + ldsw + _i * 8192), 16, 0, 0); } while (0)
#define PG8_LDA(dst, b, h) do { _Pragma("unroll") for (int m = 0; m < 4; ++m) _Pragma("unroll") for (int k = 0; k < 2; ++k) dst[m][k] = *(const LAS bf16x8*)(lds + PG8_SA(b, h) + aoff + m * 2048 + k * 1024); } while (0)
#define PG8_LDB(dst, b, h) do { _Pragma("unroll") for (int n = 0; n < 2; ++n) _Pragma("unroll") for (int k = 0; k < 2; ++k) dst[n][k] = *(const LAS bf16x8*)(lds + PG8_SB(b, h) + boff + n * 2048 + k * 1024); } while (0)
#define PG8_MMA(ai, bj, At, Bt) do { __builtin_amdgcn_s_setprio(1); _Pragma("unroll") for (int m = 0; m < 4; ++m) _Pragma("unroll") for (int n = 0; n < 2; ++n) _Pragma("unroll") for (int k = 0; k < 2; ++k) \
        acc[ai][bj][m][n] = __builtin_amdgcn_mfma_f32_16x16x32_bf16(Bt[n][k], At[m][k], acc[ai][bj][m][n], 0, 0, 0); __builtin_amdgcn_s_setprio(0); } while (0)
#define PG8_WAIT_V(n) asm volatile("s_waitcnt vmcnt(" #n ")" ::: "memory")
#define PG8_WAIT_L(n) asm volatile("s_waitcnt lgkmcnt(" #n ")" ::: "memory")
#define PG8_BAR __builtin_amdgcn_s_barrier()
#define PG8_SCHED __builtin_amdgcn_sched_barrier(0)
    Unit cur, nxt; int ui = 0;
    if (!S.next(0, cur)) return;
    f32x4 acc[2][2][4][2];
#pragma unroll
    for (int a = 0; a < 2; ++a)
#pragma unroll
        for (int b = 0; b < 2; ++b)
#pragma unroll
            for (int m = 0; m < 4; ++m)
#pragma unroll
                for (int n = 0; n < 2; ++n) acc[a][b][m][n] = (f32x4){0.f, 0.f, 0.f, 0.f};
    bf16x8 At[4][2], B0[2][2], B1[2][2];
    const char* cA = (const char*)g.A + (size_t)cur.pm * tstep; const char* cB = (const char*)g.Bt + (size_t)cur.pn * tstep;
    S.a_ready(cur);
    if constexpr (SP2) {
        PG8_STAGE(PG8_SB(0, 0), cB, voffB); PG8_STAGE(PG8_SB(0, 1), cB + hstep, voffB); PG8_STAGE(PG8_SA(0, 0), cA, voffA); PG8_STAGE(PG8_SA(0, 1), cA + hstep, voffA);
        if (wr == 1) PG8_BAR;
        PG8_WAIT_V(2); PG8_BAR;
        PG8_STAGE(PG8_SB(1, 0), cB + kstep, voffB); PG8_STAGE(PG8_SA(1, 0), cA + kstep, voffA); PG8_STAGE(PG8_SB(1, 1), cB + hstep + kstep, voffB);
        PG8_WAIT_V(6); PG8_BAR;
    } else {
        PG8_STAGE(PG8_SB(0, 0), cB, voffB); PG8_STAGE(PG8_SA(0, 0), cA, voffA); PG8_STAGE(PG8_SB(0, 1), cB + hstep, voffB); PG8_STAGE(PG8_SA(0, 1), cA + hstep, voffA);
        if (wr == 1) PG8_BAR;
        PG8_WAIT_V(4); PG8_BAR;
        PG8_STAGE(PG8_SB(1, 0), cB + kstep, voffB); PG8_STAGE(PG8_SA(1, 0), cA + kstep, voffA); PG8_STAGE(PG8_SB(1, 1), cB + hstep + kstep, voffB);
        PG8_WAIT_V(6); PG8_BAR;
    }
    for (;;) {
        const bool has_next = S.next(ui + 1, nxt);
        const char* nA = has_next ? (const char*)g.A + (size_t)nxt.pm * tstep : cA; const char* nB = has_next ? (const char*)g.Bt + (size_t)nxt.pn * tstep : cB;
        for (int t = 0; t < nt; t += 2) {
            const bool last = (t == nt - 2);
            const char* a1 = cA + (size_t)(t + 1) * kstep;
            const char* a2 = last ? nA : cA + (size_t)(t + 2) * kstep; const char* b2 = last ? nB : cB + (size_t)(t + 2) * kstep;
            const char* a3 = a2 + kstep; const char* b3 = b2 + kstep;
            if (last && has_next) S.a_ready(nxt);
            if constexpr (SP2) {
            PG8_LDB(B0, 0, 0); PG8_LDB(B1, 0, 1); PG8_SCHED; PG8_LDA(At, 0, 0); PG8_STAGE(PG8_SA(1, 1), a1 + hstep, voffA);
            PG8_WAIT_V(8); PG8_WAIT_L(0); PG8_BAR; PG8_MMA(0, 0, At, B0); PG8_MMA(0, 1, At, B1); PG8_BAR; PG8_SCHED;
            PG8_LDA(At, 0, 1); PG8_STAGE(PG8_SB(0, 0), b2, voffB); PG8_STAGE(PG8_SB(0, 1), b2 + hstep, voffB); PG8_STAGE(PG8_SA(0, 0), a2, voffA);
            PG8_WAIT_V(8); PG8_WAIT_L(0); PG8_BAR; PG8_MMA(1, 0, At, B0); PG8_MMA(1, 1, At, B1); PG8_BAR; PG8_SCHED;
            PG8_LDB(B0, 1, 0); PG8_LDB(B1, 1, 1); PG8_SCHED; PG8_LDA(At, 1, 0); PG8_STAGE(PG8_SA(0, 1), a2 + hstep, voffA);
            PG8_WAIT_V(8); PG8_WAIT_L(0); PG8_BAR; PG8_MMA(0, 0, At, B0); PG8_MMA(0, 1, At, B1); PG8_BAR; PG8_SCHED;
            PG8_LDA(At, 1, 1); PG8_STAGE(PG8_SB(1, 0), b3, voffB); PG8_STAGE(PG8_SB(1, 1), b3 + hstep, voffB); PG8_STAGE(PG8_SA(1, 0), a3, voffA);
            PG8_WAIT_V(8); PG8_WAIT_L(0); PG8_BAR; PG8_MMA(1, 0, At, B0); PG8_MMA(1, 1, At, B1); PG8_BAR; PG8_SCHED;
            } else {
            PG8_LDB(B0, 0, 0); PG8_SCHED; PG8_LDA(At, 0, 0); PG8_STAGE(PG8_SA(1, 1), a1 + hstep, voffA);
            PG8_WAIT_L(8); PG8_BAR; PG8_WAIT_L(0); PG8_MMA(0, 0, At, B0); PG8_BAR; PG8_SCHED;
            PG8_LDB(B1, 0, 1); PG8_STAGE(PG8_SB(0, 0), b2, voffB);
            PG8_BAR; PG8_WAIT_L(0); PG8_MMA(0, 1, At, B1); PG8_BAR;
            PG8_LDA(At, 0, 1); PG8_STAGE(PG8_SA(0, 0), a2, voffA);
            PG8_BAR; PG8_WAIT_L(0); PG8_MMA(1, 0, At, B0); PG8_BAR; PG8_SCHED;
            PG8_STAGE(PG8_SB(0, 1), b2 + hstep, voffB);
            PG8_WAIT_V(6); PG8_BAR; PG8_MMA(1, 1, At, B1); PG8_BAR;
            PG8_LDB(B0, 1, 0); PG8_SCHED; PG8_LDA(At, 1, 0); PG8_STAGE(PG8_SA(0, 1), a2 + hstep, voffA);
            PG8_WAIT_L(8); PG8_BAR; PG8_WAIT_L(0); PG8_MMA(0, 0, At, B0); PG8_BAR; PG8_SCHED;
            PG8_LDB(B1, 1, 1); PG8_STAGE(PG8_SB(1, 0), b3, voffB);
            PG8_BAR; PG8_WAIT_L(0); PG8_MMA(0, 1, At, B1); PG8_BAR;
            PG8_LDA(At, 1, 1); PG8_STAGE(PG8_SA(1, 0), a3, voffA);
            PG8_BAR; PG8_WAIT_L(0); PG8_MMA(1, 0, At, B0); PG8_BAR; PG8_SCHED;
            PG8_STAGE(PG8_SB(1, 1), b3 + hstep, voffB);
            PG8_WAIT_V(6); PG8_BAR; PG8_MMA(1, 1, At, B1); PG8_BAR;
            }
        }
        if constexpr (ALIGN_EPI) { if (wr == 0) PG8_BAR; }
        E(acc, cur, wr, wc, fr, fq); S.done(cur);
        if (!has_next) break;
#pragma unroll
        for (int a = 0; a < 2; ++a)
#pragma unroll
            for (int b = 0; b < 2; ++b)
#pragma unroll
                for (int m = 0; m < 4; ++m)
#pragma unroll
                    for (int n = 0; n < 2; ++n) acc[a][b][m][n] = (f32x4){0.f, 0.f, 0.f, 0.f};
        cur = nxt; cA = nA; cB = nB; ++ui;
        if constexpr (ALIGN_EPI) { if (wr == 1) PG8_BAR; }
    }
    PG8_WAIT_V(0);
    if constexpr (!ALIGN_EPI) { if (wr == 0) PG8_BAR; }
    PG8_BAR;
#undef PG8_SA
#undef PG8_SB
#undef PG8_STAGE
#undef PG8_LDA
#undef PG8_LDB
#undef PG8_MMA
#undef PG8_WAIT_V
#undef PG8_WAIT_L
#undef PG8_BAR
#undef PG8_SCHED
}
}

typedef const f32x4 (&AccRef)[2][2][4][2];
#define EPI_BIG_CALL() \
    __device__ __forceinline__ void operator()(AccRef acc, const pg8::Unit& u, int wr, int wc, int fr, int fq) const { \
        asm volatile("" : "+v"(fr), "+v"(fq));     \
        const int row0 = u.pm * 256 + wr * 64 + fr; \
        _Pragma("unroll") for (int gq = 0; gq < 8 / PF; ++gq) { \
            Pre p[PF]; \
            asm volatile("" ::: "memory"); \
            _Pragma("unroll") for (int i = 0; i < PF; ++i) { const int rg = gq * PF + i; p[i] = pre(row0 + (rg >> 2) * 128 + (rg & 3) * 16, u.pn, wc, fq); }     \
            asm volatile("" ::: "memory"); \
            _Pragma("unroll") for (int i = 0; i < PF; ++i) { const int rg = gq * PF + i; \
                rows(acc[rg >> 2][0][rg & 3][0], acc[rg >> 2][0][rg & 3][1], acc[rg >> 2][1][rg & 3][0], acc[rg >> 2][1][rg & 3][1], row0 + (rg >> 2) * 128 + (rg & 3) * 16, u.pn, wc, fq, p[i]); } } \
    }
__device__ __forceinline__ f32x4 ssq_quarter(const float* ssq, int r, int fq) { return *(const f32x4*)(ssq + (size_t)r * 16 + 4 * fq); }
__device__ __forceinline__ float rstd_from(const f32x4& q) {
    float s = (q.x + q.y) + (q.z + q.w);
    s = sum_rows4(s);
    return rsqrtf(s * (1.0f / D) + EPS);
}

struct EpiSwiglu {
    static constexpr bool PERM = true; static constexpr int PF = 8;
    bf16_t* O; const float* ssq;
    struct Pre { f32x4 q; };
    __device__ __forceinline__ Pre pre(int r, int pn, int wc, int fq) const { Pre p; p.q = ssq_quarter(ssq, r, fq); return p; }
    __device__ __forceinline__ void rows(const f32x4& c00, const f32x4& c01, const f32x4& c10, const f32x4& c11, int r, int pn, int wc, int fq, const Pre& p) const {
        const float rs = rstd_from(p.q);
        float o[8];
#pragma unroll
        for (int j = 0; j < 4; ++j) { o[j] = silu_f(c00[j] * rs) * (c10[j] * rs); o[4 + j] = silu_f(c01[j] * rs) * (c11[j] * rs); }
        u32x4 w; w.x = cvt_pk_bf16(o[0], o[1]); w.y = cvt_pk_bf16(o[2], o[3]); w.z = cvt_pk_bf16(o[4], o[5]); w.w = cvt_pk_bf16(o[6], o[7]);
        { bf16_t* dst_ = O + (size_t)r * FF + pn * 128 + wc * 32 + 8 * fq;
          asm volatile("global_store_dwordx4 %0, %1, off sc1\n\ts_nop 1" :: "v"(dst_), "v"(w) : "memory"); }
    }
    EPI_BIG_CALL()
};

template <int MODE> struct EpiResid {
    static constexpr bool PERM = true; static constexpr int PF = (MODE == 0) ? 2 : 4;
    const float* resP; const float* resS;
    float* out; bf16_t* xb; float* ssq; float scale;
    struct Pre { f32x4 r00, r01, r10, r11; u32x4 a, b; };
    __device__ __forceinline__ Pre pre(int r, int pn, int wc, int fq) const {
        Pre p; const size_t off = (size_t)r * D + pn * 256 + wc * 32 + 8 * fq;
        if (MODE == 0) { const float* rbase = (r >= MP) ? resS - (size_t)MP * D : resP;
            p.r00 = *(const f32x4*)(rbase + off); p.r01 = *(const f32x4*)(rbase + off + 4); p.r10 = *(const f32x4*)(rbase + off + 128); p.r11 = *(const f32x4*)(rbase + off + 132); }
        else { p.a = *(const u32x4*)(xb + off); p.b = *(const u32x4*)(xb + off + 128); }
        return p;
    }
    __device__ __forceinline__ void rows(const f32x4& c00, const f32x4& c01, const f32x4& c10, const f32x4& c11, int r, int pn, int wc, int fq, const Pre& p) const {
        const size_t off = (size_t)r * D + pn * 256 + wc * 32 + 8 * fq;
        f32x4 r00, r01, r10, r11;
        if (MODE == 0) { r00 = p.r00; r01 = p.r01; r10 = p.r10; r11 = p.r11; }
        else {
            const u32x4 a = p.a, b = p.b;
            r00 = (f32x4){__uint_as_float(a.x << 16), __uint_as_float(a.x & 0xffff0000u), __uint_as_float(a.y << 16), __uint_as_float(a.y & 0xffff0000u)};
            r01 = (f32x4){__uint_as_float(a.z << 16), __uint_as_float(a.z & 0xffff0000u), __uint_as_float(a.w << 16), __uint_as_float(a.w & 0xffff0000u)};
            r10 = (f32x4){__uint_as_float(b.x << 16), __uint_as_float(b.x & 0xffff0000u), __uint_as_float(b.y << 16), __uint_as_float(b.y & 0xffff0000u)};
            r11 = (f32x4){__uint_as_float(b.z << 16), __uint_as_float(b.z & 0xffff0000u), __uint_as_float(b.w << 16), __uint_as_float(b.w & 0xffff0000u)};
        }
        const f32x4 y00 = r00 + c00 * scale, y01 = r01 + c01 * scale, y10 = r10 + c10 * scale, y11 = r11 + c11 * scale;
        if (MODE == 2) {
            __builtin_nontemporal_store(y00, (f32x4*)(out + off)); __builtin_nontemporal_store(y01, (f32x4*)(out + off + 4)); __builtin_nontemporal_store(y10, (f32x4*)(out + off + 128)); __builtin_nontemporal_store(y11, (f32x4*)(out + off + 132));
        } else {
            u32x4 w0, w1;
            w0.x = cvt_pk_bf16(y00[0], y00[1]); w0.y = cvt_pk_bf16(y00[2], y00[3]); w0.z = cvt_pk_bf16(y01[0], y01[1]); w0.w = cvt_pk_bf16(y01[2], y01[3]);
            w1.x = cvt_pk_bf16(y10[0], y10[1]); w1.y = cvt_pk_bf16(y10[2], y10[3]); w1.z = cvt_pk_bf16(y11[0], y11[1]); w1.w = cvt_pk_bf16(y11[2], y11[3]);
            *(u32x4*)(xb + off) = w0; *(u32x4*)(xb + off + 128) = w1;
            float ss = (y00[0] * y00[0] + y00[1] * y00[1]) + (y00[2] * y00[2] + y00[3] * y00[3]) + (y01[0] * y01[0] + y01[1] * y01[1]) + (y01[2] * y01[2] + y01[3] * y01[3])
                     + (y10[0] * y10[0] + y10[1] * y10[1]) + (y10[2] * y10[2] + y10[3] * y10[3]) + (y11[0] * y11[0] + y11[1] * y11[1]) + (y11[2] * y11[2] + y11[3] * y11[3]);
            ss = sum_rows4(ss);
            if (fq == 0) ssq[(size_t)r * 16 + pn * 4 + wc] = ss;
        }
    }
    EPI_BIG_CALL()
};

struct EpiInProj {
    static constexpr bool PERM = true; static constexpr int PF = 1;
    unsigned char* ws; const float* gq; const float* gk; float* out;
    struct Pre { f32x4 q; };
    __device__ __forceinline__ Pre pre(int r, int pn, int wc, int fq) const { Pre p; p.q = ssq_quarter((const float*)(ws + WS_SSQ1), r, fq); return p; }
    __device__ __forceinline__ void rows(const f32x4& c00, const f32x4& c01, const f32x4& c10, const f32x4& c11, int r, int pn, int wc, int fq, const Pre& p) const {
        const bool sample = r >= MP;
        int b, t, pos;
        if (sample) { const int rr = r - MP; b = rr >> 4; t = rr & 15; pos = PAST + t; } else { b = r >> 13; t = r & (TP - 1); pos = t; }
        const float rs = rstd_from(p.q);
        if (pn < 4) {
            const int ch0 = pn * 128 + wc * 32 + 8 * fq;
            float o[8];
#pragma unroll
            for (int j = 0; j < 4; ++j) { o[j] = (c00[j] * rs) * sigmoid_f(c10[j] * rs); o[4 + j] = (c01[j] * rs) * sigmoid_f(c11[j] * rs); }
            u32x4 w; w.x = cvt_pk_bf16(o[0], o[1]); w.y = cvt_pk_bf16(o[2], o[3]); w.z = cvt_pk_bf16(o[4], o[5]); w.w = cvt_pk_bf16(o[6], o[7]);
            bf16_t* ud = sample ? (bf16_t*)(ws + WS_US) + ((size_t)(b * USROWS + HIST + t)) * CC + ch0 : (bf16_t*)(ws + WS_UP) + (size_t)r * CC + ch0;
            *(u32x4*)ud = w;
            float* dst = nullptr;
            if (sample) dst = out + O_CSS + ((size_t)(b * HIST + (HIST - TS) + t)) * CC + ch0;
            else if (t >= TP - HIST) dst = out + O_CSP + ((size_t)(b * HIST + (t - (TP - HIST)))) * CC + ch0;
            if (dst) { *(f32x4*)dst = (f32x4){o[0], o[1], o[2], o[3]}; *(f32x4*)(dst + 4) = (f32x4){o[4], o[5], o[6], o[7]}; }
        } else if (pn < 6 || wc < 2) {
            const bool isq = pn < 6;
            const int h = isq ? (pn - 4) * 4 + wc : wc;
            const float* gg = isq ? gq : gk;
            const f32x4 g00 = *(const f32x4*)(gg + 8 * fq), g01 = *(const f32x4*)(gg + 8 * fq + 4), g10 = *(const f32x4*)(gg + 32 + 8 * fq), g11 = *(const f32x4*)(gg + 32 + 8 * fq + 4);
            const float osc = isq ? QSCALE : 1.0f;
            f32x4 v00 = c00 * rs, v01 = c01 * rs, v10 = c10 * rs, v11 = c11 * rs;
            float ss = (v00[0] * v00[0] + v00[1] * v00[1]) + (v00[2] * v00[2] + v00[3] * v00[3]) + (v01[0] * v01[0] + v01[1] * v01[1]) + (v01[2] * v01[2] + v01[3] * v01[3])
                     + (v10[0] * v10[0] + v10[1] * v10[1]) + (v10[2] * v10[2] + v10[3] * v10[3]) + (v11[0] * v11[0] + v11[1] * v11[1]) + (v11[2] * v11[2] + v11[3] * v11[3]);
            ss = sum_rows4(ss);
            const float hn = rsqrtf(ss * (1.0f / HD) + EPS);
            v00 = v00 * hn * g00; v01 = v01 * hn * g01; v10 = v10 * hn * g10; v11 = v11 * hn * g11;
            f32x4 p0, p1;
#pragma unroll
            for (int j = 0; j < 4; ++j) { p0[j] = __shfl_xor(v00[j], 16); p1[j] = __shfl_xor(v01[j], 16); }
            if (fq < 2) {
                const f32x2* rp = (const f32x2*)(ws + WS_ROPE) + (size_t)pos * 8;
                const float sg = (fq == 0) ? -1.0f : 1.0f;
#pragma unroll
                for (int j = 0; j < 4; ++j) {
                    const f32x2 cs0 = rp[j], cs1 = rp[4 + j];
                    v00[j] = v00[j] * cs0.x + sg * p0[j] * cs0.y;
                    v01[j] = v01[j] * cs1.x + sg * p1[j] * cs1.y;
                }
            }
            u32x4 w0, w1;
            w0.x = cvt_pk_bf16(v00[0] * osc, v00[1] * osc); w0.y = cvt_pk_bf16(v00[2] * osc, v00[3] * osc); w0.z = cvt_pk_bf16(v01[0] * osc, v01[1] * osc); w0.w = cvt_pk_bf16(v01[2] * osc, v01[3] * osc);
            w1.x = cvt_pk_bf16(v10[0] * osc, v10[1] * osc); w1.y = cvt_pk_bf16(v10[2] * osc, v10[3] * osc); w1.z = cvt_pk_bf16(v11[0] * osc, v11[1] * osc); w1.w = cvt_pk_bf16(v11[2] * osc, v11[3] * osc);
            if (isq) {
                bf16_t* dst = (bf16_t*)(ws + WS_Q) + (size_t)r * 512 + h * 64 + 8 * fq;
                *(u32x4*)dst = w0; *(u32x4*)(dst + 32) = w1;
            } else {
                bf16_t* dst = sample ? (bf16_t*)(ws + WS_KS) + ((size_t)(b * KSROWS + WIN + t)) * 128 + h * 64 + 8 * fq : (bf16_t*)(ws + WS_KP) + (size_t)r * 128 + h * 64 + 8 * fq;
                *(u32x4*)dst = w0; *(u32x4*)(dst + 32) = w1;
                float* od = nullptr;
                if (sample) od = out + O_KWS + ((size_t)((b * WIN + (WIN - TS) + t) * 2 + h)) * 64 + 8 * fq;
                else if (t >= TP - WIN) od = out + O_KWP + ((size_t)((b * WIN + (t - (TP - WIN))) * 2 + h)) * 64 + 8 * fq;
                if (od) { *(f32x4*)od = v00; *(f32x4*)(od + 4) = v01; *(f32x4*)(od + 32) = v10; *(f32x4*)(od + 36) = v11; }
            }
        } else {
            const int kh = wc - 2;
            const f32x4 v00 = c00 * rs, v01 = c01 * rs, v10 = c10 * rs, v11 = c11 * rs;
            bf16_t* vt; size_t vs;
            if (sample) { vt = (bf16_t*)(ws + WS_VTS) + ((size_t)((b * 2 + kh) * 64)) * KSROWS + WIN + t; vs = KSROWS; }
            else { vt = (bf16_t*)(ws + WS_VTP) + ((size_t)((b * 2 + kh) * (TP / 64) + (t >> 6))) * 4096 + (t & 63); vs = 64; }
#pragma unroll
            for (int j = 0; j < 4; ++j) {
                vt[(size_t)(8 * fq + j) * vs] = f2bf(v00[j]); vt[(size_t)(8 * fq + 4 + j) * vs] = f2bf(v01[j]);
                vt[(size_t)(32 + 8 * fq + j) * vs] = f2bf(v10[j]); vt[(size_t)(32 + 8 * fq + 4 + j) * vs] = f2bf(v11[j]);
            }
            float* od = nullptr;
            if (sample) od = out + O_VWS + ((size_t)((b * WIN + (WIN - TS) + t) * 2 + kh)) * 64 + 8 * fq;
            else if (t >= TP - WIN) od = out + O_VWP + ((size_t)((b * WIN + (t - (TP - WIN))) * 2 + kh)) * 64 + 8 * fq;
            if (od) { *(f32x4*)od = v00; *(f32x4*)(od + 4) = v01; *(f32x4*)(od + 32) = v10; *(f32x4*)(od + 36) = v11; }
        }
    }
    EPI_BIG_CALL()
};

template <int KS, int MT, class Epi>
__device__ __forceinline__ void small_gemm(const bf16_t* A, const bf16_t* Bt, int N, int K, const Epi& E, LAS unsigned char* lds, int bid, int G, int wave, int lane, int wpc_in = 0) {
    constexpr int MTN = MS / (16 * MT);
    const int NT = MTN * (N / 256) * 4, NI = NT * KS, wpc = wpc_in ? wpc_in : (NI + G - 1) / G, nb = K / 64;
    asm volatile("" : "+v"(lane));
    const int fr = lane & 15, g = lane >> 4;
    for (int i0 = 0; i0 < wpc; i0 += 8) {
        const int i = i0 + wave, item = bid * wpc + i;
        const bool active = (i < wpc) && (item < NI);
        const int t = active ? item / KS : 0, ksl = item % KS;
        const int mt = t % MTN, nq = t / MTN, pn = nq >> 2, wc = nq & 3;
        const int r = MP + mt * (16 * MT) + fr;
        f32x4 acc[MT][2][2];
#pragma unroll
        for (int mi = 0; mi < MT; ++mi)
#pragma unroll
            for (int bj = 0; bj < 2; ++bj)
#pragma unroll
                for (int n = 0; n < 2; ++n) acc[mi][bj][n] = (f32x4){0.f, 0.f, 0.f, 0.f};
        if (active) {
            const int b0 = (nb * ksl) / KS, b1 = (nb * (ksl + 1)) / KS;
            const bf16_t* ap = A + (size_t)r * K + g * 8;
            const bf16_t* bp = Bt + (size_t)(pn * 256 + wc * 32 + 8 * (fr >> 2) + (fr & 3)) * K + g * 8;
            bf16x8 afA[2][MT], bfA[2][2][2], afB[2][MT], bfB[2][2][2];
#define SG_LOAD(af, bf, kb) do { const int k0_ = (kb) * 64; _Pragma("unroll") for (int s_ = 0; s_ < 2; ++s_) { \
            _Pragma("unroll") for (int mi = 0; mi < MT; ++mi) af[s_][mi] = *(const bf16x8*)(ap + (size_t)(16 * mi) * K + k0_ + s_ * 32); \
            _Pragma("unroll") for (int bj = 0; bj < 2; ++bj) _Pragma("unroll") for (int n = 0; n < 2; ++n) bf[s_][bj][n] = *(const bf16x8*)(bp + (size_t)(4 * n + 128 * bj) * K + k0_ + s_ * 32); } } while (0)
#define SG_MMA(af, bf) do { _Pragma("unroll") for (int s_ = 0; s_ < 2; ++s_) _Pragma("unroll") for (int bj = 0; bj < 2; ++bj) _Pragma("unroll") for (int n = 0; n < 2; ++n) { \
            _Pragma("unroll") for (int mi = 0; mi < MT; ++mi) acc[mi][bj][n] = __builtin_amdgcn_mfma_f32_16x16x32_bf16(bf[s_][bj][n], af[s_][mi], acc[mi][bj][n], 0, 0, 0); } } while (0)
            SG_LOAD(afA, bfA, b0);
            for (int kb = b0; kb < b1; kb += 2) {
                const int kb1 = (kb + 1 < b1) ? kb + 1 : b1 - 1, kb2 = (kb + 2 < b1) ? kb + 2 : b1 - 1;
                __builtin_amdgcn_sched_barrier(0);
                SG_LOAD(afB, bfB, kb1);
                __builtin_amdgcn_sched_barrier(0);
                SG_MMA(afA, bfA);
                __builtin_amdgcn_sched_barrier(0);
                SG_LOAD(afA, bfA, kb2);
                __builtin_amdgcn_sched_barrier(0);
                if (kb + 1 < b1) SG_MMA(afB, bfB);
            }
#undef SG_LOAD
#undef SG_MMA
        }
        if constexpr (KS > 1) {
            static_assert(KS == 1 || KS == 8, "KS: 1 or 8 (all eight waves of the workgroup on one tile)");
            LAS f32x4* red = (LAS f32x4*)lds;
            if (ksl != 0) {
#pragma unroll
                for (int mi = 0; mi < MT; ++mi)
#pragma unroll
                    for (int bj = 0; bj < 2; ++bj)
#pragma unroll
                        for (int n = 0; n < 2; ++n) red[(ksl - 1) * (MT * 256) + ((mi * 2 + bj) * 2 + n) * 64 + lane] = acc[mi][bj][n];
            }
            __syncthreads();
            if (ksl == 0) {
#pragma unroll
                for (int q = 0; q < KS - 1; ++q)
#pragma unroll
                    for (int mi = 0; mi < MT; ++mi)
#pragma unroll
                        for (int bj = 0; bj < 2; ++bj)
#pragma unroll
                            for (int n = 0; n < 2; ++n) acc[mi][bj][n] += red[q * (MT * 256) + ((mi * 2 + bj) * 2 + n) * 64 + lane];
            }
            __syncthreads();
        }
        if (active && ksl == 0) {
#pragma unroll
            for (int mi = 0; mi < MT; ++mi) { const typename Epi::Pre p = E.pre(r + 16 * mi, pn, wc, g); E.rows(acc[mi][0][0], acc[mi][0][1], acc[mi][1][0], acc[mi][1][1], r + 16 * mi, pn, wc, g, p); }
        }
    }
}

struct TItem { const float* W; const float* g; bf16_t* WT; int Nsrc, srccol0, K, destrow0, k0; };
__device__ __forceinline__ void p0_tload(const TItem& t, float (&v)[32], int lane) {
#pragma unroll
    for (int i = 0; i < 32; ++i) { const int kk = 2 * i + (lane >> 5); v[i] = t.W[(size_t)(t.k0 + kk) * t.Nsrc + t.srccol0 + (lane & 31)]; }
}
__device__ __forceinline__ void p0_tfinish(const TItem& t, const float (&v)[32], LAS float* scr, int lane) {
#pragma unroll
    for (int i = 0; i < 32; ++i) { const int kk = 2 * i + (lane >> 5); scr[kk * 33 + (lane & 31)] = v[i]; }
    asm volatile("s_waitcnt lgkmcnt(0)" ::: "memory");
    const int c = lane & 7;
    f32x4 g0 = (f32x4){1.f, 1.f, 1.f, 1.f}, g1 = g0;
    if (t.g) { g0 = *(const f32x4*)(t.g + t.k0 + 8 * c); g1 = *(const f32x4*)(t.g + t.k0 + 8 * c + 4); }
#pragma unroll
    for (int j = 0; j < 4; ++j) { const int n = (lane >> 3) + 8 * j; const LAS float* sp = scr + (8 * c) * 33 + n;
        u32x4 o; o.x = cvt_pk_bf16(sp[0 * 33] * g0.x, sp[1 * 33] * g0.y); o.y = cvt_pk_bf16(sp[2 * 33] * g0.z, sp[3 * 33] * g0.w); o.z = cvt_pk_bf16(sp[4 * 33] * g1.x, sp[5 * 33] * g1.y); o.w = cvt_pk_bf16(sp[6 * 33] * g1.z, sp[7 * 33] * g1.w);
        *(u32x4*)(t.WT + (size_t)(t.destrow0 + n) * t.K + t.k0 + 8 * c) = o; }
    asm volatile("s_waitcnt lgkmcnt(0)" ::: "memory");
}
__device__ __forceinline__ int src_up(int nb) { const int pn = nb >> 3, p0 = (nb & 7) * 32, bj = p0 >> 7; return bj * FF + pn * 128 + (p0 & 127); }
__device__ __forceinline__ int src_in(int nb) {
    const int pn = nb >> 3, p0 = (nb & 7) * 32, bj = p0 >> 7, wc = (p0 & 127) >> 5;
    if (pn < 4) return bj * CC + pn * 128 + wc * 32;
    if (pn < 6) return 1024 + ((pn - 4) * 4 + wc) * 64 + bj * 32;
    return (wc < 2) ? 1536 + wc * 64 + bj * 32 : 1664 + (wc - 2) * 64 + bj * 32;
}

struct Args { const float* in[21]; float* out; unsigned char* ws; float inv[8]; };

constexpr int I_UP = (D / 64) * (NUP / 32), I_DN = (FF / 64) * (D / 32), I_IN = (D / 64) * (NIN / 32), I_O = (D / 64) * (D / 32);
constexpr int NITEMS = 2 * I_UP + 2 * I_DN + I_IN + I_O;
constexpr int NITEMS_EARLY = I_UP + I_DN + I_IN + I_O;
__device__ __forceinline__ TItem p0_decode(const Args& a, int it) {
    unsigned char* ws = a.ws; int r = it < NITEMS ? it : NITEMS - 1; TItem t;
    if (r < I_UP) { const int nblk = NUP / 32, kb = r / nblk, nb = r % nblk; t = TItem{a.in[6], a.in[5], (bf16_t*)(ws + WS_W1T), NUP, src_up(nb), D, nb * 32, kb * 64}; return t; } r -= I_UP;
    if (r < I_DN) { const int nblk = D / 32, kb = r / nblk, nb = r % nblk; t = TItem{a.in[7], nullptr, (bf16_t*)(ws + WS_W2T), D, nb * 32, FF, nb * 32, kb * 64}; return t; } r -= I_DN;
    if (r < I_IN) { const int nblk = NIN / 32, kb = r / nblk, nb = r % nblk; t = TItem{a.in[9], a.in[8], (bf16_t*)(ws + WS_WINT), NIN, src_in(nb), D, nb * 32, kb * 64}; return t; } r -= I_IN;
    if (r < I_O) { const int nblk = D / 32, kb = r / nblk, nb = r % nblk; t = TItem{a.in[17], nullptr, (bf16_t*)(ws + WS_WOT), D, nb * 32, D, nb * 32, kb * 64}; return t; } r -= I_O;
    if (r < I_UP) { const int nblk = NUP / 32, kb = r / nblk, nb = r % nblk; t = TItem{a.in[19], a.in[18], (bf16_t*)(ws + WS_W3T), NUP, src_up(nb), D, nb * 32, kb * 64}; return t; } r -= I_UP;
    { const int nblk = D / 32, kb = r / nblk, nb = r % nblk; t = TItem{a.in[20], nullptr, (bf16_t*)(ws + WS_W4T), D, nb * 32, FF, nb * 32, kb * 64}; return t; }
}
__device__ __forceinline__ void weights_convert(const Args& a, LAS unsigned char* lds, int it0, int it1, int gw, int NGW, int wave, int lane) {
    LAS float* scr = (LAS float*)(lds + wave * 16896);
    for (int it = it0 + gw; it < it1; it += 2 * NGW) {
        const TItem t0 = p0_decode(a, it), t1 = p0_decode(a, it + NGW < it1 ? it + NGW : it);
        float v0[32], v1[32];
        p0_tload(t0, v0, lane); p0_tload(t1, v1, lane);
        p0_tfinish(t0, v0, scr, lane);
        if (it + NGW < it1) p0_tfinish(t1, v1, scr + 64 * 33, lane);
    }
}

template <int NR> __device__ __forceinline__ void x_rows(const Args& a, int m0, int lane) {
    bf16_t* AB = (bf16_t*)(a.ws + WS_AB); float* ssq0 = (float*)(a.ws + WS_SSQ0);
    f32x4 v[NR][4];
#pragma unroll
    for (int q = 0; q < NR; ++q) { const int m = m0 + q;
        const float* xrow = (m < MP) ? a.in[0] + (size_t)m * D : a.in[1] + (size_t)(m - MP) * D;
        const f32x4* xr = (const f32x4*)xrow + lane;
#pragma unroll
        for (int j = 0; j < 4; ++j) v[q][j] = xr[64 * j]; }
    float t[NR + 1];
#pragma unroll
    for (int q = 0; q < NR; ++q) { float s = 0.f;
#pragma unroll
        for (int j = 0; j < 4; ++j) s += (v[q][j].x * v[q][j].x + v[q][j].y * v[q][j].y) + (v[q][j].z * v[q][j].z + v[q][j].w * v[q][j].w);
        t[q] = s; }
    t[NR] = 0.f;
#pragma unroll
    for (int q = 0; q < NR; q += 2) wave_sum2(t[q], t[q + 1]);
#pragma unroll
    for (int q = 0; q < NR; ++q) { const int m = m0 + q;
        u32x2* o8 = (u32x2*)(AB + (size_t)m * D) + lane;
#pragma unroll
        for (int j = 0; j < 4; ++j) { u32x2 w; w.x = cvt_pk_bf16(v[q][j].x, v[q][j].y); w.y = cvt_pk_bf16(v[q][j].z, v[q][j].w); o8[64 * j] = w; }
        if (lane < 16) ssq0[(size_t)m * 16 + lane] = (lane == 0) ? t[q] : 0.f; }
}

__device__ __forceinline__ void p0_prologue(const Args& a, LAS unsigned char* lds) {
    int tid = threadIdx.x; asm volatile("" : "+v"(tid));
    const int lane = tid & 63, wave = tid >> 6;
    const int gw = blockIdx.x * 8 + wave, NGW = gridDim.x * 8;
    unsigned char* ws = a.ws;
    weights_convert(a, lds, 0, NITEMS_EARLY, gw, NGW, wave, lane);
    for (int m0 = gw * 8; m0 < MP; m0 += NGW * 8) x_rows<8>(a, m0, lane);
    for (int m = MP + gw; m < M; m += NGW) x_rows<1>(a, m, lane);
    const int gt = blockIdx.x * 512 + tid, NGT = gridDim.x * 512;
    f32x2* rope = (f32x2*)(ws + WS_ROPE);
    for (int i = gt; i < TP * 8; i += NGT) {
        const int pos = i >> 3, k = i & 7;
        const float ang = (float)pos * a.inv[k];
        const double rev = (double)ang * 0.15915494309189535;
        const float fr = (float)(rev - rint(rev));
        rope[i] = (f32x2){__builtin_amdgcn_cosf(fr), __builtin_amdgcn_sinf(fr)};
    }
    bf16_t* KS = (bf16_t*)(ws + WS_KS); bf16_t* VTS = (bf16_t*)(ws + WS_VTS); bf16_t* US = (bf16_t*)(ws + WS_US);
    for (int i = gt; i < NBS * WIN * 128; i += NGT) {
        const int c = i & 127, row = (i >> 7) & (WIN - 1), b = i >> 14;
        const float kv = a.in[3][i], vv = a.in[4][i];
        KS[((size_t)(b * KSROWS + row)) * 128 + c] = f2bf(kv);
        VTS[((size_t)(b * 128 + c)) * KSROWS + row] = f2bf(vv);
        if (row >= TS) { a.out[O_KWS + ((size_t)(b * WIN + row - TS)) * 128 + c] = kv; a.out[O_VWS + ((size_t)(b * WIN + row - TS)) * 128 + c] = vv; }
    }
    for (int i = gt; i < NBS * 128 * 16; i += NGT) { const int k = i & 15, rowd = i >> 4; VTS[(size_t)rowd * KSROWS + WIN + TS + k] = 0; }
    for (int i = gt; i < NBS * HIST * CC; i += NGT) {
        const int c = i & (CC - 1), row = (i >> 9) % HIST, b = (i >> 9) / HIST;
        const float uv = a.in[2][i];
        US[((size_t)(b * USROWS + row)) * CC + c] = f2bf(uv);
        if (row >= TS) a.out[O_CSS + ((size_t)(b * HIST + row - TS)) * CC + c] = uv;
    }
}

constexpr int ATT_VT_OFF = 192 * 128, ATT_VT_STRIDE = 400, ATT_BUF = ATT_VT_OFF + 64 * ATT_VT_STRIDE;
constexpr int ATT_UNITS_P = NBP * (TP / 64) * 2, ATT_UNITS = ATT_UNITS_P + NBS * 2;

struct AttUnit { const bf16_t* kb; const bf16_t* vt; int nkt; bool sample; };
__device__ __forceinline__ AttUnit att_decode(unsigned char* ws, int unit) {
    AttUnit u;
    if (unit < ATT_UNITS_P) { const int kh = unit & 1, c = (unit >> 1) & 127, b = unit >> 8, cs = c >= 2 ? c - 2 : 0;
        u.nkt = (c - cs + 1) * 4; u.sample = false;
        u.kb = (const bf16_t*)(ws + WS_KP) + ((size_t)(b * TP + cs * 64)) * 128 + kh * 64;
        u.vt = (const bf16_t*)(ws + WS_VTP) + ((size_t)((b * 2 + kh) * (TP / 64) + cs)) * 4096; }
    else { const int p = unit - ATT_UNITS_P, b = p >> 1, kh = p & 1;
        u.nkt = 9; u.sample = true;
        u.kb = (const bf16_t*)(ws + WS_KS) + ((size_t)(b * KSROWS)) * 128 + kh * 64;
        u.vt = (const bf16_t*)(ws + WS_VTS) + ((size_t)((b * 2 + kh) * 64)) * KSROWS; }
    return u;
}
__device__ __forceinline__ void att_stage_load(const AttUnit& u, int tid, u32x4 (&kp)[3], u32x4 (&vp)[3]) {
    const int nk = u.nkt * 16;
#pragma unroll
    for (int i = 0; i < 3; ++i) {
        const int p = tid + 512 * i; int row = p >> 3; const int ch = p & 7; row = row < nk ? row : nk - 1;
        kp[i] = *(const u32x4*)(u.kb + (size_t)row * 128 + ch * 8);
        if (u.sample) { int pp = p < 1280 ? p : 1279; const int d = pp / 20, q = pp - d * 20; vp[i] = *(const u32x4*)(u.vt + (size_t)d * KSROWS + q * 8); }
        else { const int jmax = (u.nkt >> 2) - 1, j = i < jmax ? i : jmax; vp[i] = *(const u32x4*)(u.vt + (size_t)j * 4096 + (p & 511) * 8); }
    }
}
__device__ __forceinline__ void att_stage_write(const AttUnit& u, int tid, LAS unsigned char* buf, const u32x4 (&kp)[3], const u32x4 (&vp)[3]) {
    const int nk = u.nkt * 16;
#pragma unroll
    for (int i = 0; i < 3; ++i) {
        const int p = tid + 512 * i; int row = p >> 3; const int ch = p & 7; row = row < nk ? row : nk - 1;
        *(LAS u32x4*)(buf + row * 128 + ((ch ^ ((row >> 1) & 7)) << 4)) = kp[i];
        if (u.sample) { int pp = p < 1280 ? p : 1279; const int d = pp / 20, q = pp - d * 20; *(LAS u32x4*)(buf + ATT_VT_OFF + d * ATT_VT_STRIDE + q * 16) = vp[i]; }
        else { const int jmax = (u.nkt >> 2) - 1, j = i < jmax ? i : jmax; const int d = (p & 511) >> 3, q = p & 7; *(LAS u32x4*)(buf + ATT_VT_OFF + d * ATT_VT_STRIDE + j * 128 + q * 16) = vp[i]; }
    }
}
__device__ __forceinline__ void attn_compute(const bf16x8 (&qf)[2][2], LAS const unsigned char* buf, int nkt, float sink0, float sink1, bf16_t* o0, bf16_t* o1, int lane) {
    const int fr = lane & 15, g = lane >> 4;
    f32x4 S[2][12];
    const float NEG = -INFINITY;
#pragma unroll
    for (int kt = 0; kt < 12; ++kt) {
        const int ktc = kt < nkt ? kt : nkt - 1, row = ktc * 16 + fr, sw = (row >> 1) & 7;
        const bf16x8 k0 = *(LAS const bf16x8*)(buf + row * 128 + ((g ^ sw) << 4)), k1 = *(LAS const bf16x8*)(buf + row * 128 + (((g + 4) ^ sw) << 4));
        const bool ok = kt < nkt;
#pragma unroll
        for (int qt = 0; qt < 2; ++qt) {
            f32x4 c = (f32x4){0.f, 0.f, 0.f, 0.f};
            c = __builtin_amdgcn_mfma_f32_16x16x32_bf16(k0, qf[qt][0], c, 0, 0, 0);
            c = __builtin_amdgcn_mfma_f32_16x16x32_bf16(k1, qf[qt][1], c, 0, 0, 0);
            S[qt][kt] = ok ? c : (f32x4){NEG, NEG, NEG, NEG};
        }
    }
    bf16x8 pf[2][6]; float linv[2];
#pragma unroll
    for (int qt = 0; qt < 2; ++qt) {
        const float sink = qt ? sink1 : sink0;
        float mx = sink;
#pragma unroll
        for (int kt = 0; kt < 12; ++kt) mx = fmaxf(mx, fmaxf(fmaxf(S[qt][kt][0], S[qt][kt][1]), fmaxf(S[qt][kt][2], S[qt][kt][3])));
        mx = max_rows4(mx);
        float l = 0.f;
#pragma unroll
        for (int kt = 0; kt < 12; ++kt) {
#pragma unroll
            for (int j = 0; j < 4; ++j) { const float p = __builtin_amdgcn_exp2f(S[qt][kt][j] - mx); S[qt][kt][j] = p; l += p; }
        }
        l = sum_rows4(l);
        l += __builtin_amdgcn_exp2f(sink - mx);
        linv[qt] = 1.0f / l;
#pragma unroll
        for (int kk = 0; kk < 6; ++kk) {
            u32x4 w; w.x = cvt_pk_bf16(S[qt][2 * kk][0], S[qt][2 * kk][1]); w.y = cvt_pk_bf16(S[qt][2 * kk][2], S[qt][2 * kk][3]);
            w.z = cvt_pk_bf16(S[qt][2 * kk + 1][0], S[qt][2 * kk + 1][1]); w.w = cvt_pk_bf16(S[qt][2 * kk + 1][2], S[qt][2 * kk + 1][3]);
            pf[qt][kk] = __builtin_bit_cast(bf16x8, w);
        }
    }
    f32x4 O[2][4];
    const int kkmax = (nkt - 1) >> 1;
    LAS const unsigned char* vb = buf + ATT_VT_OFF + fr * ATT_VT_STRIDE + g * 8;
#pragma unroll
    for (int dt = 0; dt < 4; ++dt) {
        O[0][dt] = (f32x4){0.f, 0.f, 0.f, 0.f}; O[1][dt] = (f32x4){0.f, 0.f, 0.f, 0.f};
#pragma unroll
        for (int kk = 0; kk < 6; ++kk) {
            const int kkc = kk < kkmax ? kk : kkmax;
            const u32x2 a0 = *(LAS const u32x2*)(vb + dt * 16 * ATT_VT_STRIDE + kkc * 64), a1 = *(LAS const u32x2*)(vb + dt * 16 * ATT_VT_STRIDE + kkc * 64 + 32);
            u32x4 aw; aw.x = a0.x; aw.y = a0.y; aw.z = a1.x; aw.w = a1.y;
            const bf16x8 af = __builtin_bit_cast(bf16x8, aw);
            O[0][dt] = __builtin_amdgcn_mfma_f32_16x16x32_bf16(af, pf[0][kk], O[0][dt], 0, 0, 0);
            O[1][dt] = __builtin_amdgcn_mfma_f32_16x16x32_bf16(af, pf[1][kk], O[1][dt], 0, 0, 0);
        }
    }
#pragma unroll
    for (int qt = 0; qt < 2; ++qt) {
        bf16_t* ob = (qt ? o1 : o0) + (size_t)fr * D + 4 * g;
#pragma unroll
        for (int dt = 0; dt < 4; ++dt) {
            const f32x4 v = O[qt][dt] * linv[qt];
            u32x2 w; w.x = cvt_pk_bf16(v[0], v[1]); w.y = cvt_pk_bf16(v[2], v[3]);
            *(u32x2*)(ob + dt * 16) = w;
        }
    }
}

__device__ __forceinline__ void attn_phase(const Args& a, LAS unsigned char* lds, int tid, int first, int G) {
    asm volatile("" : "+v"(tid));
    unsigned char* ws = a.ws;
    const int lane = tid & 63, wave = __builtin_amdgcn_readfirstlane(tid >> 6), fr = lane & 15, g = lane >> 4;
    const bf16_t* Q = (const bf16_t*)(ws + WS_Q); bf16_t* MIX = (bf16_t*)(ws + WS_MIX);
    const float* sinks = a.in[12];
    if (first >= ATT_UNITS) return;
    AttUnit cur = att_decode(ws, first);
    u32x4 kp[3], vp[3];
    att_stage_load(cur, tid, kp, vp);
    int par = 0;
    for (int unit = first; unit < ATT_UNITS; unit += G, par ^= 1) {
        LAS unsigned char* buf = lds + par * ATT_BUF;
        att_stage_write(cur, tid, buf, kp, vp);
        const bf16_t* q0; const bf16_t* q1; bf16_t* o0; bf16_t* o1; float sk0, sk1; bool work;
        if (!cur.sample) { const int kh = unit & 1, c = (unit >> 1) & 127, b = unit >> 8, h = kh * 4 + (wave >> 1), tok0 = c * 64 + (wave & 1) * 32;
            q0 = Q + ((size_t)(b * TP + tok0)) * 512 + h * 64; q1 = q0 + 16 * 512;
            o0 = MIX + ((size_t)(b * TP + tok0)) * D + 512 + h * 64; o1 = o0 + 16 * D; sk0 = sk1 = sinks[h] * LOG2E; work = true; }
        else { const int p = unit - ATT_UNITS_P, b = p >> 1, kh = p & 1, h0 = kh * 4 + (wave & 1) * 2;
            q0 = Q + ((size_t)(MP + b * TS)) * 512 + h0 * 64; q1 = q0 + 64;
            o0 = MIX + ((size_t)(MP + b * TS)) * D + 512 + h0 * 64; o1 = o0 + 64; sk0 = sinks[h0] * LOG2E; sk1 = sinks[h0 + 1] * LOG2E; work = wave < 2; }
        bf16x8 qf[2][2];
        qf[0][0] = *(const bf16x8*)(q0 + fr * 512 + g * 8); qf[0][1] = *(const bf16x8*)(q0 + fr * 512 + 32 + g * 8);
        qf[1][0] = *(const bf16x8*)(q1 + fr * 512 + g * 8); qf[1][1] = *(const bf16x8*)(q1 + fr * 512 + 32 + g * 8);
        const int nkt = cur.nkt;
        __syncthreads();
        const int nu = unit + G < ATT_UNITS ? unit + G : unit;
        cur = att_decode(ws, nu);
        att_stage_load(cur, tid, kp, vp);
        if (work) attn_compute(qf, buf, nkt, sk0, sk1, o0, o1, lane);
    }
    __syncthreads();
}

constexpr int CONV_UNITS32 = MP / 32 + NBS / 2;
struct ConvUnit { const unsigned* ub; int jmin; size_t orow; };
__device__ __forceinline__ ConvUnit conv_decode(unsigned char* ws, int cu, int half, int c0) {
    ConvUnit u;
    if (cu < MP / 32) { const int b = cu >> 8, t0 = (cu & 255) * 32 + 16 * half; u.ub = (const unsigned*)((const bf16_t*)(ws + WS_UP) + ((size_t)(b * TP) + t0 - HIST) * CC + c0); u.jmin = HIST - t0; u.orow = (size_t)b * TP + t0; }
    else { const int st = 2 * (cu - MP / 32) + half; u.ub = (const unsigned*)((const bf16_t*)(ws + WS_US) + ((size_t)(st * USROWS)) * CC + c0); u.jmin = 0; u.orow = (size_t)MP + st * TS; }
    return u;
}
__device__ __forceinline__ void conv_phase(const Args& a, LAS unsigned char* lds, int tid, int first, int G) {
    asm volatile("" : "+v"(tid));
    unsigned char* ws = a.ws;
    const int half = tid >> 8, c0 = 2 * (tid & 255), wave = tid >> 6, lane = tid & 63;
    if (first >= CONV_UNITS32) return;
    f32x2 w[CW];
#pragma unroll
    for (int j = 0; j < CW; ++j) w[j] = *(const f32x2*)(a.in[13] + j * CC + c0);
    const f32x2 bias = *(const f32x2*)(a.in[14] + c0);
    const f32x4 gc0 = *(const f32x4*)(a.in[15] + 4 * lane), gc1 = *(const f32x4*)(a.in[15] + 256 + 4 * lane);
    const f32x4 bc0 = *(const f32x4*)(a.in[16] + 4 * lane), bc1 = *(const f32x4*)(a.in[16] + 256 + 4 * lane);
    ConvUnit cur = conv_decode(ws, first, half, c0);
    unsigned xr[HIST + 16];
#pragma unroll
    for (int j = 0; j < HIST + 16; ++j) { const int jc = j > cur.jmin ? j : cur.jmin; xr[j] = cur.ub[(size_t)jc * (CC / 2)]; }
    int par = 0;
    for (int cu = first; cu < CONV_UNITS32; cu += G, par ^= 1) {
        const int jmin = cur.jmin;
        f32x2 acc[16];
#pragma unroll
        for (int i = 0; i < 16; ++i) acc[i] = bias;
#pragma unroll
        for (int j = 0; j < HIST + 16; ++j) {
            f32x2 xv = (f32x2){__uint_as_float(xr[j] << 16), __uint_as_float(xr[j] & 0xffff0000u)};
            if (j < jmin) xv = (f32x2){0.f, 0.f};
#pragma unroll
            for (int i = 0; i < 16; ++i) { if (j - i >= 0 && j - i < CW) acc[i] += xv * w[j - i]; }
        }
        __builtin_amdgcn_sched_barrier(0);
        const int cun = cu;
        { const int nu = cu + G < CONV_UNITS32 ? cu + G : cu;
          cur = conv_decode(ws, nu, half, c0);
#pragma unroll
          for (int j = 0; j < HIST + 16; ++j) { const int jc = j > cur.jmin ? j : cur.jmin; xr[j] = cur.ub[(size_t)jc * (CC / 2)]; } }
        __builtin_amdgcn_sched_barrier(0);
        LAS float* yb = (LAS float*)lds + par * (32 * CC);
#pragma unroll
        for (int i = 0; i < 16; ++i) *(LAS f32x2*)(yb + (16 * half + i) * CC + c0) = acc[i];
        __syncthreads();
#pragma unroll
        for (int tp = 0; tp < 2; ++tp) {
            const int tok = 4 * wave + 2 * tp;
            size_t orow;
            if (cun < MP / 32) orow = (size_t)(cun >> 8) * TP + (cun & 255) * 32 + tok;
            else orow = (size_t)MP + (2 * (cun - MP / 32) + (tok >> 4)) * TS + (tok & 15);
            bf16_t* MIX = (bf16_t*)(ws + WS_MIX) + orow * D;
            f32x4 v0 = *(const LAS f32x4*)(yb + tok * CC + 4 * lane), v1 = *(const LAS f32x4*)(yb + tok * CC + 256 + 4 * lane);
            f32x4 z0 = *(const LAS f32x4*)(yb + (tok + 1) * CC + 4 * lane), z1 = *(const LAS f32x4*)(yb + (tok + 1) * CC + 256 + 4 * lane);
            float sa = (v0[0] + v0[1]) + (v0[2] + v0[3]) + (v1[0] + v1[1]) + (v1[2] + v1[3]);
            float sb = (z0[0] + z0[1]) + (z0[2] + z0[3]) + (z1[0] + z1[1]) + (z1[2] + z1[3]);
            wave_sum2(sa, sb);
            const float ma = sa * (1.0f / CC), mb = sb * (1.0f / CC);
            v0 = v0 - ma; v1 = v1 - ma; z0 = z0 - mb; z1 = z1 - mb;
            float qa = (v0[0] * v0[0] + v0[1] * v0[1]) + (v0[2] * v0[2] + v0[3] * v0[3]) + (v1[0] * v1[0] + v1[1] * v1[1]) + (v1[2] * v1[2] + v1[3] * v1[3]);
            float qb = (z0[0] * z0[0] + z0[1] * z0[1]) + (z0[2] * z0[2] + z0[3] * z0[3]) + (z1[0] * z1[0] + z1[1] * z1[1]) + (z1[2] * z1[2] + z1[3] * z1[3]);
            wave_sum2(qa, qb);
            const float ra = rsqrtf(qa * (1.0f / CC) + EPS), rb = rsqrtf(qb * (1.0f / CC) + EPS);
            v0 = v0 * ra * gc0 + bc0; v1 = v1 * ra * gc1 + bc1; z0 = z0 * rb * gc0 + bc0; z1 = z1 * rb * gc1 + bc1;
            u32x2 o0, o1, p0, p1;
            o0.x = cvt_pk_bf16(silu_f(v0[0]), silu_f(v0[1])); o0.y = cvt_pk_bf16(silu_f(v0[2]), silu_f(v0[3]));
            o1.x = cvt_pk_bf16(silu_f(v1[0]), silu_f(v1[1])); o1.y = cvt_pk_bf16(silu_f(v1[2]), silu_f(v1[3]));
            p0.x = cvt_pk_bf16(silu_f(z0[0]), silu_f(z0[1])); p0.y = cvt_pk_bf16(silu_f(z0[2]), silu_f(z0[3]));
            p1.x = cvt_pk_bf16(silu_f(z1[0]), silu_f(z1[1])); p1.y = cvt_pk_bf16(silu_f(z1[2]), silu_f(z1[3]));
            *(u32x2*)(MIX + 4 * lane) = o0; *(u32x2*)(MIX + 256 + 4 * lane) = o1;
            *(u32x2*)(MIX + D + 4 * lane) = p0; *(u32x2*)(MIX + D + 256 + 4 * lane) = p1;
        }
    }
    __syncthreads();
}

#define XB_TMO      128
#define XB_XCNT(j)  (256  + 64 * (j))
#define XB_XSUB(j)  (1280 + 64 * (j))
#define XB_XGEN(j)  (2304 + 64 * (j))
#define XB_TOP      3328
#define XB_TOPGEN   3392
#define XCD_BAR_WORDS 3456
#define XB_SPIN_CAP (1u << 18)
__device__ __forceinline__ unsigned xb_ld(unsigned* p)              { return __hip_atomic_load(p, __ATOMIC_RELAXED, __HIP_MEMORY_SCOPE_AGENT); }
__device__ __forceinline__ unsigned xb_add(unsigned* p, unsigned v) { return __hip_atomic_fetch_add(p, v, __ATOMIC_RELAXED, __HIP_MEMORY_SCOPE_AGENT); }
__device__ __forceinline__ unsigned xb_xcc_id() { return (unsigned)__builtin_amdgcn_s_getreg((3 << 11) | 20) & 0xFu; }
#define XB_SPIN(cond, bar) do { unsigned _sp = 0; while (cond) { __builtin_amdgcn_s_sleep(1); \
    if ((++_sp & 255u) == 0u) { if (xb_ld(&(bar)[XB_TMO])) break; if (_sp > XB_SPIN_CAP) { atomicAdd(&(bar)[XB_TMO], 1u); break; } } } } while (0)
struct XcdBarrier { unsigned* bar; unsigned x; volatile LAS unsigned* st; };
__device__ __forceinline__ XcdBarrier xcd_barrier_post(unsigned* bar, volatile LAS unsigned* st) {
    XcdBarrier b; b.bar = bar; b.x = xb_xcc_id(); b.st = st;
    if (threadIdx.x == 0) (void)xb_add(&bar[XB_XCNT(b.x)], 1u);
    return b;
}
__device__ __forceinline__ void xcd_barrier_complete(unsigned* bar, unsigned x, unsigned& nloc, unsigned& nx) {
    const unsigned G = gridDim.x * gridDim.y * gridDim.z;
    unsigned sum, cnt, mine, sp = 0u;
    for (;;) {
        sum = 0u; cnt = 0u; mine = 0u;
#pragma unroll
        for (unsigned j = 0; j < 16; ++j) { const unsigned c = xb_ld(&bar[XB_XCNT(j)]); sum += c; cnt += (c > 0u) ? 1u : 0u; mine = (j == x) ? c : mine; }
        if (sum == G) break;
        __builtin_amdgcn_s_sleep(1);
        if ((++sp & 255u) == 0u) { if (xb_ld(&bar[XB_TMO])) break; if (sp > XB_SPIN_CAP) { atomicAdd(&bar[XB_TMO], 1u); break; } }
    }
    nloc = mine > 0u ? mine : 1u; nx = cnt > 0u ? cnt : 1u;
}
__device__ __forceinline__ void xcd_barrier(const XcdBarrier& b) {
    asm volatile("s_waitcnt vmcnt(0)" ::: "memory");
    __syncthreads();
    if (threadIdx.x == 0) {
        unsigned* bar = b.bar;
        __builtin_amdgcn_s_waitcnt(0);
        unsigned nloc = b.st[0], nx = b.st[1];
        if (nloc == 0u) { xcd_barrier_complete(bar, b.x, nloc, nx); b.st[0] = nloc; b.st[1] = nx; }
        const unsigned old = xb_add(&bar[XB_XSUB(b.x)], 1u);
        const unsigned gen = old / nloc;
        if (old + 1u == (gen + 1u) * nloc) {
            __builtin_amdgcn_fence(__ATOMIC_RELEASE, "agent");
            asm volatile("s_waitcnt vmcnt(0)" ::: "memory");
            const unsigned og = xb_add(&bar[XB_TOP], 1u);
            const unsigned tg = og / nx;
            if (og + 1u == (tg + 1u) * nx) xb_add(&bar[XB_TOPGEN], 1u);
            else XB_SPIN(xb_ld(&bar[XB_TOPGEN]) == tg, bar);
            __builtin_amdgcn_fence(__ATOMIC_ACQUIRE, "agent");
            xb_add(&bar[XB_XGEN(b.x)], 1u);
            asm volatile("s_waitcnt vmcnt(0)" ::: "memory");
        } else {
            XB_SPIN(xb_ld(&bar[XB_XGEN(b.x)]) == gen, bar);
            __builtin_amdgcn_fence(__ATOMIC_ACQUIRE, "agent");
            asm volatile("s_waitcnt vmcnt(0)" ::: "memory");
        }
    }
    __syncthreads();
}
constexpr int MISC_OFF = 143360;
constexpr size_t CTL_ZERO_BYTES = 65536;
constexpr int CW_BAR = 4096;

__global__ void __launch_bounds__(512, 2) hymba_fwd(Args a) {
    extern __shared__ __attribute__((aligned(16))) unsigned char lds_raw[];
    LAS unsigned char* lds = (LAS unsigned char*)lds_raw;
    unsigned char* ws = a.ws;
    const int tid = threadIdx.x, lane = tid & 63, wave = __builtin_amdgcn_readfirstlane(tid >> 6);
    const int G = gridDim.x, bid = blockIdx.x;
    for (int u = tid; u < (LDS_BYTES - MISC_OFF) / 4; u += 512) ((LAS unsigned*)(lds + MISC_OFF))[u] = 0u;
    __syncthreads();
    const XcdBarrier bar = xcd_barrier_post((unsigned*)ws + CW_BAR, (volatile LAS unsigned*)(lds + MISC_OFF) + 8);
#define GRID_BAR() xcd_barrier(bar)

    bf16_t* AB = (bf16_t*)(ws + WS_AB); bf16_t* ACT = (bf16_t*)(ws + WS_ACT);
    float* ssq0 = (float*)(ws + WS_SSQ0); float* ssq1 = (float*)(ws + WS_SSQ1); float* ssq2 = (float*)(ws + WS_SSQ2);

#ifndef PROBE_DUP
#define PROBE_DUP -1
#endif
#ifndef PHASE_MASK
#define PHASE_MASK 0xff
#endif
#define REPS(k) if (PHASE_MASK & (1 << (k))) for (int rep_ = 0; rep_ < ((PROBE_DUP == (k)) ? 2 : 1); ++rep_)
    REPS(0) { p0_prologue(a, lds); GRID_BAR(); }
    REPS(1) {
    { pg8::Gemm g{AB, (const bf16_t*)(ws + WS_W1T), MP, NUP, D}; pg8::StaticOrder S; S.init(MP, NUP, G, bid);
      EpiSwiglu E{ACT, ssq0};
      for (int pass = 0; pass < 2; ++pass) { if (((pass ^ (bid >> 6)) & 1) == 0) { pg8::gemm_phase<EpiSwiglu, pg8::StaticOrder, true, true>(lds, g, S, E); } else { small_gemm<1, 4>(AB, (const bf16_t*)(ws + WS_W1T), NUP, D, E, lds, bid, G, wave, lane); } } }
    GRID_BAR(); }
    REPS(2) {
    { pg8::Gemm g{ACT, (const bf16_t*)(ws + WS_W2T), MP, D, FF}; pg8::StaticOrder S; S.init(MP, D, G, bid);
      EpiResid<0> E{a.in[0], a.in[1], nullptr, AB, ssq1, 0.5f};
      for (int pass = 0; pass < 2; ++pass) { if (((pass ^ (bid >> 6)) & 1) == 0) { pg8::gemm_phase<EpiResid<0>, pg8::StaticOrder, true, true>(lds, g, S, E); } else { small_gemm<8, 2>(ACT, (const bf16_t*)(ws + WS_W2T), D, FF, E, lds, bid, G, wave, lane); } } }
    GRID_BAR(); }
    REPS(3) {
    { pg8::Gemm g{AB, (const bf16_t*)(ws + WS_WINT), MP, NIN, D}; pg8::StaticOrder S; S.init(MP, NIN, G, bid);
      EpiInProj E{ws, a.in[10], a.in[11], a.out};
      pg8::gemm_phase<EpiInProj, pg8::StaticOrder, true, true>(lds, g, S, E);
      small_gemm<1, 4>(AB, (const bf16_t*)(ws + WS_WINT), NIN, D, E, lds, G - 1 - bid, G, wave, lane, 2);
      if (rep_ == 0 && bid >= G / 2) { int ln = lane; asm volatile("" : "+v"(ln)); weights_convert(a, lds, NITEMS_EARLY, NITEMS, (bid - G / 2) * 8 + wave, (G - G / 2) * 8, wave, ln); } }
    GRID_BAR(); }
    REPS(4) {
#ifndef PROBE_P4SUB
#define PROBE_P4SUB 0
#endif
    if (!(rep_ == 1 && PROBE_P4SUB == 2)) attn_phase(a, lds, tid, bid, G);
    if (!(rep_ == 1 && PROBE_P4SUB == 1)) conv_phase(a, lds, tid, G - 1 - bid, G);
    GRID_BAR(); }
    REPS(5) {
    { pg8::Gemm g{(const bf16_t*)(ws + WS_MIX), (const bf16_t*)(ws + WS_WOT), MP, D, D}; pg8::StaticOrder S; S.init(MP, D, G, bid);
      EpiResid<1> E{nullptr, nullptr, nullptr, AB, ssq2, 1.0f};
      for (int pass = 0; pass < 2; ++pass) { if (((pass ^ (bid >> 6)) & 1) == 0) { pg8::gemm_phase<EpiResid<1>, pg8::StaticOrder, true, true>(lds, g, S, E); } else { small_gemm<8, 2>((const bf16_t*)(ws + WS_MIX), (const bf16_t*)(ws + WS_WOT), D, D, E, lds, bid, G, wave, lane); } } }
    GRID_BAR(); }
    REPS(6) {
    { pg8::Gemm g{AB, (const bf16_t*)(ws + WS_W3T), MP, NUP, D}; pg8::StaticOrder S; S.init(MP, NUP, G, bid);
      EpiSwiglu E{ACT, ssq2};
      for (int pass = 0; pass < 2; ++pass) { if (((pass ^ (bid >> 6)) & 1) == 0) { pg8::gemm_phase<EpiSwiglu, pg8::StaticOrder, true, true>(lds, g, S, E); } else { small_gemm<1, 4>(AB, (const bf16_t*)(ws + WS_W3T), NUP, D, E, lds, bid, G, wave, lane); } } }
    GRID_BAR(); }
    REPS(7) { pg8::Gemm g{ACT, (const bf16_t*)(ws + WS_W4T), MP, D, FF}; pg8::StaticOrder S; S.init(MP, D, G, bid);
      EpiResid<2> E{nullptr, nullptr, a.out, AB, nullptr, 0.5f};
      for (int pass = 0; pass < 2; ++pass) { if (((pass ^ (bid >> 6)) & 1) == 0) { pg8::gemm_phase<EpiResid<2>, pg8::StaticOrder, true, true>(lds, g, S, E); } else { small_gemm<8, 2>(ACT, (const bf16_t*)(ws + WS_W4T), D, FF, E, lds, bid, G, wave, lane); } } }
}

extern "C" void kernel_launch(void* const* d_in, const int* in_sizes, int n_in, void* d_out, int out_size, void* d_ws, size_t ws_size, hipStream_t stream) {
    static int grid = 0;
    if (grid == 0) {
        if (n_in != 21 || (size_t)out_size != O_END || ws_size < WS_END) { fprintf(stderr, "kernel_launch: unexpected shapes: n_in %d out %d ws %zu (need %zu)\n", n_in, out_size, ws_size, (size_t)WS_END); grid = -1; return; }
        int dev = 0, cus = 0, per_cu = 0;
        (void)hipGetDevice(&dev);
        (void)hipDeviceGetAttribute(&cus, hipDeviceAttributeMultiprocessorCount, dev);
        if (cus != 256) fprintf(stderr, "kernel_launch: note: built for a 256-CU device (one workgroup per CU), this device reports %d\n", cus);
        if (hipFuncSetAttribute((const void*)hymba_fwd, hipFuncAttributeMaxDynamicSharedMemorySize, LDS_BYTES) != hipSuccess) { fprintf(stderr, "kernel_launch: hipFuncSetAttribute failed\n"); grid = -1; return; }
        if (hipOccupancyMaxActiveBlocksPerMultiprocessor(&per_cu, (const void*)hymba_fwd, 512, LDS_BYTES) != hipSuccess || per_cu < 1) { fprintf(stderr, "kernel_launch: occupancy query failed (%d)\n", per_cu); grid = -1; (void)hipGetLastError(); return; }
        grid = cus;
    }
    if (grid < 0) return;
    Args a{};
    for (int i = 0; i < 21; ++i) a.in[i] = (const float*)d_in[i];
    a.out = (float*)d_out; a.ws = (unsigned char*)d_ws;
    for (int i = 0; i < 8; ++i) a.inv[i] = powf(500000.0f, -(float)i / 8.0f);
    if (hipMemsetAsync(d_ws, 0, CTL_ZERO_BYTES, stream) != hipSuccess) { fprintf(stderr, "kernel_launch: memset failed\n"); return; }
    hipLaunchKernelGGL(hymba_fwd, dim3(grid), dim3(512), LDS_BYTES, stream, a);
    const hipError_t e = hipPeekAtLastError();
    if (e != hipSuccess) fprintf(stderr, "kernel_launch: launch failed: %s (grid %d)\n", hipGetErrorString(e), grid);
}
```

```cpp
#include <hip/hip_runtime.h>
#include <cstdio>
#include <cstdint>
#include <cmath>

#define LAS __attribute__((address_space(3)))
typedef unsigned short bf16_t;
typedef short bf16x8 __attribute__((ext_vector_type(8)));
typedef float f32x4 __attribute__((ext_vector_type(4)));
typedef float f32x2 __attribute__((ext_vector_type(2)));
typedef unsigned u32x4 __attribute__((ext_vector_type(4)));
typedef unsigned u32x2 __attribute__((ext_vector_type(2)));

constexpr int D = 1024, TP = 8192, NBP = 4, NBS = 32, TS = 16, MP = NBP * TP, MS = NBS * TS, M = MP + MS;
constexpr int FF = 2816, NUP = 2 * FF, NIN = 1792, CC = 512, HD = 64, PAST = 4096;
constexpr int CW = 31, HIST = CW - 1, WIN = 128;
constexpr int KSROWS = 160;
constexpr int USROWS = HIST + TS;
constexpr float EPS = 1e-6f;
constexpr float LOG2E = 1.4426950408889634f;
constexpr float QSCALE = 0.125f * LOG2E;

constexpr size_t O_YP = 0, O_YS = (size_t)MP * D, O_CSP = O_YS + (size_t)MS * D, O_KWP = O_CSP + (size_t)NBP * HIST * CC,
                 O_VWP = O_KWP + (size_t)NBP * WIN * 128, O_CSS = O_VWP + (size_t)NBP * WIN * 128, O_KWS = O_CSS + (size_t)NBS * HIST * CC,
                 O_VWS = O_KWS + (size_t)NBS * WIN * 128, O_END = O_VWS + (size_t)NBS * WIN * 128;

constexpr size_t al(size_t x) { return (x + 4095) & ~(size_t)4095; }
constexpr size_t WS_CTL = 0;
constexpr size_t WS_W1T = 1u << 20;
constexpr size_t WS_W2T = WS_W1T + al((size_t)NUP * D * 2);
constexpr size_t WS_WINT = WS_W2T + al((size_t)D * FF * 2);
constexpr size_t WS_WOT = WS_WINT + al((size_t)NIN * D * 2);
constexpr size_t WS_W3T = WS_WOT + al((size_t)D * D * 2);
constexpr size_t WS_W4T = WS_W3T + al((size_t)NUP * D * 2);
constexpr size_t WS_ROPE = WS_W4T + al((size_t)D * FF * 2);
constexpr size_t WS_SSQ0 = WS_ROPE + al((size_t)TP * 8 * 8);
constexpr size_t WS_SSQ1 = WS_SSQ0 + al((size_t)M * 16 * 4);
constexpr size_t WS_SSQ2 = WS_SSQ1 + al((size_t)M * 16 * 4);
constexpr size_t WS_KS = WS_SSQ2 + al((size_t)M * 16 * 4);
constexpr size_t WS_VTS = WS_KS + al((size_t)NBS * KSROWS * 128 * 2);
constexpr size_t WS_US = WS_VTS + al((size_t)NBS * 128 * KSROWS * 2);
constexpr size_t WS_AB = WS_US + al((size_t)NBS * USROWS * CC * 2);
constexpr size_t WS_X1 = WS_AB + al((size_t)M * D * 2);
constexpr size_t WS_ACT = WS_X1 + al((size_t)M * D * 4);
constexpr size_t WS_END = WS_ACT + al((size_t)M * FF * 2);
constexpr size_t WS_UP = WS_ACT;
constexpr size_t WS_Q = WS_UP + al((size_t)MP * CC * 2);
constexpr size_t WS_KP = WS_Q + al((size_t)M * 512 * 2);
constexpr size_t WS_VTP = WS_KP + al((size_t)MP * 128 * 2);
constexpr size_t WS_MIX = WS_VTP + al((size_t)MP * 128 * 2);
static_assert(WS_MIX + (size_t)M * D * 2 <= WS_END, "overlay fits");

constexpr int LDS_BYTES = 155648;
constexpr int SSQ_LDS_OFF = 131072;

__device__ __forceinline__ unsigned cvt_pk_bf16(float lo, float hi) { unsigned r; asm volatile("v_cvt_pk_bf16_f32 %0, %1, %2" : "=v"(r) : "v"(lo), "v"(hi)); return r; }
__device__ __forceinline__ float bf2f(bf16_t h) { return __uint_as_float((unsigned)h << 16); }
__device__ __forceinline__ bf16_t f2bf(float f) { return (bf16_t)(cvt_pk_bf16(f, 0.f) & 0xffffu); }
__device__ __forceinline__ float silu_f(float a) { return a * __builtin_amdgcn_rcpf(1.0f + __builtin_amdgcn_exp2f(-a * LOG2E)); }
__device__ __forceinline__ float sigmoid_f(float a) { return __builtin_amdgcn_rcpf(1.0f + __builtin_amdgcn_exp2f(-a * LOG2E)); }
__device__ __forceinline__ float sum_rows4(float x) {
    float a = x, b = x;
    asm volatile("s_nop 1\n\tv_permlane16_swap_b32 %0, %1" : "+v"(a), "+v"(b));
    float t = a + b; a = t; b = t;
    asm volatile("s_nop 1\n\tv_permlane32_swap_b32 %0, %1" : "+v"(a), "+v"(b));
    return a + b;
}
__device__ __forceinline__ float max_rows4(float x) {
    float a = x, b = x;
    asm volatile("s_nop 1\n\tv_permlane16_swap_b32 %0, %1" : "+v"(a), "+v"(b));
    float t = fmaxf(a, b); a = t; b = t;
    asm volatile("s_nop 1\n\tv_permlane32_swap_b32 %0, %1" : "+v"(a), "+v"(b));
    return fmaxf(a, b);
}
__device__ __forceinline__ float wave_sum(float v) {
#pragma unroll
    for (int o = 1; o < 64; o <<= 1) v += __shfl_xor(v, o);
    return v;
}
__device__ __forceinline__ float dpp_row_sum(float v) {
    v += __builtin_bit_cast(float, __builtin_amdgcn_update_dpp(0, __builtin_bit_cast(int, v), 0xB1, 0xF, 0xF, true));
    v += __builtin_bit_cast(float, __builtin_amdgcn_update_dpp(0, __builtin_bit_cast(int, v), 0x4E, 0xF, 0xF, true));
    v += __builtin_bit_cast(float, __builtin_amdgcn_update_dpp(0, __builtin_bit_cast(int, v), 0x124, 0xF, 0xF, true));
    v += __builtin_bit_cast(float, __builtin_amdgcn_update_dpp(0, __builtin_bit_cast(int, v), 0x128, 0xF, 0xF, true));
    return v;
}
__device__ __forceinline__ void wave_sum2(float& a, float& b) {
    a = dpp_row_sum(a); b = dpp_row_sum(b);
    a = sum_rows4(a); b = sum_rows4(b);
}
__device__ __forceinline__ float row_rstd(const float* ssq, int r) {
    const f32x4* p = (const f32x4*)(ssq + (size_t)r * 16);
    const f32x4 a = p[0], b = p[1], c = p[2], d = p[3];
    const f32x4 s = (a + b) + (c + d);
    return rsqrtf(((s.x + s.y) + (s.z + s.w)) * (1.0f / D) + EPS);
}

namespace pg8 {
constexpr int BM = 256, BK = 64, HALF = 128, HTB = HALF * BK * 2, STAGE_BYTES = 8 * HTB, NXCD = 8, WGM = 8;
__host__ __device__ __forceinline__ int lds_byte(int r, int c) { const int st = (r >> 4) * 2 + (c >> 5), rr = r & 15, cc = c & 31, ob = rr * 64 + cc * 2; return st * 1024 + (ob ^ (((ob >> 9) & 1) << 5)); }
__host__ __device__ __forceinline__ void stage_rc(int b, int& R, int& C) { const int st = b / 1024, sb = b % 1024, swz = sb ^ (((sb >> 9) & 1) << 5); R = (st >> 1) * 16 + swz / 64; C = (st & 1) * 32 + (swz % 64) / 2; }
__host__ __device__ __forceinline__ int perm32(int rho) { const int n = rho >> 4, i = rho & 15; return 8 * (i >> 2) + 4 * n + (i & 3); }

struct Unit { int pm, pn; };
struct Gemm { const bf16_t* A; const bf16_t* Bt; int M, N, K; };

struct StaticOrder {
    int nM, nN, nwg, G, c;
    __host__ __device__ void init(int M_, int N_, int G_, int c_) { nM = M_ / BM; nN = N_ / BM; nwg = nM * nN; G = G_; c = c_; }
    __host__ __device__ bool next(int i, Unit& u) const {
        const long L = (long)i * G + c; if (L >= nwg) return false;
        int wgid = (int)L; { const int q = nwg / NXCD, r = nwg % NXCD, xcd = wgid % NXCD, off = wgid / NXCD; wgid = (xcd < r ? xcd * (q + 1) : r * (q + 1) + (xcd - r) * q) + off; }
        const int nig = WGM * nN, gid = wgid / nig, fm = gid * WGM, gsz = (nM - fm) < WGM ? (nM - fm) : WGM;
        u.pm = fm + ((wgid % nig) % gsz); u.pn = (wgid % nig) / gsz; return true;
    }
    __device__ __forceinline__ void a_ready(const Unit&) const {}
    __device__ __forceinline__ void done(const Unit&) const {}
};

template <class Epi, class Sched, bool ALIGN_EPI, bool SP2>
__device__ __forceinline__ void gemm_phase(LAS unsigned char* lds, const Gemm g, const Sched& S, const Epi& E) {
    int tid = threadIdx.x; asm volatile("" : "+v"(tid));
    const int wid = __builtin_amdgcn_readfirstlane(tid >> 6), lane = tid & 63, wr = wid >> 2, wc = wid & 3, fr = lane & 15, fq = lane >> 4;
    const int K = g.K, nt = K / BK;
    unsigned voffA[2], voffB[2];
#pragma unroll
    for (int i = 0; i < 2; ++i) { int R, C; stage_rc(tid * 16 + i * 8192, R, C); const int Rb = Epi::PERM ? ((R & ~31) + perm32(R & 31)) : R;
        voffA[i] = (unsigned)(R * K + C) * 2u; voffB[i] = (unsigned)(Rb * K + C) * 2u; }
    const size_t kstep = (size_t)(BK * 2);
    const size_t hstep = (size_t)HALF * K * 2;
    const size_t tstep = 2 * hstep;
    const unsigned ldsw = (unsigned)wid * 1024u;
    const int aoff = lds_byte(wr * 64 + fr, fq * 8), boff = lds_byte(wc * 32 + fr, fq * 8);
#define PG8_SA(b, h) (((b) * 2 + (h)) * HTB)
#define PG8_SB(b, h) ((4 + (b) * 2 + (h)) * HTB)
#define PG8_STAGE(bufoff, gbase, voff) do { _Pragma("unroll") for (int _i = 0; _i < 2; ++_i) \
        __builtin_amdgcn_global_load_lds((const unsigned*)((const char*)(gbase) + (voff)[_i]), (LAS unsigned*)(lds + (bufoff) + ldsw + _i * 8192), 16, 0, 0); } while (0)
#define PG8_LDA(dst, b, h) do { _Pragma("unroll") for (int m = 0; m < 4; ++m) _Pragma("unroll") for (int k = 0; k < 2; ++k) dst[m][k] = *(const LAS bf16x8*)(lds + PG8_SA(b, h) + aoff + m * 2048 + k * 1024); } while (0)
#define PG8_LDB(dst, b, h) do { _Pragma("unroll") for (int n = 0; n < 2; ++n) _Pragma("unroll") for (int k = 0; k < 2; ++k) dst[n][k] = *(const LAS bf16x8*)(lds + PG8_SB(b, h) + boff + n * 2048 + k * 1024); } while (0)
#define PG8_MMA(ai, bj, At, Bt) do { __builtin_amdgcn_s_setprio(1); _Pragma("unroll") for (int m = 0; m < 4; ++m) _Pragma("unroll") for (int n = 0; n < 2; ++n) _Pragma("unroll") for (int k = 0; k < 2; ++k) \
        acc[ai][bj][m][n] = __builtin_amdgcn_mfma_f32_16x16x32_bf16(Bt[n][k], At[m][k], acc[ai][bj][m][n], 0, 0, 0); __builtin_amdgcn_s_setprio(0); } while (0)
#define PG8_WAIT_V(n) asm volatile("s_waitcnt vmcnt(" #n ")" ::: "memory")
#define PG8_WAIT_L(n) asm volatile("s_waitcnt lgkmcnt(" #n ")" ::: "memory")
#define PG8_BAR __builtin_amdgcn_s_barrier()
#define PG8_SCHED __builtin_amdgcn_sched_barrier(0)
    Unit cur, nxt; int ui = 0;
    if (!S.next(0, cur)) return;
    f32x4 acc[2][2][4][2];
#pragma unroll
    for (int a = 0; a < 2; ++a)
#pragma unroll
        for (int b = 0; b < 2; ++b)
#pragma unroll
            for (int m = 0; m < 4; ++m)
#pragma unroll
                for (int n = 0; n < 2; ++n) acc[a][b][m][n] = (f32x4){0.f, 0.f, 0.f, 0.f};
    bf16x8 At[4][2], B0[2][2], B1[2][2];
    const char* cA = (const char*)g.A + (size_t)cur.pm * tstep; const char* cB = (const char*)g.Bt + (size_t)cur.pn * tstep;
    S.a_ready(cur);
    if constexpr (SP2) {
        PG8_STAGE(PG8_SB(0, 0), cB, voffB); PG8_STAGE(PG8_SB(0, 1), cB + hstep, voffB); PG8_STAGE(PG8_SA(0, 0), cA, voffA); PG8_STAGE(PG8_SA(0, 1), cA + hstep, voffA);
        if (wr == 1) PG8_BAR;
        PG8_WAIT_V(2); PG8_BAR;
        PG8_STAGE(PG8_SB(1, 0), cB + kstep, voffB); PG8_STAGE(PG8_SA(1, 0), cA + kstep, voffA); PG8_STAGE(PG8_SB(1, 1), cB + hstep + kstep, voffB);
        PG8_WAIT_V(6); PG8_BAR;
    } else {
        PG8_STAGE(PG8_SB(0, 0), cB, voffB); PG8_STAGE(PG8_SA(0, 0), cA, voffA); PG8_STAGE(PG8_SB(0, 1), cB + hstep, voffB); PG8_STAGE(PG8_SA(0, 1), cA + hstep, voffA);
        if (wr == 1) PG8_BAR;
        PG8_WAIT_V(4); PG8_BAR;
        PG8_STAGE(PG8_SB(1, 0), cB + kstep, voffB); PG8_STAGE(PG8_SA(1, 0), cA + kstep, voffA); PG8_STAGE(PG8_SB(1, 1), cB + hstep + kstep, voffB);
        PG8_WAIT_V(6); PG8_BAR;
    }
    for (;;) {
        const bool has_next = S.next(ui + 1, nxt);
        const char* nA = has_next ? (const char*)g.A + (size_t)nxt.pm * tstep : cA; const char* nB = has_next ? (const char*)g.Bt + (size_t)nxt.pn * tstep : cB;
        for (int t = 0; t < nt; t += 2) {
            const bool last = (t == nt - 2);
            const char* a1 = cA + (size_t)(t + 1) * kstep;
            const char* a2 = last ? nA : cA + (size_t)(t + 2) * kstep; const char* b2 = last ? nB : cB + (size_t)(t + 2) * kstep;
            const char* a3 = a2 + kstep; const char* b3 = b2 + kstep;
            if (last && has_next) S.a_ready(nxt);
            if (last) E.prefetch(cur, wid, lane, lds);
            if constexpr (SP2) {
            PG8_LDB(B0, 0, 0); PG8_LDB(B1, 0, 1); PG8_SCHED; PG8_LDA(At, 0, 0); PG8_STAGE(PG8_SA(1, 1), a1 + hstep, voffA);
            PG8_WAIT_V(8); PG8_WAIT_L(0); PG8_BAR; PG8_MMA(0, 0, At, B0); PG8_MMA(0, 1, At, B1); PG8_BAR; PG8_SCHED;
            PG8_LDA(At, 0, 1); PG8_STAGE(PG8_SB(0, 0), b2, voffB); PG8_STAGE(PG8_SB(0, 1), b2 + hstep, voffB); PG8_STAGE(PG8_SA(0, 0), a2, voffA);
            PG8_WAIT_V(8); PG8_WAIT_L(0); PG8_BAR; PG8_MMA(1, 0, At, B0); PG8_MMA(1, 1, At, B1); PG8_BAR; PG8_SCHED;
            PG8_LDB(B0, 1, 0); PG8_LDB(B1, 1, 1); PG8_SCHED; PG8_LDA(At, 1, 0); PG8_STAGE(PG8_SA(0, 1), a2 + hstep, voffA);
            PG8_WAIT_V(8); PG8_WAIT_L(0); PG8_BAR; PG8_MMA(0, 0, At, B0); PG8_MMA(0, 1, At, B1); PG8_BAR; PG8_SCHED;
            PG8_LDA(At, 1, 1); PG8_STAGE(PG8_SB(1, 0), b3, voffB); PG8_STAGE(PG8_SB(1, 1), b3 + hstep, voffB); PG8_STAGE(PG8_SA(1, 0), a3, voffA);
            PG8_WAIT_V(8); PG8_WAIT_L(0); PG8_BAR; PG8_MMA(1, 0, At, B0); PG8_MMA(1, 1, At, B1); PG8_BAR; PG8_SCHED;
            } else {
            PG8_LDB(B0, 0, 0); PG8_SCHED; PG8_LDA(At, 0, 0); PG8_STAGE(PG8_SA(1, 1), a1 + hstep, voffA);
            PG8_WAIT_L(8); PG8_BAR; PG8_WAIT_L(0); PG8_MMA(0, 0, At, B0); PG8_BAR; PG8_SCHED;
            PG8_LDB(B1, 0, 1); PG8_STAGE(PG8_SB(0, 0), b2, voffB);
            PG8_BAR; PG8_WAIT_L(0); PG8_MMA(0, 1, At, B1); PG8_BAR;
            PG8_LDA(At, 0, 1); PG8_STAGE(PG8_SA(0, 0), a2, voffA);
            PG8_BAR; PG8_WAIT_L(0); PG8_MMA(1, 0, At, B0); PG8_BAR; PG8_SCHED;
            PG8_STAGE(PG8_SB(0, 1), b2 + hstep, voffB);
            PG8_WAIT_V(6); PG8_BAR; PG8_MMA(1, 1, At, B1); PG8_BAR;
            PG8_LDB(B0, 1, 0); PG8_SCHED; PG8_LDA(At, 1, 0); PG8_STAGE(PG8_SA(0, 1), a2 + hstep, voffA);
            PG8_WAIT_L(8); PG8_BAR; PG8_WAIT_L(0); PG8_MMA(0, 0, At, B0); PG8_BAR; PG8_SCHED;
            PG8_LDB(B1, 1, 1); PG8_STAGE(PG8_SB(1, 0), b3, voffB);
            PG8_BAR; PG8_WAIT_L(0); PG8_MMA(0, 1, At, B1); PG8_BAR;
            PG8_LDA(At, 1, 1); PG8_STAGE(PG8_SA(1, 0), a3, voffA);
            PG8_BAR; PG8_WAIT_L(0); PG8_MMA(1, 0, At, B0); PG8_BAR; PG8_SCHED;
            PG8_STAGE(PG8_SB(1, 1), b3 + hstep, voffB);
            PG8_WAIT_V(6); PG8_BAR; PG8_MMA(1, 1, At, B1); PG8_BAR;
            }
        }
        if constexpr (ALIGN_EPI) { if (wr == 0) PG8_BAR; }
        E(acc, cur, wr, wc, fr, fq); S.done(cur);
        if (!has_next) break;
#pragma unroll
        for (int a = 0; a < 2; ++a)
#pragma unroll
            for (int b = 0; b < 2; ++b)
#pragma unroll
                for (int m = 0; m < 4; ++m)
#pragma unroll
                    for (int n = 0; n < 2; ++n) acc[a][b][m][n] = (f32x4){0.f, 0.f, 0.f, 0.f};
        cur = nxt; cA = nA; cB = nB; ++ui;
        if constexpr (ALIGN_EPI) { if (wr == 1) PG8_BAR; }
    }
    PG8_WAIT_V(0);
    if constexpr (!ALIGN_EPI) { if (wr == 0) PG8_BAR; }
    PG8_BAR;
#undef PG8_SA
#undef PG8_SB
#undef PG8_STAGE
#undef PG8_LDA
#undef PG8_LDB
#undef PG8_MMA
#undef PG8_WAIT_V
#undef PG8_WAIT_L
#undef PG8_BAR
#undef PG8_SCHED
}
}

typedef const f32x4 (&AccRef)[2][2][4][2];
#define EPI_BIG_CALL() \
    __device__ __forceinline__ void operator()(AccRef acc, const pg8::Unit& u, int wr, int wc, int fr, int fq) const { \
        asm volatile("" : "+v"(fr), "+v"(fq));     \
        const int row0 = u.pm * 256 + wr * 64 + fr; \
        _Pragma("unroll") for (int gq = 0; gq < 8 / PF; ++gq) { \
            Pre p[PF]; \
            asm volatile("" ::: "memory"); \
            _Pragma("unroll") for (int i = 0; i < PF; ++i) { const int rg = gq * PF + i; p[i] = pre_big(row0 + (rg >> 2) * 128 + (rg & 3) * 16, u.pn, wc, fq); }     \
            asm volatile("" ::: "memory"); \
            _Pragma("unroll") for (int i = 0; i < PF; ++i) { const int rg = gq * PF + i; \
                rows(acc[rg >> 2][0][rg & 3][0], acc[rg >> 2][0][rg & 3][1], acc[rg >> 2][1][rg & 3][0], acc[rg >> 2][1][rg & 3][1], row0 + (rg >> 2) * 128 + (rg & 3) * 16, u.pn, wc, fq, p[i]); } } \
    }
__device__ __forceinline__ f32x4 ssq_quarter(const float* ssq, int r, int fq) { return *(const f32x4*)(ssq + (size_t)r * 16 + 4 * fq); }
__device__ __forceinline__ float rstd_from(const f32x4& q) {
    float s = (q.x + q.y) + (q.z + q.w);
    s = sum_rows4(s);
    return rsqrtf(s * (1.0f / D) + EPS);
}

__device__ __forceinline__ void ssq_prefetch(const float* ssq, int pm, int wid, int lane, LAS unsigned char* lds) {
#pragma unroll
    for (int i = 0; i < 2; ++i)
        __builtin_amdgcn_global_load_lds((const unsigned*)(ssq + ((size_t)pm * 256 + wid * 32 + i * 16) * 16 + lane * 4), (LAS unsigned*)(lds + SSQ_LDS_OFF + (wid * 32 + i * 16) * 64), 16, 0, 0);
}
struct EpiSwiglu {
    static constexpr bool PERM = true; static constexpr int PF = 8;
    bf16_t* O; const float* ssq; LAS unsigned char* lds;
    struct Pre { f32x4 q; };
    __device__ __forceinline__ Pre pre(int r, int pn, int wc, int fq) const { Pre p; p.q = ssq_quarter(ssq, r, fq); return p; }
    __device__ __forceinline__ Pre pre_big(int r, int pn, int wc, int fq) const { Pre p; p.q = *(const LAS f32x4*)(lds + SSQ_LDS_OFF + (r & 255) * 64 + fq * 16); return p; }
    __device__ __forceinline__ void prefetch(const pg8::Unit& u, int wid, int lane, LAS unsigned char* l) const { ssq_prefetch(ssq, u.pm, wid, lane, l); }
    __device__ __forceinline__ void rows(const f32x4& c00, const f32x4& c01, const f32x4& c10, const f32x4& c11, int r, int pn, int wc, int fq, const Pre& p) const {
        const float rs = rstd_from(p.q);
        float o[8];
#pragma unroll
        for (int j = 0; j < 4; ++j) { o[j] = silu_f(c00[j] * rs) * (c10[j] * rs); o[4 + j] = silu_f(c01[j] * rs) * (c11[j] * rs); }
        u32x4 w; w.x = cvt_pk_bf16(o[0], o[1]); w.y = cvt_pk_bf16(o[2], o[3]); w.z = cvt_pk_bf16(o[4], o[5]); w.w = cvt_pk_bf16(o[6], o[7]);
        { bf16_t* dst_ = O + (size_t)r * FF + pn * 128 + wc * 32 + 8 * fq;
          asm volatile("global_store_dwordx4 %0, %1, off sc1\n\ts_nop 1" :: "v"(dst_), "v"(w) : "memory"); }
    }
    EPI_BIG_CALL()
};

template <int MODE> struct EpiResid {
    static constexpr bool PERM = true; static constexpr int PF = (MODE == 0) ? 2 : 4;
    const float* resP; const float* resS;
    float* out; bf16_t* xb; float* ssq; float scale;
    struct Pre { f32x4 r00, r01, r10, r11; u32x4 a, b; };
    __device__ __forceinline__ Pre pre(int r, int pn, int wc, int fq) const {
        Pre p; const size_t off = (size_t)r * D + pn * 256 + wc * 32 + 8 * fq;
        if (MODE == 0) { const float* rbase = (r >= MP) ? resS - (size_t)MP * D : resP;
            p.r00 = *(const f32x4*)(rbase + off); p.r01 = *(const f32x4*)(rbase + off + 4); p.r10 = *(const f32x4*)(rbase + off + 128); p.r11 = *(const f32x4*)(rbase + off + 132); }
        else { p.a = *(const u32x4*)(xb + off); p.b = *(const u32x4*)(xb + off + 128); }
        return p;
    }
    __device__ __forceinline__ Pre pre_big(int r, int pn, int wc, int fq) const { return pre(r, pn, wc, fq); }
    __device__ __forceinline__ void prefetch(const pg8::Unit&, int, int, LAS unsigned char*) const {}
    __device__ __forceinline__ void rows(const f32x4& c00, const f32x4& c01, const f32x4& c10, const f32x4& c11, int r, int pn, int wc, int fq, const Pre& p) const {
        const size_t off = (size_t)r * D + pn * 256 + wc * 32 + 8 * fq;
        f32x4 r00, r01, r10, r11;
        if (MODE == 0) { r00 = p.r00; r01 = p.r01; r10 = p.r10; r11 = p.r11; }
        else {
            const u32x4 a = p.a, b = p.b;
            r00 = (f32x4){__uint_as_float(a.x << 16), __uint_as_float(a.x & 0xffff0000u), __uint_as_float(a.y << 16), __uint_as_float(a.y & 0xffff0000u)};
            r01 = (f32x4){__uint_as_float(a.z << 16), __uint_as_float(a.z & 0xffff0000u), __uint_as_float(a.w << 16), __uint_as_float(a.w & 0xffff0000u)};
            r10 = (f32x4){__uint_as_float(b.x << 16), __uint_as_float(b.x & 0xffff0000u), __uint_as_float(b.y << 16), __uint_as_float(b.y & 0xffff0000u)};
            r11 = (f32x4){__uint_as_float(b.z << 16), __uint_as_float(b.z & 0xffff0000u), __uint_as_float(b.w << 16), __uint_as_float(b.w & 0xffff0000u)};
        }
        const f32x4 y00 = r00 + c00 * scale, y01 = r01 + c01 * scale, y10 = r10 + c10 * scale, y11 = r11 + c11 * scale;
        if (MODE == 2) {
            __builtin_nontemporal_store(y00, (f32x4*)(out + off)); __builtin_nontemporal_store(y01, (f32x4*)(out + off + 4)); __builtin_nontemporal_store(y10, (f32x4*)(out + off + 128)); __builtin_nontemporal_store(y11, (f32x4*)(out + off + 132));
        } else {
            u32x4 w0, w1;
            w0.x = cvt_pk_bf16(y00[0], y00[1]); w0.y = cvt_pk_bf16(y00[2], y00[3]); w0.z = cvt_pk_bf16(y01[0], y01[1]); w0.w = cvt_pk_bf16(y01[2], y01[3]);
            w1.x = cvt_pk_bf16(y10[0], y10[1]); w1.y = cvt_pk_bf16(y10[2], y10[3]); w1.z = cvt_pk_bf16(y11[0], y11[1]); w1.w = cvt_pk_bf16(y11[2], y11[3]);
            *(u32x4*)(xb + off) = w0; *(u32x4*)(xb + off + 128) = w1;
            float ss = (y00[0] * y00[0] + y00[1] * y00[1]) + (y00[2] * y00[2] + y00[3] * y00[3]) + (y01[0] * y01[0] + y01[1] * y01[1]) + (y01[2] * y01[2] + y01[3] * y01[3])
                     + (y10[0] * y10[0] + y10[1] * y10[1]) + (y10[2] * y10[2] + y10[3] * y10[3]) + (y11[0] * y11[0] + y11[1] * y11[1]) + (y11[2] * y11[2] + y11[3] * y11[3]);
            ss = sum_rows4(ss);
            if (fq == 0) ssq[(size_t)r * 16 + pn * 4 + wc] = ss;
        }
    }
    EPI_BIG_CALL()
};

struct EpiInProj {
    static constexpr bool PERM = true; static constexpr int PF = 1;
    unsigned char* ws; const float* gq; const float* gk; float* out; LAS unsigned char* lds;
    struct Pre { f32x4 q; };
    __device__ __forceinline__ Pre pre(int r, int pn, int wc, int fq) const { Pre p; p.q = ssq_quarter((const float*)(ws + WS_SSQ1), r, fq); return p; }
    __device__ __forceinline__ Pre pre_big(int r, int pn, int wc, int fq) const { Pre p; p.q = *(const LAS f32x4*)(lds + SSQ_LDS_OFF + (r & 255) * 64 + fq * 16); return p; }
    __device__ __forceinline__ void prefetch(const pg8::Unit& u, int wid, int lane, LAS unsigned char* l) const { ssq_prefetch((const float*)(ws + WS_SSQ1), u.pm, wid, lane, l); }
    __device__ __forceinline__ void rows(const f32x4& c00, const f32x4& c01, const f32x4& c10, const f32x4& c11, int r, int pn, int wc, int fq, const Pre& p) const {
        const bool sample = r >= MP;
        int b, t, pos;
        if (sample) { const int rr = r - MP; b = rr >> 4; t = rr & 15; pos = PAST + t; } else { b = r >> 13; t = r & (TP - 1); pos = t; }
        const float rs = rstd_from(p.q);
        if (pn < 4) {
            const int ch0 = pn * 128 + wc * 32 + 8 * fq;
            float o[8];
#pragma unroll
            for (int j = 0; j < 4; ++j) { o[j] = (c00[j] * rs) * sigmoid_f(c10[j] * rs); o[4 + j] = (c01[j] * rs) * sigmoid_f(c11[j] * rs); }
            u32x4 w; w.x = cvt_pk_bf16(o[0], o[1]); w.y = cvt_pk_bf16(o[2], o[3]); w.z = cvt_pk_bf16(o[4], o[5]); w.w = cvt_pk_bf16(o[6], o[7]);
            bf16_t* ud = sample ? (bf16_t*)(ws + WS_US) + ((size_t)(b * USROWS + HIST + t)) * CC + ch0 : (bf16_t*)(ws + WS_UP) + (size_t)r * CC + ch0;
            *(u32x4*)ud = w;
            float* dst = nullptr;
            if (sample) dst = out + O_CSS + ((size_t)(b * HIST + (HIST - TS) + t)) * CC + ch0;
            else if (t >= TP - HIST) dst = out + O_CSP + ((size_t)(b * HIST + (t - (TP - HIST)))) * CC + ch0;
            if (dst) { *(f32x4*)dst = (f32x4){o[0], o[1], o[2], o[3]}; *(f32x4*)(dst + 4) = (f32x4){o[4], o[5], o[6], o[7]}; }
        } else if (pn < 6 || wc < 2) {
            const bool isq = pn < 6;
            const int h = isq ? (pn - 4) * 4 + wc : wc;
            const float* gg = isq ? gq : gk;
            const f32x4 g00 = *(const f32x4*)(gg + 8 * fq), g01 = *(const f32x4*)(gg + 8 * fq + 4), g10 = *(const f32x4*)(gg + 32 + 8 * fq), g11 = *(const f32x4*)(gg + 32 + 8 * fq + 4);
            const float osc = isq ? QSCALE : 1.0f;
            f32x4 v00 = c00 * rs, v01 = c01 * rs, v10 = c10 * rs, v11 = c11 * rs;
            float ss = (v00[0] * v00[0] + v00[1] * v00[1]) + (v00[2] * v00[2] + v00[3] * v00[3]) + (v01[0] * v01[0] + v01[1] * v01[1]) + (v01[2] * v01[2] + v01[3] * v01[3])
                     + (v10[0] * v10[0] + v10[1] * v10[1]) + (v10[2] * v10[2] + v10[3] * v10[3]) + (v11[0] * v11[0] + v11[1] * v11[1]) + (v11[2] * v11[2] + v11[3] * v11[3]);
            ss = sum_rows4(ss);
            const float hn = rsqrtf(ss * (1.0f / HD) + EPS);
            v00 = v00 * hn * g00; v01 = v01 * hn * g01; v10 = v10 * hn * g10; v11 = v11 * hn * g11;
            f32x4 p0, p1;
#pragma unroll
            for (int j = 0; j < 4; ++j) { p0[j] = __shfl_xor(v00[j], 16); p1[j] = __shfl_xor(v01[j], 16); }
            if (fq < 2) {
                const f32x2* rp = (const f32x2*)(ws + WS_ROPE) + (size_t)pos * 8;
                const float sg = (fq == 0) ? -1.0f : 1.0f;
#pragma unroll
                for (int j = 0; j < 4; ++j) {
                    const f32x2 cs0 = rp[j], cs1 = rp[4 + j];
                    v00[j] = v00[j] * cs0.x + sg * p0[j] * cs0.y;
                    v01[j] = v01[j] * cs1.x + sg * p1[j] * cs1.y;
                }
            }
            u32x4 w0, w1;
            w0.x = cvt_pk_bf16(v00[0] * osc, v00[1] * osc); w0.y = cvt_pk_bf16(v00[2] * osc, v00[3] * osc); w0.z = cvt_pk_bf16(v01[0] * osc, v01[1] * osc); w0.w = cvt_pk_bf16(v01[2] * osc, v01[3] * osc);
            w1.x = cvt_pk_bf16(v10[0] * osc, v10[1] * osc); w1.y = cvt_pk_bf16(v10[2] * osc, v10[3] * osc); w1.z = cvt_pk_bf16(v11[0] * osc, v11[1] * osc); w1.w = cvt_pk_bf16(v11[2] * osc, v11[3] * osc);
            if (isq) {
                bf16_t* dst = (bf16_t*)(ws + WS_Q) + (size_t)r * 512 + h * 64 + 8 * fq;
                *(u32x4*)dst = w0; *(u32x4*)(dst + 32) = w1;
            } else {
                bf16_t* dst = sample ? (bf16_t*)(ws + WS_KS) + ((size_t)(b * KSROWS + WIN + t)) * 128 + h * 64 + 8 * fq : (bf16_t*)(ws + WS_KP) + (size_t)r * 128 + h * 64 + 8 * fq;
                *(u32x4*)dst = w0; *(u32x4*)(dst + 32) = w1;
                float* od = nullptr;
                if (sample) od = out + O_KWS + ((size_t)((b * WIN + (WIN - TS) + t) * 2 + h)) * 64 + 8 * fq;
                else if (t >= TP - WIN) od = out + O_KWP + ((size_t)((b * WIN + (t - (TP - WIN))) * 2 + h)) * 64 + 8 * fq;
                if (od) { *(f32x4*)od = v00; *(f32x4*)(od + 4) = v01; *(f32x4*)(od + 32) = v10; *(f32x4*)(od + 36) = v11; }
            }
        } else {
            const int kh = wc - 2;
            const f32x4 v00 = c00 * rs, v01 = c01 * rs, v10 = c10 * rs, v11 = c11 * rs;
            bf16_t* vt; size_t vs;
            if (sample) { vt = (bf16_t*)(ws + WS_VTS) + ((size_t)((b * 2 + kh) * 64)) * KSROWS + WIN + t; vs = KSROWS; }
            else { vt = (bf16_t*)(ws + WS_VTP) + ((size_t)((b * 2 + kh) * (TP / 64) + (t >> 6))) * 4096 + (t & 63); vs = 64; }
#pragma unroll
            for (int j = 0; j < 4; ++j) {
                vt[(size_t)(8 * fq + j) * vs] = f2bf(v00[j]); vt[(size_t)(8 * fq + 4 + j) * vs] = f2bf(v01[j]);
                vt[(size_t)(32 + 8 * fq + j) * vs] = f2bf(v10[j]); vt[(size_t)(32 + 8 * fq + 4 + j) * vs] = f2bf(v11[j]);
            }
            float* od = nullptr;
            if (sample) od = out + O_VWS + ((size_t)((b * WIN + (WIN - TS) + t) * 2 + kh)) * 64 + 8 * fq;
            else if (t >= TP - WIN) od = out + O_VWP + ((size_t)((b * WIN + (t - (TP - WIN))) * 2 + kh)) * 64 + 8 * fq;
            if (od) { *(f32x4*)od = v00; *(f32x4*)(od + 4) = v01; *(f32x4*)(od + 32) = v10; *(f32x4*)(od + 36) = v11; }
        }
    }
    EPI_BIG_CALL()
};

template <int KS, int MT, class Epi>
__device__ __forceinline__ void small_gemm(const bf16_t* A, const bf16_t* Bt, int N, int K, const Epi& E, LAS unsigned char* lds, int bid, int G, int wave, int lane, int wpc_in = 0) {
    constexpr int MTN = MS / (16 * MT);
    const int NT = MTN * (N / 256) * 4, NI = NT * KS, wpc = wpc_in ? wpc_in : (NI + G - 1) / G, nb = K / 64;
    asm volatile("" : "+v"(lane));
    const int fr = lane & 15, g = lane >> 4;
    for (int i0 = 0; i0 < wpc; i0 += 8) {
        const int i = i0 + wave, item = bid * wpc + i;
        const bool active = (i < wpc) && (item < NI);
        const int t = active ? item / KS : 0, ksl = item % KS;
        const int mt = t % MTN, nq = t / MTN, pn = nq >> 2, wc = nq & 3;
        const int r = MP + mt * (16 * MT) + fr;
        f32x4 acc[MT][2][2];
#pragma unroll
        for (int mi = 0; mi < MT; ++mi)
#pragma unroll
            for (int bj = 0; bj < 2; ++bj)
#pragma unroll
                for (int n = 0; n < 2; ++n) acc[mi][bj][n] = (f32x4){0.f, 0.f, 0.f, 0.f};
        if (active) {
            const int b0 = (nb * ksl) / KS, b1 = (nb * (ksl + 1)) / KS;
            const bf16_t* ap = A + (size_t)r * K + g * 8;
            const bf16_t* bp = Bt + (size_t)(pn * 256 + wc * 32 + 8 * (fr >> 2) + (fr & 3)) * K + g * 8;
            bf16x8 afA[2][MT], bfA[2][2][2], afB[2][MT], bfB[2][2][2];
#define SG_LOAD(af, bf, kb) do { const int k0_ = (kb) * 64; _Pragma("unroll") for (int s_ = 0; s_ < 2; ++s_) { \
            _Pragma("unroll") for (int mi = 0; mi < MT; ++mi) af[s_][mi] = *(const bf16x8*)(ap + (size_t)(16 * mi) * K + k0_ + s_ * 32); \
            _Pragma("unroll") for (int bj = 0; bj < 2; ++bj) _Pragma("unroll") for (int n = 0; n < 2; ++n) bf[s_][bj][n] = *(const bf16x8*)(bp + (size_t)(4 * n + 128 * bj) * K + k0_ + s_ * 32); } } while (0)
#define SG_MMA(af, bf) do { _Pragma("unroll") for (int s_ = 0; s_ < 2; ++s_) _Pragma("unroll") for (int bj = 0; bj < 2; ++bj) _Pragma("unroll") for (int n = 0; n < 2; ++n) { \
            _Pragma("unroll") for (int mi = 0; mi < MT; ++mi) acc[mi][bj][n] = __builtin_amdgcn_mfma_f32_16x16x32_bf16(bf[s_][bj][n], af[s_][mi], acc[mi][bj][n], 0, 0, 0); } } while (0)
            SG_LOAD(afA, bfA, b0);
            for (int kb = b0; kb < b1; kb += 2) {
                const int kb1 = (kb + 1 < b1) ? kb + 1 : b1 - 1, kb2 = (kb + 2 < b1) ? kb + 2 : b1 - 1;
                __builtin_amdgcn_sched_barrier(0);
                SG_LOAD(afB, bfB, kb1);
                __builtin_amdgcn_sched_barrier(0);
                SG_MMA(afA, bfA);
                __builtin_amdgcn_sched_barrier(0);
                SG_LOAD(afA, bfA, kb2);
                __builtin_amdgcn_sched_barrier(0);
                if (kb + 1 < b1) SG_MMA(afB, bfB);
            }
#undef SG_LOAD
#undef SG_MMA
        }
        if constexpr (KS > 1) {
            static_assert(KS == 1 || KS == 8, "KS: 1 or 8 (all eight waves of the workgroup on one tile)");
            LAS f32x4* red = (LAS f32x4*)lds;
            if (ksl != 0) {
#pragma unroll
                for (int mi = 0; mi < MT; ++mi)
#pragma unroll
                    for (int bj = 0; bj < 2; ++bj)
#pragma unroll
                        for (int n = 0; n < 2; ++n) red[(ksl - 1) * (MT * 256) + ((mi * 2 + bj) * 2 + n) * 64 + lane] = acc[mi][bj][n];
            }
            __syncthreads();
            if (ksl == 0) {
#pragma unroll
                for (int q = 0; q < KS - 1; ++q)
#pragma unroll
                    for (int mi = 0; mi < MT; ++mi)
#pragma unroll
                        for (int bj = 0; bj < 2; ++bj)
#pragma unroll
                            for (int n = 0; n < 2; ++n) acc[mi][bj][n] += red[q * (MT * 256) + ((mi * 2 + bj) * 2 + n) * 64 + lane];
            }
            __syncthreads();
        }
        if (active && ksl == 0) {
#pragma unroll
            for (int mi = 0; mi < MT; ++mi) { const typename Epi::Pre p = E.pre(r + 16 * mi, pn, wc, g); E.rows(acc[mi][0][0], acc[mi][0][1], acc[mi][1][0], acc[mi][1][1], r + 16 * mi, pn, wc, g, p); }
        }
    }
}

struct TItem { const float* W; const float* g; bf16_t* WT; int Nsrc, srccol0, K, destrow0, k0; };
__device__ __forceinline__ void p0_tload(const TItem& t, float (&v)[32], int lane) {
#pragma unroll
    for (int i = 0; i < 32; ++i) { const int kk = 2 * i + (lane >> 5); v[i] = t.W[(size_t)(t.k0 + kk) * t.Nsrc + t.srccol0 + (lane & 31)]; }
}
__device__ __forceinline__ void p0_tfinish(const TItem& t, const float (&v)[32], LAS float* scr, int lane) {
#pragma unroll
    for (int i = 0; i < 32; ++i) { const int kk = 2 * i + (lane >> 5); scr[kk * 33 + (lane & 31)] = v[i]; }
    asm volatile("s_waitcnt lgkmcnt(0)" ::: "memory");
    const int c = lane & 7;
    f32x4 g0 = (f32x4){1.f, 1.f, 1.f, 1.f}, g1 = g0;
    if (t.g) { g0 = *(const f32x4*)(t.g + t.k0 + 8 * c); g1 = *(const f32x4*)(t.g + t.k0 + 8 * c + 4); }
#pragma unroll
    for (int j = 0; j < 4; ++j) { const int n = (lane >> 3) + 8 * j; const LAS float* sp = scr + (8 * c) * 33 + n;
        u32x4 o; o.x = cvt_pk_bf16(sp[0 * 33] * g0.x, sp[1 * 33] * g0.y); o.y = cvt_pk_bf16(sp[2 * 33] * g0.z, sp[3 * 33] * g0.w); o.z = cvt_pk_bf16(sp[4 * 33] * g1.x, sp[5 * 33] * g1.y); o.w = cvt_pk_bf16(sp[6 * 33] * g1.z, sp[7 * 33] * g1.w);
        *(u32x4*)(t.WT + (size_t)(t.destrow0 + n) * t.K + t.k0 + 8 * c) = o; }
    asm volatile("s_waitcnt lgkmcnt(0)" ::: "memory");
}
__device__ __forceinline__ int src_up(int nb) { const int pn = nb >> 3, p0 = (nb & 7) * 32, bj = p0 >> 7; return bj * FF + pn * 128 + (p0 & 127); }
__device__ __forceinline__ int src_in(int nb) {
    const int pn = nb >> 3, p0 = (nb & 7) * 32, bj = p0 >> 7, wc = (p0 & 127) >> 5;
    if (pn < 4) return bj * CC + pn * 128 + wc * 32;
    if (pn < 6) return 1024 + ((pn - 4) * 4 + wc) * 64 + bj * 32;
    return (wc < 2) ? 1536 + wc * 64 + bj * 32 : 1664 + (wc - 2) * 64 + bj * 32;
}

struct Args { const float* in[21]; float* out; unsigned char* ws; float inv[8]; };

constexpr int I_UP = (D / 64) * (NUP / 32), I_DN = (FF / 64) * (D / 32), I_IN = (D / 64) * (NIN / 32), I_O = (D / 64) * (D / 32);
constexpr int NITEMS = 2 * I_UP + 2 * I_DN + I_IN + I_O;
constexpr int NITEMS_EARLY = I_UP + I_DN + I_IN + I_O;
__device__ __forceinline__ TItem p0_decode(const Args& a, int it) {
    unsigned char* ws = a.ws; int r = it < NITEMS ? it : NITEMS - 1; TItem t;
    if (r < I_UP) { const int nblk = NUP / 32, kb = r / nblk, nb = r % nblk; t = TItem{a.in[6], a.in[5], (bf16_t*)(ws + WS_W1T), NUP, src_up(nb), D, nb * 32, kb * 64}; return t; } r -= I_UP;
    if (r < I_DN) { const int nblk = D / 32, kb = r / nblk, nb = r % nblk; t = TItem{a.in[7], nullptr, (bf16_t*)(ws + WS_W2T), D, nb * 32, FF, nb * 32, kb * 64}; return t; } r -= I_DN;
    if (r < I_IN) { const int nblk = NIN / 32, kb = r / nblk, nb = r % nblk; t = TItem{a.in[9], a.in[8], (bf16_t*)(ws + WS_WINT), NIN, src_in(nb), D, nb * 32, kb * 64}; return t; } r -= I_IN;
    if (r < I_O) { const int nblk = D / 32, kb = r / nblk, nb = r % nblk; t = TItem{a.in[17], nullptr, (bf16_t*)(ws + WS_WOT), D, nb * 32, D, nb * 32, kb * 64}; return t; } r -= I_O;
    if (r < I_UP) { const int nblk = NUP / 32, kb = r / nblk, nb = r % nblk; t = TItem{a.in[19], a.in[18], (bf16_t*)(ws + WS_W3T), NUP, src_up(nb), D, nb * 32, kb * 64}; return t; } r -= I_UP;
    { const int nblk = D / 32, kb = r / nblk, nb = r % nblk; t = TItem{a.in[20], nullptr, (bf16_t*)(ws + WS_W4T), D, nb * 32, FF, nb * 32, kb * 64}; return t; }
}
__device__ __forceinline__ void weights_convert(const Args& a, LAS unsigned char* lds, int it0, int it1, int gw, int NGW, int wave, int lane) {
    LAS float* scr = (LAS float*)(lds + wave * 16896);
    for (int it = it0 + gw; it < it1; it += 2 * NGW) {
        const TItem t0 = p0_decode(a, it), t1 = p0_decode(a, it + NGW < it1 ? it + NGW : it);
        float v0[32], v1[32];
        p0_tload(t0, v0, lane); p0_tload(t1, v1, lane);
        p0_tfinish(t0, v0, scr, lane);
        if (it + NGW < it1) p0_tfinish(t1, v1, scr + 64 * 33, lane);
    }
}

template <int NR> __device__ __forceinline__ void x_rows(const Args& a, int m0, int lane) {
    bf16_t* AB = (bf16_t*)(a.ws + WS_AB); float* ssq0 = (float*)(a.ws + WS_SSQ0);
    f32x4 v[NR][4];
#pragma unroll
    for (int q = 0; q < NR; ++q) { const int m = m0 + q;
        const float* xrow = (m < MP) ? a.in[0] + (size_t)m * D : a.in[1] + (size_t)(m - MP) * D;
        const f32x4* xr = (const f32x4*)xrow + lane;
#pragma unroll
        for (int j = 0; j < 4; ++j) v[q][j] = xr[64 * j]; }
    float t[NR + 1];
#pragma unroll
    for (int q = 0; q < NR; ++q) { float s = 0.f;
#pragma unroll
        for (int j = 0; j < 4; ++j) s += (v[q][j].x * v[q][j].x + v[q][j].y * v[q][j].y) + (v[q][j].z * v[q][j].z + v[q][j].w * v[q][j].w);
        t[q] = s; }
    t[NR] = 0.f;
#pragma unroll
    for (int q = 0; q < NR; q += 2) wave_sum2(t[q], t[q + 1]);
#pragma unroll
    for (int q = 0; q < NR; ++q) { const int m = m0 + q;
        u32x2* o8 = (u32x2*)(AB + (size_t)m * D) + lane;
#pragma unroll
        for (int j = 0; j < 4; ++j) { u32x2 w; w.x = cvt_pk_bf16(v[q][j].x, v[q][j].y); w.y = cvt_pk_bf16(v[q][j].z, v[q][j].w); o8[64 * j] = w; }
        if (lane < 16) ssq0[(size_t)m * 16 + lane] = (lane == 0) ? t[q] : 0.f; }
}

__device__ __forceinline__ void p0_prologue(const Args& a, LAS unsigned char* lds) {
    int tid = threadIdx.x; asm volatile("" : "+v"(tid));
    const int lane = tid & 63, wave = tid >> 6;
    const int gw = blockIdx.x * 8 + wave, NGW = gridDim.x * 8;
    unsigned char* ws = a.ws;
    weights_convert(a, lds, 0, NITEMS_EARLY, gw, NGW, wave, lane);
    for (int m0 = gw * 8; m0 < MP; m0 += NGW * 8) x_rows<8>(a, m0, lane);
    for (int m = MP + gw; m < M; m += NGW) x_rows<1>(a, m, lane);
    const int gt = blockIdx.x * 512 + tid, NGT = gridDim.x * 512;
    f32x2* rope = (f32x2*)(ws + WS_ROPE);
    for (int i = gt; i < TP * 8; i += NGT) {
        const int pos = i >> 3, k = i & 7;
        const float ang = (float)pos * a.inv[k];
        const double rev = (double)ang * 0.15915494309189535;
        const float fr = (float)(rev - rint(rev));
        rope[i] = (f32x2){__builtin_amdgcn_cosf(fr), __builtin_amdgcn_sinf(fr)};
    }
    bf16_t* KS = (bf16_t*)(ws + WS_KS); bf16_t* VTS = (bf16_t*)(ws + WS_VTS); bf16_t* US = (bf16_t*)(ws + WS_US);
    for (int i = gt; i < NBS * WIN * 128; i += NGT) {
        const int c = i & 127, row = (i >> 7) & (WIN - 1), b = i >> 14;
        const float kv = a.in[3][i], vv = a.in[4][i];
        KS[((size_t)(b * KSROWS + row)) * 128 + c] = f2bf(kv);
        VTS[((size_t)(b * 128 + c)) * KSROWS + row] = f2bf(vv);
        if (row >= TS) { a.out[O_KWS + ((size_t)(b * WIN + row - TS)) * 128 + c] = kv; a.out[O_VWS + ((size_t)(b * WIN + row - TS)) * 128 + c] = vv; }
    }
    for (int i = gt; i < NBS * 128 * 16; i += NGT) { const int k = i & 15, rowd = i >> 4; VTS[(size_t)rowd * KSROWS + WIN + TS + k] = 0; }
    for (int i = gt; i < NBS * HIST * CC; i += NGT) {
        const int c = i & (CC - 1), row = (i >> 9) % HIST, b = (i >> 9) / HIST;
        const float uv = a.in[2][i];
        US[((size_t)(b * USROWS + row)) * CC + c] = f2bf(uv);
        if (row >= TS) a.out[O_CSS + ((size_t)(b * HIST + row - TS)) * CC + c] = uv;
    }
}

constexpr int ATT_VT_OFF = 192 * 128, ATT_VT_STRIDE = 400, ATT_BUF = ATT_VT_OFF + 64 * ATT_VT_STRIDE;
constexpr int ATT_UNITS_P = NBP * (TP / 64) * 2, ATT_UNITS = ATT_UNITS_P + NBS * 2;
constexpr int CONV_UNITS = MP / 16 + NBS;

struct AttUnit { const bf16_t* kb; const bf16_t* vt; int nkt; bool sample; };
__device__ __forceinline__ AttUnit att_decode(unsigned char* ws, int unit) {
    AttUnit u;
    if (unit < ATT_UNITS_P) { const int kh = unit & 1, c = (unit >> 1) & 127, b = unit >> 8, cs = c >= 2 ? c - 2 : 0;
        u.nkt = (c - cs + 1) * 4; u.sample = false;
        u.kb = (const bf16_t*)(ws + WS_KP) + ((size_t)(b * TP + cs * 64)) * 128 + kh * 64;
        u.vt = (const bf16_t*)(ws + WS_VTP) + ((size_t)((b * 2 + kh) * (TP / 64) + cs)) * 4096; }
    else { const int p = unit - ATT_UNITS_P, b = p >> 1, kh = p & 1;
        u.nkt = 9; u.sample = true;
        u.kb = (const bf16_t*)(ws + WS_KS) + ((size_t)(b * KSROWS)) * 128 + kh * 64;
        u.vt = (const bf16_t*)(ws + WS_VTS) + ((size_t)((b * 2 + kh) * 64)) * KSROWS; }
    return u;
}
__device__ __forceinline__ void att_stage_load(const AttUnit& u, int tid, u32x4 (&kp)[3], u32x4 (&vp)[3]) {
    const int nk = u.nkt * 16;
#pragma unroll
    for (int i = 0; i < 3; ++i) {
        const int p = tid + 512 * i; int row = p >> 3; const int ch = p & 7; row = row < nk ? row : nk - 1;
        kp[i] = *(const u32x4*)(u.kb + (size_t)row * 128 + ch * 8);
        if (u.sample) { int pp = p < 1280 ? p : 1279; const int d = pp / 20, q = pp - d * 20; vp[i] = *(const u32x4*)(u.vt + (size_t)d * KSROWS + q * 8); }
        else { const int jmax = (u.nkt >> 2) - 1, j = i < jmax ? i : jmax; vp[i] = *(const u32x4*)(u.vt + (size_t)j * 4096 + (p & 511) * 8); }
    }
}
__device__ __forceinline__ void att_stage_write(const AttUnit& u, int tid, LAS unsigned char* buf, const u32x4 (&kp)[3], const u32x4 (&vp)[3]) {
    const int nk = u.nkt * 16;
#pragma unroll
    for (int i = 0; i < 3; ++i) {
        const int p = tid + 512 * i; int row = p >> 3; const int ch = p & 7; row = row < nk ? row : nk - 1;
        *(LAS u32x4*)(buf + row * 128 + ((ch ^ ((row >> 1) & 7)) << 4)) = kp[i];
        if (u.sample) { int pp = p < 1280 ? p : 1279; const int d = pp / 20, q = pp - d * 20; *(LAS u32x4*)(buf + ATT_VT_OFF + d * ATT_VT_STRIDE + q * 16) = vp[i]; }
        else { const int jmax = (u.nkt >> 2) - 1, j = i < jmax ? i : jmax; const int d = (p & 511) >> 3, q = p & 7; *(LAS u32x4*)(buf + ATT_VT_OFF + d * ATT_VT_STRIDE + j * 128 + q * 16) = vp[i]; }
    }
}
__device__ __forceinline__ void attn_compute(const bf16x8 (&qf)[2][2], LAS const unsigned char* buf, int nkt, float sink0, float sink1, bf16_t* o0, bf16_t* o1, int lane) {
    const int fr = lane & 15, g = lane >> 4;
    f32x4 S[2][12];
    const float NEG = -INFINITY;
#pragma unroll
    for (int kt = 0; kt < 12; ++kt) {
        const int ktc = kt < nkt ? kt : nkt - 1, row = ktc * 16 + fr, sw = (row >> 1) & 7;
        const bf16x8 k0 = *(LAS const bf16x8*)(buf + row * 128 + ((g ^ sw) << 4)), k1 = *(LAS const bf16x8*)(buf + row * 128 + (((g + 4) ^ sw) << 4));
        const bool ok = kt < nkt;
#pragma unroll
        for (int qt = 0; qt < 2; ++qt) {
            f32x4 c = (f32x4){0.f, 0.f, 0.f, 0.f};
            c = __builtin_amdgcn_mfma_f32_16x16x32_bf16(k0, qf[qt][0], c, 0, 0, 0);
            c = __builtin_amdgcn_mfma_f32_16x16x32_bf16(k1, qf[qt][1], c, 0, 0, 0);
            S[qt][kt] = ok ? c : (f32x4){NEG, NEG, NEG, NEG};
        }
    }
    bf16x8 pf[2][6]; float linv[2];
#pragma unroll
    for (int qt = 0; qt < 2; ++qt) {
        const float sink = qt ? sink1 : sink0;
        float mx = sink;
#pragma unroll
        for (int kt = 0; kt < 12; ++kt) mx = fmaxf(mx, fmaxf(fmaxf(S[qt][kt][0], S[qt][kt][1]), fmaxf(S[qt][kt][2], S[qt][kt][3])));
        mx = max_rows4(mx);
        float l = 0.f;
#pragma unroll
        for (int kt = 0; kt < 12; ++kt) {
#pragma unroll
            for (int j = 0; j < 4; ++j) { const float p = __builtin_amdgcn_exp2f(S[qt][kt][j] - mx); S[qt][kt][j] = p; l += p; }
        }
        l = sum_rows4(l);
        l += __builtin_amdgcn_exp2f(sink - mx);
        linv[qt] = 1.0f / l;
#pragma unroll
        for (int kk = 0; kk < 6; ++kk) {
            u32x4 w; w.x = cvt_pk_bf16(S[qt][2 * kk][0], S[qt][2 * kk][1]); w.y = cvt_pk_bf16(S[qt][2 * kk][2], S[qt][2 * kk][3]);
            w.z = cvt_pk_bf16(S[qt][2 * kk + 1][0], S[qt][2 * kk + 1][1]); w.w = cvt_pk_bf16(S[qt][2 * kk + 1][2], S[qt][2 * kk + 1][3]);
            pf[qt][kk] = __builtin_bit_cast(bf16x8, w);
        }
    }
    f32x4 O[2][4];
    const int kkmax = (nkt - 1) >> 1;
    LAS const unsigned char* vb = buf + ATT_VT_OFF + fr * ATT_VT_STRIDE + g * 8;
#pragma unroll
    for (int dt = 0; dt < 4; ++dt) {
        O[0][dt] = (f32x4){0.f, 0.f, 0.f, 0.f}; O[1][dt] = (f32x4){0.f, 0.f, 0.f, 0.f};
#pragma unroll
        for (int kk = 0; kk < 6; ++kk) {
            const int kkc = kk < kkmax ? kk : kkmax;
            const u32x2 a0 = *(LAS const u32x2*)(vb + dt * 16 * ATT_VT_STRIDE + kkc * 64), a1 = *(LAS const u32x2*)(vb + dt * 16 * ATT_VT_STRIDE + kkc * 64 + 32);
            u32x4 aw; aw.x = a0.x; aw.y = a0.y; aw.z = a1.x; aw.w = a1.y;
            const bf16x8 af = __builtin_bit_cast(bf16x8, aw);
            O[0][dt] = __builtin_amdgcn_mfma_f32_16x16x32_bf16(af, pf[0][kk], O[0][dt], 0, 0, 0);
            O[1][dt] = __builtin_amdgcn_mfma_f32_16x16x32_bf16(af, pf[1][kk], O[1][dt], 0, 0, 0);
        }
    }
#pragma unroll
    for (int qt = 0; qt < 2; ++qt) {
        bf16_t* ob = (qt ? o1 : o0) + (size_t)fr * D + 4 * g;
#pragma unroll
        for (int dt = 0; dt < 4; ++dt) {
            const f32x4 v = O[qt][dt] * linv[qt];
            u32x2 w; w.x = cvt_pk_bf16(v[0], v[1]); w.y = cvt_pk_bf16(v[2], v[3]);
            *(u32x2*)(ob + dt * 16) = w;
        }
    }
}

__device__ __forceinline__ void attn_phase(const Args& a, LAS unsigned char* lds, int tid, int first, int G) {
    asm volatile("" : "+v"(tid));
    unsigned char* ws = a.ws;
    const int lane = tid & 63, wave = __builtin_amdgcn_readfirstlane(tid >> 6), fr = lane & 15, g = lane >> 4;
    const bf16_t* Q = (const bf16_t*)(ws + WS_Q); bf16_t* MIX = (bf16_t*)(ws + WS_MIX);
    const float* sinks = a.in[12];
    if (first >= ATT_UNITS) return;
    AttUnit cur = att_decode(ws, first);
    u32x4 kp[3], vp[3];
    att_stage_load(cur, tid, kp, vp);
    int par = 0;
    for (int unit = first; unit < ATT_UNITS; unit += G, par ^= 1) {
        LAS unsigned char* buf = lds + par * ATT_BUF;
        att_stage_write(cur, tid, buf, kp, vp);
        const bf16_t* q0; const bf16_t* q1; bf16_t* o0; bf16_t* o1; float sk0, sk1; bool work;
        if (!cur.sample) { const int kh = unit & 1, c = (unit >> 1) & 127, b = unit >> 8, h = kh * 4 + (wave >> 1), tok0 = c * 64 + (wave & 1) * 32;
            q0 = Q + ((size_t)(b * TP + tok0)) * 512 + h * 64; q1 = q0 + 16 * 512;
            o0 = MIX + ((size_t)(b * TP + tok0)) * D + 512 + h * 64; o1 = o0 + 16 * D; sk0 = sk1 = sinks[h] * LOG2E; work = true; }
        else { const int p = unit - ATT_UNITS_P, b = p >> 1, kh = p & 1, h0 = kh * 4 + (wave & 1) * 2;
            q0 = Q + ((size_t)(MP + b * TS)) * 512 + h0 * 64; q1 = q0 + 64;
            o0 = MIX + ((size_t)(MP + b * TS)) * D + 512 + h0 * 64; o1 = o0 + 64; sk0 = sinks[h0] * LOG2E; sk1 = sinks[h0 + 1] * LOG2E; work = wave < 2; }
        bf16x8 qf[2][2];
        qf[0][0] = *(const bf16x8*)(q0 + fr * 512 + g * 8); qf[0][1] = *(const bf16x8*)(q0 + fr * 512 + 32 + g * 8);
        qf[1][0] = *(const bf16x8*)(q1 + fr * 512 + g * 8); qf[1][1] = *(const bf16x8*)(q1 + fr * 512 + 32 + g * 8);
        const int nkt = cur.nkt;
        __syncthreads();
        const int nu = unit + G < ATT_UNITS ? unit + G : unit;
        cur = att_decode(ws, nu);
        att_stage_load(cur, tid, kp, vp);
        if (work) attn_compute(qf, buf, nkt, sk0, sk1, o0, o1, lane);
    }
    __syncthreads();
}

struct ConvUnit { const bf16_t* ub; int jmin; size_t orow; };
__device__ __forceinline__ ConvUnit conv_decode(unsigned char* ws, int cu, int ch) {
    ConvUnit u;
    if (cu < MP / 16) { const int b = cu >> 9, t0 = (cu & 511) * 16; u.ub = (const bf16_t*)(ws + WS_UP) + ((size_t)(b * TP) + t0 - HIST) * CC + ch; u.jmin = HIST - t0; u.orow = (size_t)b * TP + t0; }
    else { const int b = cu - MP / 16; u.ub = (const bf16_t*)(ws + WS_US) + ((size_t)(b * USROWS)) * CC + ch; u.jmin = 0; u.orow = (size_t)MP + b * TS; }
    return u;
}
__device__ __forceinline__ void conv_phase(const Args& a, LAS unsigned char* lds, int tid, int first, int G) {
    asm volatile("" : "+v"(tid));
    unsigned char* ws = a.ws;
    const int ch = tid, wave = tid >> 6, lane = tid & 63;
    if (first >= CONV_UNITS) return;
    const float* wdw = a.in[13] + ch;
    float w[CW];
#pragma unroll
    for (int j = 0; j < CW; ++j) w[j] = wdw[j * CC];
    const float bias = a.in[14][ch];
    const f32x4 gc0 = *(const f32x4*)(a.in[15] + 4 * lane), gc1 = *(const f32x4*)(a.in[15] + 256 + 4 * lane);
    const f32x4 bc0 = *(const f32x4*)(a.in[16] + 4 * lane), bc1 = *(const f32x4*)(a.in[16] + 256 + 4 * lane);
    ConvUnit cur = conv_decode(ws, first, ch);
    bf16_t xr[HIST + 16];
#pragma unroll
    for (int j = 0; j < HIST + 16; ++j) { const int jc = j > cur.jmin ? j : cur.jmin; xr[j] = cur.ub[(size_t)jc * CC]; }
    int par = 0;
    for (int cu = first; cu < CONV_UNITS; cu += G, par ^= 1) {
        const int jmin = cur.jmin; const size_t orow = cur.orow;
        float acc[16];
#pragma unroll
        for (int i = 0; i < 16; ++i) acc[i] = bias;
#pragma unroll
        for (int j = 0; j < HIST + 16; ++j) {
            const float xv = (j >= jmin) ? bf2f(xr[j]) : 0.f;
#pragma unroll
            for (int i = 0; i < 16; ++i) { if (j - i >= 0 && j - i < CW) acc[i] += xv * w[j - i]; }
        }
        __builtin_amdgcn_sched_barrier(0);
        { const int nu = cu + G < CONV_UNITS ? cu + G : cu;
          cur = conv_decode(ws, nu, ch);
#pragma unroll
          for (int j = 0; j < HIST + 16; ++j) { const int jc = j > cur.jmin ? j : cur.jmin; xr[j] = cur.ub[(size_t)jc * CC]; } }
        __builtin_amdgcn_sched_barrier(0);
        LAS float* yb = (LAS float*)lds + par * (16 * CC);
#pragma unroll
        for (int i = 0; i < 16; ++i) yb[i * CC + ch] = acc[i];
        __syncthreads();
        bf16_t* MIX = (bf16_t*)(ws + WS_MIX) + orow * D;
        {
            const int tok = 2 * wave;
            f32x4 v0 = *(const LAS f32x4*)(yb + tok * CC + 4 * lane), v1 = *(const LAS f32x4*)(yb + tok * CC + 256 + 4 * lane);
            f32x4 z0 = *(const LAS f32x4*)(yb + (tok + 1) * CC + 4 * lane), z1 = *(const LAS f32x4*)(yb + (tok + 1) * CC + 256 + 4 * lane);
            float sa = (v0[0] + v0[1]) + (v0[2] + v0[3]) + (v1[0] + v1[1]) + (v1[2] + v1[3]);
            float sb = (z0[0] + z0[1]) + (z0[2] + z0[3]) + (z1[0] + z1[1]) + (z1[2] + z1[3]);
            wave_sum2(sa, sb);
            const float ma = sa * (1.0f / CC), mb = sb * (1.0f / CC);
            v0 = v0 - ma; v1 = v1 - ma; z0 = z0 - mb; z1 = z1 - mb;
            float qa = (v0[0] * v0[0] + v0[1] * v0[1]) + (v0[2] * v0[2] + v0[3] * v0[3]) + (v1[0] * v1[0] + v1[1] * v1[1]) + (v1[2] * v1[2] + v1[3] * v1[3]);
            float qb = (z0[0] * z0[0] + z0[1] * z0[1]) + (z0[2] * z0[2] + z0[3] * z0[3]) + (z1[0] * z1[0] + z1[1] * z1[1]) + (z1[2] * z1[2] + z1[3] * z1[3]);
            wave_sum2(qa, qb);
            const float ra = rsqrtf(qa * (1.0f / CC) + EPS), rb = rsqrtf(qb * (1.0f / CC) + EPS);
            v0 = v0 * ra * gc0 + bc0; v1 = v1 * ra * gc1 + bc1; z0 = z0 * rb * gc0 + bc0; z1 = z1 * rb * gc1 + bc1;
            u32x2 o0, o1, p0, p1;
            o0.x = cvt_pk_bf16(silu_f(v0[0]), silu_f(v0[1])); o0.y = cvt_pk_bf16(silu_f(v0[2]), silu_f(v0[3]));
            o1.x = cvt_pk_bf16(silu_f(v1[0]), silu_f(v1[1])); o1.y = cvt_pk_bf16(silu_f(v1[2]), silu_f(v1[3]));
            p0.x = cvt_pk_bf16(silu_f(z0[0]), silu_f(z0[1])); p0.y = cvt_pk_bf16(silu_f(z0[2]), silu_f(z0[3]));
            p1.x = cvt_pk_bf16(silu_f(z1[0]), silu_f(z1[1])); p1.y = cvt_pk_bf16(silu_f(z1[2]), silu_f(z1[3]));
            *(u32x2*)(MIX + (size_t)tok * D + 4 * lane) = o0; *(u32x2*)(MIX + (size_t)tok * D + 256 + 4 * lane) = o1;
            *(u32x2*)(MIX + (size_t)(tok + 1) * D + 4 * lane) = p0; *(u32x2*)(MIX + (size_t)(tok + 1) * D + 256 + 4 * lane) = p1;
        }
    }
    __syncthreads();
}

#define XB_TMO      128
#define XB_XCNT(j)  (256  + 64 * (j))
#define XB_XSUB(j)  (1280 + 64 * (j))
#define XB_XGEN(j)  (2304 + 64 * (j))
#define XB_TOP      3328
#define XB_TOPGEN   3392
#define XCD_BAR_WORDS 3456
#define XB_SPIN_CAP (1u << 18)
__device__ __forceinline__ unsigned xb_ld(unsigned* p)              { return __hip_atomic_load(p, __ATOMIC_RELAXED, __HIP_MEMORY_SCOPE_AGENT); }
__device__ __forceinline__ unsigned xb_add(unsigned* p, unsigned v) { return __hip_atomic_fetch_add(p, v, __ATOMIC_RELAXED, __HIP_MEMORY_SCOPE_AGENT); }
__device__ __forceinline__ unsigned xb_xcc_id() { return (unsigned)__builtin_amdgcn_s_getreg((3 << 11) | 20) & 0xFu; }
#define XB_SPIN(cond, bar) do { unsigned _sp = 0; while (cond) { __builtin_amdgcn_s_sleep(1); \
    if ((++_sp & 255u) == 0u) { if (xb_ld(&(bar)[XB_TMO])) break; if (_sp > XB_SPIN_CAP) { atomicAdd(&(bar)[XB_TMO], 1u); break; } } } } while (0)
struct XcdBarrier { unsigned* bar; unsigned x; volatile LAS unsigned* st; };
__device__ __forceinline__ XcdBarrier xcd_barrier_post(unsigned* bar, volatile LAS unsigned* st) {
    XcdBarrier b; b.bar = bar; b.x = xb_xcc_id(); b.st = st;
    if (threadIdx.x == 0) (void)xb_add(&bar[XB_XCNT(b.x)], 1u);
    return b;
}
__device__ __forceinline__ void xcd_barrier_complete(unsigned* bar, unsigned x, unsigned& nloc, unsigned& nx) {
    const unsigned G = gridDim.x * gridDim.y * gridDim.z;
    unsigned sum, cnt, mine, sp = 0u;
    for (;;) {
        sum = 0u; cnt = 0u; mine = 0u;
#pragma unroll
        for (unsigned j = 0; j < 16; ++j) { const unsigned c = xb_ld(&bar[XB_XCNT(j)]); sum += c; cnt += (c > 0u) ? 1u : 0u; mine = (j == x) ? c : mine; }
        if (sum == G) break;
        __builtin_amdgcn_s_sleep(1);
        if ((++sp & 255u) == 0u) { if (xb_ld(&bar[XB_TMO])) break; if (sp > XB_SPIN_CAP) { atomicAdd(&bar[XB_TMO], 1u); break; } }
    }
    nloc = mine > 0u ? mine : 1u; nx = cnt > 0u ? cnt : 1u;
}
__device__ __forceinline__ void xcd_barrier(const XcdBarrier& b) {
    asm volatile("s_waitcnt vmcnt(0)" ::: "memory");
    __syncthreads();
    if (threadIdx.x == 0) {
        unsigned* bar = b.bar;
        __builtin_amdgcn_s_waitcnt(0);
        unsigned nloc = b.st[0], nx = b.st[1];
        if (nloc == 0u) { xcd_barrier_complete(bar, b.x, nloc, nx); b.st[0] = nloc; b.st[1] = nx; }
        const unsigned old = xb_add(&bar[XB_XSUB(b.x)], 1u);
        const unsigned gen = old / nloc;
        if (old + 1u == (gen + 1u) * nloc) {
            __builtin_amdgcn_fence(__ATOMIC_RELEASE, "agent");
            asm volatile("s_waitcnt vmcnt(0)" ::: "memory");
            const unsigned og = xb_add(&bar[XB_TOP], 1u);
            const unsigned tg = og / nx;
            if (og + 1u == (tg + 1u) * nx) xb_add(&bar[XB_TOPGEN], 1u);
            else XB_SPIN(xb_ld(&bar[XB_TOPGEN]) == tg, bar);
            __builtin_amdgcn_fence(__ATOMIC_ACQUIRE, "agent");
            xb_add(&bar[XB_XGEN(b.x)], 1u);
            asm volatile("s_waitcnt vmcnt(0)" ::: "memory");
        } else {
            XB_SPIN(xb_ld(&bar[XB_XGEN(b.x)]) == gen, bar);
            __builtin_amdgcn_fence(__ATOMIC_ACQUIRE, "agent");
            asm volatile("s_waitcnt vmcnt(0)" ::: "memory");
        }
    }
    __syncthreads();
}
constexpr int MISC_OFF = 151552;
constexpr size_t CTL_ZERO_BYTES = 65536;
constexpr int CW_BAR = 4096;

__global__ void __launch_bounds__(512, 2) hymba_fwd(Args a) {
    extern __shared__ __attribute__((aligned(16))) unsigned char lds_raw[];
    LAS unsigned char* lds = (LAS unsigned char*)lds_raw;
    unsigned char* ws = a.ws;
    const int tid = threadIdx.x, lane = tid & 63, wave = __builtin_amdgcn_readfirstlane(tid >> 6);
    const int G = gridDim.x, bid = blockIdx.x;
    for (int u = tid; u < (LDS_BYTES - MISC_OFF) / 4; u += 512) ((LAS unsigned*)(lds + MISC_OFF))[u] = 0u;
    __syncthreads();
    const XcdBarrier bar = xcd_barrier_post((unsigned*)ws + CW_BAR, (volatile LAS unsigned*)(lds + MISC_OFF) + 8);
#define GRID_BAR() xcd_barrier(bar)

    bf16_t* AB = (bf16_t*)(ws + WS_AB); bf16_t* ACT = (bf16_t*)(ws + WS_ACT);
    float* ssq0 = (float*)(ws + WS_SSQ0); float* ssq1 = (float*)(ws + WS_SSQ1); float* ssq2 = (float*)(ws + WS_SSQ2);

#ifndef PROBE_DUP
#define PROBE_DUP -1
#endif
#ifndef PHASE_MASK
#define PHASE_MASK 0xff
#endif
#define REPS(k) if (PHASE_MASK & (1 << (k))) for (int rep_ = 0; rep_ < ((PROBE_DUP == (k)) ? 2 : 1); ++rep_)
    REPS(0) { p0_prologue(a, lds); GRID_BAR(); }
    REPS(1) {
    { pg8::Gemm g{AB, (const bf16_t*)(ws + WS_W1T), MP, NUP, D}; pg8::StaticOrder S; S.init(MP, NUP, G, bid);
      EpiSwiglu E{ACT, ssq0, lds};
      for (int pass = 0; pass < 2; ++pass) { if (((pass ^ (bid >> 6)) & 1) == 0) { pg8::gemm_phase<EpiSwiglu, pg8::StaticOrder, true, true>(lds, g, S, E); } else { small_gemm<1, 4>(AB, (const bf16_t*)(ws + WS_W1T), NUP, D, E, lds, bid, G, wave, lane); } } }
    GRID_BAR(); }
    REPS(2) {
    { pg8::Gemm g{ACT, (const bf16_t*)(ws + WS_W2T), MP, D, FF}; pg8::StaticOrder S; S.init(MP, D, G, bid);
      EpiResid<0> E{a.in[0], a.in[1], nullptr, AB, ssq1, 0.5f};
      for (int pass = 0; pass < 2; ++pass) { if (((pass ^ (bid >> 6)) & 1) == 0) { pg8::gemm_phase<EpiResid<0>, pg8::StaticOrder, true, true>(lds, g, S, E); } else { small_gemm<8, 2>(ACT, (const bf16_t*)(ws + WS_W2T), D, FF, E, lds, bid, G, wave, lane); } } }
    GRID_BAR(); }
    REPS(3) {
    { pg8::Gemm g{AB, (const bf16_t*)(ws + WS_WINT), MP, NIN, D}; pg8::StaticOrder S; S.init(MP, NIN, G, bid);
      EpiInProj E{ws, a.in[10], a.in[11], a.out, lds};
      pg8::gemm_phase<EpiInProj, pg8::StaticOrder, true, true>(lds, g, S, E);
      small_gemm<1, 4>(AB, (const bf16_t*)(ws + WS_WINT), NIN, D, E, lds, G - 1 - bid, G, wave, lane, 2);
      if (rep_ == 0 && bid >= G / 2) { int ln = lane; asm volatile("" : "+v"(ln)); weights_convert(a, lds, NITEMS_EARLY, NITEMS, (bid - G / 2) * 8 + wave, (G - G / 2) * 8, wave, ln); } }
    GRID_BAR(); }
    REPS(4) {
#ifndef PROBE_P4SUB
#define PROBE_P4SUB 0
#endif
    if (!(rep_ == 1 && PROBE_P4SUB == 2)) attn_phase(a, lds, tid, bid, G);
    if (!(rep_ == 1 && PROBE_P4SUB == 1)) conv_phase(a, lds, tid, G - 1 - bid, G);
    GRID_BAR(); }
    REPS(5) {
    { pg8::Gemm g{(const bf16_t*)(ws + WS_MIX), (const bf16_t*)(ws + WS_WOT), MP, D, D}; pg8::StaticOrder S; S.init(MP, D, G, bid);
      EpiResid<1> E{nullptr, nullptr, nullptr, AB, ssq2, 1.0f};
      for (int pass = 0; pass < 2; ++pass) { if (((pass ^ (bid >> 6)) & 1) == 0) { pg8::gemm_phase<EpiResid<1>, pg8::StaticOrder, true, true>(lds, g, S, E); } else { small_gemm<8, 2>((const bf16_t*)(ws + WS_MIX), (const bf16_t*)(ws + WS_WOT), D, D, E, lds, bid, G, wave, lane); } } }
    GRID_BAR(); }
    REPS(6) {
    { pg8::Gemm g{AB, (const bf16_t*)(ws + WS_W3T), MP, NUP, D}; pg8::StaticOrder S; S.init(MP, NUP, G, bid);
      EpiSwiglu E{ACT, ssq2, lds};
      for (int pass = 0; pass < 2; ++pass) { if (((pass ^ (bid >> 6)) & 1) == 0) { pg8::gemm_phase<EpiSwiglu, pg8::StaticOrder, true, true>(lds, g, S, E); } else { small_gemm<1, 4>(AB, (const bf16_t*)(ws + WS_W3T), NUP, D, E, lds, bid, G, wave, lane); } } }
    GRID_BAR(); }
    REPS(7) { pg8::Gemm g{ACT, (const bf16_t*)(ws + WS_W4T), MP, D, FF}; pg8::StaticOrder S; S.init(MP, D, G, bid);
      EpiResid<2> E{nullptr, nullptr, a.out, AB, nullptr, 0.5f};
      for (int pass = 0; pass < 2; ++pass) { if (((pass ^ (bid >> 6)) & 1) == 0) { pg8::gemm_phase<EpiResid<2>, pg8::StaticOrder, true, true>(lds, g, S, E); } else { small_gemm<8, 2>(ACT, (const bf16_t*)(ws + WS_W4T), D, FF, E, lds, bid, G, wave, lane); } } }
}

extern "C" void kernel_launch(void* const* d_in, const int* in_sizes, int n_in, void* d_out, int out_size, void* d_ws, size_t ws_size, hipStream_t stream) {
    static int grid = 0;
    if (grid == 0) {
        if (n_in != 21 || (size_t)out_size != O_END || ws_size < WS_END) { fprintf(stderr, "kernel_launch: unexpected shapes: n_in %d out %d ws %zu (need %zu)\n", n_in, out_size, ws_size, (size_t)WS_END); grid = -1; return; }
        int dev = 0, cus = 0, per_cu = 0;
        (void)hipGetDevice(&dev);
        (void)hipDeviceGetAttribute(&cus, hipDeviceAttributeMultiprocessorCount, dev);
        if (cus != 256) fprintf(stderr, "kernel_launch: note: built for a 256-CU device (one workgroup per CU), this device reports %d\n", cus);
        if (hipFuncSetAttribute((const void*)hymba_fwd, hipFuncAttributeMaxDynamicSharedMemorySize, LDS_BYTES) != hipSuccess) { fprintf(stderr, "kernel_launch: hipFuncSetAttribute failed\n"); grid = -1; return; }
        if (hipOccupancyMaxActiveBlocksPerMultiprocessor(&per_cu, (const void*)hymba_fwd, 512, LDS_BYTES) != hipSuccess || per_cu < 1) { fprintf(stderr, "kernel_launch: occupancy query failed (%d)\n", per_cu); grid = -1; (void)hipGetLastError(); return; }
        grid = cus;
    }
    if (grid < 0) return;
    Args a{};
    for (int i = 0; i < 21; ++i) a.in[i] = (const float*)d_in[i];
    a.out = (float*)d_out; a.ws = (unsigned char*)d_ws;
    for (int i = 0; i < 8; ++i) a.inv[i] = powf(500000.0f, -(float)i / 8.0f);
    if (hipMemsetAsync(d_ws, 0, CTL_ZERO_BYTES, stream) != hipSuccess) { fprintf(stderr, "kernel_launch: memset failed\n"); return; }
    hipLaunchKernelGGL(hymba_fwd, dim3(grid), dim3(512), LDS_BYTES, stream, a);
    const hipError_t e = hipPeekAtLastError();
    if (e != hipSuccess) fprintf(stderr, "kernel_launch: launch failed: %s (grid %d)\n", hipGetErrorString(e), grid);
}
```

```cpp
#include <hip/hip_runtime.h>
#include <cstdio>
#include <cstdint>
#include <cmath>

#define LAS __attribute__((address_space(3)))
typedef unsigned short bf16_t;
typedef short bf16x8 __attribute__((ext_vector_type(8)));
typedef float f32x4 __attribute__((ext_vector_type(4)));
typedef float f32x2 __attribute__((ext_vector_type(2)));
typedef unsigned u32x4 __attribute__((ext_vector_type(4)));
typedef unsigned u32x2 __attribute__((ext_vector_type(2)));
typedef int i32x4 __attribute__((ext_vector_type(4)));

constexpr int D = 1024, TP = 8192, NBP = 4, NBS = 32, TS = 16, MP = NBP * TP, MS = NBS * TS, M = MP + MS;
constexpr int FF = 2816, NUP = 2 * FF, NIN = 1792, CC = 512, HD = 64, PAST = 4096;
constexpr int CW = 31, HIST = CW - 1, WIN = 128;
constexpr int KSROWS = 160;
constexpr int USROWS = HIST + TS;
constexpr float EPS = 1e-6f;
constexpr float LOG2E = 1.4426950408889634f;
constexpr float QSCALE = 0.125f * LOG2E;

constexpr size_t O_YP = 0, O_YS = (size_t)MP * D, O_CSP = O_YS + (size_t)MS * D, O_KWP = O_CSP + (size_t)NBP * HIST * CC,
                 O_VWP = O_KWP + (size_t)NBP * WIN * 128, O_CSS = O_VWP + (size_t)NBP * WIN * 128, O_KWS = O_CSS + (size_t)NBS * HIST * CC,
                 O_VWS = O_KWS + (size_t)NBS * WIN * 128, O_END = O_VWS + (size_t)NBS * WIN * 128;

constexpr size_t al(size_t x) { return (x + 4095) & ~(size_t)4095; }
constexpr size_t WS_CTL = 0;
constexpr size_t WS_W1T = 1u << 20;
constexpr size_t WS_W2T = WS_W1T + al((size_t)NUP * D * 2);
constexpr size_t WS_WINT = WS_W2T + al((size_t)D * FF * 2);
constexpr size_t WS_WOT = WS_WINT + al((size_t)NIN * D * 2);
constexpr size_t WS_W3T = WS_WOT + al((size_t)D * D * 2);
constexpr size_t WS_W4T = WS_W3T + al((size_t)NUP * D * 2);
constexpr size_t WS_ROPE = WS_W4T + al((size_t)D * FF * 2);
constexpr size_t WS_SSQ0 = WS_ROPE + al((size_t)TP * 8 * 8);
constexpr size_t WS_SSQ1 = WS_SSQ0 + al((size_t)M * 16 * 4);
constexpr size_t WS_SSQ2 = WS_SSQ1 + al((size_t)M * 16 * 4);
constexpr size_t WS_KS = WS_SSQ2 + al((size_t)M * 16 * 4);
constexpr size_t WS_VTS = WS_KS + al((size_t)NBS * KSROWS * 128 * 2);
constexpr size_t WS_US = WS_VTS + al((size_t)NBS * 128 * KSROWS * 2);
constexpr size_t WS_AB = WS_US + al((size_t)NBS * USROWS * CC * 2);
constexpr size_t WS_X1 = WS_AB + al((size_t)M * D * 2);
constexpr size_t WS_ACT = WS_X1 + al((size_t)M * D * 4);
constexpr size_t WS_A8 = WS_X1;
constexpr size_t WS_W3Q = WS_A8 + al((size_t)M * D);
constexpr size_t WS_W1Q = WS_W3Q + al((size_t)NUP * D);
constexpr size_t WS_RS = WS_W1Q + al((size_t)NUP * D);
constexpr size_t WS_CS3 = WS_RS + al((size_t)M * 4);
constexpr size_t WS_CS1 = WS_CS3 + al((size_t)NUP * 4);
static_assert(WS_CS1 + (size_t)NUP * 4 <= WS_ACT, "int8 operands fit in the f32 scratch");
constexpr size_t WS_END = WS_ACT + al((size_t)M * FF * 2);
constexpr size_t WS_UP = WS_ACT;
constexpr size_t WS_Q = WS_UP + al((size_t)MP * CC * 2);
constexpr size_t WS_KP = WS_Q + al((size_t)M * 512 * 2);
constexpr size_t WS_VTP = WS_KP + al((size_t)MP * 128 * 2);
constexpr size_t WS_MIX = WS_VTP + al((size_t)MP * 128 * 2);
static_assert(WS_MIX + (size_t)M * D * 2 <= WS_END, "overlay fits");

constexpr int LDS_BYTES = 155648;
constexpr int SSQ_LDS_OFF = 131072;

__device__ __forceinline__ unsigned cvt_pk_bf16(float lo, float hi) { unsigned r; asm volatile("v_cvt_pk_bf16_f32 %0, %1, %2" : "=v"(r) : "v"(lo), "v"(hi)); return r; }
__device__ __forceinline__ float bf2f(bf16_t h) { return __uint_as_float((unsigned)h << 16); }
__device__ __forceinline__ bf16_t f2bf(float f) { return (bf16_t)(cvt_pk_bf16(f, 0.f) & 0xffffu); }
__device__ __forceinline__ float silu_f(float a) { return a * __builtin_amdgcn_rcpf(1.0f + __builtin_amdgcn_exp2f(-a * LOG2E)); }
__device__ __forceinline__ float sigmoid_f(float a) { return __builtin_amdgcn_rcpf(1.0f + __builtin_amdgcn_exp2f(-a * LOG2E)); }
__device__ __forceinline__ float sum_rows4(float x) {
    float a = x, b = x;
    asm volatile("s_nop 1\n\tv_permlane16_swap_b32 %0, %1" : "+v"(a), "+v"(b));
    float t = a + b; a = t; b = t;
    asm volatile("s_nop 1\n\tv_permlane32_swap_b32 %0, %1" : "+v"(a), "+v"(b));
    return a + b;
}
__device__ __forceinline__ float max_rows4(float x) {
    float a = x, b = x;
    asm volatile("s_nop 1\n\tv_permlane16_swap_b32 %0, %1" : "+v"(a), "+v"(b));
    float t = fmaxf(a, b); a = t; b = t;
    asm volatile("s_nop 1\n\tv_permlane32_swap_b32 %0, %1" : "+v"(a), "+v"(b));
    return fmaxf(a, b);
}
__device__ __forceinline__ float wave_sum(float v) {
#pragma unroll
    for (int o = 1; o < 64; o <<= 1) v += __shfl_xor(v, o);
    return v;
}
__device__ __forceinline__ float dpp_row_sum(float v) {
    v += __builtin_bit_cast(float, __builtin_amdgcn_update_dpp(0, __builtin_bit_cast(int, v), 0xB1, 0xF, 0xF, true));
    v += __builtin_bit_cast(float, __builtin_amdgcn_update_dpp(0, __builtin_bit_cast(int, v), 0x4E, 0xF, 0xF, true));
    v += __builtin_bit_cast(float, __builtin_amdgcn_update_dpp(0, __builtin_bit_cast(int, v), 0x124, 0xF, 0xF, true));
    v += __builtin_bit_cast(float, __builtin_amdgcn_update_dpp(0, __builtin_bit_cast(int, v), 0x128, 0xF, 0xF, true));
    return v;
}
__device__ __forceinline__ void wave_sum2(float& a, float& b) {
    a = dpp_row_sum(a); b = dpp_row_sum(b);
    a = sum_rows4(a); b = sum_rows4(b);
}
__device__ __forceinline__ float row_rstd(const float* ssq, int r) {
    const f32x4* p = (const f32x4*)(ssq + (size_t)r * 16);
    const f32x4 a = p[0], b = p[1], c = p[2], d = p[3];
    const f32x4 s = (a + b) + (c + d);
    return rsqrtf(((s.x + s.y) + (s.z + s.w)) * (1.0f / D) + EPS);
}

namespace pg8 {
constexpr int BM = 256, BK = 64, HALF = 128, HTB = HALF * BK * 2, STAGE_BYTES = 8 * HTB, NXCD = 8, WGM = 8;
__host__ __device__ __forceinline__ int lds_byte(int r, int c) { const int st = (r >> 4) * 2 + (c >> 5), rr = r & 15, cc = c & 31, ob = rr * 64 + cc * 2; return st * 1024 + (ob ^ (((ob >> 9) & 1) << 5)); }
__host__ __device__ __forceinline__ void stage_rc(int b, int& R, int& C) { const int st = b / 1024, sb = b % 1024, swz = sb ^ (((sb >> 9) & 1) << 5); R = (st >> 1) * 16 + swz / 64; C = (st & 1) * 32 + (swz % 64) / 2; }
__host__ __device__ __forceinline__ int perm32(int rho) { const int n = rho >> 4, i = rho & 15; return 8 * (i >> 2) + 4 * n + (i & 3); }

struct Unit { int pm, pn; };
struct Gemm { const bf16_t* A; const bf16_t* Bt; int M, N, K; };

struct StaticOrder {
    int nM, nN, nwg, G, c;
    __host__ __device__ void init(int M_, int N_, int G_, int c_) { nM = M_ / BM; nN = N_ / BM; nwg = nM * nN; G = G_; c = c_; }
    __host__ __device__ bool next(int i, Unit& u) const {
        const long L = (long)i * G + c; if (L >= nwg) return false;
        int wgid = (int)L; { const int q = nwg / NXCD, r = nwg % NXCD, xcd = wgid % NXCD, off = wgid / NXCD; wgid = (xcd < r ? xcd * (q + 1) : r * (q + 1) + (xcd - r) * q) + off; }
        const int nig = WGM * nN, gid = wgid / nig, fm = gid * WGM, gsz = (nM - fm) < WGM ? (nM - fm) : WGM;
        u.pm = fm + ((wgid % nig) % gsz); u.pn = (wgid % nig) / gsz; return true;
    }
    __device__ __forceinline__ void a_ready(const Unit&) const {}
    __device__ __forceinline__ void done(const Unit&) const {}
};

__device__ __forceinline__ f32x4 mma16(bf16x8 b, bf16x8 a, f32x4 c) { return __builtin_amdgcn_mfma_f32_16x16x32_bf16(b, a, c, 0, 0, 0); }
__device__ __forceinline__ i32x4 mma16(bf16x8 b, bf16x8 a, i32x4 c) { return __builtin_amdgcn_mfma_i32_16x16x64_i8(__builtin_bit_cast(i32x4, b), __builtin_bit_cast(i32x4, a), c, 0, 0, 0); }
template <bool I8> struct AccT { typedef f32x4 type; };
template <> struct AccT<true> { typedef i32x4 type; };
template <class Epi, class Sched, bool ALIGN_EPI, bool SP2, bool I8 = false>
__device__ __forceinline__ void gemm_phase(LAS unsigned char* lds, const Gemm g, const Sched& S, const Epi& E) {
    int tid = threadIdx.x; asm volatile("" : "+v"(tid));
    const int wid = __builtin_amdgcn_readfirstlane(tid >> 6), lane = tid & 63, wr = wid >> 2, wc = wid & 3, fr = lane & 15, fq = lane >> 4;
    const int K = g.K, nt = K / BK;
    unsigned voffA[2], voffB[2];
#pragma unroll
    for (int i = 0; i < 2; ++i) { int R, C; stage_rc(tid * 16 + i * 8192, R, C); const int Rb = Epi::PERM ? ((R & ~31) + perm32(R & 31)) : R;
        voffA[i] = (unsigned)(R * K + C) * 2u; voffB[i] = (unsigned)(Rb * K + C) * 2u; }
    const size_t kstep = (size_t)(BK * 2);
    const size_t hstep = (size_t)HALF * K * 2;
    const size_t tstep = 2 * hstep;
    const unsigned ldsw = (unsigned)wid * 1024u;
    const int aoff = lds_byte(wr * 64 + fr, fq * 8), boff = lds_byte(wc * 32 + fr, fq * 8);
#define PG8_SA(b, h) (((b) * 2 + (h)) * HTB)
#define PG8_SB(b, h) ((4 + (b) * 2 + (h)) * HTB)
#define PG8_STAGE(bufoff, gbase, voff) do { _Pragma("unroll") for (int _i = 0; _i < 2; ++_i) \
        __builtin_amdgcn_global_load_lds((const unsigned*)((const char*)(gbase) + (voff)[_i]), (LAS unsigned*)(lds + (bufoff) + ldsw + _i * 8192), 16, 0, 0); } while (0)
#define PG8_LDA(dst, b, h) do { _Pragma("unroll") for (int m = 0; m < 4; ++m) _Pragma("unroll") for (int k = 0; k < 2; ++k) dst[m][k] = *(const LAS bf16x8*)(lds + PG8_SA(b, h) + aoff + m * 2048 + k * 1024); } while (0)
#define PG8_LDB(dst, b, h) do { _Pragma("unroll") for (int n = 0; n < 2; ++n) _Pragma("unroll") for (int k = 0; k < 2; ++k) dst[n][k] = *(const LAS bf16x8*)(lds + PG8_SB(b, h) + boff + n * 2048 + k * 1024); } while (0)
#define PG8_MMA(ai, bj, At, Bt) do { __builtin_amdgcn_s_setprio(1); _Pragma("unroll") for (int m = 0; m < 4; ++m) _Pragma("unroll") for (int n = 0; n < 2; ++n) _Pragma("unroll") for (int k = 0; k < 2; ++k) \
        acc[ai][bj][m][n] = mma16(Bt[n][k], At[m][k], acc[ai][bj][m][n]); __builtin_amdgcn_s_setprio(0); } while (0)
#define PG8_WAIT_V(n) asm volatile("s_waitcnt vmcnt(" #n ")" ::: "memory")
#define PG8_WAIT_L(n) asm volatile("s_waitcnt lgkmcnt(" #n ")" ::: "memory")
#define PG8_BAR __builtin_amdgcn_s_barrier()
#define PG8_SCHED __builtin_amdgcn_sched_barrier(0)
    Unit cur, nxt; int ui = 0;
    if (!S.next(0, cur)) return;
    typedef typename AccT<I8>::type acc_t;
    acc_t acc[2][2][4][2];
#pragma unroll
    for (int a = 0; a < 2; ++a)
#pragma unroll
        for (int b = 0; b < 2; ++b)
#pragma unroll
            for (int m = 0; m < 4; ++m)
#pragma unroll
                for (int n = 0; n < 2; ++n) acc[a][b][m][n] = acc_t{};
    bf16x8 At[4][2], B0[2][2], B1[2][2];
    const char* cA = (const char*)g.A + (size_t)cur.pm * tstep; const char* cB = (const char*)g.Bt + (size_t)cur.pn * tstep;
    S.a_ready(cur);
    if constexpr (SP2) {
        PG8_STAGE(PG8_SB(0, 0), cB, voffB); PG8_STAGE(PG8_SB(0, 1), cB + hstep, voffB); PG8_STAGE(PG8_SA(0, 0), cA, voffA); PG8_STAGE(PG8_SA(0, 1), cA + hstep, voffA);
        if (wr == 1) PG8_BAR;
        PG8_WAIT_V(2); PG8_BAR;
        PG8_STAGE(PG8_SB(1, 0), cB + kstep, voffB); PG8_STAGE(PG8_SA(1, 0), cA + kstep, voffA); PG8_STAGE(PG8_SB(1, 1), cB + hstep + kstep, voffB);
        PG8_WAIT_V(6); PG8_BAR;
    } else {
        PG8_STAGE(PG8_SB(0, 0), cB, voffB); PG8_STAGE(PG8_SA(0, 0), cA, voffA); PG8_STAGE(PG8_SB(0, 1), cB + hstep, voffB); PG8_STAGE(PG8_SA(0, 1), cA + hstep, voffA);
        if (wr == 1) PG8_BAR;
        PG8_WAIT_V(4); PG8_BAR;
        PG8_STAGE(PG8_SB(1, 0), cB + kstep, voffB); PG8_STAGE(PG8_SA(1, 0), cA + kstep, voffA); PG8_STAGE(PG8_SB(1, 1), cB + hstep + kstep, voffB);
        PG8_WAIT_V(6); PG8_BAR;
    }
    for (;;) {
        const bool has_next = S.next(ui + 1, nxt);
        const char* nA = has_next ? (const char*)g.A + (size_t)nxt.pm * tstep : cA; const char* nB = has_next ? (const char*)g.Bt + (size_t)nxt.pn * tstep : cB;
        for (int t = 0; t < nt; t += 2) {
            const bool last = (t == nt - 2);
            const char* a1 = cA + (size_t)(t + 1) * kstep;
            const char* a2 = last ? nA : cA + (size_t)(t + 2) * kstep; const char* b2 = last ? nB : cB + (size_t)(t + 2) * kstep;
            const char* a3 = a2 + kstep; const char* b3 = b2 + kstep;
            if (last && has_next) S.a_ready(nxt);
            if (last) E.prefetch(cur, wid, lane, lds);
            if constexpr (SP2) {
            PG8_LDB(B0, 0, 0); PG8_LDB(B1, 0, 1); PG8_SCHED; PG8_LDA(At, 0, 0); PG8_STAGE(PG8_SA(1, 1), a1 + hstep, voffA);
            PG8_WAIT_V(8); PG8_WAIT_L(0); PG8_BAR; PG8_MMA(0, 0, At, B0); PG8_MMA(0, 1, At, B1); PG8_BAR; PG8_SCHED;
            PG8_LDA(At, 0, 1); PG8_STAGE(PG8_SB(0, 0), b2, voffB); PG8_STAGE(PG8_SB(0, 1), b2 + hstep, voffB); PG8_STAGE(PG8_SA(0, 0), a2, voffA);
            PG8_WAIT_V(8); PG8_WAIT_L(0); PG8_BAR; PG8_MMA(1, 0, At, B0); PG8_MMA(1, 1, At, B1); PG8_BAR; PG8_SCHED;
            PG8_LDB(B0, 1, 0); PG8_LDB(B1, 1, 1); PG8_SCHED; PG8_LDA(At, 1, 0); PG8_STAGE(PG8_SA(0, 1), a2 + hstep, voffA);
            PG8_WAIT_V(8); PG8_WAIT_L(0); PG8_BAR; PG8_MMA(0, 0, At, B0); PG8_MMA(0, 1, At, B1); PG8_BAR; PG8_SCHED;
            PG8_LDA(At, 1, 1); PG8_STAGE(PG8_SB(1, 0), b3, voffB); PG8_STAGE(PG8_SB(1, 1), b3 + hstep, voffB); PG8_STAGE(PG8_SA(1, 0), a3, voffA);
            PG8_WAIT_V(8); PG8_WAIT_L(0); PG8_BAR; PG8_MMA(1, 0, At, B0); PG8_MMA(1, 1, At, B1); PG8_BAR; PG8_SCHED;
            } else {
            PG8_LDB(B0, 0, 0); PG8_SCHED; PG8_LDA(At, 0, 0); PG8_STAGE(PG8_SA(1, 1), a1 + hstep, voffA);
            PG8_WAIT_L(8); PG8_BAR; PG8_WAIT_L(0); PG8_MMA(0, 0, At, B0); PG8_BAR; PG8_SCHED;
            PG8_LDB(B1, 0, 1); PG8_STAGE(PG8_SB(0, 0), b2, voffB);
            PG8_BAR; PG8_WAIT_L(0); PG8_MMA(0, 1, At, B1); PG8_BAR;
            PG8_LDA(At, 0, 1); PG8_STAGE(PG8_SA(0, 0), a2, voffA);
            PG8_BAR; PG8_WAIT_L(0); PG8_MMA(1, 0, At, B0); PG8_BAR; PG8_SCHED;
            PG8_STAGE(PG8_SB(0, 1), b2 + hstep, voffB);
            PG8_WAIT_V(6); PG8_BAR; PG8_MMA(1, 1, At, B1); PG8_BAR;
            PG8_LDB(B0, 1, 0); PG8_SCHED; PG8_LDA(At, 1, 0); PG8_STAGE(PG8_SA(0, 1), a2 + hstep, voffA);
            PG8_WAIT_L(8); PG8_BAR; PG8_WAIT_L(0); PG8_MMA(0, 0, At, B0); PG8_BAR; PG8_SCHED;
            PG8_LDB(B1, 1, 1); PG8_STAGE(PG8_SB(1, 0), b3, voffB);
            PG8_BAR; PG8_WAIT_L(0); PG8_MMA(0, 1, At, B1); PG8_BAR;
            PG8_LDA(At, 1, 1); PG8_STAGE(PG8_SA(1, 0), a3, voffA);
            PG8_BAR; PG8_WAIT_L(0); PG8_MMA(1, 0, At, B0); PG8_BAR; PG8_SCHED;
            PG8_STAGE(PG8_SB(1, 1), b3 + hstep, voffB);
            PG8_WAIT_V(6); PG8_BAR; PG8_MMA(1, 1, At, B1); PG8_BAR;
            }
        }
        if constexpr (ALIGN_EPI) { if (wr == 0) PG8_BAR; }
        E(acc, cur, wr, wc, fr, fq); S.done(cur);
        if (!has_next) break;
#pragma unroll
        for (int a = 0; a < 2; ++a)
#pragma unroll
            for (int b = 0; b < 2; ++b)
#pragma unroll
                for (int m = 0; m < 4; ++m)
#pragma unroll
                    for (int n = 0; n < 2; ++n) acc[a][b][m][n] = acc_t{};
        cur = nxt; cA = nA; cB = nB; ++ui;
        if constexpr (ALIGN_EPI) { if (wr == 1) PG8_BAR; }
    }
    PG8_WAIT_V(0);
    if constexpr (!ALIGN_EPI) { if (wr == 0) PG8_BAR; }
    PG8_BAR;
#undef PG8_SA
#undef PG8_SB
#undef PG8_STAGE
#undef PG8_LDA
#undef PG8_LDB
#undef PG8_MMA
#undef PG8_WAIT_V
#undef PG8_WAIT_L
#undef PG8_BAR
#undef PG8_SCHED
}
}

typedef const f32x4 (&AccRef)[2][2][4][2];
#define EPI_BIG_CALL() \
    __device__ __forceinline__ void operator()(AccRef acc, const pg8::Unit& u, int wr, int wc, int fr, int fq) const { \
        asm volatile("" : "+v"(fr), "+v"(fq));     \
        const int row0 = u.pm * 256 + wr * 64 + fr; \
        _Pragma("unroll") for (int gq = 0; gq < 8 / PF; ++gq) { \
            Pre p[PF]; \
            asm volatile("" ::: "memory"); \
            _Pragma("unroll") for (int i = 0; i < PF; ++i) { const int rg = gq * PF + i; p[i] = pre_big(row0 + (rg >> 2) * 128 + (rg & 3) * 16, u.pn, wc, fq); }     \
            asm volatile("" ::: "memory"); \
            _Pragma("unroll") for (int i = 0; i < PF; ++i) { const int rg = gq * PF + i; \
                rows(acc[rg >> 2][0][rg & 3][0], acc[rg >> 2][0][rg & 3][1], acc[rg >> 2][1][rg & 3][0], acc[rg >> 2][1][rg & 3][1], row0 + (rg >> 2) * 128 + (rg & 3) * 16, u.pn, wc, fq, p[i]); } } \
    }
__device__ __forceinline__ f32x4 ssq_quarter(const float* ssq, int r, int fq) { return *(const f32x4*)(ssq + (size_t)r * 16 + 4 * fq); }
__device__ __forceinline__ float rstd_from(const f32x4& q) {
    float s = (q.x + q.y) + (q.z + q.w);
    s = sum_rows4(s);
    return rsqrtf(s * (1.0f / D) + EPS);
}

__device__ __forceinline__ void ssq_prefetch(const float* ssq, int pm, int wid, int lane, LAS unsigned char* lds) {
#pragma unroll
    for (int i = 0; i < 2; ++i)
        __builtin_amdgcn_global_load_lds((const unsigned*)(ssq + ((size_t)pm * 256 + wid * 32 + i * 16) * 16 + lane * 4), (LAS unsigned*)(lds + SSQ_LDS_OFF + (wid * 32 + i * 16) * 64), 16, 0, 0);
}
struct EpiSwiglu {
    static constexpr bool PERM = true; static constexpr int PF = 8;
    bf16_t* O; const float* ssq; LAS unsigned char* lds;
    struct Pre { f32x4 q; };
    __device__ __forceinline__ Pre pre(int r, int pn, int wc, int fq) const { Pre p; p.q = ssq_quarter(ssq, r, fq); return p; }
    __device__ __forceinline__ Pre pre_big(int r, int pn, int wc, int fq) const { Pre p; p.q = *(const LAS f32x4*)(lds + SSQ_LDS_OFF + (r & 255) * 64 + fq * 16); return p; }
    __device__ __forceinline__ void prefetch(const pg8::Unit& u, int wid, int lane, LAS unsigned char* l) const { ssq_prefetch(ssq, u.pm, wid, lane, l); }
    __device__ __forceinline__ void rows(const f32x4& c00, const f32x4& c01, const f32x4& c10, const f32x4& c11, int r, int pn, int wc, int fq, const Pre& p) const {
        const float rs = rstd_from(p.q);
        float o[8];
#pragma unroll
        for (int j = 0; j < 4; ++j) { o[j] = silu_f(c00[j] * rs) * (c10[j] * rs); o[4 + j] = silu_f(c01[j] * rs) * (c11[j] * rs); }
        u32x4 w; w.x = cvt_pk_bf16(o[0], o[1]); w.y = cvt_pk_bf16(o[2], o[3]); w.z = cvt_pk_bf16(o[4], o[5]); w.w = cvt_pk_bf16(o[6], o[7]);
        { bf16_t* dst_ = O + (size_t)r * FF + pn * 128 + wc * 32 + 8 * fq;
          asm volatile("global_store_dwordx4 %0, %1, off sc1\n\ts_nop 1" :: "v"(dst_), "v"(w) : "memory"); }
    }
    EPI_BIG_CALL()
};

struct EpiSwigluI8 {
    static constexpr bool PERM = true;
    bf16_t* O; const float* rs; const float* cs; LAS unsigned char* lds;
    struct Pre { float sa; };
    __device__ __forceinline__ Pre pre(int r, int pn, int wc, int fq) const { Pre p; p.sa = rs[r]; return p; }
    __device__ __forceinline__ void prefetch(const pg8::Unit& u, int wid, int lane, LAS unsigned char* l) const {
        if (wid == 0) __builtin_amdgcn_global_load_lds((const unsigned*)(rs + (size_t)u.pm * 256 + lane * 4), (LAS unsigned*)(l + SSQ_LDS_OFF), 16, 0, 0);
        if (wid == 1) __builtin_amdgcn_global_load_lds((const unsigned*)(cs + (size_t)u.pn * 256 + lane * 4), (LAS unsigned*)(l + SSQ_LDS_OFF + 1024), 16, 0, 0);
    }
    __device__ __forceinline__ void emit(const f32x4& c00, const f32x4& c01, const f32x4& c10, const f32x4& c11, float sa, const f32x4& w00, const f32x4& w01, const f32x4& w10, const f32x4& w11,
                                         int r, int pn, int wc, int fq) const {
        float o[8];
#pragma unroll
        for (int j = 0; j < 4; ++j) { o[j] = silu_f(c00[j] * (sa * w00[j])) * (c10[j] * (sa * w10[j])); o[4 + j] = silu_f(c01[j] * (sa * w01[j])) * (c11[j] * (sa * w11[j])); }
        u32x4 w; w.x = cvt_pk_bf16(o[0], o[1]); w.y = cvt_pk_bf16(o[2], o[3]); w.z = cvt_pk_bf16(o[4], o[5]); w.w = cvt_pk_bf16(o[6], o[7]);
        { bf16_t* dst_ = O + (size_t)r * FF + pn * 128 + wc * 32 + 8 * fq;
          asm volatile("global_store_dwordx4 %0, %1, off sc1\n\ts_nop 1" :: "v"(dst_), "v"(w) : "memory"); }
    }
    __device__ __forceinline__ void rows(const f32x4& c00, const f32x4& c01, const f32x4& c10, const f32x4& c11, int r, int pn, int wc, int fq, const Pre& p) const {
        const float* cp = cs + (size_t)pn * 256 + wc * 32 + 8 * fq;
        emit(c00, c01, c10, c11, p.sa, *(const f32x4*)cp, *(const f32x4*)(cp + 4), *(const f32x4*)(cp + 128), *(const f32x4*)(cp + 132), r, pn, wc, fq);
    }
    template <class AccTy> __device__ __forceinline__ void operator()(const AccTy (&acc)[2][2][4][2], const pg8::Unit& u, int wr, int wc, int fr, int fq) const {
        { int l_ = threadIdx.x; asm volatile("" : "+v"(l_)); fr = l_ & 15; fq = (l_ >> 4) & 3; }
        const int row0 = u.pm * 256 + wr * 64 + fr;
        LAS const float* lr = (LAS const float*)(lds + SSQ_LDS_OFF); LAS const float* lc = lr + 256 + wc * 32 + 8 * fq;
        const f32x4 w00 = *(LAS const f32x4*)lc, w01 = *(LAS const f32x4*)(lc + 4), w10 = *(LAS const f32x4*)(lc + 128), w11 = *(LAS const f32x4*)(lc + 132);
#pragma unroll
        for (int rg = 0; rg < 8; ++rg) {
            const int ai = rg >> 2, m = rg & 3, r = row0 + ai * 128 + m * 16;
            const float sa = lr[r & 255];
            emit(__builtin_convertvector(acc[ai][0][m][0], f32x4), __builtin_convertvector(acc[ai][0][m][1], f32x4), __builtin_convertvector(acc[ai][1][m][0], f32x4), __builtin_convertvector(acc[ai][1][m][1], f32x4),
                 sa, w00, w01, w10, w11, r, u.pn, wc, fq);
        }
    }
};

template <int MODE> struct EpiResid {
    static constexpr bool PERM = true; static constexpr int PF = (MODE == 0) ? 2 : 4;
    const float* resP; const float* resS;
    float* out; bf16_t* xb; float* ssq; float scale;
    struct Pre { f32x4 r00, r01, r10, r11; u32x4 a, b; };
    __device__ __forceinline__ Pre pre(int r, int pn, int wc, int fq) const {
        Pre p; const size_t off = (size_t)r * D + pn * 256 + wc * 32 + 8 * fq;
        if (MODE == 0) { const float* rbase = (r >= MP) ? resS - (size_t)MP * D : resP;
            p.r00 = *(const f32x4*)(rbase + off); p.r01 = *(const f32x4*)(rbase + off + 4); p.r10 = *(const f32x4*)(rbase + off + 128); p.r11 = *(const f32x4*)(rbase + off + 132); }
        else { p.a = *(const u32x4*)(xb + off); p.b = *(const u32x4*)(xb + off + 128); }
        return p;
    }
    __device__ __forceinline__ Pre pre_big(int r, int pn, int wc, int fq) const { return pre(r, pn, wc, fq); }
    __device__ __forceinline__ void prefetch(const pg8::Unit&, int, int, LAS unsigned char*) const {}
    __device__ __forceinline__ void rows(const f32x4& c00, const f32x4& c01, const f32x4& c10, const f32x4& c11, int r, int pn, int wc, int fq, const Pre& p) const {
        const size_t off = (size_t)r * D + pn * 256 + wc * 32 + 8 * fq;
        f32x4 r00, r01, r10, r11;
        if (MODE == 0) { r00 = p.r00; r01 = p.r01; r10 = p.r10; r11 = p.r11; }
        else {
            const u32x4 a = p.a, b = p.b;
            r00 = (f32x4){__uint_as_float(a.x << 16), __uint_as_float(a.x & 0xffff0000u), __uint_as_float(a.y << 16), __uint_as_float(a.y & 0xffff0000u)};
            r01 = (f32x4){__uint_as_float(a.z << 16), __uint_as_float(a.z & 0xffff0000u), __uint_as_float(a.w << 16), __uint_as_float(a.w & 0xffff0000u)};
            r10 = (f32x4){__uint_as_float(b.x << 16), __uint_as_float(b.x & 0xffff0000u), __uint_as_float(b.y << 16), __uint_as_float(b.y & 0xffff0000u)};
            r11 = (f32x4){__uint_as_float(b.z << 16), __uint_as_float(b.z & 0xffff0000u), __uint_as_float(b.w << 16), __uint_as_float(b.w & 0xffff0000u)};
        }
        const f32x4 y00 = r00 + c00 * scale, y01 = r01 + c01 * scale, y10 = r10 + c10 * scale, y11 = r11 + c11 * scale;
        if (MODE == 2) {
            __builtin_nontemporal_store(y00, (f32x4*)(out + off)); __builtin_nontemporal_store(y01, (f32x4*)(out + off + 4)); __builtin_nontemporal_store(y10, (f32x4*)(out + off + 128)); __builtin_nontemporal_store(y11, (f32x4*)(out + off + 132));
        } else {
            u32x4 w0, w1;
            w0.x = cvt_pk_bf16(y00[0], y00[1]); w0.y = cvt_pk_bf16(y00[2], y00[3]); w0.z = cvt_pk_bf16(y01[0], y01[1]); w0.w = cvt_pk_bf16(y01[2], y01[3]);
            w1.x = cvt_pk_bf16(y10[0], y10[1]); w1.y = cvt_pk_bf16(y10[2], y10[3]); w1.z = cvt_pk_bf16(y11[0], y11[1]); w1.w = cvt_pk_bf16(y11[2], y11[3]);
            *(u32x4*)(xb + off) = w0; *(u32x4*)(xb + off + 128) = w1;
            float ss = (y00[0] * y00[0] + y00[1] * y00[1]) + (y00[2] * y00[2] + y00[3] * y00[3]) + (y01[0] * y01[0] + y01[1] * y01[1]) + (y01[2] * y01[2] + y01[3] * y01[3])
                     + (y10[0] * y10[0] + y10[1] * y10[1]) + (y10[2] * y10[2] + y10[3] * y10[3]) + (y11[0] * y11[0] + y11[1] * y11[1]) + (y11[2] * y11[2] + y11[3] * y11[3]);
            ss = sum_rows4(ss);
            if (fq == 0) ssq[(size_t)r * 16 + pn * 4 + wc] = ss;
        }
    }
    EPI_BIG_CALL()
};

struct EpiInProj {
    static constexpr bool PERM = true; static constexpr int PF = 1;
    unsigned char* ws; const float* gq; const float* gk; float* out; LAS unsigned char* lds;
    struct Pre { f32x4 q; };
    __device__ __forceinline__ Pre pre(int r, int pn, int wc, int fq) const { Pre p; p.q = ssq_quarter((const float*)(ws + WS_SSQ1), r, fq); return p; }
    __device__ __forceinline__ Pre pre_big(int r, int pn, int wc, int fq) const { Pre p; p.q = *(const LAS f32x4*)(lds + SSQ_LDS_OFF + (r & 255) * 64 + fq * 16); return p; }
    __device__ __forceinline__ void prefetch(const pg8::Unit& u, int wid, int lane, LAS unsigned char* l) const { ssq_prefetch((const float*)(ws + WS_SSQ1), u.pm, wid, lane, l); }
    __device__ __forceinline__ void rows(const f32x4& c00, const f32x4& c01, const f32x4& c10, const f32x4& c11, int r, int pn, int wc, int fq, const Pre& p) const {
        const bool sample = r >= MP;
        int b, t, pos;
        if (sample) { const int rr = r - MP; b = rr >> 4; t = rr & 15; pos = PAST + t; } else { b = r >> 13; t = r & (TP - 1); pos = t; }
        const float rs = rstd_from(p.q);
        if (pn < 4) {
            const int ch0 = pn * 128 + wc * 32 + 8 * fq;
            float o[8];
#pragma unroll
            for (int j = 0; j < 4; ++j) { o[j] = (c00[j] * rs) * sigmoid_f(c10[j] * rs); o[4 + j] = (c01[j] * rs) * sigmoid_f(c11[j] * rs); }
            u32x4 w; w.x = cvt_pk_bf16(o[0], o[1]); w.y = cvt_pk_bf16(o[2], o[3]); w.z = cvt_pk_bf16(o[4], o[5]); w.w = cvt_pk_bf16(o[6], o[7]);
            bf16_t* ud = sample ? (bf16_t*)(ws + WS_US) + ((size_t)(b * USROWS + HIST + t)) * CC + ch0 : (bf16_t*)(ws + WS_UP) + (size_t)r * CC + ch0;
            *(u32x4*)ud = w;
            float* dst = nullptr;
            if (sample) dst = out + O_CSS + ((size_t)(b * HIST + (HIST - TS) + t)) * CC + ch0;
            else if (t >= TP - HIST) dst = out + O_CSP + ((size_t)(b * HIST + (t - (TP - HIST)))) * CC + ch0;
            if (dst) { *(f32x4*)dst = (f32x4){o[0], o[1], o[2], o[3]}; *(f32x4*)(dst + 4) = (f32x4){o[4], o[5], o[6], o[7]}; }
        } else if (pn < 6 || wc < 2) {
            const bool isq = pn < 6;
            const int h = isq ? (pn - 4) * 4 + wc : wc;
            const float* gg = isq ? gq : gk;
            const f32x4 g00 = *(const f32x4*)(gg + 8 * fq), g01 = *(const f32x4*)(gg + 8 * fq + 4), g10 = *(const f32x4*)(gg + 32 + 8 * fq), g11 = *(const f32x4*)(gg + 32 + 8 * fq + 4);
            const float osc = isq ? QSCALE : 1.0f;
            f32x4 v00 = c00 * rs, v01 = c01 * rs, v10 = c10 * rs, v11 = c11 * rs;
            float ss = (v00[0] * v00[0] + v00[1] * v00[1]) + (v00[2] * v00[2] + v00[3] * v00[3]) + (v01[0] * v01[0] + v01[1] * v01[1]) + (v01[2] * v01[2] + v01[3] * v01[3])
                     + (v10[0] * v10[0] + v10[1] * v10[1]) + (v10[2] * v10[2] + v10[3] * v10[3]) + (v11[0] * v11[0] + v11[1] * v11[1]) + (v11[2] * v11[2] + v11[3] * v11[3]);
            ss = sum_rows4(ss);
            const float hn = rsqrtf(ss * (1.0f / HD) + EPS);
            v00 = v00 * hn * g00; v01 = v01 * hn * g01; v10 = v10 * hn * g10; v11 = v11 * hn * g11;
            f32x4 p0, p1;
#pragma unroll
            for (int j = 0; j < 4; ++j) { p0[j] = __shfl_xor(v00[j], 16); p1[j] = __shfl_xor(v01[j], 16); }
            if (fq < 2) {
                const f32x2* rp = (const f32x2*)(ws + WS_ROPE) + (size_t)pos * 8;
                const float sg = (fq == 0) ? -1.0f : 1.0f;
#pragma unroll
                for (int j = 0; j < 4; ++j) {
                    const f32x2 cs0 = rp[j], cs1 = rp[4 + j];
                    v00[j] = v00[j] * cs0.x + sg * p0[j] * cs0.y;
                    v01[j] = v01[j] * cs1.x + sg * p1[j] * cs1.y;
                }
            }
            u32x4 w0, w1;
            w0.x = cvt_pk_bf16(v00[0] * osc, v00[1] * osc); w0.y = cvt_pk_bf16(v00[2] * osc, v00[3] * osc); w0.z = cvt_pk_bf16(v01[0] * osc, v01[1] * osc); w0.w = cvt_pk_bf16(v01[2] * osc, v01[3] * osc);
            w1.x = cvt_pk_bf16(v10[0] * osc, v10[1] * osc); w1.y = cvt_pk_bf16(v10[2] * osc, v10[3] * osc); w1.z = cvt_pk_bf16(v11[0] * osc, v11[1] * osc); w1.w = cvt_pk_bf16(v11[2] * osc, v11[3] * osc);
            if (isq) {
                bf16_t* dst = (bf16_t*)(ws + WS_Q) + (size_t)r * 512 + h * 64 + 8 * fq;
                *(u32x4*)dst = w0; *(u32x4*)(dst + 32) = w1;
            } else {
                bf16_t* dst = sample ? (bf16_t*)(ws + WS_KS) + ((size_t)(b * KSROWS + WIN + t)) * 128 + h * 64 + 8 * fq : (bf16_t*)(ws + WS_KP) + (size_t)r * 128 + h * 64 + 8 * fq;
                *(u32x4*)dst = w0; *(u32x4*)(dst + 32) = w1;
                float* od = nullptr;
                if (sample) od = out + O_KWS + ((size_t)((b * WIN + (WIN - TS) + t) * 2 + h)) * 64 + 8 * fq;
                else if (t >= TP - WIN) od = out + O_KWP + ((size_t)((b * WIN + (t - (TP - WIN))) * 2 + h)) * 64 + 8 * fq;
                if (od) { *(f32x4*)od = v00; *(f32x4*)(od + 4) = v01; *(f32x4*)(od + 32) = v10; *(f32x4*)(od + 36) = v11; }
            }
        } else {
            const int kh = wc - 2;
            const f32x4 v00 = c00 * rs, v01 = c01 * rs, v10 = c10 * rs, v11 = c11 * rs;
            bf16_t* vt; size_t vs;
            if (sample) { vt = (bf16_t*)(ws + WS_VTS) + ((size_t)((b * 2 + kh) * 64)) * KSROWS + WIN + t; vs = KSROWS; }
            else { vt = (bf16_t*)(ws + WS_VTP) + ((size_t)((b * 2 + kh) * (TP / 64) + (t >> 6))) * 4096 + (t & 63); vs = 64; }
#pragma unroll
            for (int j = 0; j < 4; ++j) {
                vt[(size_t)(8 * fq + j) * vs] = f2bf(v00[j]); vt[(size_t)(8 * fq + 4 + j) * vs] = f2bf(v01[j]);
                vt[(size_t)(32 + 8 * fq + j) * vs] = f2bf(v10[j]); vt[(size_t)(32 + 8 * fq + 4 + j) * vs] = f2bf(v11[j]);
            }
            float* od = nullptr;
            if (sample) od = out + O_VWS + ((size_t)((b * WIN + (WIN - TS) + t) * 2 + kh)) * 64 + 8 * fq;
            else if (t >= TP - WIN) od = out + O_VWP + ((size_t)((b * WIN + (t - (TP - WIN))) * 2 + kh)) * 64 + 8 * fq;
            if (od) { *(f32x4*)od = v00; *(f32x4*)(od + 4) = v01; *(f32x4*)(od + 32) = v10; *(f32x4*)(od + 36) = v11; }
        }
    }
    EPI_BIG_CALL()
};

template <int KS, int MT, bool I8, class Epi>
__device__ __forceinline__ void small_gemm(const bf16_t* A, const bf16_t* Bt, int N, int K, const Epi& E, LAS unsigned char* lds, int bid, int G, int wave, int lane, int wpc_in = 0) {
    constexpr int MTN = MS / (16 * MT);
    const int NT = MTN * (N / 256) * 4, NI = NT * KS, wpc = wpc_in ? wpc_in : (NI + G - 1) / G, nb = K / 64;
    asm volatile("" : "+v"(lane));
    const int fr = lane & 15, g = lane >> 4;
    for (int i0 = 0; i0 < wpc; i0 += 8) {
        const int i = i0 + wave, item = bid * wpc + i;
        const bool active = (i < wpc) && (item < NI);
        const int t = active ? item / KS : 0, ksl = item % KS;
        const int mt = t % MTN, nq = t / MTN, pn = nq >> 2, wc = nq & 3;
        const int r = MP + mt * (16 * MT) + fr;
        typedef typename pg8::AccT<I8>::type acc_t;
        acc_t acc[MT][2][2];
#pragma unroll
        for (int mi = 0; mi < MT; ++mi)
#pragma unroll
            for (int bj = 0; bj < 2; ++bj)
#pragma unroll
                for (int n = 0; n < 2; ++n) acc[mi][bj][n] = acc_t{};
        if (active) {
            const int b0 = (nb * ksl) / KS, b1 = (nb * (ksl + 1)) / KS;
            const bf16_t* ap = A + (size_t)r * K + g * 8;
            const bf16_t* bp = Bt + (size_t)(pn * 256 + wc * 32 + 8 * (fr >> 2) + (fr & 3)) * K + g * 8;
            bf16x8 afA[2][MT], bfA[2][2][2], afB[2][MT], bfB[2][2][2];
#define SG_LOAD(af, bf, kb) do { const int k0_ = (kb) * 64; _Pragma("unroll") for (int s_ = 0; s_ < 2; ++s_) { \
            _Pragma("unroll") for (int mi = 0; mi < MT; ++mi) af[s_][mi] = *(const bf16x8*)(ap + (size_t)(16 * mi) * K + k0_ + s_ * 32); \
            _Pragma("unroll") for (int bj = 0; bj < 2; ++bj) _Pragma("unroll") for (int n = 0; n < 2; ++n) bf[s_][bj][n] = *(const bf16x8*)(bp + (size_t)(4 * n + 128 * bj) * K + k0_ + s_ * 32); } } while (0)
#define SG_MMA(af, bf) do { _Pragma("unroll") for (int s_ = 0; s_ < 2; ++s_) _Pragma("unroll") for (int bj = 0; bj < 2; ++bj) _Pragma("unroll") for (int n = 0; n < 2; ++n) { \
            _Pragma("unroll") for (int mi = 0; mi < MT; ++mi) acc[mi][bj][n] = pg8::mma16(bf[s_][bj][n], af[s_][mi], acc[mi][bj][n]); } } while (0)
            SG_LOAD(afA, bfA, b0);
            for (int kb = b0; kb < b1; kb += 2) {
                const int kb1 = (kb + 1 < b1) ? kb + 1 : b1 - 1, kb2 = (kb + 2 < b1) ? kb + 2 : b1 - 1;
                __builtin_amdgcn_sched_barrier(0);
                SG_LOAD(afB, bfB, kb1);
                __builtin_amdgcn_sched_barrier(0);
                SG_MMA(afA, bfA);
                __builtin_amdgcn_sched_barrier(0);
                SG_LOAD(afA, bfA, kb2);
                __builtin_amdgcn_sched_barrier(0);
                if (kb + 1 < b1) SG_MMA(afB, bfB);
            }
#undef SG_LOAD
#undef SG_MMA
        }
        if constexpr (KS > 1) {
            static_assert(KS == 1 || KS == 8, "KS: 1 or 8 (all eight waves of the workgroup on one tile)");
            LAS acc_t* red = (LAS acc_t*)lds;
            if (ksl != 0) {
#pragma unroll
                for (int mi = 0; mi < MT; ++mi)
#pragma unroll
                    for (int bj = 0; bj < 2; ++bj)
#pragma unroll
                        for (int n = 0; n < 2; ++n) red[(ksl - 1) * (MT * 256) + ((mi * 2 + bj) * 2 + n) * 64 + lane] = acc[mi][bj][n];
            }
            __syncthreads();
            if (ksl == 0) {
#pragma unroll
                for (int q = 0; q < KS - 1; ++q)
#pragma unroll
                    for (int mi = 0; mi < MT; ++mi)
#pragma unroll
                        for (int bj = 0; bj < 2; ++bj)
#pragma unroll
                            for (int n = 0; n < 2; ++n) acc[mi][bj][n] += red[q * (MT * 256) + ((mi * 2 + bj) * 2 + n) * 64 + lane];
            }
            __syncthreads();
        }
        if (active && ksl == 0) {
#pragma unroll
            for (int mi = 0; mi < MT; ++mi) { const typename Epi::Pre p = E.pre(r + 16 * mi, pn, wc, g);
                E.rows(__builtin_convertvector(acc[mi][0][0], f32x4), __builtin_convertvector(acc[mi][0][1], f32x4), __builtin_convertvector(acc[mi][1][0], f32x4), __builtin_convertvector(acc[mi][1][1], f32x4), r + 16 * mi, pn, wc, g, p); }
        }
    }
}

struct TItem { const float* W; const float* g; bf16_t* WT; int Nsrc, srccol0, K, destrow0, k0; };
__device__ __forceinline__ void p0_tload(const TItem& t, float (&v)[32], int lane) {
#pragma unroll
    for (int i = 0; i < 32; ++i) { const int kk = 2 * i + (lane >> 5); v[i] = t.W[(size_t)(t.k0 + kk) * t.Nsrc + t.srccol0 + (lane & 31)]; }
}
__device__ __forceinline__ void p0_tfinish(const TItem& t, const float (&v)[32], LAS float* scr, int lane) {
#pragma unroll
    for (int i = 0; i < 32; ++i) { const int kk = 2 * i + (lane >> 5); scr[kk * 33 + (lane & 31)] = v[i]; }
    asm volatile("s_waitcnt lgkmcnt(0)" ::: "memory");
    const int c = lane & 7;
    f32x4 g0 = (f32x4){1.f, 1.f, 1.f, 1.f}, g1 = g0;
    if (t.g) { g0 = *(const f32x4*)(t.g + t.k0 + 8 * c); g1 = *(const f32x4*)(t.g + t.k0 + 8 * c + 4); }
#pragma unroll
    for (int j = 0; j < 4; ++j) { const int n = (lane >> 3) + 8 * j; const LAS float* sp = scr + (8 * c) * 33 + n;
        u32x4 o; o.x = cvt_pk_bf16(sp[0 * 33] * g0.x, sp[1 * 33] * g0.y); o.y = cvt_pk_bf16(sp[2 * 33] * g0.z, sp[3 * 33] * g0.w); o.z = cvt_pk_bf16(sp[4 * 33] * g1.x, sp[5 * 33] * g1.y); o.w = cvt_pk_bf16(sp[6 * 33] * g1.z, sp[7 * 33] * g1.w);
        *(u32x4*)(t.WT + (size_t)(t.destrow0 + n) * t.K + t.k0 + 8 * c) = o; }
    asm volatile("s_waitcnt lgkmcnt(0)" ::: "memory");
}
__device__ __forceinline__ int src_up(int nb) { const int pn = nb >> 3, p0 = (nb & 7) * 32, bj = p0 >> 7; return bj * FF + pn * 128 + (p0 & 127); }
__device__ __forceinline__ int src_in(int nb) {
    const int pn = nb >> 3, p0 = (nb & 7) * 32, bj = p0 >> 7, wc = (p0 & 127) >> 5;
    if (pn < 4) return bj * CC + pn * 128 + wc * 32;
    if (pn < 6) return 1024 + ((pn - 4) * 4 + wc) * 64 + bj * 32;
    return (wc < 2) ? 1536 + wc * 64 + bj * 32 : 1664 + (wc - 2) * 64 + bj * 32;
}

struct Args { const float* in[21]; float* out; unsigned char* ws; float inv[8]; };

constexpr int I_UP = (D / 64) * (NUP / 32), I_DN = (FF / 64) * (D / 32), I_IN = (D / 64) * (NIN / 32), I_O = (D / 64) * (D / 32);
constexpr int NITEMS = 2 * I_UP + 2 * I_DN + I_IN + I_O;
constexpr int NITEMS_EARLY = I_UP + I_DN + I_IN + I_O;
__device__ __forceinline__ TItem p0_decode(const Args& a, int it) {
    unsigned char* ws = a.ws; int r = it < NITEMS ? it : NITEMS - 1; TItem t;
    if (r < I_UP) { const int nblk = NUP / 32, kb = r / nblk, nb = r % nblk; t = TItem{a.in[6], a.in[5], (bf16_t*)(ws + WS_W1T), NUP, src_up(nb), D, nb * 32, kb * 64}; return t; } r -= I_UP;
    if (r < I_DN) { const int nblk = D / 32, kb = r / nblk, nb = r % nblk; t = TItem{a.in[7], nullptr, (bf16_t*)(ws + WS_W2T), D, nb * 32, FF, nb * 32, kb * 64}; return t; } r -= I_DN;
    if (r < I_IN) { const int nblk = NIN / 32, kb = r / nblk, nb = r % nblk; t = TItem{a.in[9], a.in[8], (bf16_t*)(ws + WS_WINT), NIN, src_in(nb), D, nb * 32, kb * 64}; return t; } r -= I_IN;
    if (r < I_O) { const int nblk = D / 32, kb = r / nblk, nb = r % nblk; t = TItem{a.in[17], nullptr, (bf16_t*)(ws + WS_WOT), D, nb * 32, D, nb * 32, kb * 64}; return t; } r -= I_O;
    if (r < I_UP) { const int nblk = NUP / 32, kb = r / nblk, nb = r % nblk; t = TItem{a.in[19], a.in[18], (bf16_t*)(ws + WS_W3T), NUP, src_up(nb), D, nb * 32, kb * 64}; return t; } r -= I_UP;
    { const int nblk = D / 32, kb = r / nblk, nb = r % nblk; t = TItem{a.in[20], nullptr, (bf16_t*)(ws + WS_W4T), D, nb * 32, FF, nb * 32, kb * 64}; return t; }
}
__device__ __forceinline__ void weights_convert(const Args& a, LAS unsigned char* lds, int it0, int it1, int gw, int NGW, int wave, int lane) {
    LAS float* scr = (LAS float*)(lds + wave * 16896);
    for (int it = it0 + gw; it < it1; it += 2 * NGW) {
        const TItem t0 = p0_decode(a, it), t1 = p0_decode(a, it + NGW < it1 ? it + NGW : it);
        float v0[32], v1[32];
        p0_tload(t0, v0, lane); p0_tload(t1, v1, lane);
        p0_tfinish(t0, v0, scr, lane);
        if (it + NGW < it1) p0_tfinish(t1, v1, scr + 64 * 33, lane);
    }
}


__device__ __forceinline__ void w8_strip(const float* W, const float* g, signed char* Wq, float* cs, int nb, LAS unsigned char* lds, int wave, int lane) {
    LAS float* scr = (LAS float*)(lds + wave * 16896);
    LAS float* red = (LAS float*)(lds + 139264);
    const int src0 = src_up(nb), k0 = 128 * wave, c = lane & 7;
    TItem t0{W, nullptr, nullptr, NUP, src0, D, 0, k0}, t1{W, nullptr, nullptr, NUP, src0, D, 0, k0 + 64};
    float v0[32], v1[32];
    p0_tload(t0, v0, lane); p0_tload(t1, v1, lane);
#pragma unroll
    for (int i = 0; i < 32; ++i) { const int kk = 2 * i + (lane >> 5); scr[kk * 33 + (lane & 31)] = v0[i]; scr[64 * 33 + kk * 33 + (lane & 31)] = v1[i]; }
    asm volatile("s_waitcnt lgkmcnt(0)" ::: "memory");
    float val[2][4][8]; float mx[4];
#pragma unroll
    for (int h = 0; h < 2; ++h) { const f32x4 ga = *(const f32x4*)(g + k0 + 64 * h + 8 * c), gb = *(const f32x4*)(g + k0 + 64 * h + 8 * c + 4);
#pragma unroll
        for (int j = 0; j < 4; ++j) { const LAS float* sp = scr + h * (64 * 33) + (8 * c) * 33 + (lane >> 3) + 8 * j;
#pragma unroll
            for (int i = 0; i < 8; ++i) val[h][j][i] = sp[i * 33] * (i < 4 ? ga[i] : gb[i - 4]); } }
#pragma unroll
    for (int j = 0; j < 4; ++j) { float m = 0.f;
#pragma unroll
        for (int h = 0; h < 2; ++h)
#pragma unroll
            for (int i = 0; i < 8; ++i) m = fmaxf(m, fabsf(val[h][j][i]));
        m = fmaxf(m, __shfl_xor(m, 1)); m = fmaxf(m, __shfl_xor(m, 2)); m = fmaxf(m, __shfl_xor(m, 4));
        mx[j] = m; }
    if (c == 0) {
#pragma unroll
        for (int j = 0; j < 4; ++j) red[wave * 32 + (lane >> 3) + 8 * j] = mx[j]; }
    __syncthreads();
#pragma unroll
    for (int j = 0; j < 4; ++j) { float m = 0.f;
#pragma unroll
        for (int w = 0; w < 8; ++w) m = fmaxf(m, red[w * 32 + (lane >> 3) + 8 * j]);
        mx[j] = m; }
#pragma unroll
    for (int j = 0; j < 4; ++j) { const int n = (lane >> 3) + 8 * j; const float inv = mx[j] > 0.f ? 127.0f / mx[j] : 0.f;
        if (wave == 0 && c == 0) cs[nb * 32 + n] = mx[j] > 0.f ? mx[j] * (1.0f / 127.0f) : 1.0f;
#pragma unroll
        for (int h = 0; h < 2; ++h) { unsigned lo = 0u, hi = 0u;
#pragma unroll
            for (int i = 0; i < 4; ++i) { lo |= ((unsigned)(int)rintf(val[h][j][i] * inv) & 0xffu) << (8 * i); hi |= ((unsigned)(int)rintf(val[h][j][4 + i] * inv) & 0xffu) << (8 * i); }
            *(u32x2*)(Wq + (size_t)(nb * 32 + n) * D + k0 + 64 * h + 8 * c) = (u32x2){lo, hi}; } }
    __syncthreads();
}
template <int NR> __device__ __forceinline__ void q8_rows(unsigned char* ws, const float* ssq, int m0, int lane) {
    const bf16_t* AB = (const bf16_t*)(ws + WS_AB); signed char* A8 = (signed char*)(ws + WS_A8); float* RS = (float*)(ws + WS_RS);
    u32x4 xa[NR], xb[NR]; float sq[NR];
#pragma unroll
    for (int q = 0; q < NR; ++q) { const bf16_t* row = AB + (size_t)(m0 + q) * D; xa[q] = *(const u32x4*)(row + 8 * lane); xb[q] = *(const u32x4*)(row + 512 + 8 * lane); sq[q] = lane < 16 ? ssq[(size_t)(m0 + q) * 16 + lane] : 0.f; }
#pragma unroll
    for (int q = 0; q < NR; ++q) {
        float s = dpp_row_sum(sq[q]); s = __builtin_bit_cast(float, __builtin_amdgcn_readfirstlane(__builtin_bit_cast(int, s)));
        const float rstd = rsqrtf(s * (1.0f / D) + EPS);
        float v[16];
#pragma unroll
        for (int i = 0; i < 4; ++i) { const unsigned a = xa[q][i], b = xb[q][i];
            v[2 * i] = __uint_as_float(a << 16) * rstd; v[2 * i + 1] = __uint_as_float(a & 0xffff0000u) * rstd; v[8 + 2 * i] = __uint_as_float(b << 16) * rstd; v[8 + 2 * i + 1] = __uint_as_float(b & 0xffff0000u) * rstd; }
        float m = 0.f;
#pragma unroll
        for (int i = 0; i < 16; ++i) m = fmaxf(m, fabsf(v[i]));
        m = fmaxf(m, __shfl_xor(m, 1)); m = fmaxf(m, __shfl_xor(m, 2)); m = fmaxf(m, __shfl_xor(m, 4)); m = fmaxf(m, __shfl_xor(m, 8)); m = max_rows4(m);
        const float inv = m > 0.f ? 127.0f / m : 0.f;
        unsigned p[4];
#pragma unroll
        for (int i = 0; i < 4; ++i) { unsigned w = 0u;
#pragma unroll
            for (int e = 0; e < 4; ++e) w |= ((unsigned)(int)rintf(v[4 * i + e] * inv) & 0xffu) << (8 * e);
            p[i] = w; }
        signed char* orow = A8 + (size_t)(m0 + q) * D;
        *(u32x2*)(orow + 8 * lane) = (u32x2){p[0], p[1]}; *(u32x2*)(orow + 512 + 8 * lane) = (u32x2){p[2], p[3]};
        if (lane == 0) RS[m0 + q] = m > 0.f ? m * (1.0f / 127.0f) : 1.0f;
    }
}
template <int NR> __device__ __forceinline__ void x_rows(const Args& a, int m0, int lane) {
    bf16_t* AB = (bf16_t*)(a.ws + WS_AB); float* ssq0 = (float*)(a.ws + WS_SSQ0);
    f32x4 v[NR][4];
#pragma unroll
    for (int q = 0; q < NR; ++q) { const int m = m0 + q;
        const float* xrow = (m < MP) ? a.in[0] + (size_t)m * D : a.in[1] + (size_t)(m - MP) * D;
        const f32x4* xr = (const f32x4*)xrow + lane;
#pragma unroll
        for (int j = 0; j < 4; ++j) v[q][j] = xr[64 * j]; }
    float t[NR + 1];
#pragma unroll
    for (int q = 0; q < NR; ++q) { float s = 0.f;
#pragma unroll
        for (int j = 0; j < 4; ++j) s += (v[q][j].x * v[q][j].x + v[q][j].y * v[q][j].y) + (v[q][j].z * v[q][j].z + v[q][j].w * v[q][j].w);
        t[q] = s; }
    t[NR] = 0.f;
#pragma unroll
    for (int q = 0; q < NR; q += 2) wave_sum2(t[q], t[q + 1]);
#pragma unroll
    for (int q = 0; q < NR; ++q) { const int m = m0 + q;
        u32x2* o8 = (u32x2*)(AB + (size_t)m * D) + lane;
#pragma unroll
        for (int j = 0; j < 4; ++j) { u32x2 w; w.x = cvt_pk_bf16(v[q][j].x, v[q][j].y); w.y = cvt_pk_bf16(v[q][j].z, v[q][j].w); o8[64 * j] = w; }
        if (lane < 16) ssq0[(size_t)m * 16 + lane] = (lane == 0) ? t[q] : 0.f; }
}

__device__ __forceinline__ void p0_prologue(const Args& a, LAS unsigned char* lds) {
    int tid = threadIdx.x; asm volatile("" : "+v"(tid));
    const int lane = tid & 63, wave = tid >> 6;
    const int gw = blockIdx.x * 8 + wave, NGW = gridDim.x * 8;
    unsigned char* ws = a.ws;
    weights_convert(a, lds, 0, NITEMS_EARLY, gw, NGW, wave, lane);
    for (int m0 = gw * 8; m0 < MP; m0 += NGW * 8) x_rows<8>(a, m0, lane);
    for (int m = MP + gw; m < M; m += NGW) x_rows<1>(a, m, lane);
    const int gt = blockIdx.x * 512 + tid, NGT = gridDim.x * 512;
    f32x2* rope = (f32x2*)(ws + WS_ROPE);
    for (int i = gt; i < TP * 8; i += NGT) {
        const int pos = i >> 3, k = i & 7;
        const float ang = (float)pos * a.inv[k];
        const double rev = (double)ang * 0.15915494309189535;
        const float fr = (float)(rev - rint(rev));
        rope[i] = (f32x2){__builtin_amdgcn_cosf(fr), __builtin_amdgcn_sinf(fr)};
    }
    bf16_t* KS = (bf16_t*)(ws + WS_KS); bf16_t* VTS = (bf16_t*)(ws + WS_VTS); bf16_t* US = (bf16_t*)(ws + WS_US);
    for (int i = gt; i < NBS * WIN * 128; i += NGT) {
        const int c = i & 127, row = (i >> 7) & (WIN - 1), b = i >> 14;
        const float kv = a.in[3][i], vv = a.in[4][i];
        KS[((size_t)(b * KSROWS + row)) * 128 + c] = f2bf(kv);
        VTS[((size_t)(b * 128 + c)) * KSROWS + row] = f2bf(vv);
        if (row >= TS) { a.out[O_KWS + ((size_t)(b * WIN + row - TS)) * 128 + c] = kv; a.out[O_VWS + ((size_t)(b * WIN + row - TS)) * 128 + c] = vv; }
    }
    for (int i = gt; i < NBS * 128 * 16; i += NGT) { const int k = i & 15, rowd = i >> 4; VTS[(size_t)rowd * KSROWS + WIN + TS + k] = 0; }
    for (int i = gt; i < NBS * HIST * CC; i += NGT) {
        const int c = i & (CC - 1), row = (i >> 9) % HIST, b = (i >> 9) / HIST;
        const float uv = a.in[2][i];
        US[((size_t)(b * USROWS + row)) * CC + c] = f2bf(uv);
        if (row >= TS) a.out[O_CSS + ((size_t)(b * HIST + row - TS)) * CC + c] = uv;
    }
}

constexpr int ATT_VT_OFF = 192 * 128, ATT_VT_STRIDE = 400, ATT_BUF = ATT_VT_OFF + 64 * ATT_VT_STRIDE;
constexpr int ATT_UNITS_P = NBP * (TP / 64) * 2, ATT_UNITS = ATT_UNITS_P + NBS * 2;
constexpr int CONV_UNITS = MP / 16 + NBS;

struct AttUnit { const bf16_t* kb; const bf16_t* vt; int nkt; bool sample; };
__device__ __forceinline__ AttUnit att_decode(unsigned char* ws, int unit) {
    AttUnit u;
    if (unit < ATT_UNITS_P) { const int kh = unit & 1, c = (unit >> 1) & 127, b = unit >> 8, cs = c >= 2 ? c - 2 : 0;
        u.nkt = (c - cs + 1) * 4; u.sample = false;
        u.kb = (const bf16_t*)(ws + WS_KP) + ((size_t)(b * TP + cs * 64)) * 128 + kh * 64;
        u.vt = (const bf16_t*)(ws + WS_VTP) + ((size_t)((b * 2 + kh) * (TP / 64) + cs)) * 4096; }
    else { const int p = unit - ATT_UNITS_P, b = p >> 1, kh = p & 1;
        u.nkt = 9; u.sample = true;
        u.kb = (const bf16_t*)(ws + WS_KS) + ((size_t)(b * KSROWS)) * 128 + kh * 64;
        u.vt = (const bf16_t*)(ws + WS_VTS) + ((size_t)((b * 2 + kh) * 64)) * KSROWS; }
    return u;
}
__device__ __forceinline__ void att_stage_load(const AttUnit& u, int tid, u32x4 (&kp)[3], u32x4 (&vp)[3]) {
    const int nk = u.nkt * 16;
#pragma unroll
    for (int i = 0; i < 3; ++i) {
        const int p = tid + 512 * i; int row = p >> 3; const int ch = p & 7; row = row < nk ? row : nk - 1;
        kp[i] = *(const u32x4*)(u.kb + (size_t)row * 128 + ch * 8);
        if (u.sample) { int pp = p < 1280 ? p : 1279; const int d = pp / 20, q = pp - d * 20; vp[i] = *(const u32x4*)(u.vt + (size_t)d * KSROWS + q * 8); }
        else { const int jmax = (u.nkt >> 2) - 1, j = i < jmax ? i : jmax; vp[i] = *(const u32x4*)(u.vt + (size_t)j * 4096 + (p & 511) * 8); }
    }
}
__device__ __forceinline__ void att_stage_write(const AttUnit& u, int tid, LAS unsigned char* buf, const u32x4 (&kp)[3], const u32x4 (&vp)[3]) {
    const int nk = u.nkt * 16;
#pragma unroll
    for (int i = 0; i < 3; ++i) {
        const int p = tid + 512 * i; int row = p >> 3; const int ch = p & 7; row = row < nk ? row : nk - 1;
        *(LAS u32x4*)(buf + row * 128 + ((ch ^ ((row >> 1) & 7)) << 4)) = kp[i];
        if (u.sample) { int pp = p < 1280 ? p : 1279; const int d = pp / 20, q = pp - d * 20; *(LAS u32x4*)(buf + ATT_VT_OFF + d * ATT_VT_STRIDE + q * 16) = vp[i]; }
        else { const int jmax = (u.nkt >> 2) - 1, j = i < jmax ? i : jmax; const int d = (p & 511) >> 3, q = p & 7; *(LAS u32x4*)(buf + ATT_VT_OFF + d * ATT_VT_STRIDE + j * 128 + q * 16) = vp[i]; }
    }
}
__device__ __forceinline__ void attn_compute(const bf16x8 (&qf)[2][2], LAS const unsigned char* buf, int nkt, float sink0, float sink1, bf16_t* o0, bf16_t* o1, int lane) {
    const int fr = lane & 15, g = lane >> 4;
    f32x4 S[2][12];
    const float NEG = -INFINITY;
#pragma unroll
    for (int kt = 0; kt < 12; ++kt) {
        const int ktc = kt < nkt ? kt : nkt - 1, row = ktc * 16 + fr, sw = (row >> 1) & 7;
        const bf16x8 k0 = *(LAS const bf16x8*)(buf + row * 128 + ((g ^ sw) << 4)), k1 = *(LAS const bf16x8*)(buf + row * 128 + (((g + 4) ^ sw) << 4));
        const bool ok = kt < nkt;
#pragma unroll
        for (int qt = 0; qt < 2; ++qt) {
            f32x4 c = (f32x4){0.f, 0.f, 0.f, 0.f};
            c = __builtin_amdgcn_mfma_f32_16x16x32_bf16(k0, qf[qt][0], c, 0, 0, 0);
            c = __builtin_amdgcn_mfma_f32_16x16x32_bf16(k1, qf[qt][1], c, 0, 0, 0);
            S[qt][kt] = ok ? c : (f32x4){NEG, NEG, NEG, NEG};
        }
    }
    bf16x8 pf[2][6]; float linv[2];
#pragma unroll
    for (int qt = 0; qt < 2; ++qt) {
        const float sink = qt ? sink1 : sink0;
        float mx = sink;
#pragma unroll
        for (int kt = 0; kt < 12; ++kt) mx = fmaxf(mx, fmaxf(fmaxf(S[qt][kt][0], S[qt][kt][1]), fmaxf(S[qt][kt][2], S[qt][kt][3])));
        mx = max_rows4(mx);
        float l = 0.f;
#pragma unroll
        for (int kt = 0; kt < 12; ++kt) {
#pragma unroll
            for (int j = 0; j < 4; ++j) { const float p = __builtin_amdgcn_exp2f(S[qt][kt][j] - mx); S[qt][kt][j] = p; l += p; }
        }
        l = sum_rows4(l);
        l += __builtin_amdgcn_exp2f(sink - mx);
        linv[qt] = 1.0f / l;
#pragma unroll
        for (int kk = 0; kk < 6; ++kk) {
            u32x4 w; w.x = cvt_pk_bf16(S[qt][2 * kk][0], S[qt][2 * kk][1]); w.y = cvt_pk_bf16(S[qt][2 * kk][2], S[qt][2 * kk][3]);
            w.z = cvt_pk_bf16(S[qt][2 * kk + 1][0], S[qt][2 * kk + 1][1]); w.w = cvt_pk_bf16(S[qt][2 * kk + 1][2], S[qt][2 * kk + 1][3]);
            pf[qt][kk] = __builtin_bit_cast(bf16x8, w);
        }
    }
    f32x4 O[2][4];
    const int kkmax = (nkt - 1) >> 1;
    LAS const unsigned char* vb = buf + ATT_VT_OFF + fr * ATT_VT_STRIDE + g * 8;
#pragma unroll
    for (int dt = 0; dt < 4; ++dt) {
        O[0][dt] = (f32x4){0.f, 0.f, 0.f, 0.f}; O[1][dt] = (f32x4){0.f, 0.f, 0.f, 0.f};
#pragma unroll
        for (int kk = 0; kk < 6; ++kk) {
            const int kkc = kk < kkmax ? kk : kkmax;
            const u32x2 a0 = *(LAS const u32x2*)(vb + dt * 16 * ATT_VT_STRIDE + kkc * 64), a1 = *(LAS const u32x2*)(vb + dt * 16 * ATT_VT_STRIDE + kkc * 64 + 32);
            u32x4 aw; aw.x = a0.x; aw.y = a0.y; aw.z = a1.x; aw.w = a1.y;
            const bf16x8 af = __builtin_bit_cast(bf16x8, aw);
            O[0][dt] = __builtin_amdgcn_mfma_f32_16x16x32_bf16(af, pf[0][kk], O[0][dt], 0, 0, 0);
            O[1][dt] = __builtin_amdgcn_mfma_f32_16x16x32_bf16(af, pf[1][kk], O[1][dt], 0, 0, 0);
        }
    }
#pragma unroll
    for (int qt = 0; qt < 2; ++qt) {
        bf16_t* ob = (qt ? o1 : o0) + (size_t)fr * D + 4 * g;
#pragma unroll
        for (int dt = 0; dt < 4; ++dt) {
            const f32x4 v = O[qt][dt] * linv[qt];
            u32x2 w; w.x = cvt_pk_bf16(v[0], v[1]); w.y = cvt_pk_bf16(v[2], v[3]);
            *(u32x2*)(ob + dt * 16) = w;
        }
    }
}

__device__ __forceinline__ void attn_phase(const Args& a, LAS unsigned char* lds, int tid, int first, int G) {
    asm volatile("" : "+v"(tid));
    unsigned char* ws = a.ws;
    const int lane = tid & 63, wave = __builtin_amdgcn_readfirstlane(tid >> 6), fr = lane & 15, g = lane >> 4;
    const bf16_t* Q = (const bf16_t*)(ws + WS_Q); bf16_t* MIX = (bf16_t*)(ws + WS_MIX);
    const float* sinks = a.in[12];
    if (first >= ATT_UNITS) return;
    AttUnit cur = att_decode(ws, first);
    u32x4 kp[3], vp[3];
    att_stage_load(cur, tid, kp, vp);
    int par = 0;
    for (int unit = first; unit < ATT_UNITS; unit += G, par ^= 1) {
        LAS unsigned char* buf = lds + par * ATT_BUF;
        att_stage_write(cur, tid, buf, kp, vp);
        const bf16_t* q0; const bf16_t* q1; bf16_t* o0; bf16_t* o1; float sk0, sk1; bool work;
        if (!cur.sample) { const int kh = unit & 1, c = (unit >> 1) & 127, b = unit >> 8, h = kh * 4 + (wave >> 1), tok0 = c * 64 + (wave & 1) * 32;
            q0 = Q + ((size_t)(b * TP + tok0)) * 512 + h * 64; q1 = q0 + 16 * 512;
            o0 = MIX + ((size_t)(b * TP + tok0)) * D + 512 + h * 64; o1 = o0 + 16 * D; sk0 = sk1 = sinks[h] * LOG2E; work = true; }
        else { const int p = unit - ATT_UNITS_P, b = p >> 1, kh = p & 1, h0 = kh * 4 + (wave & 1) * 2;
            q0 = Q + ((size_t)(MP + b * TS)) * 512 + h0 * 64; q1 = q0 + 64;
            o0 = MIX + ((size_t)(MP + b * TS)) * D + 512 + h0 * 64; o1 = o0 + 64; sk0 = sinks[h0] * LOG2E; sk1 = sinks[h0 + 1] * LOG2E; work = wave < 2; }
        bf16x8 qf[2][2];
        qf[0][0] = *(const bf16x8*)(q0 + fr * 512 + g * 8); qf[0][1] = *(const bf16x8*)(q0 + fr * 512 + 32 + g * 8);
        qf[1][0] = *(const bf16x8*)(q1 + fr * 512 + g * 8); qf[1][1] = *(const bf16x8*)(q1 + fr * 512 + 32 + g * 8);
        const int nkt = cur.nkt;
        __syncthreads();
        const int nu = unit + G < ATT_UNITS ? unit + G : unit;
        cur = att_decode(ws, nu);
        att_stage_load(cur, tid, kp, vp);
        if (work) attn_compute(qf, buf, nkt, sk0, sk1, o0, o1, lane);
    }
    __syncthreads();
}

struct ConvUnit { const bf16_t* ub; int jmin; size_t orow; };
__device__ __forceinline__ ConvUnit conv_decode(unsigned char* ws, int cu, int ch) {
    ConvUnit u;
    if (cu < MP / 16) { const int b = cu >> 9, t0 = (cu & 511) * 16; u.ub = (const bf16_t*)(ws + WS_UP) + ((size_t)(b * TP) + t0 - HIST) * CC + ch; u.jmin = HIST - t0; u.orow = (size_t)b * TP + t0; }
    else { const int b = cu - MP / 16; u.ub = (const bf16_t*)(ws + WS_US) + ((size_t)(b * USROWS)) * CC + ch; u.jmin = 0; u.orow = (size_t)MP + b * TS; }
    return u;
}
__device__ __forceinline__ void conv_phase(const Args& a, LAS unsigned char* lds, int tid, int first, int G) {
    asm volatile("" : "+v"(tid));
    unsigned char* ws = a.ws;
    const int ch = tid, wave = tid >> 6, lane = tid & 63;
    if (first >= CONV_UNITS) return;
    const float* wdw = a.in[13] + ch;
    float w[CW];
#pragma unroll
    for (int j = 0; j < CW; ++j) w[j] = wdw[j * CC];
    const float bias = a.in[14][ch];
    const f32x4 gc0 = *(const f32x4*)(a.in[15] + 4 * lane), gc1 = *(const f32x4*)(a.in[15] + 256 + 4 * lane);
    const f32x4 bc0 = *(const f32x4*)(a.in[16] + 4 * lane), bc1 = *(const f32x4*)(a.in[16] + 256 + 4 * lane);
    ConvUnit cur = conv_decode(ws, first, ch);
    bf16_t xr[HIST + 16];
#pragma unroll
    for (int j = 0; j < HIST + 16; ++j) { const int jc = j > cur.jmin ? j : cur.jmin; xr[j] = cur.ub[(size_t)jc * CC]; }
    int par = 0;
    for (int cu = first; cu < CONV_UNITS; cu += G, par ^= 1) {
        const int jmin = cur.jmin; const size_t orow = cur.orow;
        float acc[16];
#pragma unroll
        for (int i = 0; i < 16; ++i) acc[i] = bias;
#pragma unroll
        for (int j = 0; j < HIST + 16; ++j) {
            const float xv = (j >= jmin) ? bf2f(xr[j]) : 0.f;
#pragma unroll
            for (int i = 0; i < 16; ++i) { if (j - i >= 0 && j - i < CW) acc[i] += xv * w[j - i]; }
        }
        __builtin_amdgcn_sched_barrier(0);
        { const int nu = cu + G < CONV_UNITS ? cu + G : cu;
          cur = conv_decode(ws, nu, ch);
#pragma unroll
          for (int j = 0; j < HIST + 16; ++j) { const int jc = j > cur.jmin ? j : cur.jmin; xr[j] = cur.ub[(size_t)jc * CC]; } }
        __builtin_amdgcn_sched_barrier(0);
        LAS float* yb = (LAS float*)lds + par * (16 * CC);
#pragma unroll
        for (int i = 0; i < 16; ++i) yb[i * CC + ch] = acc[i];
        __syncthreads();
        bf16_t* MIX = (bf16_t*)(ws + WS_MIX) + orow * D;
        {
            const int tok = 2 * wave;
            f32x4 v0 = *(const LAS f32x4*)(yb + tok * CC + 4 * lane), v1 = *(const LAS f32x4*)(yb + tok * CC + 256 + 4 * lane);
            f32x4 z0 = *(const LAS f32x4*)(yb + (tok + 1) * CC + 4 * lane), z1 = *(const LAS f32x4*)(yb + (tok + 1) * CC + 256 + 4 * lane);
            float sa = (v0[0] + v0[1]) + (v0[2] + v0[3]) + (v1[0] + v1[1]) + (v1[2] + v1[3]);
            float sb = (z0[0] + z0[1]) + (z0[2] + z0[3]) + (z1[0] + z1[1]) + (z1[2] + z1[3]);
            wave_sum2(sa, sb);
            const float ma = sa * (1.0f / CC), mb = sb * (1.0f / CC);
            v0 = v0 - ma; v1 = v1 - ma; z0 = z0 - mb; z1 = z1 - mb;
            float qa = (v0[0] * v0[0] + v0[1] * v0[1]) + (v0[2] * v0[2] + v0[3] * v0[3]) + (v1[0] * v1[0] + v1[1] * v1[1]) + (v1[2] * v1[2] + v1[3] * v1[3]);
            float qb = (z0[0] * z0[0] + z0[1] * z0[1]) + (z0[2] * z0[2] + z0[3] * z0[3]) + (z1[0] * z1[0] + z1[1] * z1[1]) + (z1[2] * z1[2] + z1[3] * z1[3]);
            wave_sum2(qa, qb);
            const float ra = rsqrtf(qa * (1.0f / CC) + EPS), rb = rsqrtf(qb * (1.0f / CC) + EPS);
            v0 = v0 * ra * gc0 + bc0; v1 = v1 * ra * gc1 + bc1; z0 = z0 * rb * gc0 + bc0; z1 = z1 * rb * gc1 + bc1;
            u32x2 o0, o1, p0, p1;
            o0.x = cvt_pk_bf16(silu_f(v0[0]), silu_f(v0[1])); o0.y = cvt_pk_bf16(silu_f(v0[2]), silu_f(v0[3]));
            o1.x = cvt_pk_bf16(silu_f(v1[0]), silu_f(v1[1])); o1.y = cvt_pk_bf16(silu_f(v1[2]), silu_f(v1[3]));
            p0.x = cvt_pk_bf16(silu_f(z0[0]), silu_f(z0[1])); p0.y = cvt_pk_bf16(silu_f(z0[2]), silu_f(z0[3]));
            p1.x = cvt_pk_bf16(silu_f(z1[0]), silu_f(z1[1])); p1.y = cvt_pk_bf16(silu_f(z1[2]), silu_f(z1[3]));
            *(u32x2*)(MIX + (size_t)tok * D + 4 * lane) = o0; *(u32x2*)(MIX + (size_t)tok * D + 256 + 4 * lane) = o1;
            *(u32x2*)(MIX + (size_t)(tok + 1) * D + 4 * lane) = p0; *(u32x2*)(MIX + (size_t)(tok + 1) * D + 256 + 4 * lane) = p1;
        }
    }
    __syncthreads();
}

#define XB_TMO      128
#define XB_XCNT(j)  (256  + 64 * (j))
#define XB_XSUB(j)  (1280 + 64 * (j))
#define XB_XGEN(j)  (2304 + 64 * (j))
#define XB_TOP      3328
#define XB_TOPGEN   3392
#define XCD_BAR_WORDS 3456
#define XB_SPIN_CAP (1u << 18)
__device__ __forceinline__ unsigned xb_ld(unsigned* p)              { return __hip_atomic_load(p, __ATOMIC_RELAXED, __HIP_MEMORY_SCOPE_AGENT); }
__device__ __forceinline__ unsigned xb_add(unsigned* p, unsigned v) { return __hip_atomic_fetch_add(p, v, __ATOMIC_RELAXED, __HIP_MEMORY_SCOPE_AGENT); }
__device__ __forceinline__ unsigned xb_xcc_id() { return (unsigned)__builtin_amdgcn_s_getreg((3 << 11) | 20) & 0xFu; }
#define XB_SPIN(cond, bar) do { unsigned _sp = 0; while (cond) { __builtin_amdgcn_s_sleep(1); \
    if ((++_sp & 255u) == 0u) { if (xb_ld(&(bar)[XB_TMO])) break; if (_sp > XB_SPIN_CAP) { atomicAdd(&(bar)[XB_TMO], 1u); break; } } } } while (0)
struct XcdBarrier { unsigned* bar; unsigned x; volatile LAS unsigned* st; };
__device__ __forceinline__ XcdBarrier xcd_barrier_post(unsigned* bar, volatile LAS unsigned* st) {
    XcdBarrier b; b.bar = bar; b.x = xb_xcc_id(); b.st = st;
    if (threadIdx.x == 0) (void)xb_add(&bar[XB_XCNT(b.x)], 1u);
    return b;
}
__device__ __forceinline__ void xcd_barrier_complete(unsigned* bar, unsigned x, unsigned& nloc, unsigned& nx) {
    const unsigned G = gridDim.x * gridDim.y * gridDim.z;
    unsigned sum, cnt, mine, sp = 0u;
    for (;;) {
        sum = 0u; cnt = 0u; mine = 0u;
#pragma unroll
        for (unsigned j = 0; j < 16; ++j) { const unsigned c = xb_ld(&bar[XB_XCNT(j)]); sum += c; cnt += (c > 0u) ? 1u : 0u; mine = (j == x) ? c : mine; }
        if (sum == G) break;
        __builtin_amdgcn_s_sleep(1);
        if ((++sp & 255u) == 0u) { if (xb_ld(&bar[XB_TMO])) break; if (sp > XB_SPIN_CAP) { atomicAdd(&bar[XB_TMO], 1u); break; } }
    }
    nloc = mine > 0u ? mine : 1u; nx = cnt > 0u ? cnt : 1u;
}
__device__ __forceinline__ void xcd_barrier(const XcdBarrier& b) {
    asm volatile("s_waitcnt vmcnt(0)" ::: "memory");
    __syncthreads();
    if (threadIdx.x == 0) {
        unsigned* bar = b.bar;
        __builtin_amdgcn_s_waitcnt(0);
        unsigned nloc = b.st[0], nx = b.st[1];
        if (nloc == 0u) { xcd_barrier_complete(bar, b.x, nloc, nx); b.st[0] = nloc; b.st[1] = nx; }
        const unsigned old = xb_add(&bar[XB_XSUB(b.x)], 1u);
        const unsigned gen = old / nloc;
        if (old + 1u == (gen + 1u) * nloc) {
            __builtin_amdgcn_fence(__ATOMIC_RELEASE, "agent");
            asm volatile("s_waitcnt vmcnt(0)" ::: "memory");
            const unsigned og = xb_add(&bar[XB_TOP], 1u);
            const unsigned tg = og / nx;
            if (og + 1u == (tg + 1u) * nx) xb_add(&bar[XB_TOPGEN], 1u);
            else XB_SPIN(xb_ld(&bar[XB_TOPGEN]) == tg, bar);
            __builtin_amdgcn_fence(__ATOMIC_ACQUIRE, "agent");
            xb_add(&bar[XB_XGEN(b.x)], 1u);
            asm volatile("s_waitcnt vmcnt(0)" ::: "memory");
        } else {
            XB_SPIN(xb_ld(&bar[XB_XGEN(b.x)]) == gen, bar);
            __builtin_amdgcn_fence(__ATOMIC_ACQUIRE, "agent");
            asm volatile("s_waitcnt vmcnt(0)" ::: "memory");
        }
    }
    __syncthreads();
}
constexpr int MISC_OFF = 151552;
constexpr size_t CTL_ZERO_BYTES = 65536;
constexpr int CW_BAR = 4096;

__global__ void __launch_bounds__(512, 2) hymba_fwd(Args a) {
    extern __shared__ __attribute__((aligned(16))) unsigned char lds_raw[];
    LAS unsigned char* lds = (LAS unsigned char*)lds_raw;
    unsigned char* ws = a.ws;
    const int tid = threadIdx.x, lane = tid & 63, wave = __builtin_amdgcn_readfirstlane(tid >> 6);
    const int G = gridDim.x, bid = blockIdx.x;
    for (int u = tid; u < (LDS_BYTES - MISC_OFF) / 4; u += 512) ((LAS unsigned*)(lds + MISC_OFF))[u] = 0u;
    __syncthreads();
    const XcdBarrier bar = xcd_barrier_post((unsigned*)ws + CW_BAR, (volatile LAS unsigned*)(lds + MISC_OFF) + 8);
#define GRID_BAR() xcd_barrier(bar)

    bf16_t* AB = (bf16_t*)(ws + WS_AB); bf16_t* ACT = (bf16_t*)(ws + WS_ACT);
    float* ssq0 = (float*)(ws + WS_SSQ0); float* ssq1 = (float*)(ws + WS_SSQ1); float* ssq2 = (float*)(ws + WS_SSQ2);

#ifndef PROBE_DUP
#define PROBE_DUP -1
#endif
#ifndef PHASE_MASK
#define PHASE_MASK 0xff
#endif
#define REPS(k) if (PHASE_MASK & (1 << (k))) for (int rep_ = 0; rep_ < ((PROBE_DUP == (k)) ? 2 : 1); ++rep_)
    REPS(0) { p0_prologue(a, lds); GRID_BAR(); }
    REPS(1) {
    { pg8::Gemm g{AB, (const bf16_t*)(ws + WS_W1T), MP, NUP, D}; pg8::StaticOrder S; S.init(MP, NUP, G, bid);
      EpiSwiglu E{ACT, ssq0, lds};
      for (int pass = 0; pass < 2; ++pass) { if (((pass ^ (bid >> 6)) & 1) == 0) { pg8::gemm_phase<EpiSwiglu, pg8::StaticOrder, true, true>(lds, g, S, E); } else { small_gemm<1, 4, false>(AB, (const bf16_t*)(ws + WS_W1T), NUP, D, E, lds, bid, G, wave, lane); } } }
    GRID_BAR(); }
    REPS(2) {
    { pg8::Gemm g{ACT, (const bf16_t*)(ws + WS_W2T), MP, D, FF}; pg8::StaticOrder S; S.init(MP, D, G, bid);
      EpiResid<0> E{a.in[0], a.in[1], nullptr, AB, ssq1, 0.5f};
      for (int pass = 0; pass < 2; ++pass) { if (((pass ^ (bid >> 6)) & 1) == 0) { pg8::gemm_phase<EpiResid<0>, pg8::StaticOrder, true, true>(lds, g, S, E); } else { small_gemm<8, 2, false>(ACT, (const bf16_t*)(ws + WS_W2T), D, FF, E, lds, bid, G, wave, lane); } } }
    GRID_BAR(); }
    REPS(3) {
    { pg8::Gemm g{AB, (const bf16_t*)(ws + WS_WINT), MP, NIN, D}; pg8::StaticOrder S; S.init(MP, NIN, G, bid);
      EpiInProj E{ws, a.in[10], a.in[11], a.out, lds};
      pg8::gemm_phase<EpiInProj, pg8::StaticOrder, true, true>(lds, g, S, E);
      small_gemm<1, 4, false>(AB, (const bf16_t*)(ws + WS_WINT), NIN, D, E, lds, G - 1 - bid, G, wave, lane, 2);
      if (rep_ == 0 && bid >= G / 2) { int ln = lane; asm volatile("" : "+v"(ln));
        weights_convert(a, lds, NITEMS_EARLY + I_UP, NITEMS, (bid - G / 2) * 8 + wave, (G - G / 2) * 8, wave, ln);
        __syncthreads();
        for (int nb = bid - G / 2; nb < NUP / 32; nb += G - G / 2) w8_strip(a.in[19], a.in[18], (signed char*)(ws + WS_W3Q), (float*)(ws + WS_CS3), nb, lds, wave, ln); } }
    GRID_BAR(); }
    REPS(4) {
#ifndef PROBE_P4SUB
#define PROBE_P4SUB 0
#endif
    if (!(rep_ == 1 && PROBE_P4SUB == 2)) attn_phase(a, lds, tid, bid, G);
    if (!(rep_ == 1 && PROBE_P4SUB == 1)) conv_phase(a, lds, tid, G - 1 - bid, G);
    GRID_BAR(); }
    REPS(5) {
    { pg8::Gemm g{(const bf16_t*)(ws + WS_MIX), (const bf16_t*)(ws + WS_WOT), MP, D, D}; pg8::StaticOrder S; S.init(MP, D, G, bid);
      EpiResid<1> E{nullptr, nullptr, nullptr, AB, ssq2, 1.0f};
      for (int pass = 0; pass < 2; ++pass) { if (((pass ^ (bid >> 6)) & 1) == 0) { pg8::gemm_phase<EpiResid<1>, pg8::StaticOrder, true, true>(lds, g, S, E); } else { small_gemm<8, 2, false>((const bf16_t*)(ws + WS_MIX), (const bf16_t*)(ws + WS_WOT), D, D, E, lds, bid, G, wave, lane); } } }
    GRID_BAR(); }
    { const int gw = bid * 8 + wave, NGW = G * 8; int ln = lane; asm volatile("" : "+v"(ln));
      for (int m0 = gw * 4; m0 < M; m0 += NGW * 4) q8_rows<4>(ws, ssq2, m0, ln);
      GRID_BAR(); }
    REPS(6) {
    { pg8::Gemm g{(const bf16_t*)(ws + WS_A8), (const bf16_t*)(ws + WS_W3Q), MP, NUP, D / 2}; pg8::StaticOrder S; S.init(MP, NUP, G, bid);
      EpiSwigluI8 E{ACT, (const float*)(ws + WS_RS), (const float*)(ws + WS_CS3), lds};
      for (int pass = 0; pass < 2; ++pass) { if (((pass ^ (bid >> 6)) & 1) == 0) { pg8::gemm_phase<EpiSwigluI8, pg8::StaticOrder, true, true, true>(lds, g, S, E); } else { small_gemm<1, 4, true>((const bf16_t*)(ws + WS_A8), (const bf16_t*)(ws + WS_W3Q), NUP, D / 2, E, lds, bid, G, wave, lane); } } }
    GRID_BAR(); }
    REPS(7) { pg8::Gemm g{ACT, (const bf16_t*)(ws + WS_W4T), MP, D, FF}; pg8::StaticOrder S; S.init(MP, D, G, bid);
      EpiResid<2> E{nullptr, nullptr, a.out, AB, nullptr, 0.5f};
      for (int pass = 0; pass < 2; ++pass) { if (((pass ^ (bid >> 6)) & 1) == 0) { pg8::gemm_phase<EpiResid<2>, pg8::StaticOrder, true, true>(lds, g, S, E); } else { small_gemm<8, 2, false>(ACT, (const bf16_t*)(ws + WS_W4T), D, FF, E, lds, bid, G, wave, lane); } } }
}

extern "C" void kernel_launch(void* const* d_in, const int* in_sizes, int n_in, void* d_out, int out_size, void* d_ws, size_t ws_size, hipStream_t stream) {
    static int grid = 0;
    if (grid == 0) {
        if (n_in != 21 || (size_t)out_size != O_END || ws_size < WS_END) { fprintf(stderr, "kernel_launch: unexpected shapes: n_in %d out %d ws %zu (need %zu)\n", n_in, out_size, ws_size, (size_t)WS_END); grid = -1; return; }
        int dev = 0, cus = 0, per_cu = 0;
        (void)hipGetDevice(&dev);
        (void)hipDeviceGetAttribute(&cus, hipDeviceAttributeMultiprocessorCount, dev);
        if (cus != 256) fprintf(stderr, "kernel_launch: note: built for a 256-CU device (one workgroup per CU), this device reports %d\n", cus);
        if (hipFuncSetAttribute((const void*)hymba_fwd, hipFuncAttributeMaxDynamicSharedMemorySize, LDS_BYTES) != hipSuccess) { fprintf(stderr, "kernel_launch: hipFuncSetAttribute failed\n"); grid = -1; return; }
        if (hipOccupancyMaxActiveBlocksPerMultiprocessor(&per_cu, (const void*)hymba_fwd, 512, LDS_BYTES) != hipSuccess || per_cu < 1) { fprintf(stderr, "kernel_launch: occupancy query failed (%d)\n", per_cu); grid = -1; (void)hipGetLastError(); return; }
        grid = cus;
    }
    if (grid < 0) return;
    Args a{};
    for (int i = 0; i < 21; ++i) a.in[i] = (const float*)d_in[i];
    a.out = (float*)d_out; a.ws = (unsigned char*)d_ws;
    for (int i = 0; i < 8; ++i) a.inv[i] = powf(500000.0f, -(float)i / 8.0f);
    if (hipMemsetAsync(d_ws, 0, CTL_ZERO_BYTES, stream) != hipSuccess) { fprintf(stderr, "kernel_launch: memset failed\n"); return; }
    hipLaunchKernelGGL(hymba_fwd, dim3(grid), dim3(512), LDS_BYTES, stream, a);
    const hipError_t e = hipPeekAtLastError();
    if (e != hipSuccess) fprintf(stderr, "kernel_launch: launch failed: %s (grid %d)\n", hipGetErrorString(e), grid);
}
```

```cpp
#include <hip/hip_runtime.h>
#include <cstdio>
#include <cstdint>
#include <cmath>

#define LAS __attribute__((address_space(3)))
typedef unsigned short bf16_t;
typedef short bf16x8 __attribute__((ext_vector_type(8)));
typedef float f32x4 __attribute__((ext_vector_type(4)));
typedef float f32x2 __attribute__((ext_vector_type(2)));
typedef unsigned u32x4 __attribute__((ext_vector_type(4)));
typedef unsigned u32x2 __attribute__((ext_vector_type(2)));
typedef int i32x4 __attribute__((ext_vector_type(4)));

constexpr int D = 1024, TP = 8192, NBP = 4, NBS = 32, TS = 16, MP = NBP * TP, MS = NBS * TS, M = MP + MS;
constexpr int FF = 2816, NUP = 2 * FF, NIN = 1792, CC = 512, HD = 64, PAST = 4096;
constexpr int CW = 31, HIST = CW - 1, WIN = 128;
constexpr int KSROWS = 160;
constexpr int USROWS = HIST + TS;
constexpr float EPS = 1e-6f;
constexpr float LOG2E = 1.4426950408889634f;
constexpr float QSCALE = 0.125f * LOG2E;

constexpr size_t O_YP = 0, O_YS = (size_t)MP * D, O_CSP = O_YS + (size_t)MS * D, O_KWP = O_CSP + (size_t)NBP * HIST * CC,
                 O_VWP = O_KWP + (size_t)NBP * WIN * 128, O_CSS = O_VWP + (size_t)NBP * WIN * 128, O_KWS = O_CSS + (size_t)NBS * HIST * CC,
                 O_VWS = O_KWS + (size_t)NBS * WIN * 128, O_END = O_VWS + (size_t)NBS * WIN * 128;

constexpr size_t al(size_t x) { return (x + 4095) & ~(size_t)4095; }
constexpr size_t WS_CTL = 0;
constexpr size_t WS_W1T = 1u << 20;
constexpr size_t WS_W2T = WS_W1T + al((size_t)NUP * D * 2);
constexpr size_t WS_WINT = WS_W2T + al((size_t)D * FF * 2);
constexpr size_t WS_WOT = WS_WINT + al((size_t)NIN * D * 2);
constexpr size_t WS_W3T = WS_WOT + al((size_t)D * D * 2);
constexpr size_t WS_W4T = WS_W3T + al((size_t)NUP * D * 2);
constexpr size_t WS_ROPE = WS_W4T + al((size_t)D * FF * 2);
constexpr size_t WS_SSQ0 = WS_ROPE + al((size_t)TP * 8 * 8);
constexpr size_t WS_SSQ1 = WS_SSQ0 + al((size_t)M * 16 * 4);
constexpr size_t WS_SSQ2 = WS_SSQ1 + al((size_t)M * 16 * 4);
constexpr size_t WS_KS = WS_SSQ2 + al((size_t)M * 16 * 4);
constexpr size_t WS_VTS = WS_KS + al((size_t)NBS * KSROWS * 128 * 2);
constexpr size_t WS_US = WS_VTS + al((size_t)NBS * 128 * KSROWS * 2);
constexpr size_t WS_AB = WS_US + al((size_t)NBS * USROWS * CC * 2);
constexpr size_t WS_X1 = WS_AB + al((size_t)M * D * 2);
constexpr size_t WS_ACT = WS_X1 + al((size_t)M * D * 4);
constexpr size_t WS_A8 = WS_X1;
constexpr size_t WS_W3Q = WS_A8 + al((size_t)M * D);
constexpr size_t WS_W1Q = WS_W3Q + al((size_t)NUP * D);
constexpr size_t WS_RS = WS_W1Q + al((size_t)NUP * D);
constexpr size_t WS_CS3 = WS_RS + al((size_t)M * 4);
constexpr size_t WS_CS1 = WS_CS3 + al((size_t)NUP * 4);
static_assert(WS_CS1 + (size_t)NUP * 4 <= WS_ACT, "int8 operands fit in the f32 scratch");
constexpr size_t WS_END = WS_ACT + al((size_t)M * FF * 2);
constexpr size_t WS_UP = WS_ACT;
constexpr size_t WS_Q = WS_UP + al((size_t)MP * CC * 2);
constexpr size_t WS_KP = WS_Q + al((size_t)M * 512 * 2);
constexpr size_t WS_VTP = WS_KP + al((size_t)MP * 128 * 2);
constexpr size_t WS_MIX = WS_VTP + al((size_t)MP * 128 * 2);
static_assert(WS_MIX + (size_t)M * D * 2 <= WS_END, "overlay fits");

constexpr int LDS_BYTES = 155648;
constexpr int SSQ_LDS_OFF = 131072;

__device__ __forceinline__ unsigned cvt_pk_bf16(float lo, float hi) { unsigned r; asm volatile("v_cvt_pk_bf16_f32 %0, %1, %2" : "=v"(r) : "v"(lo), "v"(hi)); return r; }
__device__ __forceinline__ float bf2f(bf16_t h) { return __uint_as_float((unsigned)h << 16); }
__device__ __forceinline__ bf16_t f2bf(float f) { return (bf16_t)(cvt_pk_bf16(f, 0.f) & 0xffffu); }
__device__ __forceinline__ float silu_f(float a) { return a * __builtin_amdgcn_rcpf(1.0f + __builtin_amdgcn_exp2f(-a * LOG2E)); }
__device__ __forceinline__ float sigmoid_f(float a) { return __builtin_amdgcn_rcpf(1.0f + __builtin_amdgcn_exp2f(-a * LOG2E)); }
__device__ __forceinline__ float sum_rows4(float x) {
    float a = x, b = x;
    asm volatile("s_nop 1\n\tv_permlane16_swap_b32 %0, %1" : "+v"(a), "+v"(b));
    float t = a + b; a = t; b = t;
    asm volatile("s_nop 1\n\tv_permlane32_swap_b32 %0, %1" : "+v"(a), "+v"(b));
    return a + b;
}
__device__ __forceinline__ float max_rows4(float x) {
    float a = x, b = x;
    asm volatile("s_nop 1\n\tv_permlane16_swap_b32 %0, %1" : "+v"(a), "+v"(b));
    float t = fmaxf(a, b); a = t; b = t;
    asm volatile("s_nop 1\n\tv_permlane32_swap_b32 %0, %1" : "+v"(a), "+v"(b));
    return fmaxf(a, b);
}
__device__ __forceinline__ float wave_sum(float v) {
#pragma unroll
    for (int o = 1; o < 64; o <<= 1) v += __shfl_xor(v, o);
    return v;
}
__device__ __forceinline__ float dpp_row_sum(float v) {
    v += __builtin_bit_cast(float, __builtin_amdgcn_update_dpp(0, __builtin_bit_cast(int, v), 0xB1, 0xF, 0xF, true));
    v += __builtin_bit_cast(float, __builtin_amdgcn_update_dpp(0, __builtin_bit_cast(int, v), 0x4E, 0xF, 0xF, true));
    v += __builtin_bit_cast(float, __builtin_amdgcn_update_dpp(0, __builtin_bit_cast(int, v), 0x124, 0xF, 0xF, true));
    v += __builtin_bit_cast(float, __builtin_amdgcn_update_dpp(0, __builtin_bit_cast(int, v), 0x128, 0xF, 0xF, true));
    return v;
}
__device__ __forceinline__ void wave_sum2(float& a, float& b) {
    a = dpp_row_sum(a); b = dpp_row_sum(b);
    a = sum_rows4(a); b = sum_rows4(b);
}
__device__ __forceinline__ float row_rstd(const float* ssq, int r) {
    const f32x4* p = (const f32x4*)(ssq + (size_t)r * 16);
    const f32x4 a = p[0], b = p[1], c = p[2], d = p[3];
    const f32x4 s = (a + b) + (c + d);
    return rsqrtf(((s.x + s.y) + (s.z + s.w)) * (1.0f / D) + EPS);
}

namespace pg8 {
constexpr int BM = 256, BK = 64, HALF = 128, HTB = HALF * BK * 2, STAGE_BYTES = 8 * HTB, NXCD = 8, WGM = 8;
__host__ __device__ __forceinline__ int lds_byte(int r, int c) { const int st = (r >> 4) * 2 + (c >> 5), rr = r & 15, cc = c & 31, ob = rr * 64 + cc * 2; return st * 1024 + (ob ^ (((ob >> 9) & 1) << 5)); }
__host__ __device__ __forceinline__ void stage_rc(int b, int& R, int& C) { const int st = b / 1024, sb = b % 1024, swz = sb ^ (((sb >> 9) & 1) << 5); R = (st >> 1) * 16 + swz / 64; C = (st & 1) * 32 + (swz % 64) / 2; }
__host__ __device__ __forceinline__ int perm32(int rho) { const int n = rho >> 4, i = rho & 15; return 8 * (i >> 2) + 4 * n + (i & 3); }

struct Unit { int pm, pn; };
struct Gemm { const bf16_t* A; const bf16_t* Bt; int M, N, K; };

struct StaticOrder {
    int nM, nN, nwg, G, c;
    __host__ __device__ void init(int M_, int N_, int G_, int c_) { nM = M_ / BM; nN = N_ / BM; nwg = nM * nN; G = G_; c = c_; }
    __host__ __device__ bool next(int i, Unit& u) const {
        const long L = (long)i * G + c; if (L >= nwg) return false;
        int wgid = (int)L; { const int q = nwg / NXCD, r = nwg % NXCD, xcd = wgid % NXCD, off = wgid / NXCD; wgid = (xcd < r ? xcd * (q + 1) : r * (q + 1) + (xcd - r) * q) + off; }
        const int nig = WGM * nN, gid = wgid / nig, fm = gid * WGM, gsz = (nM - fm) < WGM ? (nM - fm) : WGM;
        u.pm = fm + ((wgid % nig) % gsz); u.pn = (wgid % nig) / gsz; return true;
    }
    __device__ __forceinline__ void a_ready(const Unit&) const {}
    __device__ __forceinline__ void done(const Unit&) const {}
};

__device__ __forceinline__ f32x4 mma16(bf16x8 b, bf16x8 a, f32x4 c) { return __builtin_amdgcn_mfma_f32_16x16x32_bf16(b, a, c, 0, 0, 0); }
__device__ __forceinline__ i32x4 mma16(bf16x8 b, bf16x8 a, i32x4 c) { return __builtin_amdgcn_mfma_i32_16x16x64_i8(__builtin_bit_cast(i32x4, b), __builtin_bit_cast(i32x4, a), c, 0, 0, 0); }
template <bool I8> struct AccT { typedef f32x4 type; };
template <> struct AccT<true> { typedef i32x4 type; };
template <class Epi, class Sched, bool ALIGN_EPI, bool SP2, bool I8 = false>
__device__ __forceinline__ void gemm_phase(LAS unsigned char* lds, const Gemm g, const Sched& S, const Epi& E) {
    int tid = threadIdx.x; asm volatile("" : "+v"(tid));
    const int wid = __builtin_amdgcn_readfirstlane(tid >> 6), lane = tid & 63, wr = wid >> 2, wc = wid & 3, fr = lane & 15, fq = lane >> 4;
    const int K = g.K, nt = K / BK;
    unsigned voffA[2], voffB[2];
#pragma unroll
    for (int i = 0; i < 2; ++i) { int R, C; stage_rc(tid * 16 + i * 8192, R, C); const int Rb = Epi::PERM ? ((R & ~31) + perm32(R & 31)) : R;
        voffA[i] = (unsigned)(R * K + C) * 2u; voffB[i] = (unsigned)(Rb * K + C) * 2u; }
    const size_t kstep = (size_t)(BK * 2);
    const size_t hstep = (size_t)HALF * K * 2;
    const size_t tstep = 2 * hstep;
    const unsigned ldsw = (unsigned)wid * 1024u;
    const int aoff = lds_byte(wr * 64 + fr, fq * 8), boff = lds_byte(wc * 32 + fr, fq * 8);
#define PG8_SA(b, h) (((b) * 2 + (h)) * HTB)
#define PG8_SB(b, h) ((4 + (b) * 2 + (h)) * HTB)
#define PG8_STAGE(bufoff, gbase, voff) do { _Pragma("unroll") for (int _i = 0; _i < 2; ++_i) \
        __builtin_amdgcn_global_load_lds((const unsigned*)((const char*)(gbase) + (voff)[_i]), (LAS unsigned*)(lds + (bufoff) + ldsw + _i * 8192), 16, 0, 0); } while (0)
#define PG8_LDA(dst, b, h) do { _Pragma("unroll") for (int m = 0; m < 4; ++m) _Pragma("unroll") for (int k = 0; k < 2; ++k) dst[m][k] = *(const LAS bf16x8*)(lds + PG8_SA(b, h) + aoff + m * 2048 + k * 1024); } while (0)
#define PG8_LDB(dst, b, h) do { _Pragma("unroll") for (int n = 0; n < 2; ++n) _Pragma("unroll") for (int k = 0; k < 2; ++k) dst[n][k] = *(const LAS bf16x8*)(lds + PG8_SB(b, h) + boff + n * 2048 + k * 1024); } while (0)
#define PG8_MMA(ai, bj, At, Bt) do { __builtin_amdgcn_s_setprio(1); _Pragma("unroll") for (int m = 0; m < 4; ++m) _Pragma("unroll") for (int n = 0; n < 2; ++n) _Pragma("unroll") for (int k = 0; k < 2; ++k) \
        acc[ai][bj][m][n] = mma16(Bt[n][k], At[m][k], acc[ai][bj][m][n]); __builtin_amdgcn_s_setprio(0); } while (0)
#define PG8_WAIT_V(n) asm volatile("s_waitcnt vmcnt(" #n ")" ::: "memory")
#define PG8_WAIT_L(n) asm volatile("s_waitcnt lgkmcnt(" #n ")" ::: "memory")
#define PG8_BAR __builtin_amdgcn_s_barrier()
#define PG8_SCHED __builtin_amdgcn_sched_barrier(0)
    Unit cur, nxt; int ui = 0;
    if (!S.next(0, cur)) return;
    typedef typename AccT<I8>::type acc_t;
    acc_t acc[2][2][4][2];
#pragma unroll
    for (int a = 0; a < 2; ++a)
#pragma unroll
        for (int b = 0; b < 2; ++b)
#pragma unroll
            for (int m = 0; m < 4; ++m)
#pragma unroll
                for (int n = 0; n < 2; ++n) acc[a][b][m][n] = acc_t{};
    bf16x8 At[4][2], B0[2][2], B1[2][2];
    const char* cA = (const char*)g.A + (size_t)cur.pm * tstep; const char* cB = (const char*)g.Bt + (size_t)cur.pn * tstep;
    S.a_ready(cur);
    if constexpr (SP2) {
        PG8_STAGE(PG8_SB(0, 0), cB, voffB); PG8_STAGE(PG8_SB(0, 1), cB + hstep, voffB); PG8_STAGE(PG8_SA(0, 0), cA, voffA); PG8_STAGE(PG8_SA(0, 1), cA + hstep, voffA);
        if (wr == 1) PG8_BAR;
        PG8_WAIT_V(2); PG8_BAR;
        PG8_STAGE(PG8_SB(1, 0), cB + kstep, voffB); PG8_STAGE(PG8_SA(1, 0), cA + kstep, voffA); PG8_STAGE(PG8_SB(1, 1), cB + hstep + kstep, voffB);
        PG8_WAIT_V(6); PG8_BAR;
    } else {
        PG8_STAGE(PG8_SB(0, 0), cB, voffB); PG8_STAGE(PG8_SA(0, 0), cA, voffA); PG8_STAGE(PG8_SB(0, 1), cB + hstep, voffB); PG8_STAGE(PG8_SA(0, 1), cA + hstep, voffA);
        if (wr == 1) PG8_BAR;
        PG8_WAIT_V(4); PG8_BAR;
        PG8_STAGE(PG8_SB(1, 0), cB + kstep, voffB); PG8_STAGE(PG8_SA(1, 0), cA + kstep, voffA); PG8_STAGE(PG8_SB(1, 1), cB + hstep + kstep, voffB);
        PG8_WAIT_V(6); PG8_BAR;
    }
    for (;;) {
        const bool has_next = S.next(ui + 1, nxt);
        const char* nA = has_next ? (const char*)g.A + (size_t)nxt.pm * tstep : cA; const char* nB = has_next ? (const char*)g.Bt + (size_t)nxt.pn * tstep : cB;
        for (int t = 0; t < nt; t += 2) {
            const bool last = (t == nt - 2);
            const char* a1 = cA + (size_t)(t + 1) * kstep;
            const char* a2 = last ? nA : cA + (size_t)(t + 2) * kstep; const char* b2 = last ? nB : cB + (size_t)(t + 2) * kstep;
            const char* a3 = a2 + kstep; const char* b3 = b2 + kstep;
            if (last && has_next) S.a_ready(nxt);
            if (last) E.prefetch(cur, wid, lane, lds);
            if constexpr (SP2) {
            PG8_LDB(B0, 0, 0); PG8_LDB(B1, 0, 1); PG8_SCHED; PG8_LDA(At, 0, 0); PG8_STAGE(PG8_SA(1, 1), a1 + hstep, voffA);
            PG8_WAIT_V(8); PG8_WAIT_L(0); PG8_BAR; PG8_MMA(0, 0, At, B0); PG8_MMA(0, 1, At, B1); PG8_BAR; PG8_SCHED;
            PG8_LDA(At, 0, 1); PG8_STAGE(PG8_SB(0, 0), b2, voffB); PG8_STAGE(PG8_SB(0, 1), b2 + hstep, voffB); PG8_STAGE(PG8_SA(0, 0), a2, voffA);
            PG8_WAIT_V(8); PG8_WAIT_L(0); PG8_BAR; PG8_MMA(1, 0, At, B0); PG8_MMA(1, 1, At, B1); PG8_BAR; PG8_SCHED;
            PG8_LDB(B0, 1, 0); PG8_LDB(B1, 1, 1); PG8_SCHED; PG8_LDA(At, 1, 0); PG8_STAGE(PG8_SA(0, 1), a2 + hstep, voffA);
            PG8_WAIT_V(8); PG8_WAIT_L(0); PG8_BAR; PG8_MMA(0, 0, At, B0); PG8_MMA(0, 1, At, B1); PG8_BAR; PG8_SCHED;
            PG8_LDA(At, 1, 1); PG8_STAGE(PG8_SB(1, 0), b3, voffB); PG8_STAGE(PG8_SB(1, 1), b3 + hstep, voffB); PG8_STAGE(PG8_SA(1, 0), a3, voffA);
            PG8_WAIT_V(8); PG8_WAIT_L(0); PG8_BAR; PG8_MMA(1, 0, At, B0); PG8_MMA(1, 1, At, B1); PG8_BAR; PG8_SCHED;
            } else {
            PG8_LDB(B0, 0, 0); PG8_SCHED; PG8_LDA(At, 0, 0); PG8_STAGE(PG8_SA(1, 1), a1 + hstep, voffA);
            PG8_WAIT_L(8); PG8_BAR; PG8_WAIT_L(0); PG8_MMA(0, 0, At, B0); PG8_BAR; PG8_SCHED;
            PG8_LDB(B1, 0, 1); PG8_STAGE(PG8_SB(0, 0), b2, voffB);
            PG8_BAR; PG8_WAIT_L(0); PG8_MMA(0, 1, At, B1); PG8_BAR;
            PG8_LDA(At, 0, 1); PG8_STAGE(PG8_SA(0, 0), a2, voffA);
            PG8_BAR; PG8_WAIT_L(0); PG8_MMA(1, 0, At, B0); PG8_BAR; PG8_SCHED;
            PG8_STAGE(PG8_SB(0, 1), b2 + hstep, voffB);
            PG8_WAIT_V(6); PG8_BAR; PG8_MMA(1, 1, At, B1); PG8_BAR;
            PG8_LDB(B0, 1, 0); PG8_SCHED; PG8_LDA(At, 1, 0); PG8_STAGE(PG8_SA(0, 1), a2 + hstep, voffA);
            PG8_WAIT_L(8); PG8_BAR; PG8_WAIT_L(0); PG8_MMA(0, 0, At, B0); PG8_BAR; PG8_SCHED;
            PG8_LDB(B1, 1, 1); PG8_STAGE(PG8_SB(1, 0), b3, voffB);
            PG8_BAR; PG8_WAIT_L(0); PG8_MMA(0, 1, At, B1); PG8_BAR;
            PG8_LDA(At, 1, 1); PG8_STAGE(PG8_SA(1, 0), a3, voffA);
            PG8_BAR; PG8_WAIT_L(0); PG8_MMA(1, 0, At, B0); PG8_BAR; PG8_SCHED;
            PG8_STAGE(PG8_SB(1, 1), b3 + hstep, voffB);
            PG8_WAIT_V(6); PG8_BAR; PG8_MMA(1, 1, At, B1); PG8_BAR;
            }
        }
        if constexpr (ALIGN_EPI) { if (wr == 0) PG8_BAR; }
        E(acc, cur, wr, wc, fr, fq); S.done(cur);
        if (!has_next) break;
#pragma unroll
        for (int a = 0; a < 2; ++a)
#pragma unroll
            for (int b = 0; b < 2; ++b)
#pragma unroll
                for (int m = 0; m < 4; ++m)
#pragma unroll
                    for (int n = 0; n < 2; ++n) acc[a][b][m][n] = acc_t{};
        cur = nxt; cA = nA; cB = nB; ++ui;
        if constexpr (ALIGN_EPI) { if (wr == 1) PG8_BAR; }
    }
    PG8_WAIT_V(0);
    if constexpr (!ALIGN_EPI) { if (wr == 0) PG8_BAR; }
    PG8_BAR;
#undef PG8_SA
#undef PG8_SB
#undef PG8_STAGE
#undef PG8_LDA
#undef PG8_LDB
#undef PG8_MMA
#undef PG8_WAIT_V
#undef PG8_WAIT_L
#undef PG8_BAR
#undef PG8_SCHED
}
}

typedef const f32x4 (&AccRef)[2][2][4][2];
#define EPI_BIG_CALL() \
    __device__ __forceinline__ void operator()(AccRef acc, const pg8::Unit& u, int wr, int wc, int fr, int fq) const { \
        asm volatile("" : "+v"(fr), "+v"(fq));     \
        const int row0 = u.pm * 256 + wr * 64 + fr; \
        _Pragma("unroll") for (int gq = 0; gq < 8 / PF; ++gq) { \
            Pre p[PF]; \
            asm volatile("" ::: "memory"); \
            _Pragma("unroll") for (int i = 0; i < PF; ++i) { const int rg = gq * PF + i; p[i] = pre_big(row0 + (rg >> 2) * 128 + (rg & 3) * 16, u.pn, wc, fq); }     \
            asm volatile("" ::: "memory"); \
            _Pragma("unroll") for (int i = 0; i < PF; ++i) { const int rg = gq * PF + i; \
                rows(acc[rg >> 2][0][rg & 3][0], acc[rg >> 2][0][rg & 3][1], acc[rg >> 2][1][rg & 3][0], acc[rg >> 2][1][rg & 3][1], row0 + (rg >> 2) * 128 + (rg & 3) * 16, u.pn, wc, fq, p[i]); } } \
    }
__device__ __forceinline__ f32x4 ssq_quarter(const float* ssq, int r, int fq) { return *(const f32x4*)(ssq + (size_t)r * 16 + 4 * fq); }
__device__ __forceinline__ float rstd_from(const f32x4& q) {
    float s = (q.x + q.y) + (q.z + q.w);
    s = sum_rows4(s);
    return rsqrtf(s * (1.0f / D) + EPS);
}

__device__ __forceinline__ void ssq_prefetch(const float* ssq, int pm, int wid, int lane, LAS unsigned char* lds) {
#pragma unroll
    for (int i = 0; i < 2; ++i)
        __builtin_amdgcn_global_load_lds((const unsigned*)(ssq + ((size_t)pm * 256 + wid * 32 + i * 16) * 16 + lane * 4), (LAS unsigned*)(lds + SSQ_LDS_OFF + (wid * 32 + i * 16) * 64), 16, 0, 0);
}
struct EpiSwiglu {
    static constexpr bool PERM = true; static constexpr int PF = 8;
    bf16_t* O; const float* ssq; LAS unsigned char* lds;
    struct Pre { f32x4 q; };
    __device__ __forceinline__ Pre pre(int r, int pn, int wc, int fq) const { Pre p; p.q = ssq_quarter(ssq, r, fq); return p; }
    __device__ __forceinline__ Pre pre_big(int r, int pn, int wc, int fq) const { Pre p; p.q = *(const LAS f32x4*)(lds + SSQ_LDS_OFF + (r & 255) * 64 + fq * 16); return p; }
    __device__ __forceinline__ void prefetch(const pg8::Unit& u, int wid, int lane, LAS unsigned char* l) const { ssq_prefetch(ssq, u.pm, wid, lane, l); }
    __device__ __forceinline__ void rows(const f32x4& c00, const f32x4& c01, const f32x4& c10, const f32x4& c11, int r, int pn, int wc, int fq, const Pre& p) const {
        const float rs = rstd_from(p.q);
        float o[8];
#pragma unroll
        for (int j = 0; j < 4; ++j) { o[j] = silu_f(c00[j] * rs) * (c10[j] * rs); o[4 + j] = silu_f(c01[j] * rs) * (c11[j] * rs); }
        u32x4 w; w.x = cvt_pk_bf16(o[0], o[1]); w.y = cvt_pk_bf16(o[2], o[3]); w.z = cvt_pk_bf16(o[4], o[5]); w.w = cvt_pk_bf16(o[6], o[7]);
        { bf16_t* dst_ = O + (size_t)r * FF + pn * 128 + wc * 32 + 8 * fq;
          asm volatile("global_store_dwordx4 %0, %1, off sc1\n\ts_nop 1" :: "v"(dst_), "v"(w) : "memory"); }
    }
    EPI_BIG_CALL()
};

struct EpiSwigluI8 {
    static constexpr bool PERM = true;
    bf16_t* O; const float* rs; const float* cs; LAS unsigned char* lds;
    struct Pre { float sa; };
    __device__ __forceinline__ Pre pre(int r, int pn, int wc, int fq) const { Pre p; p.sa = rs[r]; return p; }
    __device__ __forceinline__ void prefetch(const pg8::Unit& u, int wid, int lane, LAS unsigned char* l) const {
        if (wid == 0) __builtin_amdgcn_global_load_lds((const unsigned*)(rs + (size_t)u.pm * 256 + lane * 4), (LAS unsigned*)(l + SSQ_LDS_OFF), 16, 0, 0);
        if (wid == 1) __builtin_amdgcn_global_load_lds((const unsigned*)(cs + (size_t)u.pn * 256 + lane * 4), (LAS unsigned*)(l + SSQ_LDS_OFF + 1024), 16, 0, 0);
    }
    __device__ __forceinline__ void emit(const f32x4& c00, const f32x4& c01, const f32x4& c10, const f32x4& c11, float sa, const f32x4& w00, const f32x4& w01, const f32x4& w10, const f32x4& w11,
                                         int r, int pn, int wc, int fq) const {
        float o[8];
#pragma unroll
        for (int j = 0; j < 4; ++j) { o[j] = silu_f(c00[j] * (sa * w00[j])) * (c10[j] * (sa * w10[j])); o[4 + j] = silu_f(c01[j] * (sa * w01[j])) * (c11[j] * (sa * w11[j])); }
        u32x4 w; w.x = cvt_pk_bf16(o[0], o[1]); w.y = cvt_pk_bf16(o[2], o[3]); w.z = cvt_pk_bf16(o[4], o[5]); w.w = cvt_pk_bf16(o[6], o[7]);
        { bf16_t* dst_ = O + (size_t)r * FF + pn * 128 + wc * 32 + 8 * fq;
          asm volatile("global_store_dwordx4 %0, %1, off sc1\n\ts_nop 1" :: "v"(dst_), "v"(w) : "memory"); }
    }
    __device__ __forceinline__ void rows(const f32x4& c00, const f32x4& c01, const f32x4& c10, const f32x4& c11, int r, int pn, int wc, int fq, const Pre& p) const {
        const float* cp = cs + (size_t)pn * 256 + wc * 32 + 8 * fq;
        emit(c00, c01, c10, c11, p.sa, *(const f32x4*)cp, *(const f32x4*)(cp + 4), *(const f32x4*)(cp + 128), *(const f32x4*)(cp + 132), r, pn, wc, fq);
    }
    template <class AccTy> __device__ __forceinline__ void operator()(const AccTy (&acc)[2][2][4][2], const pg8::Unit& u, int wr, int wc, int fr, int fq) const {
        { int l_ = threadIdx.x; asm volatile("" : "+v"(l_)); fr = l_ & 15; fq = (l_ >> 4) & 3; }
        const int row0 = u.pm * 256 + wr * 64 + fr;
        LAS const float* lr = (LAS const float*)(lds + SSQ_LDS_OFF); LAS const float* lc = lr + 256 + wc * 32 + 8 * fq;
        const f32x4 w00 = *(LAS const f32x4*)lc, w01 = *(LAS const f32x4*)(lc + 4), w10 = *(LAS const f32x4*)(lc + 128), w11 = *(LAS const f32x4*)(lc + 132);
#pragma unroll
        for (int rg = 0; rg < 8; ++rg) {
            const int ai = rg >> 2, m = rg & 3, r = row0 + ai * 128 + m * 16;
            const float sa = lr[r & 255];
            emit(__builtin_convertvector(acc[ai][0][m][0], f32x4), __builtin_convertvector(acc[ai][0][m][1], f32x4), __builtin_convertvector(acc[ai][1][m][0], f32x4), __builtin_convertvector(acc[ai][1][m][1], f32x4),
                 sa, w00, w01, w10, w11, r, u.pn, wc, fq);
        }
    }
};

template <int MODE> struct EpiResid {
    static constexpr bool PERM = true; static constexpr int PF = (MODE == 0) ? 2 : 4;
    const float* resP; const float* resS;
    float* out; bf16_t* xb; float* ssq; float scale;
    struct Pre { f32x4 r00, r01, r10, r11; u32x4 a, b; };
    __device__ __forceinline__ Pre pre(int r, int pn, int wc, int fq) const {
        Pre p; const size_t off = (size_t)r * D + pn * 256 + wc * 32 + 8 * fq;
        if (MODE == 0) { const float* rbase = (r >= MP) ? resS - (size_t)MP * D : resP;
            p.r00 = *(const f32x4*)(rbase + off); p.r01 = *(const f32x4*)(rbase + off + 4); p.r10 = *(const f32x4*)(rbase + off + 128); p.r11 = *(const f32x4*)(rbase + off + 132); }
        else { p.a = *(const u32x4*)(xb + off); p.b = *(const u32x4*)(xb + off + 128); }
        return p;
    }
    __device__ __forceinline__ Pre pre_big(int r, int pn, int wc, int fq) const { return pre(r, pn, wc, fq); }
    __device__ __forceinline__ void prefetch(const pg8::Unit&, int, int, LAS unsigned char*) const {}
    __device__ __forceinline__ void rows(const f32x4& c00, const f32x4& c01, const f32x4& c10, const f32x4& c11, int r, int pn, int wc, int fq, const Pre& p) const {
        const size_t off = (size_t)r * D + pn * 256 + wc * 32 + 8 * fq;
        f32x4 r00, r01, r10, r11;
        if (MODE == 0) { r00 = p.r00; r01 = p.r01; r10 = p.r10; r11 = p.r11; }
        else {
            const u32x4 a = p.a, b = p.b;
            r00 = (f32x4){__uint_as_float(a.x << 16), __uint_as_float(a.x & 0xffff0000u), __uint_as_float(a.y << 16), __uint_as_float(a.y & 0xffff0000u)};
            r01 = (f32x4){__uint_as_float(a.z << 16), __uint_as_float(a.z & 0xffff0000u), __uint_as_float(a.w << 16), __uint_as_float(a.w & 0xffff0000u)};
            r10 = (f32x4){__uint_as_float(b.x << 16), __uint_as_float(b.x & 0xffff0000u), __uint_as_float(b.y << 16), __uint_as_float(b.y & 0xffff0000u)};
            r11 = (f32x4){__uint_as_float(b.z << 16), __uint_as_float(b.z & 0xffff0000u), __uint_as_float(b.w << 16), __uint_as_float(b.w & 0xffff0000u)};
        }
        const f32x4 y00 = r00 + c00 * scale, y01 = r01 + c01 * scale, y10 = r10 + c10 * scale, y11 = r11 + c11 * scale;
        if (MODE == 2) {
            __builtin_nontemporal_store(y00, (f32x4*)(out + off)); __builtin_nontemporal_store(y01, (f32x4*)(out + off + 4)); __builtin_nontemporal_store(y10, (f32x4*)(out + off + 128)); __builtin_nontemporal_store(y11, (f32x4*)(out + off + 132));
        } else {
            u32x4 w0, w1;
            w0.x = cvt_pk_bf16(y00[0], y00[1]); w0.y = cvt_pk_bf16(y00[2], y00[3]); w0.z = cvt_pk_bf16(y01[0], y01[1]); w0.w = cvt_pk_bf16(y01[2], y01[3]);
            w1.x = cvt_pk_bf16(y10[0], y10[1]); w1.y = cvt_pk_bf16(y10[2], y10[3]); w1.z = cvt_pk_bf16(y11[0], y11[1]); w1.w = cvt_pk_bf16(y11[2], y11[3]);
            *(u32x4*)(xb + off) = w0; *(u32x4*)(xb + off + 128) = w1;
            float ss = (y00[0] * y00[0] + y00[1] * y00[1]) + (y00[2] * y00[2] + y00[3] * y00[3]) + (y01[0] * y01[0] + y01[1] * y01[1]) + (y01[2] * y01[2] + y01[3] * y01[3])
                     + (y10[0] * y10[0] + y10[1] * y10[1]) + (y10[2] * y10[2] + y10[3] * y10[3]) + (y11[0] * y11[0] + y11[1] * y11[1]) + (y11[2] * y11[2] + y11[3] * y11[3]);
            ss = sum_rows4(ss);
            if (fq == 0) ssq[(size_t)r * 16 + pn * 4 + wc] = ss;
        }
    }
    EPI_BIG_CALL()
};

struct EpiInProj {
    static constexpr bool PERM = true; static constexpr int PF = 1;
    unsigned char* ws; const float* gq; const float* gk; float* out; LAS unsigned char* lds;
    struct Pre { f32x4 q; };
    __device__ __forceinline__ Pre pre(int r, int pn, int wc, int fq) const { Pre p; p.q = ssq_quarter((const float*)(ws + WS_SSQ1), r, fq); return p; }
    __device__ __forceinline__ Pre pre_big(int r, int pn, int wc, int fq) const { Pre p; p.q = *(const LAS f32x4*)(lds + SSQ_LDS_OFF + (r & 255) * 64 + fq * 16); return p; }
    __device__ __forceinline__ void prefetch(const pg8::Unit& u, int wid, int lane, LAS unsigned char* l) const { ssq_prefetch((const float*)(ws + WS_SSQ1), u.pm, wid, lane, l); }
    __device__ __forceinline__ void rows(const f32x4& c00, const f32x4& c01, const f32x4& c10, const f32x4& c11, int r, int pn, int wc, int fq, const Pre& p) const {
        const bool sample = r >= MP;
        int b, t, pos;
        if (sample) { const int rr = r - MP; b = rr >> 4; t = rr & 15; pos = PAST + t; } else { b = r >> 13; t = r & (TP - 1); pos = t; }
        const float rs = rstd_from(p.q);
        if (pn < 4) {
            const int ch0 = pn * 128 + wc * 32 + 8 * fq;
            float o[8];
#pragma unroll
            for (int j = 0; j < 4; ++j) { o[j] = (c00[j] * rs) * sigmoid_f(c10[j] * rs); o[4 + j] = (c01[j] * rs) * sigmoid_f(c11[j] * rs); }
            u32x4 w; w.x = cvt_pk_bf16(o[0], o[1]); w.y = cvt_pk_bf16(o[2], o[3]); w.z = cvt_pk_bf16(o[4], o[5]); w.w = cvt_pk_bf16(o[6], o[7]);
            bf16_t* ud = sample ? (bf16_t*)(ws + WS_US) + ((size_t)(b * USROWS + HIST + t)) * CC + ch0 : (bf16_t*)(ws + WS_UP) + (size_t)r * CC + ch0;
            *(u32x4*)ud = w;
            float* dst = nullptr;
            if (sample) dst = out + O_CSS + ((size_t)(b * HIST + (HIST - TS) + t)) * CC + ch0;
            else if (t >= TP - HIST) dst = out + O_CSP + ((size_t)(b * HIST + (t - (TP - HIST)))) * CC + ch0;
            if (dst) { *(f32x4*)dst = (f32x4){o[0], o[1], o[2], o[3]}; *(f32x4*)(dst + 4) = (f32x4){o[4], o[5], o[6], o[7]}; }
        } else if (pn < 6 || wc < 2) {
            const bool isq = pn < 6;
            const int h = isq ? (pn - 4) * 4 + wc : wc;
            const float* gg = isq ? gq : gk;
            const f32x4 g00 = *(const f32x4*)(gg + 8 * fq), g01 = *(const f32x4*)(gg + 8 * fq + 4), g10 = *(const f32x4*)(gg + 32 + 8 * fq), g11 = *(const f32x4*)(gg + 32 + 8 * fq + 4);
            const float osc = isq ? QSCALE : 1.0f;
            f32x4 v00 = c00 * rs, v01 = c01 * rs, v10 = c10 * rs, v11 = c11 * rs;
            float ss = (v00[0] * v00[0] + v00[1] * v00[1]) + (v00[2] * v00[2] + v00[3] * v00[3]) + (v01[0] * v01[0] + v01[1] * v01[1]) + (v01[2] * v01[2] + v01[3] * v01[3])
                     + (v10[0] * v10[0] + v10[1] * v10[1]) + (v10[2] * v10[2] + v10[3] * v10[3]) + (v11[0] * v11[0] + v11[1] * v11[1]) + (v11[2] * v11[2] + v11[3] * v11[3]);
            ss = sum_rows4(ss);
            const float hn = rsqrtf(ss * (1.0f / HD) + EPS);
            v00 = v00 * hn * g00; v01 = v01 * hn * g01; v10 = v10 * hn * g10; v11 = v11 * hn * g11;
            f32x4 p0, p1;
#pragma unroll
            for (int j = 0; j < 4; ++j) { p0[j] = __shfl_xor(v00[j], 16); p1[j] = __shfl_xor(v01[j], 16); }
            if (fq < 2) {
                const f32x2* rp = (const f32x2*)(ws + WS_ROPE) + (size_t)pos * 8;
                const float sg = (fq == 0) ? -1.0f : 1.0f;
#pragma unroll
                for (int j = 0; j < 4; ++j) {
                    const f32x2 cs0 = rp[j], cs1 = rp[4 + j];
                    v00[j] = v00[j] * cs0.x + sg * p0[j] * cs0.y;
                    v01[j] = v01[j] * cs1.x + sg * p1[j] * cs1.y;
                }
            }
            u32x4 w0, w1;
            w0.x = cvt_pk_bf16(v00[0] * osc, v00[1] * osc); w0.y = cvt_pk_bf16(v00[2] * osc, v00[3] * osc); w0.z = cvt_pk_bf16(v01[0] * osc, v01[1] * osc); w0.w = cvt_pk_bf16(v01[2] * osc, v01[3] * osc);
            w1.x = cvt_pk_bf16(v10[0] * osc, v10[1] * osc); w1.y = cvt_pk_bf16(v10[2] * osc, v10[3] * osc); w1.z = cvt_pk_bf16(v11[0] * osc, v11[1] * osc); w1.w = cvt_pk_bf16(v11[2] * osc, v11[3] * osc);
            if (isq) {
                bf16_t* dst = (bf16_t*)(ws + WS_Q) + (size_t)r * 512 + h * 64 + 8 * fq;
                *(u32x4*)dst = w0; *(u32x4*)(dst + 32) = w1;
            } else {
                bf16_t* dst = sample ? (bf16_t*)(ws + WS_KS) + ((size_t)(b * KSROWS + WIN + t)) * 128 + h * 64 + 8 * fq : (bf16_t*)(ws + WS_KP) + (size_t)r * 128 + h * 64 + 8 * fq;
                *(u32x4*)dst = w0; *(u32x4*)(dst + 32) = w1;
                float* od = nullptr;
                if (sample) od = out + O_KWS + ((size_t)((b * WIN + (WIN - TS) + t) * 2 + h)) * 64 + 8 * fq;
                else if (t >= TP - WIN) od = out + O_KWP + ((size_t)((b * WIN + (t - (TP - WIN))) * 2 + h)) * 64 + 8 * fq;
                if (od) { *(f32x4*)od = v00; *(f32x4*)(od + 4) = v01; *(f32x4*)(od + 32) = v10; *(f32x4*)(od + 36) = v11; }
            }
        } else {
            const int kh = wc - 2;
            const f32x4 v00 = c00 * rs, v01 = c01 * rs, v10 = c10 * rs, v11 = c11 * rs;
            bf16_t* vt; size_t vs;
            if (sample) { vt = (bf16_t*)(ws + WS_VTS) + ((size_t)((b * 2 + kh) * 64)) * KSROWS + WIN + t; vs = KSROWS; }
            else { vt = (bf16_t*)(ws + WS_VTP) + ((size_t)((b * 2 + kh) * (TP / 64) + (t >> 6))) * 4096 + (t & 63); vs = 64; }
#pragma unroll
            for (int j = 0; j < 4; ++j) {
                vt[(size_t)(8 * fq + j) * vs] = f2bf(v00[j]); vt[(size_t)(8 * fq + 4 + j) * vs] = f2bf(v01[j]);
                vt[(size_t)(32 + 8 * fq + j) * vs] = f2bf(v10[j]); vt[(size_t)(32 + 8 * fq + 4 + j) * vs] = f2bf(v11[j]);
            }
            float* od = nullptr;
            if (sample) od = out + O_VWS + ((size_t)((b * WIN + (WIN - TS) + t) * 2 + kh)) * 64 + 8 * fq;
            else if (t >= TP - WIN) od = out + O_VWP + ((size_t)((b * WIN + (t - (TP - WIN))) * 2 + kh)) * 64 + 8 * fq;
            if (od) { *(f32x4*)od = v00; *(f32x4*)(od + 4) = v01; *(f32x4*)(od + 32) = v10; *(f32x4*)(od + 36) = v11; }
        }
    }
    EPI_BIG_CALL()
};

template <int KS, int MT, bool I8, class Epi>
__device__ __forceinline__ void small_gemm(const bf16_t* A, const bf16_t* Bt, int N, int K, const Epi& E, LAS unsigned char* lds, int bid, int G, int wave, int lane, int wpc_in = 0) {
    constexpr int MTN = MS / (16 * MT);
    const int NT = MTN * (N / 256) * 4, NI = NT * KS, wpc = wpc_in ? wpc_in : (NI + G - 1) / G, nb = K / 64;
    asm volatile("" : "+v"(lane));
    const int fr = lane & 15, g = lane >> 4;
    for (int i0 = 0; i0 < wpc; i0 += 8) {
        const int i = i0 + wave, item = bid * wpc + i;
        const bool active = (i < wpc) && (item < NI);
        const int t = active ? item / KS : 0, ksl = item % KS;
        const int mt = t % MTN, nq = t / MTN, pn = nq >> 2, wc = nq & 3;
        const int r = MP + mt * (16 * MT) + fr;
        typedef typename pg8::AccT<I8>::type acc_t;
        acc_t acc[MT][2][2];
#pragma unroll
        for (int mi = 0; mi < MT; ++mi)
#pragma unroll
            for (int bj = 0; bj < 2; ++bj)
#pragma unroll
                for (int n = 0; n < 2; ++n) acc[mi][bj][n] = acc_t{};
        if (active) {
            const int b0 = (nb * ksl) / KS, b1 = (nb * (ksl + 1)) / KS;
            const bf16_t* ap = A + (size_t)r * K + g * 8;
            const bf16_t* bp = Bt + (size_t)(pn * 256 + wc * 32 + 8 * (fr >> 2) + (fr & 3)) * K + g * 8;
            bf16x8 afA[2][MT], bfA[2][2][2], afB[2][MT], bfB[2][2][2];
#define SG_LOAD(af, bf, kb) do { const int k0_ = (kb) * 64; _Pragma("unroll") for (int s_ = 0; s_ < 2; ++s_) { \
            _Pragma("unroll") for (int mi = 0; mi < MT; ++mi) af[s_][mi] = *(const bf16x8*)(ap + (size_t)(16 * mi) * K + k0_ + s_ * 32); \
            _Pragma("unroll") for (int bj = 0; bj < 2; ++bj) _Pragma("unroll") for (int n = 0; n < 2; ++n) bf[s_][bj][n] = *(const bf16x8*)(bp + (size_t)(4 * n + 128 * bj) * K + k0_ + s_ * 32); } } while (0)
#define SG_MMA(af, bf) do { _Pragma("unroll") for (int s_ = 0; s_ < 2; ++s_) _Pragma("unroll") for (int bj = 0; bj < 2; ++bj) _Pragma("unroll") for (int n = 0; n < 2; ++n) { \
            _Pragma("unroll") for (int mi = 0; mi < MT; ++mi) acc[mi][bj][n] = pg8::mma16(bf[s_][bj][n], af[s_][mi], acc[mi][bj][n]); } } while (0)
            SG_LOAD(afA, bfA, b0);
            for (int kb = b0; kb < b1; kb += 2) {
                const int kb1 = (kb + 1 < b1) ? kb + 1 : b1 - 1, kb2 = (kb + 2 < b1) ? kb + 2 : b1 - 1;
                __builtin_amdgcn_sched_barrier(0);
                SG_LOAD(afB, bfB, kb1);
                __builtin_amdgcn_sched_barrier(0);
                SG_MMA(afA, bfA);
                __builtin_amdgcn_sched_barrier(0);
                SG_LOAD(afA, bfA, kb2);
                __builtin_amdgcn_sched_barrier(0);
                if (kb + 1 < b1) SG_MMA(afB, bfB);
            }
#undef SG_LOAD
#undef SG_MMA
        }
        if constexpr (KS > 1) {
            static_assert(KS == 1 || KS == 8, "KS: 1 or 8 (all eight waves of the workgroup on one tile)");
            LAS acc_t* red = (LAS acc_t*)lds;
            if (ksl != 0) {
#pragma unroll
                for (int mi = 0; mi < MT; ++mi)
#pragma unroll
                    for (int bj = 0; bj < 2; ++bj)
#pragma unroll
                        for (int n = 0; n < 2; ++n) red[(ksl - 1) * (MT * 256) + ((mi * 2 + bj) * 2 + n) * 64 + lane] = acc[mi][bj][n];
            }
            __syncthreads();
            if (ksl == 0) {
#pragma unroll
                for (int q = 0; q < KS - 1; ++q)
#pragma unroll
                    for (int mi = 0; mi < MT; ++mi)
#pragma unroll
                        for (int bj = 0; bj < 2; ++bj)
#pragma unroll
                            for (int n = 0; n < 2; ++n) acc[mi][bj][n] += red[q * (MT * 256) + ((mi * 2 + bj) * 2 + n) * 64 + lane];
            }
            __syncthreads();
        }
        if (active && ksl == 0) {
#pragma unroll
            for (int mi = 0; mi < MT; ++mi) { const typename Epi::Pre p = E.pre(r + 16 * mi, pn, wc, g);
                E.rows(__builtin_convertvector(acc[mi][0][0], f32x4), __builtin_convertvector(acc[mi][0][1], f32x4), __builtin_convertvector(acc[mi][1][0], f32x4), __builtin_convertvector(acc[mi][1][1], f32x4), r + 16 * mi, pn, wc, g, p); }
        }
    }
}

struct TItem { const float* W; const float* g; bf16_t* WT; int Nsrc, srccol0, K, destrow0, k0; };
__device__ __forceinline__ void p0_tload(const TItem& t, float (&v)[32], int lane) {
#pragma unroll
    for (int i = 0; i < 32; ++i) { const int kk = 2 * i + (lane >> 5); v[i] = t.W[(size_t)(t.k0 + kk) * t.Nsrc + t.srccol0 + (lane & 31)]; }
}
__device__ __forceinline__ void p0_tfinish(const TItem& t, const float (&v)[32], LAS float* scr, int lane) {
#pragma unroll
    for (int i = 0; i < 32; ++i) { const int kk = 2 * i + (lane >> 5); scr[kk * 33 + (lane & 31)] = v[i]; }
    asm volatile("s_waitcnt lgkmcnt(0)" ::: "memory");
    const int c = lane & 7;
    f32x4 g0 = (f32x4){1.f, 1.f, 1.f, 1.f}, g1 = g0;
    if (t.g) { g0 = *(const f32x4*)(t.g + t.k0 + 8 * c); g1 = *(const f32x4*)(t.g + t.k0 + 8 * c + 4); }
#pragma unroll
    for (int j = 0; j < 4; ++j) { const int n = (lane >> 3) + 8 * j; const LAS float* sp = scr + (8 * c) * 33 + n;
        u32x4 o; o.x = cvt_pk_bf16(sp[0 * 33] * g0.x, sp[1 * 33] * g0.y); o.y = cvt_pk_bf16(sp[2 * 33] * g0.z, sp[3 * 33] * g0.w); o.z = cvt_pk_bf16(sp[4 * 33] * g1.x, sp[5 * 33] * g1.y); o.w = cvt_pk_bf16(sp[6 * 33] * g1.z, sp[7 * 33] * g1.w);
        *(u32x4*)(t.WT + (size_t)(t.destrow0 + n) * t.K + t.k0 + 8 * c) = o; }
    asm volatile("s_waitcnt lgkmcnt(0)" ::: "memory");
}
__device__ __forceinline__ int src_up(int nb) { const int pn = nb >> 3, p0 = (nb & 7) * 32, bj = p0 >> 7; return bj * FF + pn * 128 + (p0 & 127); }
__device__ __forceinline__ int src_in(int nb) {
    const int pn = nb >> 3, p0 = (nb & 7) * 32, bj = p0 >> 7, wc = (p0 & 127) >> 5;
    if (pn < 4) return bj * CC + pn * 128 + wc * 32;
    if (pn < 6) return 1024 + ((pn - 4) * 4 + wc) * 64 + bj * 32;
    return (wc < 2) ? 1536 + wc * 64 + bj * 32 : 1664 + (wc - 2) * 64 + bj * 32;
}

struct Args { const float* in[21]; float* out; unsigned char* ws; float inv[8]; };

constexpr int I_UP = (D / 64) * (NUP / 32), I_DN = (FF / 64) * (D / 32), I_IN = (D / 64) * (NIN / 32), I_O = (D / 64) * (D / 32);
constexpr int NITEMS = 2 * I_UP + 2 * I_DN + I_IN + I_O;
constexpr int NITEMS_EARLY = I_UP + I_DN + I_IN + I_O;
__device__ __forceinline__ TItem p0_decode(const Args& a, int it) {
    unsigned char* ws = a.ws; int r = it < NITEMS ? it : NITEMS - 1; TItem t;
    if (r < I_UP) { const int nblk = NUP / 32, kb = r / nblk, nb = r % nblk; t = TItem{a.in[6], a.in[5], (bf16_t*)(ws + WS_W1T), NUP, src_up(nb), D, nb * 32, kb * 64}; return t; } r -= I_UP;
    if (r < I_DN) { const int nblk = D / 32, kb = r / nblk, nb = r % nblk; t = TItem{a.in[7], nullptr, (bf16_t*)(ws + WS_W2T), D, nb * 32, FF, nb * 32, kb * 64}; return t; } r -= I_DN;
    if (r < I_IN) { const int nblk = NIN / 32, kb = r / nblk, nb = r % nblk; t = TItem{a.in[9], a.in[8], (bf16_t*)(ws + WS_WINT), NIN, src_in(nb), D, nb * 32, kb * 64}; return t; } r -= I_IN;
    if (r < I_O) { const int nblk = D / 32, kb = r / nblk, nb = r % nblk; t = TItem{a.in[17], nullptr, (bf16_t*)(ws + WS_WOT), D, nb * 32, D, nb * 32, kb * 64}; return t; } r -= I_O;
    if (r < I_UP) { const int nblk = NUP / 32, kb = r / nblk, nb = r % nblk; t = TItem{a.in[19], a.in[18], (bf16_t*)(ws + WS_W3T), NUP, src_up(nb), D, nb * 32, kb * 64}; return t; } r -= I_UP;
    { const int nblk = D / 32, kb = r / nblk, nb = r % nblk; t = TItem{a.in[20], nullptr, (bf16_t*)(ws + WS_W4T), D, nb * 32, FF, nb * 32, kb * 64}; return t; }
}
__device__ __forceinline__ void weights_convert(const Args& a, LAS unsigned char* lds, int it0, int it1, int gw, int NGW, int wave, int lane) {
    LAS float* scr = (LAS float*)(lds + wave * 16896);
    for (int it = it0 + gw; it < it1; it += 2 * NGW) {
        const TItem t0 = p0_decode(a, it), t1 = p0_decode(a, it + NGW < it1 ? it + NGW : it);
        float v0[32], v1[32];
        p0_tload(t0, v0, lane); p0_tload(t1, v1, lane);
        p0_tfinish(t0, v0, scr, lane);
        if (it + NGW < it1) p0_tfinish(t1, v1, scr + 64 * 33, lane);
    }
}


__device__ __forceinline__ void w8_strip(const float* W, const float* g, signed char* Wq, float* cs, int nb, LAS unsigned char* lds, int wave, int lane) {
    LAS float* scr = (LAS float*)(lds + wave * 16896);
    LAS float* red = (LAS float*)(lds + 139264);
    const int src0 = src_up(nb), k0 = 128 * wave, c = lane & 7;
    TItem t0{W, nullptr, nullptr, NUP, src0, D, 0, k0}, t1{W, nullptr, nullptr, NUP, src0, D, 0, k0 + 64};
    float v0[32], v1[32];
    p0_tload(t0, v0, lane); p0_tload(t1, v1, lane);
#pragma unroll
    for (int i = 0; i < 32; ++i) { const int kk = 2 * i + (lane >> 5); scr[kk * 33 + (lane & 31)] = v0[i]; scr[64 * 33 + kk * 33 + (lane & 31)] = v1[i]; }
    asm volatile("s_waitcnt lgkmcnt(0)" ::: "memory");
    float val[2][4][8]; float mx[4];
#pragma unroll
    for (int h = 0; h < 2; ++h) { const f32x4 ga = *(const f32x4*)(g + k0 + 64 * h + 8 * c), gb = *(const f32x4*)(g + k0 + 64 * h + 8 * c + 4);
#pragma unroll
        for (int j = 0; j < 4; ++j) { const LAS float* sp = scr + h * (64 * 33) + (8 * c) * 33 + (lane >> 3) + 8 * j;
#pragma unroll
            for (int i = 0; i < 8; ++i) val[h][j][i] = sp[i * 33] * (i < 4 ? ga[i] : gb[i - 4]); } }
#pragma unroll
    for (int j = 0; j < 4; ++j) { float m = 0.f;
#pragma unroll
        for (int h = 0; h < 2; ++h)
#pragma unroll
            for (int i = 0; i < 8; ++i) m = fmaxf(m, fabsf(val[h][j][i]));
        m = fmaxf(m, __shfl_xor(m, 1)); m = fmaxf(m, __shfl_xor(m, 2)); m = fmaxf(m, __shfl_xor(m, 4));
        mx[j] = m; }
    if (c == 0) {
#pragma unroll
        for (int j = 0; j < 4; ++j) red[wave * 32 + (lane >> 3) + 8 * j] = mx[j]; }
    __syncthreads();
#pragma unroll
    for (int j = 0; j < 4; ++j) { float m = 0.f;
#pragma unroll
        for (int w = 0; w < 8; ++w) m = fmaxf(m, red[w * 32 + (lane >> 3) + 8 * j]);
        mx[j] = m; }
#pragma unroll
    for (int j = 0; j < 4; ++j) { const int n = (lane >> 3) + 8 * j; const float inv = mx[j] > 0.f ? 127.0f / mx[j] : 0.f;
        if (wave == 0 && c == 0) cs[nb * 32 + n] = mx[j] > 0.f ? mx[j] * (1.0f / 127.0f) : 1.0f;
#pragma unroll
        for (int h = 0; h < 2; ++h) { unsigned lo = 0u, hi = 0u;
#pragma unroll
            for (int i = 0; i < 4; ++i) { lo |= ((unsigned)(int)rintf(val[h][j][i] * inv) & 0xffu) << (8 * i); hi |= ((unsigned)(int)rintf(val[h][j][4 + i] * inv) & 0xffu) << (8 * i); }
            *(u32x2*)(Wq + (size_t)(nb * 32 + n) * D + k0 + 64 * h + 8 * c) = (u32x2){lo, hi}; } }
    __syncthreads();
}
template <int NR> __device__ __forceinline__ void q8_rows(unsigned char* ws, const float* ssq, int m0, int lane) {
    const bf16_t* AB = (const bf16_t*)(ws + WS_AB); signed char* A8 = (signed char*)(ws + WS_A8); float* RS = (float*)(ws + WS_RS);
    u32x4 xa[NR], xb[NR]; float sq[NR];
#pragma unroll
    for (int q = 0; q < NR; ++q) { const bf16_t* row = AB + (size_t)(m0 + q) * D; xa[q] = *(const u32x4*)(row + 8 * lane); xb[q] = *(const u32x4*)(row + 512 + 8 * lane); sq[q] = lane < 16 ? ssq[(size_t)(m0 + q) * 16 + lane] : 0.f; }
#pragma unroll
    for (int q = 0; q < NR; ++q) {
        float s = dpp_row_sum(sq[q]); s = __builtin_bit_cast(float, __builtin_amdgcn_readfirstlane(__builtin_bit_cast(int, s)));
        const float rstd = rsqrtf(s * (1.0f / D) + EPS);
        float v[16];
#pragma unroll
        for (int i = 0; i < 4; ++i) { const unsigned a = xa[q][i], b = xb[q][i];
            v[2 * i] = __uint_as_float(a << 16) * rstd; v[2 * i + 1] = __uint_as_float(a & 0xffff0000u) * rstd; v[8 + 2 * i] = __uint_as_float(b << 16) * rstd; v[8 + 2 * i + 1] = __uint_as_float(b & 0xffff0000u) * rstd; }
        float m = 0.f;
#pragma unroll
        for (int i = 0; i < 16; ++i) m = fmaxf(m, fabsf(v[i]));
        m = fmaxf(m, __shfl_xor(m, 1)); m = fmaxf(m, __shfl_xor(m, 2)); m = fmaxf(m, __shfl_xor(m, 4)); m = fmaxf(m, __shfl_xor(m, 8)); m = max_rows4(m);
        const float inv = m > 0.f ? 127.0f / m : 0.f;
        unsigned p[4];
#pragma unroll
        for (int i = 0; i < 4; ++i) { unsigned w = 0u;
#pragma unroll
            for (int e = 0; e < 4; ++e) w |= ((unsigned)(int)rintf(v[4 * i + e] * inv) & 0xffu) << (8 * e);
            p[i] = w; }
        signed char* orow = A8 + (size_t)(m0 + q) * D;
        *(u32x2*)(orow + 8 * lane) = (u32x2){p[0], p[1]}; *(u32x2*)(orow + 512 + 8 * lane) = (u32x2){p[2], p[3]};
        if (lane == 0) RS[m0 + q] = m > 0.f ? m * (1.0f / 127.0f) : 1.0f;
    }
}
template <int NR> __device__ __forceinline__ void x_rows(const Args& a, int m0, int lane) {
    bf16_t* AB = (bf16_t*)(a.ws + WS_AB); float* ssq0 = (float*)(a.ws + WS_SSQ0);
    f32x4 v[NR][4];
#pragma unroll
    for (int q = 0; q < NR; ++q) { const int m = m0 + q;
        const float* xrow = (m < MP) ? a.in[0] + (size_t)m * D : a.in[1] + (size_t)(m - MP) * D;
        const f32x4* xr = (const f32x4*)xrow + lane;
#pragma unroll
        for (int j = 0; j < 4; ++j) v[q][j] = xr[64 * j]; }
    float t[NR + 1];
#pragma unroll
    for (int q = 0; q < NR; ++q) { float s = 0.f;
#pragma unroll
        for (int j = 0; j < 4; ++j) s += (v[q][j].x * v[q][j].x + v[q][j].y * v[q][j].y) + (v[q][j].z * v[q][j].z + v[q][j].w * v[q][j].w);
        t[q] = s; }
    t[NR] = 0.f;
#pragma unroll
    for (int q = 0; q < NR; q += 2) wave_sum2(t[q], t[q + 1]);
#pragma unroll
    for (int q = 0; q < NR; ++q) { const int m = m0 + q;
        u32x2* o8 = (u32x2*)(AB + (size_t)m * D) + lane;
#pragma unroll
        for (int j = 0; j < 4; ++j) { u32x2 w; w.x = cvt_pk_bf16(v[q][j].x, v[q][j].y); w.y = cvt_pk_bf16(v[q][j].z, v[q][j].w); o8[64 * j] = w; }
        if (lane < 16) ssq0[(size_t)m * 16 + lane] = (lane == 0) ? t[q] : 0.f; }
}

template <int NR> __device__ __forceinline__ void xq8_rows(const Args& a, int m0, int lane) {
    signed char* A8 = (signed char*)(a.ws + WS_A8); float* RS = (float*)(a.ws + WS_RS);
    f32x4 v[NR][4];
#pragma unroll
    for (int q = 0; q < NR; ++q) { const int m = m0 + q;
        const float* xrow = (m < MP) ? a.in[0] + (size_t)m * D : a.in[1] + (size_t)(m - MP) * D;
        const f32x4* xr = (const f32x4*)xrow + lane;
#pragma unroll
        for (int j = 0; j < 4; ++j) v[q][j] = xr[64 * j]; }
    float t[NR + 1], mxv[NR + 1];
#pragma unroll
    for (int q = 0; q < NR; ++q) { float s = 0.f, m = 0.f;
#pragma unroll
        for (int j = 0; j < 4; ++j) { s += (v[q][j].x * v[q][j].x + v[q][j].y * v[q][j].y) + (v[q][j].z * v[q][j].z + v[q][j].w * v[q][j].w);
            m = fmaxf(fmaxf(m, fmaxf(fabsf(v[q][j].x), fabsf(v[q][j].y))), fmaxf(fabsf(v[q][j].z), fabsf(v[q][j].w))); }
        t[q] = s; mxv[q] = m; }
    t[NR] = 0.f;
#pragma unroll
    for (int q = 0; q < NR; q += 2) wave_sum2(t[q], t[q + 1]);
#pragma unroll
    for (int q = 0; q < NR; ++q) { const int m = m0 + q;
        float mx = mxv[q]; mx = fmaxf(mx, __shfl_xor(mx, 1)); mx = fmaxf(mx, __shfl_xor(mx, 2)); mx = fmaxf(mx, __shfl_xor(mx, 4)); mx = fmaxf(mx, __shfl_xor(mx, 8)); mx = max_rows4(mx);
        const float rstd = rsqrtf(t[q] * (1.0f / D) + EPS), inv = mx > 0.f ? 127.0f / mx : 0.f;
        unsigned* o4 = (unsigned*)(A8 + (size_t)m * D) + lane;
#pragma unroll
        for (int j = 0; j < 4; ++j) { const f32x4 x4 = v[q][j];
            o4[64 * j] = ((unsigned)(int)rintf(x4.x * inv) & 0xffu) | (((unsigned)(int)rintf(x4.y * inv) & 0xffu) << 8) | (((unsigned)(int)rintf(x4.z * inv) & 0xffu) << 16) | (((unsigned)(int)rintf(x4.w * inv) & 0xffu) << 24); }
        if (lane == 0) RS[m] = mx > 0.f ? mx * rstd * (1.0f / 127.0f) : 1.0f; }
}

__device__ __forceinline__ void p0_prologue(const Args& a, LAS unsigned char* lds) {
    int tid = threadIdx.x; asm volatile("" : "+v"(tid));
    const int lane = tid & 63, wave = tid >> 6;
    const int gw = blockIdx.x * 8 + wave, NGW = gridDim.x * 8;
    unsigned char* ws = a.ws;
    for (int nb = blockIdx.x; nb < NUP / 32; nb += gridDim.x) w8_strip(a.in[6], a.in[5], (signed char*)(ws + WS_W1Q), (float*)(ws + WS_CS1), nb, lds, wave, lane);
    { const int nsw = (NUP / 32) * 8, gwr = gw >= nsw ? gw - nsw : gw + NGW - nsw;
      weights_convert(a, lds, I_UP, NITEMS_EARLY, NGW > nsw ? gwr : gw, NGW, wave, lane); }
    for (int m0 = gw * 8; m0 < MP; m0 += NGW * 8) xq8_rows<8>(a, m0, lane);
    for (int m = MP + gw; m < M; m += NGW) xq8_rows<1>(a, m, lane);
    const int gt = blockIdx.x * 512 + tid, NGT = gridDim.x * 512;
    f32x2* rope = (f32x2*)(ws + WS_ROPE);
    for (int i = gt; i < TP * 8; i += NGT) {
        const int pos = i >> 3, k = i & 7;
        const float ang = (float)pos * a.inv[k];
        const double rev = (double)ang * 0.15915494309189535;
        const float fr = (float)(rev - rint(rev));
        rope[i] = (f32x2){__builtin_amdgcn_cosf(fr), __builtin_amdgcn_sinf(fr)};
    }
    bf16_t* KS = (bf16_t*)(ws + WS_KS); bf16_t* VTS = (bf16_t*)(ws + WS_VTS); bf16_t* US = (bf16_t*)(ws + WS_US);
    for (int i = gt; i < NBS * WIN * 128; i += NGT) {
        const int c = i & 127, row = (i >> 7) & (WIN - 1), b = i >> 14;
        const float kv = a.in[3][i], vv = a.in[4][i];
        KS[((size_t)(b * KSROWS + row)) * 128 + c] = f2bf(kv);
        VTS[((size_t)(b * 128 + c)) * KSROWS + row] = f2bf(vv);
        if (row >= TS) { a.out[O_KWS + ((size_t)(b * WIN + row - TS)) * 128 + c] = kv; a.out[O_VWS + ((size_t)(b * WIN + row - TS)) * 128 + c] = vv; }
    }
    for (int i = gt; i < NBS * 128 * 16; i += NGT) { const int k = i & 15, rowd = i >> 4; VTS[(size_t)rowd * KSROWS + WIN + TS + k] = 0; }
    for (int i = gt; i < NBS * HIST * CC; i += NGT) {
        const int c = i & (CC - 1), row = (i >> 9) % HIST, b = (i >> 9) / HIST;
        const float uv = a.in[2][i];
        US[((size_t)(b * USROWS + row)) * CC + c] = f2bf(uv);
        if (row >= TS) a.out[O_CSS + ((size_t)(b * HIST + row - TS)) * CC + c] = uv;
    }
}

constexpr int ATT_VT_OFF = 192 * 128, ATT_VT_STRIDE = 400, ATT_BUF = ATT_VT_OFF + 64 * ATT_VT_STRIDE;
constexpr int ATT_UNITS_P = NBP * (TP / 64) * 2, ATT_UNITS = ATT_UNITS_P + NBS * 2;
constexpr int CONV_UNITS = MP / 16 + NBS;

struct AttUnit { const bf16_t* kb; const bf16_t* vt; int nkt; bool sample; };
__device__ __forceinline__ AttUnit att_decode(unsigned char* ws, int unit) {
    AttUnit u;
    if (unit < ATT_UNITS_P) { const int kh = unit & 1, c = (unit >> 1) & 127, b = unit >> 8, cs = c >= 2 ? c - 2 : 0;
        u.nkt = (c - cs + 1) * 4; u.sample = false;
        u.kb = (const bf16_t*)(ws + WS_KP) + ((size_t)(b * TP + cs * 64)) * 128 + kh * 64;
        u.vt = (const bf16_t*)(ws + WS_VTP) + ((size_t)((b * 2 + kh) * (TP / 64) + cs)) * 4096; }
    else { const int p = unit - ATT_UNITS_P, b = p >> 1, kh = p & 1;
        u.nkt = 9; u.sample = true;
        u.kb = (const bf16_t*)(ws + WS_KS) + ((size_t)(b * KSROWS)) * 128 + kh * 64;
        u.vt = (const bf16_t*)(ws + WS_VTS) + ((size_t)((b * 2 + kh) * 64)) * KSROWS; }
    return u;
}
__device__ __forceinline__ void att_stage_load(const AttUnit& u, int tid, u32x4 (&kp)[3], u32x4 (&vp)[3]) {
    const int nk = u.nkt * 16;
#pragma unroll
    for (int i = 0; i < 3; ++i) {
        const int p = tid + 512 * i; int row = p >> 3; const int ch = p & 7; row = row < nk ? row : nk - 1;
        kp[i] = *(const u32x4*)(u.kb + (size_t)row * 128 + ch * 8);
        if (u.sample) { int pp = p < 1280 ? p : 1279; const int d = pp / 20, q = pp - d * 20; vp[i] = *(const u32x4*)(u.vt + (size_t)d * KSROWS + q * 8); }
        else { const int jmax = (u.nkt >> 2) - 1, j = i < jmax ? i : jmax; vp[i] = *(const u32x4*)(u.vt + (size_t)j * 4096 + (p & 511) * 8); }
    }
}
__device__ __forceinline__ void att_stage_write(const AttUnit& u, int tid, LAS unsigned char* buf, const u32x4 (&kp)[3], const u32x4 (&vp)[3]) {
    const int nk = u.nkt * 16;
#pragma unroll
    for (int i = 0; i < 3; ++i) {
        const int p = tid + 512 * i; int row = p >> 3; const int ch = p & 7; row = row < nk ? row : nk - 1;
        *(LAS u32x4*)(buf + row * 128 + ((ch ^ ((row >> 1) & 7)) << 4)) = kp[i];
        if (u.sample) { int pp = p < 1280 ? p : 1279; const int d = pp / 20, q = pp - d * 20; *(LAS u32x4*)(buf + ATT_VT_OFF + d * ATT_VT_STRIDE + q * 16) = vp[i]; }
        else { const int jmax = (u.nkt >> 2) - 1, j = i < jmax ? i : jmax; const int d = (p & 511) >> 3, q = p & 7; *(LAS u32x4*)(buf + ATT_VT_OFF + d * ATT_VT_STRIDE + j * 128 + q * 16) = vp[i]; }
    }
}
__device__ __forceinline__ void attn_compute(const bf16x8 (&qf)[2][2], LAS const unsigned char* buf, int nkt, float sink0, float sink1, bf16_t* o0, bf16_t* o1, int lane) {
    const int fr = lane & 15, g = lane >> 4;
    f32x4 S[2][12];
    const float NEG = -INFINITY;
#pragma unroll
    for (int kt = 0; kt < 12; ++kt) {
        const int ktc = kt < nkt ? kt : nkt - 1, row = ktc * 16 + fr, sw = (row >> 1) & 7;
        const bf16x8 k0 = *(LAS const bf16x8*)(buf + row * 128 + ((g ^ sw) << 4)), k1 = *(LAS const bf16x8*)(buf + row * 128 + (((g + 4) ^ sw) << 4));
        const bool ok = kt < nkt;
#pragma unroll
        for (int qt = 0; qt < 2; ++qt) {
            f32x4 c = (f32x4){0.f, 0.f, 0.f, 0.f};
            c = __builtin_amdgcn_mfma_f32_16x16x32_bf16(k0, qf[qt][0], c, 0, 0, 0);
            c = __builtin_amdgcn_mfma_f32_16x16x32_bf16(k1, qf[qt][1], c, 0, 0, 0);
            S[qt][kt] = ok ? c : (f32x4){NEG, NEG, NEG, NEG};
        }
    }
    bf16x8 pf[2][6]; float linv[2];
#pragma unroll
    for (int qt = 0; qt < 2; ++qt) {
        const float sink = qt ? sink1 : sink0;
        float mx = sink;
#pragma unroll
        for (int kt = 0; kt < 12; ++kt) mx = fmaxf(mx, fmaxf(fmaxf(S[qt][kt][0], S[qt][kt][1]), fmaxf(S[qt][kt][2], S[qt][kt][3])));
        mx = max_rows4(mx);
        float l = 0.f;
#pragma unroll
        for (int kt = 0; kt < 12; ++kt) {
#pragma unroll
            for (int j = 0; j < 4; ++j) { const float p = __builtin_amdgcn_exp2f(S[qt][kt][j] - mx); S[qt][kt][j] = p; l += p; }
        }
        l = sum_rows4(l);
        l += __builtin_amdgcn_exp2f(sink - mx);
        linv[qt] = 1.0f / l;
#pragma unroll
        for (int kk = 0; kk < 6; ++kk) {
            u32x4 w; w.x = cvt_pk_bf16(S[qt][2 * kk][0], S[qt][2 * kk][1]); w.y = cvt_pk_bf16(S[qt][2 * kk][2], S[qt][2 * kk][3]);
            w.z = cvt_pk_bf16(S[qt][2 * kk + 1][0], S[qt][2 * kk + 1][1]); w.w = cvt_pk_bf16(S[qt][2 * kk + 1][2], S[qt][2 * kk + 1][3]);
            pf[qt][kk] = __builtin_bit_cast(bf16x8, w);
        }
    }
    f32x4 O[2][4];
    const int kkmax = (nkt - 1) >> 1;
    LAS const unsigned char* vb = buf + ATT_VT_OFF + fr * ATT_VT_STRIDE + g * 8;
#pragma unroll
    for (int dt = 0; dt < 4; ++dt) {
        O[0][dt] = (f32x4){0.f, 0.f, 0.f, 0.f}; O[1][dt] = (f32x4){0.f, 0.f, 0.f, 0.f};
#pragma unroll
        for (int kk = 0; kk < 6; ++kk) {
            const int kkc = kk < kkmax ? kk : kkmax;
            const u32x2 a0 = *(LAS const u32x2*)(vb + dt * 16 * ATT_VT_STRIDE + kkc * 64), a1 = *(LAS const u32x2*)(vb + dt * 16 * ATT_VT_STRIDE + kkc * 64 + 32);
            u32x4 aw; aw.x = a0.x; aw.y = a0.y; aw.z = a1.x; aw.w = a1.y;
            const bf16x8 af = __builtin_bit_cast(bf16x8, aw);
            O[0][dt] = __builtin_amdgcn_mfma_f32_16x16x32_bf16(af, pf[0][kk], O[0][dt], 0, 0, 0);
            O[1][dt] = __builtin_amdgcn_mfma_f32_16x16x32_bf16(af, pf[1][kk], O[1][dt], 0, 0, 0);
        }
    }
#pragma unroll
    for (int qt = 0; qt < 2; ++qt) {
        bf16_t* ob = (qt ? o1 : o0) + (size_t)fr * D + 4 * g;
#pragma unroll
        for (int dt = 0; dt < 4; ++dt) {
            const f32x4 v = O[qt][dt] * linv[qt];
            u32x2 w; w.x = cvt_pk_bf16(v[0], v[1]); w.y = cvt_pk_bf16(v[2], v[3]);
            *(u32x2*)(ob + dt * 16) = w;
        }
    }
}

__device__ __forceinline__ void attn_phase(const Args& a, LAS unsigned char* lds, int tid, int first, int G) {
    asm volatile("" : "+v"(tid));
    unsigned char* ws = a.ws;
    const int lane = tid & 63, wave = __builtin_amdgcn_readfirstlane(tid >> 6), fr = lane & 15, g = lane >> 4;
    const bf16_t* Q = (const bf16_t*)(ws + WS_Q); bf16_t* MIX = (bf16_t*)(ws + WS_MIX);
    const float* sinks = a.in[12];
    if (first >= ATT_UNITS) return;
    AttUnit cur = att_decode(ws, first);
    u32x4 kp[3], vp[3];
    att_stage_load(cur, tid, kp, vp);
    int par = 0;
    for (int unit = first; unit < ATT_UNITS; unit += G, par ^= 1) {
        LAS unsigned char* buf = lds + par * ATT_BUF;
        att_stage_write(cur, tid, buf, kp, vp);
        const bf16_t* q0; const bf16_t* q1; bf16_t* o0; bf16_t* o1; float sk0, sk1; bool work;
        if (!cur.sample) { const int kh = unit & 1, c = (unit >> 1) & 127, b = unit >> 8, h = kh * 4 + (wave >> 1), tok0 = c * 64 + (wave & 1) * 32;
            q0 = Q + ((size_t)(b * TP + tok0)) * 512 + h * 64; q1 = q0 + 16 * 512;
            o0 = MIX + ((size_t)(b * TP + tok0)) * D + 512 + h * 64; o1 = o0 + 16 * D; sk0 = sk1 = sinks[h] * LOG2E; work = true; }
        else { const int p = unit - ATT_UNITS_P, b = p >> 1, kh = p & 1, h0 = kh * 4 + (wave & 1) * 2;
            q0 = Q + ((size_t)(MP + b * TS)) * 512 + h0 * 64; q1 = q0 + 64;
            o0 = MIX + ((size_t)(MP + b * TS)) * D + 512 + h0 * 64; o1 = o0 + 64; sk0 = sinks[h0] * LOG2E; sk1 = sinks[h0 + 1] * LOG2E; work = wave < 2; }
        bf16x8 qf[2][2];
        qf[0][0] = *(const bf16x8*)(q0 + fr * 512 + g * 8); qf[0][1] = *(const bf16x8*)(q0 + fr * 512 + 32 + g * 8);
        qf[1][0] = *(const bf16x8*)(q1 + fr * 512 + g * 8); qf[1][1] = *(const bf16x8*)(q1 + fr * 512 + 32 + g * 8);
        const int nkt = cur.nkt;
        __syncthreads();
        const int nu = unit + G < ATT_UNITS ? unit + G : unit;
        cur = att_decode(ws, nu);
        att_stage_load(cur, tid, kp, vp);
        if (work) attn_compute(qf, buf, nkt, sk0, sk1, o0, o1, lane);
    }
    __syncthreads();
}

struct ConvUnit { const bf16_t* ub; int jmin; size_t orow; };
__device__ __forceinline__ ConvUnit conv_decode(unsigned char* ws, int cu, int ch) {
    ConvUnit u;
    if (cu < MP / 16) { const int b = cu >> 9, t0 = (cu & 511) * 16; u.ub = (const bf16_t*)(ws + WS_UP) + ((size_t)(b * TP) + t0 - HIST) * CC + ch; u.jmin = HIST - t0; u.orow = (size_t)b * TP + t0; }
    else { const int b = cu - MP / 16; u.ub = (const bf16_t*)(ws + WS_US) + ((size_t)(b * USROWS)) * CC + ch; u.jmin = 0; u.orow = (size_t)MP + b * TS; }
    return u;
}
__device__ __forceinline__ void conv_phase(const Args& a, LAS unsigned char* lds, int tid, int first, int G) {
    asm volatile("" : "+v"(tid));
    unsigned char* ws = a.ws;
    const int ch = tid, wave = tid >> 6, lane = tid & 63;
    if (first >= CONV_UNITS) return;
    const float* wdw = a.in[13] + ch;
    float w[CW];
#pragma unroll
    for (int j = 0; j < CW; ++j) w[j] = wdw[j * CC];
    const float bias = a.in[14][ch];
    const f32x4 gc0 = *(const f32x4*)(a.in[15] + 4 * lane), gc1 = *(const f32x4*)(a.in[15] + 256 + 4 * lane);
    const f32x4 bc0 = *(const f32x4*)(a.in[16] + 4 * lane), bc1 = *(const f32x4*)(a.in[16] + 256 + 4 * lane);
    ConvUnit cur = conv_decode(ws, first, ch);
    bf16_t xr[HIST + 16];
#pragma unroll
    for (int j = 0; j < HIST + 16; ++j) { const int jc = j > cur.jmin ? j : cur.jmin; xr[j] = cur.ub[(size_t)jc * CC]; }
    int par = 0;
    for (int cu = first; cu < CONV_UNITS; cu += G, par ^= 1) {
        const int jmin = cur.jmin; const size_t orow = cur.orow;
        float acc[16];
#pragma unroll
        for (int i = 0; i < 16; ++i) acc[i] = bias;
#pragma unroll
        for (int j = 0; j < HIST + 16; ++j) {
            const float xv = (j >= jmin) ? bf2f(xr[j]) : 0.f;
#pragma unroll
            for (int i = 0; i < 16; ++i) { if (j - i >= 0 && j - i < CW) acc[i] += xv * w[j - i]; }
        }
        __builtin_amdgcn_sched_barrier(0);
        { const int nu = cu + G < CONV_UNITS ? cu + G : cu;
          cur = conv_decode(ws, nu, ch);
#pragma unroll
          for (int j = 0; j < HIST + 16; ++j) { const int jc = j > cur.jmin ? j : cur.jmin; xr[j] = cur.ub[(size_t)jc * CC]; } }
        __builtin_amdgcn_sched_barrier(0);
        LAS float* yb = (LAS float*)lds + par * (16 * CC);
#pragma unroll
        for (int i = 0; i < 16; ++i) yb[i * CC + ch] = acc[i];
        __syncthreads();
        bf16_t* MIX = (bf16_t*)(ws + WS_MIX) + orow * D;
        {
            const int tok = 2 * wave;
            f32x4 v0 = *(const LAS f32x4*)(yb + tok * CC + 4 * lane), v1 = *(const LAS f32x4*)(yb + tok * CC + 256 + 4 * lane);
            f32x4 z0 = *(const LAS f32x4*)(yb + (tok + 1) * CC + 4 * lane), z1 = *(const LAS f32x4*)(yb + (tok + 1) * CC + 256 + 4 * lane);
            float sa = (v0[0] + v0[1]) + (v0[2] + v0[3]) + (v1[0] + v1[1]) + (v1[2] + v1[3]);
            float sb = (z0[0] + z0[1]) + (z0[2] + z0[3]) + (z1[0] + z1[1]) + (z1[2] + z1[3]);
            wave_sum2(sa, sb);
            const float ma = sa * (1.0f / CC), mb = sb * (1.0f / CC);
            v0 = v0 - ma; v1 = v1 - ma; z0 = z0 - mb; z1 = z1 - mb;
            float qa = (v0[0] * v0[0] + v0[1] * v0[1]) + (v0[2] * v0[2] + v0[3] * v0[3]) + (v1[0] * v1[0] + v1[1] * v1[1]) + (v1[2] * v1[2] + v1[3] * v1[3]);
            float qb = (z0[0] * z0[0] + z0[1] * z0[1]) + (z0[2] * z0[2] + z0[3] * z0[3]) + (z1[0] * z1[0] + z1[1] * z1[1]) + (z1[2] * z1[2] + z1[3] * z1[3]);
            wave_sum2(qa, qb);
            const float ra = rsqrtf(qa * (1.0f / CC) + EPS), rb = rsqrtf(qb * (1.0f / CC) + EPS);
            v0 = v0 * ra * gc0 + bc0; v1 = v1 * ra * gc1 + bc1; z0 = z0 * rb * gc0 + bc0; z1 = z1 * rb * gc1 + bc1;
            u32x2 o0, o1, p0, p1;
            o0.x = cvt_pk_bf16(silu_f(v0[0]), silu_f(v0[1])); o0.y = cvt_pk_bf16(silu_f(v0[2]), silu_f(v0[3]));
            o1.x = cvt_pk_bf16(silu_f(v1[0]), silu_f(v1[1])); o1.y = cvt_pk_bf16(silu_f(v1[2]), silu_f(v1[3]));
            p0.x = cvt_pk_bf16(silu_f(z0[0]), silu_f(z0[1])); p0.y = cvt_pk_bf16(silu_f(z0[2]), silu_f(z0[3]));
            p1.x = cvt_pk_bf16(silu_f(z1[0]), silu_f(z1[1])); p1.y = cvt_pk_bf16(silu_f(z1[2]), silu_f(z1[3]));
            *(u32x2*)(MIX + (size_t)tok * D + 4 * lane) = o0; *(u32x2*)(MIX + (size_t)tok * D + 256 + 4 * lane) = o1;
            *(u32x2*)(MIX + (size_t)(tok + 1) * D + 4 * lane) = p0; *(u32x2*)(MIX + (size_t)(tok + 1) * D + 256 + 4 * lane) = p1;
        }
    }
    __syncthreads();
}

#define XB_TMO      128
#define XB_XCNT(j)  (256  + 64 * (j))
#define XB_XSUB(j)  (1280 + 64 * (j))
#define XB_XGEN(j)  (2304 + 64 * (j))
#define XB_TOP      3328
#define XB_TOPGEN   3392
#define XCD_BAR_WORDS 3456
#define XB_SPIN_CAP (1u << 18)
__device__ __forceinline__ unsigned xb_ld(unsigned* p)              { return __hip_atomic_load(p, __ATOMIC_RELAXED, __HIP_MEMORY_SCOPE_AGENT); }
__device__ __forceinline__ unsigned xb_add(unsigned* p, unsigned v) { return __hip_atomic_fetch_add(p, v, __ATOMIC_RELAXED, __HIP_MEMORY_SCOPE_AGENT); }
__device__ __forceinline__ unsigned xb_xcc_id() { return (unsigned)__builtin_amdgcn_s_getreg((3 << 11) | 20) & 0xFu; }
#define XB_SPIN(cond, bar) do { unsigned _sp = 0; while (cond) { __builtin_amdgcn_s_sleep(1); \
    if ((++_sp & 255u) == 0u) { if (xb_ld(&(bar)[XB_TMO])) break; if (_sp > XB_SPIN_CAP) { atomicAdd(&(bar)[XB_TMO], 1u); break; } } } } while (0)
struct XcdBarrier { unsigned* bar; unsigned x; volatile LAS unsigned* st; };
__device__ __forceinline__ XcdBarrier xcd_barrier_post(unsigned* bar, volatile LAS unsigned* st) {
    XcdBarrier b; b.bar = bar; b.x = xb_xcc_id(); b.st = st;
    if (threadIdx.x == 0) (void)xb_add(&bar[XB_XCNT(b.x)], 1u);
    return b;
}
__device__ __forceinline__ void xcd_barrier_complete(unsigned* bar, unsigned x, unsigned& nloc, unsigned& nx) {
    const unsigned G = gridDim.x * gridDim.y * gridDim.z;
    unsigned sum, cnt, mine, sp = 0u;
    for (;;) {
        sum = 0u; cnt = 0u; mine = 0u;
#pragma unroll
        for (unsigned j = 0; j < 16; ++j) { const unsigned c = xb_ld(&bar[XB_XCNT(j)]); sum += c; cnt += (c > 0u) ? 1u : 0u; mine = (j == x) ? c : mine; }
        if (sum == G) break;
        __builtin_amdgcn_s_sleep(1);
        if ((++sp & 255u) == 0u) { if (xb_ld(&bar[XB_TMO])) break; if (sp > XB_SPIN_CAP) { atomicAdd(&bar[XB_TMO], 1u); break; } }
    }
    nloc = mine > 0u ? mine : 1u; nx = cnt > 0u ? cnt : 1u;
}
__device__ __forceinline__ void xcd_barrier(const XcdBarrier& b) {
    asm volatile("s_waitcnt vmcnt(0)" ::: "memory");
    __syncthreads();
    if (threadIdx.x == 0) {
        unsigned* bar = b.bar;
        __builtin_amdgcn_s_waitcnt(0);
        unsigned nloc = b.st[0], nx = b.st[1];
        if (nloc == 0u) { xcd_barrier_complete(bar, b.x, nloc, nx); b.st[0] = nloc; b.st[1] = nx; }
        const unsigned old = xb_add(&bar[XB_XSUB(b.x)], 1u);
        const unsigned gen = old / nloc;
        if (old + 1u == (gen + 1u) * nloc) {
            __builtin_amdgcn_fence(__ATOMIC_RELEASE, "agent");
            asm volatile("s_waitcnt vmcnt(0)" ::: "memory");
            const unsigned og = xb_add(&bar[XB_TOP], 1u);
            const unsigned tg = og / nx;
            if (og + 1u == (tg + 1u) * nx) xb_add(&bar[XB_TOPGEN], 1u);
            else XB_SPIN(xb_ld(&bar[XB_TOPGEN]) == tg, bar);
            __builtin_amdgcn_fence(__ATOMIC_ACQUIRE, "agent");
            xb_add(&bar[XB_XGEN(b.x)], 1u);
            asm volatile("s_waitcnt vmcnt(0)" ::: "memory");
        } else {
            XB_SPIN(xb_ld(&bar[XB_XGEN(b.x)]) == gen, bar);
            __builtin_amdgcn_fence(__ATOMIC_ACQUIRE, "agent");
            asm volatile("s_waitcnt vmcnt(0)" ::: "memory");
        }
    }
    __syncthreads();
}
constexpr int MISC_OFF = 151552;
constexpr size_t CTL_ZERO_BYTES = 65536;
constexpr int CW_BAR = 4096;

__global__ void __launch_bounds__(512, 2) hymba_fwd(Args a) {
    extern __shared__ __attribute__((aligned(16))) unsigned char lds_raw[];
    LAS unsigned char* lds = (LAS unsigned char*)lds_raw;
    unsigned char* ws = a.ws;
    const int tid = threadIdx.x, lane = tid & 63, wave = __builtin_amdgcn_readfirstlane(tid >> 6);
    const int G = gridDim.x, bid = blockIdx.x;
    for (int u = tid; u < (LDS_BYTES - MISC_OFF) / 4; u += 512) ((LAS unsigned*)(lds + MISC_OFF))[u] = 0u;
    __syncthreads();
    const XcdBarrier bar = xcd_barrier_post((unsigned*)ws + CW_BAR, (volatile LAS unsigned*)(lds + MISC_OFF) + 8);
#define GRID_BAR() xcd_barrier(bar)

    bf16_t* AB = (bf16_t*)(ws + WS_AB); bf16_t* ACT = (bf16_t*)(ws + WS_ACT);
    float* ssq0 = (float*)(ws + WS_SSQ0); float* ssq1 = (float*)(ws + WS_SSQ1); float* ssq2 = (float*)(ws + WS_SSQ2);

#ifndef PROBE_DUP
#define PROBE_DUP -1
#endif
#ifndef PHASE_MASK
#define PHASE_MASK 0xff
#endif
#define REPS(k) if (PHASE_MASK & (1 << (k))) for (int rep_ = 0; rep_ < ((PROBE_DUP == (k)) ? 2 : 1); ++rep_)
    REPS(0) { p0_prologue(a, lds); GRID_BAR(); }
    REPS(1) {
    { pg8::Gemm g{(const bf16_t*)(ws + WS_A8), (const bf16_t*)(ws + WS_W1Q), MP, NUP, D / 2}; pg8::StaticOrder S; S.init(MP, NUP, G, bid);
      EpiSwigluI8 E{ACT, (const float*)(ws + WS_RS), (const float*)(ws + WS_CS1), lds};
      for (int pass = 0; pass < 2; ++pass) { if (((pass ^ (bid >> 6)) & 1) == 0) { pg8::gemm_phase<EpiSwigluI8, pg8::StaticOrder, true, true, true>(lds, g, S, E); } else { small_gemm<1, 4, true>((const bf16_t*)(ws + WS_A8), (const bf16_t*)(ws + WS_W1Q), NUP, D / 2, E, lds, bid, G, wave, lane); } } }
    GRID_BAR(); }
    REPS(2) {
    { pg8::Gemm g{ACT, (const bf16_t*)(ws + WS_W2T), MP, D, FF}; pg8::StaticOrder S; S.init(MP, D, G, bid);
      EpiResid<0> E{a.in[0], a.in[1], nullptr, AB, ssq1, 0.5f};
      for (int pass = 0; pass < 2; ++pass) { if (((pass ^ (bid >> 6)) & 1) == 0) { pg8::gemm_phase<EpiResid<0>, pg8::StaticOrder, true, true>(lds, g, S, E); } else { small_gemm<8, 2, false>(ACT, (const bf16_t*)(ws + WS_W2T), D, FF, E, lds, bid, G, wave, lane); } } }
    GRID_BAR(); }
    REPS(3) {
    { pg8::Gemm g{AB, (const bf16_t*)(ws + WS_WINT), MP, NIN, D}; pg8::StaticOrder S; S.init(MP, NIN, G, bid);
      EpiInProj E{ws, a.in[10], a.in[11], a.out, lds};
      pg8::gemm_phase<EpiInProj, pg8::StaticOrder, true, true>(lds, g, S, E);
      small_gemm<1, 4, false>(AB, (const bf16_t*)(ws + WS_WINT), NIN, D, E, lds, G - 1 - bid, G, wave, lane, 2);
      if (rep_ == 0 && bid >= G / 2) { int ln = lane; asm volatile("" : "+v"(ln));
        weights_convert(a, lds, NITEMS_EARLY + I_UP, NITEMS, (bid - G / 2) * 8 + wave, (G - G / 2) * 8, wave, ln);
        __syncthreads();
        for (int nb = bid - G / 2; nb < NUP / 32; nb += G - G / 2) w8_strip(a.in[19], a.in[18], (signed char*)(ws + WS_W3Q), (float*)(ws + WS_CS3), nb, lds, wave, ln); } }
    GRID_BAR(); }
    REPS(4) {
#ifndef PROBE_P4SUB
#define PROBE_P4SUB 0
#endif
    if (!(rep_ == 1 && PROBE_P4SUB == 2)) attn_phase(a, lds, tid, bid, G);
    if (!(rep_ == 1 && PROBE_P4SUB == 1)) conv_phase(a, lds, tid, G - 1 - bid, G);
    GRID_BAR(); }
    REPS(5) {
    { pg8::Gemm g{(const bf16_t*)(ws + WS_MIX), (const bf16_t*)(ws + WS_WOT), MP, D, D}; pg8::StaticOrder S; S.init(MP, D, G, bid);
      EpiResid<1> E{nullptr, nullptr, nullptr, AB, ssq2, 1.0f};
      for (int pass = 0; pass < 2; ++pass) { if (((pass ^ (bid >> 6)) & 1) == 0) { pg8::gemm_phase<EpiResid<1>, pg8::StaticOrder, true, true>(lds, g, S, E); } else { small_gemm<8, 2, false>((const bf16_t*)(ws + WS_MIX), (const bf16_t*)(ws + WS_WOT), D, D, E, lds, bid, G, wave, lane); } } }
    GRID_BAR(); }
    { const int gw = bid * 8 + wave, NGW = G * 8; int ln = lane; asm volatile("" : "+v"(ln));
      for (int m0 = gw * 4; m0 < M; m0 += NGW * 4) q8_rows<4>(ws, ssq2, m0, ln);
      GRID_BAR(); }
    REPS(6) {
    { pg8::Gemm g{(const bf16_t*)(ws + WS_A8), (const bf16_t*)(ws + WS_W3Q), MP, NUP, D / 2}; pg8::StaticOrder S; S.init(MP, NUP, G, bid);
      EpiSwigluI8 E{ACT, (const float*)(ws + WS_RS), (const float*)(ws + WS_CS3), lds};
      for (int pass = 0; pass < 2; ++pass) { if (((pass ^ (bid >> 6)) & 1) == 0) { pg8::gemm_phase<EpiSwigluI8, pg8::StaticOrder, true, true, true>(lds, g, S, E); } else { small_gemm<1, 4, true>((const bf16_t*)(ws + WS_A8), (const bf16_t*)(ws + WS_W3Q), NUP, D / 2, E, lds, bid, G, wave, lane); } } }
    GRID_BAR(); }
    REPS(7) { pg8::Gemm g{ACT, (const bf16_t*)(ws + WS_W4T), MP, D, FF}; pg8::StaticOrder S; S.init(MP, D, G, bid);
      EpiResid<2> E{nullptr, nullptr, a.out, AB, nullptr, 0.5f};
      for (int pass = 0; pass < 2; ++pass) { if (((pass ^ (bid >> 6)) & 1) == 0) { pg8::gemm_phase<EpiResid<2>, pg8::StaticOrder, true, true>(lds, g, S, E); } else { small_gemm<8, 2, false>(ACT, (const bf16_t*)(ws + WS_W4T), D, FF, E, lds, bid, G, wave, lane); } } }
}

extern "C" void kernel_launch(void* const* d_in, const int* in_sizes, int n_in, void* d_out, int out_size, void* d_ws, size_t ws_size, hipStream_t stream) {
    static int grid = 0;
    if (grid == 0) {
        if (n_in != 21 || (size_t)out_size != O_END || ws_size < WS_END) { fprintf(stderr, "kernel_launch: unexpected shapes: n_in %d out %d ws %zu (need %zu)\n", n_in, out_size, ws_size, (size_t)WS_END); grid = -1; return; }
        int dev = 0, cus = 0, per_cu = 0;
        (void)hipGetDevice(&dev);
        (void)hipDeviceGetAttribute(&cus, hipDeviceAttributeMultiprocessorCount, dev);
        if (cus != 256) fprintf(stderr, "kernel_launch: note: built for a 256-CU device (one workgroup per CU), this device reports %d\n", cus);
        if (hipFuncSetAttribute((const void*)hymba_fwd, hipFuncAttributeMaxDynamicSharedMemorySize, LDS_BYTES) != hipSuccess) { fprintf(stderr, "kernel_launch: hipFuncSetAttribute failed\n"); grid = -1; return; }
        if (hipOccupancyMaxActiveBlocksPerMultiprocessor(&per_cu, (const void*)hymba_fwd, 512, LDS_BYTES) != hipSuccess || per_cu < 1) { fprintf(stderr, "kernel_launch: occupancy query failed (%d)\n", per_cu); grid = -1; (void)hipGetLastError(); return; }
        grid = cus;
    }
    if (grid < 0) return;
    Args a{};
    for (int i = 0; i < 21; ++i) a.in[i] = (const float*)d_in[i];
    a.out = (float*)d_out; a.ws = (unsigned char*)d_ws;
    for (int i = 0; i < 8; ++i) a.inv[i] = powf(500000.0f, -(float)i / 8.0f);
    if (hipMemsetAsync(d_ws, 0, CTL_ZERO_BYTES, stream) != hipSuccess) { fprintf(stderr, "kernel_launch: memset failed\n"); return; }
    hipLaunchKernelGGL(hymba_fwd, dim3(grid), dim3(512), LDS_BYTES, stream, a);
    const hipError_t e = hipPeekAtLastError();
    if (e != hipSuccess) fprintf(stderr, "kernel_launch: launch failed: %s (grid %d)\n", hipGetErrorString(e), grid);
}
```

```cpp
#include <hip/hip_runtime.h>
#include <cstdio>
#include <cstdint>
#include <cmath>

#define LAS __attribute__((address_space(3)))
typedef unsigned short bf16_t;
typedef short bf16x8 __attribute__((ext_vector_type(8)));
typedef float f32x4 __attribute__((ext_vector_type(4)));
typedef float f32x2 __attribute__((ext_vector_type(2)));
typedef unsigned u32x4 __attribute__((ext_vector_type(4)));
typedef unsigned u32x2 __attribute__((ext_vector_type(2)));
typedef int i32x4 __attribute__((ext_vector_type(4)));

constexpr int D = 1024, TP = 8192, NBP = 4, NBS = 32, TS = 16, MP = NBP * TP, MS = NBS * TS, M = MP + MS;
constexpr int FF = 2816, NUP = 2 * FF, NIN = 1792, CC = 512, HD = 64, PAST = 4096;
constexpr int CW = 31, HIST = CW - 1, WIN = 128;
constexpr int KSROWS = 160;
constexpr int USROWS = HIST + TS;
constexpr float EPS = 1e-6f;
constexpr float LOG2E = 1.4426950408889634f;
constexpr float QSCALE = 0.125f * LOG2E;

constexpr size_t O_YP = 0, O_YS = (size_t)MP * D, O_CSP = O_YS + (size_t)MS * D, O_KWP = O_CSP + (size_t)NBP * HIST * CC,
                 O_VWP = O_KWP + (size_t)NBP * WIN * 128, O_CSS = O_VWP + (size_t)NBP * WIN * 128, O_KWS = O_CSS + (size_t)NBS * HIST * CC,
                 O_VWS = O_KWS + (size_t)NBS * WIN * 128, O_END = O_VWS + (size_t)NBS * WIN * 128;

constexpr size_t al(size_t x) { return (x + 4095) & ~(size_t)4095; }
constexpr size_t WS_CTL = 0;
constexpr size_t WS_W1T = 1u << 20;
constexpr size_t WS_W2T = WS_W1T + al((size_t)NUP * D * 2);
constexpr size_t WS_WINT = WS_W2T + al((size_t)D * FF * 2);
constexpr size_t WS_WOT = WS_WINT + al((size_t)NIN * D * 2);
constexpr size_t WS_W3T = WS_WOT + al((size_t)D * D * 2);
constexpr size_t WS_W4T = WS_W3T + al((size_t)NUP * D * 2);
constexpr size_t WS_ROPE = WS_W4T + al((size_t)D * FF * 2);
constexpr size_t WS_SSQ0 = WS_ROPE + al((size_t)TP * 8 * 8);
constexpr size_t WS_SSQ1 = WS_SSQ0 + al((size_t)M * 16 * 4);
constexpr size_t WS_SSQ2 = WS_SSQ1 + al((size_t)M * 16 * 4);
constexpr size_t WS_KS = WS_SSQ2 + al((size_t)M * 16 * 4);
constexpr size_t WS_VTS = WS_KS + al((size_t)NBS * KSROWS * 128 * 2);
constexpr size_t WS_US = WS_VTS + al((size_t)NBS * 128 * KSROWS * 2);
constexpr size_t WS_AB = WS_US + al((size_t)NBS * USROWS * CC * 2);
constexpr size_t WS_X1 = WS_AB + al((size_t)M * D * 2);
constexpr size_t WS_ACT = WS_X1 + al((size_t)M * D * 4);
constexpr size_t WS_A8 = WS_X1;
constexpr size_t WS_W3Q = WS_A8 + al((size_t)M * D);
constexpr size_t WS_W1Q = WS_W3Q + al((size_t)NUP * D);
constexpr size_t WS_RS = WS_W1Q + al((size_t)NUP * D);
constexpr size_t WS_CS3 = WS_RS + al((size_t)M * 4);
constexpr size_t WS_CS1 = WS_CS3 + al((size_t)NUP * 4);
static_assert(WS_CS1 + (size_t)NUP * 4 <= WS_ACT, "int8 operands fit in the f32 scratch");
constexpr size_t WS_END = WS_ACT + al((size_t)M * FF * 2);
constexpr size_t WS_UP = WS_ACT;
constexpr size_t WS_Q = WS_UP + al((size_t)MP * CC * 2);
constexpr size_t WS_KP = WS_Q + al((size_t)M * 512 * 2);
constexpr size_t WS_VTP = WS_KP + al((size_t)MP * 128 * 2);
constexpr size_t WS_MIX = WS_VTP + al((size_t)MP * 128 * 2);
static_assert(WS_MIX + (size_t)M * D * 2 <= WS_END, "overlay fits");

constexpr int LDS_BYTES = 155648;
constexpr int SSQ_LDS_OFF = 131072;

__device__ __forceinline__ unsigned cvt_pk_bf16(float lo, float hi) { unsigned r; asm volatile("v_cvt_pk_bf16_f32 %0, %1, %2" : "=v"(r) : "v"(lo), "v"(hi)); return r; }
__device__ __forceinline__ float bf2f(bf16_t h) { return __uint_as_float((unsigned)h << 16); }
__device__ __forceinline__ bf16_t f2bf(float f) { return (bf16_t)(cvt_pk_bf16(f, 0.f) & 0xffffu); }
__device__ __forceinline__ float silu_f(float a) { return a * __builtin_amdgcn_rcpf(1.0f + __builtin_amdgcn_exp2f(-a * LOG2E)); }
__device__ __forceinline__ float sigmoid_f(float a) { return __builtin_amdgcn_rcpf(1.0f + __builtin_amdgcn_exp2f(-a * LOG2E)); }
__device__ __forceinline__ float sum_rows4(float x) {
    float a = x, b = x;
    asm volatile("s_nop 1\n\tv_permlane16_swap_b32 %0, %1" : "+v"(a), "+v"(b));
    float t = a + b; a = t; b = t;
    asm volatile("s_nop 1\n\tv_permlane32_swap_b32 %0, %1" : "+v"(a), "+v"(b));
    return a + b;
}
__device__ __forceinline__ float max_rows4(float x) {
    float a = x, b = x;
    asm volatile("s_nop 1\n\tv_permlane16_swap_b32 %0, %1" : "+v"(a), "+v"(b));
    float t = fmaxf(a, b); a = t; b = t;
    asm volatile("s_nop 1\n\tv_permlane32_swap_b32 %0, %1" : "+v"(a), "+v"(b));
    return fmaxf(a, b);
}
__device__ __forceinline__ float dpp_max8(float v) {
    v = fmaxf(v, __builtin_bit_cast(float, __builtin_amdgcn_update_dpp(0, __builtin_bit_cast(int, v), 0xB1, 0xF, 0xF, true)));
    v = fmaxf(v, __builtin_bit_cast(float, __builtin_amdgcn_update_dpp(0, __builtin_bit_cast(int, v), 0x4E, 0xF, 0xF, true)));
    v = fmaxf(v, __builtin_bit_cast(float, __builtin_amdgcn_update_dpp(0, __builtin_bit_cast(int, v), 0x141, 0xF, 0xF, true)));
    return v;
}
__device__ __forceinline__ float dpp_max16(float v) {
    v = dpp_max8(v);
    return fmaxf(v, __builtin_bit_cast(float, __builtin_amdgcn_update_dpp(0, __builtin_bit_cast(int, v), 0x140, 0xF, 0xF, true)));
}
__device__ __forceinline__ float dpp_row_sum(float v) {
    v += __builtin_bit_cast(float, __builtin_amdgcn_update_dpp(0, __builtin_bit_cast(int, v), 0xB1, 0xF, 0xF, true));
    v += __builtin_bit_cast(float, __builtin_amdgcn_update_dpp(0, __builtin_bit_cast(int, v), 0x4E, 0xF, 0xF, true));
    v += __builtin_bit_cast(float, __builtin_amdgcn_update_dpp(0, __builtin_bit_cast(int, v), 0x124, 0xF, 0xF, true));
    v += __builtin_bit_cast(float, __builtin_amdgcn_update_dpp(0, __builtin_bit_cast(int, v), 0x128, 0xF, 0xF, true));
    return v;
}
__device__ __forceinline__ void wave_sum2(float& a, float& b) {
    a = dpp_row_sum(a); b = dpp_row_sum(b);
    a = sum_rows4(a); b = sum_rows4(b);
}
__device__ __forceinline__ float row_rstd(const float* ssq, int r) {
    const f32x4* p = (const f32x4*)(ssq + (size_t)r * 16);
    const f32x4 a = p[0], b = p[1], c = p[2], d = p[3];
    const f32x4 s = (a + b) + (c + d);
    return rsqrtf(((s.x + s.y) + (s.z + s.w)) * (1.0f / D) + EPS);
}

__device__ __forceinline__ int lane_now() { int l; asm volatile("v_mbcnt_lo_u32_b32 %0, -1, 0\n\tv_mbcnt_hi_u32_b32 %0, -1, %0" : "=v"(l)); return l; }
namespace pg8 {
constexpr int BM = 256, BK = 64, HALF = 128, HTB = HALF * BK * 2, STAGE_BYTES = 8 * HTB, NXCD = 8, WGM = 8;
__host__ __device__ __forceinline__ int lds_byte(int r, int c) { const int st = (r >> 4) * 2 + (c >> 5), rr = r & 15, cc = c & 31, ob = rr * 64 + cc * 2; return st * 1024 + (ob ^ (((ob >> 9) & 1) << 5)); }
__host__ __device__ __forceinline__ void stage_rc(int b, int& R, int& C) { const int st = b / 1024, sb = b % 1024, swz = sb ^ (((sb >> 9) & 1) << 5); R = (st >> 1) * 16 + swz / 64; C = (st & 1) * 32 + (swz % 64) / 2; }
__host__ __device__ __forceinline__ int perm32(int rho) { const int n = rho >> 4, i = rho & 15; return 8 * (i >> 2) + 4 * n + (i & 3); }

struct Unit { int pm, pn; };
struct Gemm { const bf16_t* A; const bf16_t* Bt; int M, N, K; };

struct StaticOrder {
    int nM, nN, nwg, G, c;
    __host__ __device__ void init(int M_, int N_, int G_, int c_) { nM = M_ / BM; nN = N_ / BM; nwg = nM * nN; G = G_; c = c_; }
    __host__ __device__ bool next(int i, Unit& u) const {
        const long L = (long)i * G + c; if (L >= nwg) return false;
        int wgid = (int)L; { const int q = nwg / NXCD, r = nwg % NXCD, xcd = wgid % NXCD, off = wgid / NXCD; wgid = (xcd < r ? xcd * (q + 1) : r * (q + 1) + (xcd - r) * q) + off; }
        const int nig = WGM * nN, gid = wgid / nig, fm = gid * WGM, gsz = (nM - fm) < WGM ? (nM - fm) : WGM;
        u.pm = fm + ((wgid % nig) % gsz); u.pn = (wgid % nig) / gsz; return true;
    }
    __device__ __forceinline__ void a_ready(const Unit&) const {}
    __device__ __forceinline__ void done(const Unit&) const {}
};

__device__ __forceinline__ f32x4 mma16(bf16x8 b, bf16x8 a, f32x4 c) { return __builtin_amdgcn_mfma_f32_16x16x32_bf16(b, a, c, 0, 0, 0); }
__device__ __forceinline__ i32x4 mma16(bf16x8 b, bf16x8 a, i32x4 c) { return __builtin_amdgcn_mfma_i32_16x16x64_i8(__builtin_bit_cast(i32x4, b), __builtin_bit_cast(i32x4, a), c, 0, 0, 0); }
template <bool I8> struct AccT { typedef f32x4 type; };
template <> struct AccT<true> { typedef i32x4 type; };
template <class Epi, class Sched, bool ALIGN_EPI, bool SP2, bool I8 = false>
__device__ __forceinline__ void gemm_phase(LAS unsigned char* lds, const Gemm g, const Sched& S, const Epi& E, int wave_) {
    static_assert(ALIGN_EPI && SP2, "only the aligned-epilogue, two-MFMA-cluster schedule is kept");
    const int tid = wave_ * 64 + lane_now();
    const int wid = wave_, lane = tid & 63, wr = wid >> 2, wc = wid & 3, fr = lane & 15, fq = lane >> 4;
    const int K = g.K, nt = K / BK;
    unsigned voffA, voffB;
    { int R, C; stage_rc(tid * 16, R, C); const int Rb = Epi::PERM ? ((R & ~31) + perm32(R & 31)) : R; voffA = (unsigned)(R * K + C) * 2u; voffB = (unsigned)(Rb * K + C) * 2u; }
    const __amdgpu_buffer_rsrc_t srdA = __builtin_amdgcn_make_buffer_rsrc((void*)g.A, (short)0, -1, 0x00020000);
    const __amdgpu_buffer_rsrc_t srdB = __builtin_amdgcn_make_buffer_rsrc((void*)g.Bt, (short)0, -1, 0x00020000);
    const unsigned kstep = BK * 2u, hstep = (unsigned)HALF * (unsigned)K * 2u, tstep = 2u * hstep, pstep = 64u * (unsigned)K * 2u;
    const unsigned ldsb = (unsigned)(size_t)lds + (unsigned)wid * 1024u;
    const int aoff = lds_byte(wr * 64 + fr, fq * 8), boff = lds_byte(wc * 32 + fr, fq * 8);
#define PG8_SA(b, h) (((b) * 2 + (h)) * HTB)
#define PG8_SB(b, h) ((4 + (b) * 2 + (h)) * HTB)
#define PG8_STAGE(bufoff, srd, soff, voff) do { _Pragma("unroll") for (int _i = 0; _i < 2; ++_i) \
        asm volatile("s_add_u32 m0, %0, %4\n\ts_nop 0\n\tbuffer_load_dwordx4 %1, %2, %3 offen lds" :: "s"(ldsb), "v"(voff), "s"(srd), "s"((soff) + _i * pstep), "n"((bufoff) + _i * 8192) : "m0", "scc", "memory"); } while (0)
#define PG8_STA(b, h, soff) PG8_STAGE(PG8_SA(b, h), srdA, soff, voffA)
#define PG8_STB(b, h, soff) PG8_STAGE(PG8_SB(b, h), srdB, soff, voffB)
#define PG8_LDA(dst, b, h) do { _Pragma("unroll") for (int m = 0; m < 4; ++m) _Pragma("unroll") for (int k = 0; k < 2; ++k) dst[m][k] = *(const LAS bf16x8*)(lds + PG8_SA(b, h) + aoff + m * 2048 + k * 1024); } while (0)
#define PG8_LDB(dst, b, h) do { _Pragma("unroll") for (int n = 0; n < 2; ++n) _Pragma("unroll") for (int k = 0; k < 2; ++k) dst[n][k] = *(const LAS bf16x8*)(lds + PG8_SB(b, h) + boff + n * 2048 + k * 1024); } while (0)
#define PG8_MMA(ai, bj, At, Bt) do { __builtin_amdgcn_s_setprio(1); _Pragma("unroll") for (int m = 0; m < 4; ++m) _Pragma("unroll") for (int n = 0; n < 2; ++n) _Pragma("unroll") for (int k = 0; k < 2; ++k) \
        acc[ai][bj][m][n] = mma16(Bt[n][k], At[m][k], acc[ai][bj][m][n]); __builtin_amdgcn_s_setprio(0); } while (0)
#define PG8_MMAZ(ai, bj, At, Bt) do { __builtin_amdgcn_s_setprio(1); _Pragma("unroll") for (int m = 0; m < 4; ++m) _Pragma("unroll") for (int n = 0; n < 2; ++n) { \
        acc[ai][bj][m][n] = mma16(Bt[n][0], At[m][0], acc_t{}); acc[ai][bj][m][n] = mma16(Bt[n][1], At[m][1], acc[ai][bj][m][n]); } __builtin_amdgcn_s_setprio(0); } while (0)
#define PG8_WAIT_V(n) asm volatile("s_waitcnt vmcnt(%0)" :: "n"(n) : "memory")
#define PG8_WAIT_L(n) asm volatile("s_waitcnt lgkmcnt(" #n ")" ::: "memory")
#define PG8_BAR __builtin_amdgcn_s_barrier()
#define PG8_SCHED __builtin_amdgcn_sched_barrier(0)
#ifndef PG8_RELAX
#define PG8_RELAX 1
#endif
#define PG8_WAIT_R(relaxed, nst) do { if (relaxed) PG8_WAIT_V(8 + PG8_RELAX * (nst)); else PG8_WAIT_V(8); } while (0)
#define PG8_TRIP(first, relaxed, nst) do { \
            PG8_LDB(B0, 0, 0); PG8_LDB(B1, 0, 1); PG8_SCHED; PG8_LDA(At, 0, 0); if (!(first)) PG8_STA(1, 1, a1 + hstep); \
            PG8_WAIT_R(relaxed, nst); PG8_WAIT_L(0); PG8_BAR; PG8_MMA(0, 0, At, B0); PG8_MMA(0, 1, At, B1); PG8_BAR; PG8_SCHED; \
            PG8_LDA(At, 0, 1); PG8_STB(0, 0, b2); PG8_STB(0, 1, b2 + hstep); PG8_STA(0, 0, a2); \
            PG8_WAIT_R(relaxed, nst); PG8_WAIT_L(0); PG8_BAR; PG8_MMA(1, 0, At, B0); PG8_MMA(1, 1, At, B1); PG8_BAR; PG8_SCHED; \
            PG8_LDB(B0, 1, 0); PG8_LDB(B1, 1, 1); PG8_SCHED; PG8_LDA(At, 1, 0); PG8_STA(0, 1, a2 + hstep); \
            PG8_WAIT_R(relaxed, nst); PG8_WAIT_L(0); PG8_BAR; PG8_MMA(0, 0, At, B0); PG8_MMA(0, 1, At, B1); PG8_BAR; PG8_SCHED; \
            PG8_LDA(At, 1, 1); PG8_STB(1, 0, b3); PG8_STB(1, 1, b3 + hstep); PG8_STA(1, 0, a3); \
            PG8_WAIT_V(8); PG8_WAIT_L(0); PG8_BAR; PG8_MMA(1, 0, At, B0); PG8_MMA(1, 1, At, B1); PG8_BAR; PG8_SCHED; } while (0)
    constexpr bool EARLY = Epi::NST > 0;
    Unit cur, nxt; int ui = 0;
    if (!S.next(0, cur)) return;
    typedef typename AccT<I8>::type acc_t;
    acc_t acc[2][2][4][2];
    bf16x8 At[4][2], B0[2][2], B1[2][2];
    unsigned cA = (unsigned)cur.pm * tstep, cB = (unsigned)cur.pn * tstep;
    S.a_ready(cur);
    PG8_STB(0, 0, cB); PG8_STB(0, 1, cB + hstep); PG8_STA(0, 0, cA); PG8_STA(0, 1, cA + hstep);
    if (wr == 1) PG8_BAR;
    PG8_WAIT_V(2); PG8_BAR;
    PG8_STB(1, 0, cB + kstep); PG8_STA(1, 0, cA + kstep); PG8_STB(1, 1, cB + hstep + kstep);
    if constexpr (EARLY) { PG8_STA(1, 1, cA + hstep + kstep); PG8_WAIT_V(8); } else { PG8_WAIT_V(6); }
    PG8_BAR;
#pragma unroll
    for (int a = 0; a < 2; ++a)
#pragma unroll
        for (int b = 0; b < 2; ++b)
#pragma unroll
            for (int m = 0; m < 4; ++m)
#pragma unroll
                for (int n = 0; n < 2; ++n) acc[a][b][m][n] = acc_t{};
    for (;;) {
        const bool has_next = S.next(ui + 1, nxt);
        const unsigned nA = has_next ? (unsigned)nxt.pm * tstep : cA, nB = has_next ? (unsigned)nxt.pn * tstep : cB;
        for (int t = 0; t < nt; t += 2) {
            const bool last = (t == nt - 2), first = EARLY && (t == 0), relaxed = first && ui > 0;
            const unsigned a1 = cA + (unsigned)(t + 1) * kstep;
            const unsigned a2 = last ? nA : cA + (unsigned)(t + 2) * kstep, b2 = last ? nB : cB + (unsigned)(t + 2) * kstep;
            const unsigned a3 = a2 + kstep, b3 = b2 + kstep;
            if (last && has_next) S.a_ready(nxt);
            if (last) E.prefetch(cur, wid, lane, lds);
            PG8_TRIP(first, relaxed, Epi::NST);
        }
        if constexpr (EARLY) PG8_STA(1, 1, nA + kstep + hstep);
        if (wr == 0) PG8_BAR;
        E(acc, cur, wr, wc, fr, fq); S.done(cur);
        if (!has_next) break;
#pragma unroll
        for (int a = 0; a < 2; ++a)
#pragma unroll
            for (int b = 0; b < 2; ++b)
#pragma unroll
                for (int m = 0; m < 4; ++m)
#pragma unroll
                    for (int n = 0; n < 2; ++n) acc[a][b][m][n] = acc_t{};
        cur = nxt; cA = nA; cB = nB; ++ui;
        if (wr == 1) PG8_BAR;
    }
    PG8_WAIT_V(0);
    PG8_BAR;
#undef PG8_SA
#undef PG8_SB
#undef PG8_STAGE
#undef PG8_STA
#undef PG8_STB
#undef PG8_LDA
#undef PG8_LDB
#undef PG8_MMA
#undef PG8_MMAZ
#undef PG8_TRIP
#undef PG8_WAIT_R
#undef PG8_WAIT_V
#undef PG8_WAIT_L
#undef PG8_BAR
#undef PG8_SCHED
}
}

typedef const f32x4 (&AccRef)[2][2][4][2];
#define EPI_BIG_CALL() \
    __device__ __forceinline__ void operator()(AccRef acc, const pg8::Unit& u, int wr, int wc, int fr, int fq) const { \
        { const int l_ = lane_now(); fr = l_ & 15; fq = (l_ >> 4) & 3; }     \
        const int row0 = u.pm * 256 + wr * 64 + fr; \
        _Pragma("unroll") for (int gq = 0; gq < 8 / PF; ++gq) { \
            Pre p[PF]; \
            asm volatile("" ::: "memory"); \
            _Pragma("unroll") for (int i = 0; i < PF; ++i) { const int rg = gq * PF + i; p[i] = pre_big(row0 + (rg >> 2) * 128 + (rg & 3) * 16, u.pn, wc, fq); }     \
            asm volatile("" ::: "memory"); \
            _Pragma("unroll") for (int i = 0; i < PF; ++i) { const int rg = gq * PF + i; \
                rows(acc[rg >> 2][0][rg & 3][0], acc[rg >> 2][0][rg & 3][1], acc[rg >> 2][1][rg & 3][0], acc[rg >> 2][1][rg & 3][1], row0 + (rg >> 2) * 128 + (rg & 3) * 16, u.pn, wc, fq, p[i]); } } \
    }
__device__ __forceinline__ f32x4 ssq_quarter(const float* ssq, int r, int fq) { return *(const f32x4*)(ssq + (size_t)r * 16 + 4 * fq); }
__device__ __forceinline__ float rstd_from(const f32x4& q) {
    float s = (q.x + q.y) + (q.z + q.w);
    s = sum_rows4(s);
    return rsqrtf(s * (1.0f / D) + EPS);
}

__device__ __forceinline__ void ssq_prefetch(const float* ssq, int pm, int wid, int lane, LAS unsigned char* lds) {
    asm volatile("" : "+v"(lane));
#pragma unroll
    for (int i = 0; i < 2; ++i)
        __builtin_amdgcn_global_load_lds((const unsigned*)(ssq + ((size_t)pm * 256 + wid * 32 + i * 16) * 16 + lane * 4), (LAS unsigned*)(lds + SSQ_LDS_OFF + (wid * 32 + i * 16) * 64), 16, 0, 0);
}
struct EpiSwiglu {
    static constexpr bool PERM = true; static constexpr int PF = 8; static constexpr int NST = 8;
    bf16_t* O; const float* ssq; LAS unsigned char* lds;
    struct Pre { f32x4 q; };
    __device__ __forceinline__ Pre pre(int r, int pn, int wc, int fq) const { Pre p; p.q = ssq_quarter(ssq, r, fq); return p; }
    __device__ __forceinline__ Pre pre_big(int r, int pn, int wc, int fq) const { Pre p; p.q = *(const LAS f32x4*)(lds + SSQ_LDS_OFF + (r & 255) * 64 + fq * 16); return p; }
    __device__ __forceinline__ void prefetch(const pg8::Unit& u, int wid, int lane, LAS unsigned char* l) const { ssq_prefetch(ssq, u.pm, wid, lane, l); }
    __device__ __forceinline__ void rows(const f32x4& c00, const f32x4& c01, const f32x4& c10, const f32x4& c11, int r, int pn, int wc, int fq, const Pre& p) const {
        const float rs = rstd_from(p.q);
        float o[8];
#pragma unroll
        for (int j = 0; j < 4; ++j) { o[j] = silu_f(c00[j] * rs) * (c10[j] * rs); o[4 + j] = silu_f(c01[j] * rs) * (c11[j] * rs); }
        u32x4 w; w.x = cvt_pk_bf16(o[0], o[1]); w.y = cvt_pk_bf16(o[2], o[3]); w.z = cvt_pk_bf16(o[4], o[5]); w.w = cvt_pk_bf16(o[6], o[7]);
        { bf16_t* dst_ = O + (size_t)r * FF + pn * 128 + wc * 32 + 8 * fq;
          asm volatile("global_store_dwordx4 %0, %1, off sc1\n\ts_nop 1" :: "v"(dst_), "v"(w) : "memory"); }
    }
    EPI_BIG_CALL()
};

struct EpiSwigluI8 {
    static constexpr bool PERM = true; static constexpr int NST = 8;
    bf16_t* O; const float* rs; const float* cs; LAS unsigned char* lds;
    struct Pre { float sa; };
    __device__ __forceinline__ Pre pre(int r, int pn, int wc, int fq) const { Pre p; p.sa = rs[r]; return p; }
    __device__ __forceinline__ void prefetch(const pg8::Unit& u, int wid, int lane, LAS unsigned char* l) const {
        asm volatile("" : "+v"(lane));
        if (wid == 0) __builtin_amdgcn_global_load_lds((const unsigned*)(rs + (size_t)u.pm * 256 + lane * 4), (LAS unsigned*)(l + SSQ_LDS_OFF), 16, 0, 0);
        if (wid == 1) __builtin_amdgcn_global_load_lds((const unsigned*)(cs + (size_t)u.pn * 256 + lane * 4), (LAS unsigned*)(l + SSQ_LDS_OFF + 1024), 16, 0, 0);
    }
    __device__ __forceinline__ void emit(const f32x4& c00, const f32x4& c01, const f32x4& c10, const f32x4& c11, float sa, const f32x4& w00, const f32x4& w01, const f32x4& w10, const f32x4& w11,
                                         int r, int pn, int wc, int fq) const {
        float o[8];
#pragma unroll
        for (int j = 0; j < 4; ++j) { o[j] = silu_f(c00[j] * (sa * w00[j])) * (c10[j] * (sa * w10[j])); o[4 + j] = silu_f(c01[j] * (sa * w01[j])) * (c11[j] * (sa * w11[j])); }
        u32x4 w; w.x = cvt_pk_bf16(o[0], o[1]); w.y = cvt_pk_bf16(o[2], o[3]); w.z = cvt_pk_bf16(o[4], o[5]); w.w = cvt_pk_bf16(o[6], o[7]);
        { bf16_t* dst_ = O + (size_t)r * FF + pn * 128 + wc * 32 + 8 * fq;
          asm volatile("global_store_dwordx4 %0, %1, off sc1\n\ts_nop 1" :: "v"(dst_), "v"(w) : "memory"); }
    }
    __device__ __forceinline__ void rows(const f32x4& c00, const f32x4& c01, const f32x4& c10, const f32x4& c11, int r, int pn, int wc, int fq, const Pre& p) const {
        const float* cp = cs + (size_t)pn * 256 + wc * 32 + 8 * fq;
        emit(c00, c01, c10, c11, p.sa, *(const f32x4*)cp, *(const f32x4*)(cp + 4), *(const f32x4*)(cp + 128), *(const f32x4*)(cp + 132), r, pn, wc, fq);
    }
    template <class AccTy> __device__ __forceinline__ void operator()(const AccTy (&acc)[2][2][4][2], const pg8::Unit& u, int wr, int wc, int fr, int fq) const {
        { const int l_ = lane_now(); fr = l_ & 15; fq = (l_ >> 4) & 3; }
        const int row0 = u.pm * 256 + wr * 64 + fr;
        LAS const float* lr = (LAS const float*)(lds + SSQ_LDS_OFF); LAS const float* lc = lr + 256 + wc * 32 + 8 * fq;
        const f32x4 w00 = *(LAS const f32x4*)lc, w01 = *(LAS const f32x4*)(lc + 4), w10 = *(LAS const f32x4*)(lc + 128), w11 = *(LAS const f32x4*)(lc + 132);
#pragma unroll
        for (int rg = 0; rg < 8; ++rg) {
            const int ai = rg >> 2, m = rg & 3, r = row0 + ai * 128 + m * 16;
            const float sa = lr[r & 255];
            emit(__builtin_convertvector(acc[ai][0][m][0], f32x4), __builtin_convertvector(acc[ai][0][m][1], f32x4), __builtin_convertvector(acc[ai][1][m][0], f32x4), __builtin_convertvector(acc[ai][1][m][1], f32x4),
                 sa, w00, w01, w10, w11, r, u.pn, wc, fq);
        }
    }
};

template <int MODE> struct EpiResid {
    static constexpr bool PERM = true; static constexpr int PF = (MODE == 0) ? 2 : 4;
    static constexpr int NST = (MODE == 2) ? 16 : (MODE == 1) ? 8 : 4;
    const float* resP; const float* resS;
    float* out; bf16_t* xb; float* ssq; float scale;
    struct Pre { f32x4 r00, r01, r10, r11; u32x4 a, b; };
    __device__ __forceinline__ Pre pre(int r, int pn, int wc, int fq) const {
        Pre p; const size_t off = (size_t)r * D + pn * 256 + wc * 32 + 8 * fq;
        if (MODE == 0) { const float* rbase = (r >= MP) ? resS - (size_t)MP * D : resP;
            p.r00 = *(const f32x4*)(rbase + off); p.r01 = *(const f32x4*)(rbase + off + 4); p.r10 = *(const f32x4*)(rbase + off + 128); p.r11 = *(const f32x4*)(rbase + off + 132); }
        else { p.a = *(const u32x4*)(xb + off); p.b = *(const u32x4*)(xb + off + 128); }
        return p;
    }
    __device__ __forceinline__ Pre pre_big(int r, int pn, int wc, int fq) const { return pre(r, pn, wc, fq); }
    __device__ __forceinline__ void prefetch(const pg8::Unit&, int, int, LAS unsigned char*) const {}
    __device__ __forceinline__ void rows(const f32x4& c00, const f32x4& c01, const f32x4& c10, const f32x4& c11, int r, int pn, int wc, int fq, const Pre& p) const {
        const size_t off = (size_t)r * D + pn * 256 + wc * 32 + 8 * fq;
        f32x4 r00, r01, r10, r11;
        if (MODE == 0) { r00 = p.r00; r01 = p.r01; r10 = p.r10; r11 = p.r11; }
        else {
            const u32x4 a = p.a, b = p.b;
            r00 = (f32x4){__uint_as_float(a.x << 16), __uint_as_float(a.x & 0xffff0000u), __uint_as_float(a.y << 16), __uint_as_float(a.y & 0xffff0000u)};
            r01 = (f32x4){__uint_as_float(a.z << 16), __uint_as_float(a.z & 0xffff0000u), __uint_as_float(a.w << 16), __uint_as_float(a.w & 0xffff0000u)};
            r10 = (f32x4){__uint_as_float(b.x << 16), __uint_as_float(b.x & 0xffff0000u), __uint_as_float(b.y << 16), __uint_as_float(b.y & 0xffff0000u)};
            r11 = (f32x4){__uint_as_float(b.z << 16), __uint_as_float(b.z & 0xffff0000u), __uint_as_float(b.w << 16), __uint_as_float(b.w & 0xffff0000u)};
        }
        const f32x4 y00 = r00 + c00 * scale, y01 = r01 + c01 * scale, y10 = r10 + c10 * scale, y11 = r11 + c11 * scale;
        if (MODE == 2) {
            __builtin_nontemporal_store(y00, (f32x4*)(out + off)); __builtin_nontemporal_store(y01, (f32x4*)(out + off + 4)); __builtin_nontemporal_store(y10, (f32x4*)(out + off + 128)); __builtin_nontemporal_store(y11, (f32x4*)(out + off + 132));
        } else {
            u32x4 w0, w1;
            w0.x = cvt_pk_bf16(y00[0], y00[1]); w0.y = cvt_pk_bf16(y00[2], y00[3]); w0.z = cvt_pk_bf16(y01[0], y01[1]); w0.w = cvt_pk_bf16(y01[2], y01[3]);
            w1.x = cvt_pk_bf16(y10[0], y10[1]); w1.y = cvt_pk_bf16(y10[2], y10[3]); w1.z = cvt_pk_bf16(y11[0], y11[1]); w1.w = cvt_pk_bf16(y11[2], y11[3]);
            *(u32x4*)(xb + off) = w0; *(u32x4*)(xb + off + 128) = w1;
            float ss = (y00[0] * y00[0] + y00[1] * y00[1]) + (y00[2] * y00[2] + y00[3] * y00[3]) + (y01[0] * y01[0] + y01[1] * y01[1]) + (y01[2] * y01[2] + y01[3] * y01[3])
                     + (y10[0] * y10[0] + y10[1] * y10[1]) + (y10[2] * y10[2] + y10[3] * y10[3]) + (y11[0] * y11[0] + y11[1] * y11[1]) + (y11[2] * y11[2] + y11[3] * y11[3]);
            ss = sum_rows4(ss);
            if (fq == 0) ssq[(size_t)r * 16 + pn * 4 + wc] = ss;
        }
    }
    EPI_BIG_CALL()
};

struct EpiInProj {
    static constexpr bool PERM = true; static constexpr int PF = 1; static constexpr int NST = 0;
    unsigned char* ws; const float* gq; const float* gk; float* out; LAS unsigned char* lds;
    struct Pre { f32x4 q; };
    __device__ __forceinline__ Pre pre(int r, int pn, int wc, int fq) const { Pre p; p.q = ssq_quarter((const float*)(ws + WS_SSQ1), r, fq); return p; }
    __device__ __forceinline__ Pre pre_big(int r, int pn, int wc, int fq) const { Pre p; p.q = *(const LAS f32x4*)(lds + SSQ_LDS_OFF + (r & 255) * 64 + fq * 16); return p; }
    __device__ __forceinline__ void prefetch(const pg8::Unit& u, int wid, int lane, LAS unsigned char* l) const { ssq_prefetch((const float*)(ws + WS_SSQ1), u.pm, wid, lane, l); }
    __device__ __forceinline__ void rows(const f32x4& c00, const f32x4& c01, const f32x4& c10, const f32x4& c11, int r, int pn, int wc, int fq, const Pre& p) const {
        const bool sample = r >= MP;
        int b, t, pos;
        if (sample) { const int rr = r - MP; b = rr >> 4; t = rr & 15; pos = PAST + t; } else { b = r >> 13; t = r & (TP - 1); pos = t; }
        const float rs = rstd_from(p.q);
        if (pn < 4) {
            const int ch0 = pn * 128 + wc * 32 + 8 * fq;
            float o[8];
#pragma unroll
            for (int j = 0; j < 4; ++j) { o[j] = (c00[j] * rs) * sigmoid_f(c10[j] * rs); o[4 + j] = (c01[j] * rs) * sigmoid_f(c11[j] * rs); }
            u32x4 w; w.x = cvt_pk_bf16(o[0], o[1]); w.y = cvt_pk_bf16(o[2], o[3]); w.z = cvt_pk_bf16(o[4], o[5]); w.w = cvt_pk_bf16(o[6], o[7]);
            bf16_t* ud = sample ? (bf16_t*)(ws + WS_US) + ((size_t)(b * USROWS + HIST + t)) * CC + ch0 : (bf16_t*)(ws + WS_UP) + (size_t)r * CC + ch0;
            *(u32x4*)ud = w;
            float* dst = nullptr;
            if (sample) dst = out + O_CSS + ((size_t)(b * HIST + (HIST - TS) + t)) * CC + ch0;
            else if (t >= TP - HIST) dst = out + O_CSP + ((size_t)(b * HIST + (t - (TP - HIST)))) * CC + ch0;
            if (dst) { *(f32x4*)dst = (f32x4){o[0], o[1], o[2], o[3]}; *(f32x4*)(dst + 4) = (f32x4){o[4], o[5], o[6], o[7]}; }
        } else if (pn < 6 || wc < 2) {
            const bool isq = pn < 6;
            const int h = isq ? (pn - 4) * 4 + wc : wc;
            const float* gg = isq ? gq : gk;
            const f32x4 g00 = *(const f32x4*)(gg + 8 * fq), g01 = *(const f32x4*)(gg + 8 * fq + 4), g10 = *(const f32x4*)(gg + 32 + 8 * fq), g11 = *(const f32x4*)(gg + 32 + 8 * fq + 4);
            const float osc = isq ? QSCALE : 1.0f;
            f32x4 v00 = c00 * rs, v01 = c01 * rs, v10 = c10 * rs, v11 = c11 * rs;
            float ss = (v00[0] * v00[0] + v00[1] * v00[1]) + (v00[2] * v00[2] + v00[3] * v00[3]) + (v01[0] * v01[0] + v01[1] * v01[1]) + (v01[2] * v01[2] + v01[3] * v01[3])
                     + (v10[0] * v10[0] + v10[1] * v10[1]) + (v10[2] * v10[2] + v10[3] * v10[3]) + (v11[0] * v11[0] + v11[1] * v11[1]) + (v11[2] * v11[2] + v11[3] * v11[3]);
            ss = sum_rows4(ss);
            const float hn = rsqrtf(ss * (1.0f / HD) + EPS);
            v00 = v00 * hn * g00; v01 = v01 * hn * g01; v10 = v10 * hn * g10; v11 = v11 * hn * g11;
            f32x4 p0, p1;
#pragma unroll
            for (int j = 0; j < 4; ++j) { p0[j] = __shfl_xor(v00[j], 16); p1[j] = __shfl_xor(v01[j], 16);     }
            if (fq < 2) {
                const f32x2* rp = (const f32x2*)(ws + WS_ROPE) + (size_t)pos * 8;
                const float sg = (fq == 0) ? -1.0f : 1.0f;
#pragma unroll
                for (int j = 0; j < 4; ++j) {
                    const f32x2 cs0 = rp[j], cs1 = rp[4 + j];
                    v00[j] = v00[j] * cs0.x + sg * p0[j] * cs0.y;
                    v01[j] = v01[j] * cs1.x + sg * p1[j] * cs1.y;
                }
            }
            u32x4 w0, w1;
            w0.x = cvt_pk_bf16(v00[0] * osc, v00[1] * osc); w0.y = cvt_pk_bf16(v00[2] * osc, v00[3] * osc); w0.z = cvt_pk_bf16(v01[0] * osc, v01[1] * osc); w0.w = cvt_pk_bf16(v01[2] * osc, v01[3] * osc);
            w1.x = cvt_pk_bf16(v10[0] * osc, v10[1] * osc); w1.y = cvt_pk_bf16(v10[2] * osc, v10[3] * osc); w1.z = cvt_pk_bf16(v11[0] * osc, v11[1] * osc); w1.w = cvt_pk_bf16(v11[2] * osc, v11[3] * osc);
            if (isq) {
                bf16_t* dst = (bf16_t*)(ws + WS_Q) + (size_t)r * 512 + h * 64 + 8 * fq;
                *(u32x4*)dst = w0; *(u32x4*)(dst + 32) = w1;
            } else {
                bf16_t* dst = sample ? (bf16_t*)(ws + WS_KS) + ((size_t)(b * KSROWS + WIN + t)) * 128 + h * 64 + 8 * fq : (bf16_t*)(ws + WS_KP) + (size_t)r * 128 + h * 64 + 8 * fq;
                *(u32x4*)dst = w0; *(u32x4*)(dst + 32) = w1;
                float* od = nullptr;
                if (sample) od = out + O_KWS + ((size_t)((b * WIN + (WIN - TS) + t) * 2 + h)) * 64 + 8 * fq;
                else if (t >= TP - WIN) od = out + O_KWP + ((size_t)((b * WIN + (t - (TP - WIN))) * 2 + h)) * 64 + 8 * fq;
                if (od) { *(f32x4*)od = v00; *(f32x4*)(od + 4) = v01; *(f32x4*)(od + 32) = v10; *(f32x4*)(od + 36) = v11; }
            }
        } else {
            const int kh = wc - 2;
            const f32x4 v00 = c00 * rs, v01 = c01 * rs, v10 = c10 * rs, v11 = c11 * rs;
            bf16_t* vt; size_t vs;
            if (sample) { vt = (bf16_t*)(ws + WS_VTS) + ((size_t)((b * 2 + kh) * 64)) * KSROWS + WIN + t; vs = KSROWS; }
            else { vt = (bf16_t*)(ws + WS_VTP) + ((size_t)((b * 2 + kh) * (TP / 64) + (t >> 6))) * 4096 + (t & 63); vs = 64; }
#pragma unroll
            for (int j = 0; j < 4; ++j) {
                vt[(size_t)(8 * fq + j) * vs] = f2bf(v00[j]); vt[(size_t)(8 * fq + 4 + j) * vs] = f2bf(v01[j]);
                vt[(size_t)(32 + 8 * fq + j) * vs] = f2bf(v10[j]); vt[(size_t)(32 + 8 * fq + 4 + j) * vs] = f2bf(v11[j]);
            }
            float* od = nullptr;
            if (sample) od = out + O_VWS + ((size_t)((b * WIN + (WIN - TS) + t) * 2 + kh)) * 64 + 8 * fq;
            else if (t >= TP - WIN) od = out + O_VWP + ((size_t)((b * WIN + (t - (TP - WIN))) * 2 + kh)) * 64 + 8 * fq;
            if (od) { *(f32x4*)od = v00; *(f32x4*)(od + 4) = v01; *(f32x4*)(od + 32) = v10; *(f32x4*)(od + 36) = v11; }
        }
    }
    EPI_BIG_CALL()
};

template <int KS, int MT, bool I8, class Epi>
__device__ __forceinline__ void small_gemm(const bf16_t* A, const bf16_t* Bt, int N, int K, const Epi& E, LAS unsigned char* lds, int bid, int G, int wave, int lane, int wpc_in = 0) {
    constexpr int MTN = MS / (16 * MT);
    const int NT = MTN * (N / 256) * 4, NI = NT * KS, wpc = wpc_in ? wpc_in : (NI + G - 1) / G, nb = K / 64;
    asm volatile("" : "+v"(lane));
    const int fr = lane & 15, g = lane >> 4;
    for (int i0 = 0; i0 < wpc; i0 += 8) {
        const int i = i0 + wave, item = bid * wpc + i;
        const bool active = (i < wpc) && (item < NI);
        const int t = active ? item / KS : 0, ksl = item % KS;
        const int mt = t % MTN, nq = t / MTN, pn = nq >> 2, wc = nq & 3;
        const int r = MP + mt * (16 * MT) + fr;
        typedef typename pg8::AccT<I8>::type acc_t;
        acc_t acc[MT][2][2];
#pragma unroll
        for (int mi = 0; mi < MT; ++mi)
#pragma unroll
            for (int bj = 0; bj < 2; ++bj)
#pragma unroll
                for (int n = 0; n < 2; ++n) acc[mi][bj][n] = acc_t{};
        if (active) {
            const int b0 = (nb * ksl) / KS, b1 = (nb * (ksl + 1)) / KS;
            const bf16_t* ap = A + (size_t)r * K + g * 8;
            const bf16_t* bp = Bt + (size_t)(pn * 256 + wc * 32 + 8 * (fr >> 2) + (fr & 3)) * K + g * 8;
            bf16x8 afA[2][MT], bfA[2][2][2], afB[2][MT], bfB[2][2][2];
#define SG_LOAD(af, bf, kb) do { const int k0_ = (kb) * 64; _Pragma("unroll") for (int s_ = 0; s_ < 2; ++s_) { \
            _Pragma("unroll") for (int mi = 0; mi < MT; ++mi) af[s_][mi] = *(const bf16x8*)(ap + (size_t)(16 * mi) * K + k0_ + s_ * 32); \
            _Pragma("unroll") for (int bj = 0; bj < 2; ++bj) _Pragma("unroll") for (int n = 0; n < 2; ++n) bf[s_][bj][n] = *(const bf16x8*)(bp + (size_t)(4 * n + 128 * bj) * K + k0_ + s_ * 32); } } while (0)
#define SG_MMA(af, bf) do { _Pragma("unroll") for (int s_ = 0; s_ < 2; ++s_) _Pragma("unroll") for (int bj = 0; bj < 2; ++bj) _Pragma("unroll") for (int n = 0; n < 2; ++n) { \
            _Pragma("unroll") for (int mi = 0; mi < MT; ++mi) acc[mi][bj][n] = pg8::mma16(bf[s_][bj][n], af[s_][mi], acc[mi][bj][n]); } } while (0)
            SG_LOAD(afA, bfA, b0);
            for (int kb = b0; kb < b1; kb += 2) {
                const int kb1 = (kb + 1 < b1) ? kb + 1 : b1 - 1, kb2 = (kb + 2 < b1) ? kb + 2 : b1 - 1;
                __builtin_amdgcn_sched_barrier(0);
                SG_LOAD(afB, bfB, kb1);
                __builtin_amdgcn_sched_barrier(0);
                SG_MMA(afA, bfA);
                __builtin_amdgcn_sched_barrier(0);
                SG_LOAD(afA, bfA, kb2);
                __builtin_amdgcn_sched_barrier(0);
                if (kb + 1 < b1) SG_MMA(afB, bfB);
            }
#undef SG_LOAD
#undef SG_MMA
        }
        if constexpr (KS > 1) {
            static_assert(KS == 1 || KS == 8, "KS: 1 or 8 (all eight waves of the workgroup on one tile)");
            LAS acc_t* red = (LAS acc_t*)lds;
            if (ksl != 0) {
#pragma unroll
                for (int mi = 0; mi < MT; ++mi)
#pragma unroll
                    for (int bj = 0; bj < 2; ++bj)
#pragma unroll
                        for (int n = 0; n < 2; ++n) red[(ksl - 1) * (MT * 256) + ((mi * 2 + bj) * 2 + n) * 64 + lane] = acc[mi][bj][n];
            }
            __syncthreads();
            if (ksl == 0) {
#pragma unroll
                for (int q = 0; q < KS - 1; ++q)
#pragma unroll
                    for (int mi = 0; mi < MT; ++mi)
#pragma unroll
                        for (int bj = 0; bj < 2; ++bj)
#pragma unroll
                            for (int n = 0; n < 2; ++n) acc[mi][bj][n] += red[q * (MT * 256) + ((mi * 2 + bj) * 2 + n) * 64 + lane];
            }
            __syncthreads();
        }
        if (active && ksl == 0) {
#pragma unroll
            for (int mi = 0; mi < MT; ++mi) { const typename Epi::Pre p = E.pre(r + 16 * mi, pn, wc, g);
                E.rows(__builtin_convertvector(acc[mi][0][0], f32x4), __builtin_convertvector(acc[mi][0][1], f32x4), __builtin_convertvector(acc[mi][1][0], f32x4), __builtin_convertvector(acc[mi][1][1], f32x4), r + 16 * mi, pn, wc, g, p); }
        }
    }
}

struct TItem { const float* W; const float* g; bf16_t* WT; int Nsrc, srccol0, K, destrow0, k0; };
__device__ __forceinline__ void p0_tload(const TItem& t, float (&v)[32], int lane) {
#pragma unroll
    for (int i = 0; i < 32; ++i) { const int kk = 2 * i + (lane >> 5); v[i] = t.W[(size_t)(t.k0 + kk) * t.Nsrc + t.srccol0 + (lane & 31)]; }
}
__device__ __forceinline__ void p0_tfinish(const TItem& t, const float (&v)[32], LAS float* scr, int lane) {
#pragma unroll
    for (int i = 0; i < 32; ++i) { const int kk = 2 * i + (lane >> 5); scr[kk * 33 + (lane & 31)] = v[i]; }
    asm volatile("s_waitcnt lgkmcnt(0)" ::: "memory");
    const int c = lane & 7;
    f32x4 g0 = (f32x4){1.f, 1.f, 1.f, 1.f}, g1 = g0;
    if (t.g) { g0 = *(const f32x4*)(t.g + t.k0 + 8 * c); g1 = *(const f32x4*)(t.g + t.k0 + 8 * c + 4); }
#pragma unroll
    for (int j = 0; j < 4; ++j) { const int n = (lane >> 3) + 8 * j; const LAS float* sp = scr + (8 * c) * 33 + n;
        u32x4 o; o.x = cvt_pk_bf16(sp[0 * 33] * g0.x, sp[1 * 33] * g0.y); o.y = cvt_pk_bf16(sp[2 * 33] * g0.z, sp[3 * 33] * g0.w); o.z = cvt_pk_bf16(sp[4 * 33] * g1.x, sp[5 * 33] * g1.y); o.w = cvt_pk_bf16(sp[6 * 33] * g1.z, sp[7 * 33] * g1.w);
        *(u32x4*)(t.WT + (size_t)(t.destrow0 + n) * t.K + t.k0 + 8 * c) = o; }
    asm volatile("s_waitcnt lgkmcnt(0)" ::: "memory");
}
__device__ __forceinline__ int src_up(int nb) { const int pn = nb >> 3, p0 = (nb & 7) * 32, bj = p0 >> 7; return bj * FF + pn * 128 + (p0 & 127); }
__device__ __forceinline__ int src_in(int nb) {
    const int pn = nb >> 3, p0 = (nb & 7) * 32, bj = p0 >> 7, wc = (p0 & 127) >> 5;
    if (pn < 4) return bj * CC + pn * 128 + wc * 32;
    if (pn < 6) return 1024 + ((pn - 4) * 4 + wc) * 64 + bj * 32;
    return (wc < 2) ? 1536 + wc * 64 + bj * 32 : 1664 + (wc - 2) * 64 + bj * 32;
}

struct Args { const float* in[21]; float* out; unsigned char* ws; float inv[8]; };
typedef const __attribute__((address_space(4))) Args& ArgsRef;
__device__ __forceinline__ const __attribute__((address_space(4))) Args* args_now() {
#if defined(__HIP_DEVICE_COMPILE__)
    auto p = (const __attribute__((address_space(4))) Args*)__builtin_amdgcn_kernarg_segment_ptr(); asm volatile("" : "+s"(p)); return p;
#else
    return nullptr;
#endif
}

constexpr int I_UP = (D / 64) * (NUP / 32), I_DN = (FF / 64) * (D / 32), I_IN = (D / 64) * (NIN / 32), I_O = (D / 64) * (D / 32);
constexpr int NITEMS = 2 * I_UP + 2 * I_DN + I_IN + I_O;
constexpr int NITEMS_EARLY = I_UP + I_DN + I_IN + I_O;
__device__ __forceinline__ TItem p0_decode(ArgsRef a, int it) {
    unsigned char* ws = a.ws; int r = it < NITEMS ? it : NITEMS - 1; TItem t;
    if (r < I_UP) { const int nblk = NUP / 32, kb = r / nblk, nb = r % nblk; t = TItem{a.in[6], a.in[5], (bf16_t*)(ws + WS_W1T), NUP, src_up(nb), D, nb * 32, kb * 64}; return t; } r -= I_UP;
    if (r < I_DN) { const int nblk = D / 32, kb = r / nblk, nb = r % nblk; t = TItem{a.in[7], nullptr, (bf16_t*)(ws + WS_W2T), D, nb * 32, FF, nb * 32, kb * 64}; return t; } r -= I_DN;
    if (r < I_IN) { const int nblk = NIN / 32, kb = r / nblk, nb = r % nblk; t = TItem{a.in[9], a.in[8], (bf16_t*)(ws + WS_WINT), NIN, src_in(nb), D, nb * 32, kb * 64}; return t; } r -= I_IN;
    if (r < I_O) { const int nblk = D / 32, kb = r / nblk, nb = r % nblk; t = TItem{a.in[17], nullptr, (bf16_t*)(ws + WS_WOT), D, nb * 32, D, nb * 32, kb * 64}; return t; } r -= I_O;
    if (r < I_UP) { const int nblk = NUP / 32, kb = r / nblk, nb = r % nblk; t = TItem{a.in[19], a.in[18], (bf16_t*)(ws + WS_W3T), NUP, src_up(nb), D, nb * 32, kb * 64}; return t; } r -= I_UP;
    { const int nblk = D / 32, kb = r / nblk, nb = r % nblk; t = TItem{a.in[20], nullptr, (bf16_t*)(ws + WS_W4T), D, nb * 32, FF, nb * 32, kb * 64}; return t; }
}
__device__ __forceinline__ void weights_convert(ArgsRef a, LAS unsigned char* lds, int it0, int it1, int gw, int NGW, int wave, int lane) {
    LAS float* scr = (LAS float*)(lds + wave * 16896);
    for (int it = it0 + gw; it < it1; it += 2 * NGW) {
        const TItem t0 = p0_decode(a, it), t1 = p0_decode(a, it + NGW < it1 ? it + NGW : it);
        float v0[32], v1[32];
        p0_tload(t0, v0, lane); p0_tload(t1, v1, lane);
        p0_tfinish(t0, v0, scr, lane);
        if (it + NGW < it1) p0_tfinish(t1, v1, scr + 64 * 33, lane);
    }
}


__device__ __forceinline__ void w8_strip(const float* W, const float* g, signed char* Wq, float* cs, int nb, LAS unsigned char* lds, int wave, int lane) {
    LAS float* scr = (LAS float*)(lds + wave * 16896);
    LAS float* red = (LAS float*)(lds + 139264);
    const int src0 = src_up(nb), k0 = 128 * wave, c = lane & 7;
    TItem t0{W, nullptr, nullptr, NUP, src0, D, 0, k0}, t1{W, nullptr, nullptr, NUP, src0, D, 0, k0 + 64};
    float v0[32], v1[32];
    p0_tload(t0, v0, lane); p0_tload(t1, v1, lane);
#pragma unroll
    for (int i = 0; i < 32; ++i) { const int kk = 2 * i + (lane >> 5); scr[kk * 33 + (lane & 31)] = v0[i]; scr[64 * 33 + kk * 33 + (lane & 31)] = v1[i]; }
    asm volatile("s_waitcnt lgkmcnt(0)" ::: "memory");
    float val[2][4][8]; float mx[4];
#pragma unroll
    for (int h = 0; h < 2; ++h) { const f32x4 ga = *(const f32x4*)(g + k0 + 64 * h + 8 * c), gb = *(const f32x4*)(g + k0 + 64 * h + 8 * c + 4);
#pragma unroll
        for (int j = 0; j < 4; ++j) { const LAS float* sp = scr + h * (64 * 33) + (8 * c) * 33 + (lane >> 3) + 8 * j;
#pragma unroll
            for (int i = 0; i < 8; ++i) val[h][j][i] = sp[i * 33] * (i < 4 ? ga[i] : gb[i - 4]); } }
#pragma unroll
    for (int j = 0; j < 4; ++j) { float m = 0.f;
#pragma unroll
        for (int h = 0; h < 2; ++h)
#pragma unroll
            for (int i = 0; i < 8; ++i) m = fmaxf(m, fabsf(val[h][j][i]));
        m = dpp_max8(m);
        mx[j] = m; }
    if (c == 0) {
#pragma unroll
        for (int j = 0; j < 4; ++j) red[wave * 32 + (lane >> 3) + 8 * j] = mx[j]; }
    __syncthreads();
#pragma unroll
    for (int j = 0; j < 4; ++j) { float m = 0.f;
#pragma unroll
        for (int w = 0; w < 8; ++w) m = fmaxf(m, red[w * 32 + (lane >> 3) + 8 * j]);
        mx[j] = m; }
#pragma unroll
    for (int j = 0; j < 4; ++j) { const int n = (lane >> 3) + 8 * j; const float inv = mx[j] > 0.f ? 127.0f / mx[j] : 0.f;
        if (wave == 0 && c == 0) cs[nb * 32 + n] = mx[j] > 0.f ? mx[j] * (1.0f / 127.0f) : 1.0f;
#pragma unroll
        for (int h = 0; h < 2; ++h) { unsigned lo = 0u, hi = 0u;
#pragma unroll
            for (int i = 0; i < 4; ++i) { lo |= ((unsigned)(int)rintf(val[h][j][i] * inv) & 0xffu) << (8 * i); hi |= ((unsigned)(int)rintf(val[h][j][4 + i] * inv) & 0xffu) << (8 * i); }
            *(u32x2*)(Wq + (size_t)(nb * 32 + n) * D + k0 + 64 * h + 8 * c) = (u32x2){lo, hi}; } }
    __syncthreads();
}
template <int NR> __device__ __forceinline__ void q8_rows(unsigned char* ws, const float* ssq, int m0, int lane) {
    const bf16_t* AB = (const bf16_t*)(ws + WS_AB); signed char* A8 = (signed char*)(ws + WS_A8); float* RS = (float*)(ws + WS_RS);
    u32x4 xa[NR], xb[NR]; float sq[NR];
#pragma unroll
    for (int q = 0; q < NR; ++q) { const bf16_t* row = AB + (size_t)(m0 + q) * D; xa[q] = *(const u32x4*)(row + 8 * lane); xb[q] = *(const u32x4*)(row + 512 + 8 * lane); sq[q] = lane < 16 ? ssq[(size_t)(m0 + q) * 16 + lane] : 0.f; }
#pragma unroll
    for (int q = 0; q < NR; ++q) {
        float s = dpp_row_sum(sq[q]); s = __builtin_bit_cast(float, __builtin_amdgcn_readfirstlane(__builtin_bit_cast(int, s)));
        const float rstd = rsqrtf(s * (1.0f / D) + EPS);
        float v[16];
#pragma unroll
        for (int i = 0; i < 4; ++i) { const unsigned a = xa[q][i], b = xb[q][i];
            v[2 * i] = __uint_as_float(a << 16) * rstd; v[2 * i + 1] = __uint_as_float(a & 0xffff0000u) * rstd; v[8 + 2 * i] = __uint_as_float(b << 16) * rstd; v[8 + 2 * i + 1] = __uint_as_float(b & 0xffff0000u) * rstd; }
        float m = 0.f;
#pragma unroll
        for (int i = 0; i < 16; ++i) m = fmaxf(m, fabsf(v[i]));
        m = dpp_max16(m); m = max_rows4(m);
        const float inv = m > 0.f ? 127.0f / m : 0.f;
        unsigned p[4];
#pragma unroll
        for (int i = 0; i < 4; ++i) { unsigned w = 0u;
#pragma unroll
            for (int e = 0; e < 4; ++e) w |= ((unsigned)(int)rintf(v[4 * i + e] * inv) & 0xffu) << (8 * e);
            p[i] = w; }
        signed char* orow = A8 + (size_t)(m0 + q) * D;
        *(u32x2*)(orow + 8 * lane) = (u32x2){p[0], p[1]}; *(u32x2*)(orow + 512 + 8 * lane) = (u32x2){p[2], p[3]};
        if (lane == 0) RS[m0 + q] = m > 0.f ? m * (1.0f / 127.0f) : 1.0f;
    }
}
template <int NR> __device__ __forceinline__ void x_rows(ArgsRef a, int m0, int lane) {
    bf16_t* AB = (bf16_t*)(a.ws + WS_AB); float* ssq0 = (float*)(a.ws + WS_SSQ0);
    f32x4 v[NR][4];
#pragma unroll
    for (int q = 0; q < NR; ++q) { const int m = m0 + q;
        const float* xrow = (m < MP) ? a.in[0] + (size_t)m * D : a.in[1] + (size_t)(m - MP) * D;
        const f32x4* xr = (const f32x4*)xrow + lane;
#pragma unroll
        for (int j = 0; j < 4; ++j) v[q][j] = xr[64 * j]; }
    float t[NR + 1];
#pragma unroll
    for (int q = 0; q < NR; ++q) { float s = 0.f;
#pragma unroll
        for (int j = 0; j < 4; ++j) s += (v[q][j].x * v[q][j].x + v[q][j].y * v[q][j].y) + (v[q][j].z * v[q][j].z + v[q][j].w * v[q][j].w);
        t[q] = s; }
    t[NR] = 0.f;
#pragma unroll
    for (int q = 0; q < NR; q += 2) wave_sum2(t[q], t[q + 1]);
#pragma unroll
    for (int q = 0; q < NR; ++q) { const int m = m0 + q;
        u32x2* o8 = (u32x2*)(AB + (size_t)m * D) + lane;
#pragma unroll
        for (int j = 0; j < 4; ++j) { u32x2 w; w.x = cvt_pk_bf16(v[q][j].x, v[q][j].y); w.y = cvt_pk_bf16(v[q][j].z, v[q][j].w); o8[64 * j] = w; }
        if (lane < 16) ssq0[(size_t)m * 16 + lane] = (lane == 0) ? t[q] : 0.f; }
}

template <int NR> __device__ __forceinline__ void xq8_rows(ArgsRef a, int m0, int lane) {
    signed char* A8 = (signed char*)(a.ws + WS_A8); float* RS = (float*)(a.ws + WS_RS);
    f32x4 v[NR][4];
#pragma unroll
    for (int q = 0; q < NR; ++q) { const int m = m0 + q;
        const float* xrow = (m < MP) ? a.in[0] + (size_t)m * D : a.in[1] + (size_t)(m - MP) * D;
        const f32x4* xr = (const f32x4*)xrow + lane;
#pragma unroll
        for (int j = 0; j < 4; ++j) v[q][j] = xr[64 * j]; }
    float t[NR + 1], mxv[NR + 1];
#pragma unroll
    for (int q = 0; q < NR; ++q) { float s = 0.f, m = 0.f;
#pragma unroll
        for (int j = 0; j < 4; ++j) { s += (v[q][j].x * v[q][j].x + v[q][j].y * v[q][j].y) + (v[q][j].z * v[q][j].z + v[q][j].w * v[q][j].w);
            m = fmaxf(fmaxf(m, fmaxf(fabsf(v[q][j].x), fabsf(v[q][j].y))), fmaxf(fabsf(v[q][j].z), fabsf(v[q][j].w))); }
        t[q] = s; mxv[q] = m; }
    t[NR] = 0.f;
#pragma unroll
    for (int q = 0; q < NR; q += 2) wave_sum2(t[q], t[q + 1]);
#pragma unroll
    for (int q = 0; q < NR; ++q) { const int m = m0 + q;
        float mx = mxv[q]; mx = dpp_max16(mx); mx = max_rows4(mx);
        const float rstd = rsqrtf(t[q] * (1.0f / D) + EPS), inv = mx > 0.f ? 127.0f / mx : 0.f;
        unsigned* o4 = (unsigned*)(A8 + (size_t)m * D) + lane;
#pragma unroll
        for (int j = 0; j < 4; ++j) { const f32x4 x4 = v[q][j];
            o4[64 * j] = ((unsigned)(int)rintf(x4.x * inv) & 0xffu) | (((unsigned)(int)rintf(x4.y * inv) & 0xffu) << 8) | (((unsigned)(int)rintf(x4.z * inv) & 0xffu) << 16) | (((unsigned)(int)rintf(x4.w * inv) & 0xffu) << 24); }
        if (lane == 0) RS[m] = mx > 0.f ? mx * rstd * (1.0f / 127.0f) : 1.0f; }
}

__device__ __forceinline__ void p0_prologue(ArgsRef a, LAS unsigned char* lds, int wave_) {
    const int tid = wave_ * 64 + lane_now();
    const int lane = tid & 63, wave = tid >> 6;
    const int gw = blockIdx.x * 8 + wave, NGW = gridDim.x * 8;
    unsigned char* ws = a.ws;
    for (int nb = blockIdx.x; nb < NUP / 32; nb += gridDim.x) w8_strip(a.in[6], a.in[5], (signed char*)(ws + WS_W1Q), (float*)(ws + WS_CS1), nb, lds, wave, lane);
    { const int nsw = (NUP / 32) * 8, gwr = gw >= nsw ? gw - nsw : gw + NGW - nsw;
      weights_convert(a, lds, I_UP, NITEMS_EARLY, NGW > nsw ? gwr : gw, NGW, wave, lane); }
    for (int m0 = gw * 8; m0 < MP; m0 += NGW * 8) xq8_rows<8>(a, m0, lane);
    for (int m = MP + gw; m < M; m += NGW) xq8_rows<1>(a, m, lane);
    const int gt = blockIdx.x * 512 + tid, NGT = gridDim.x * 512;
    f32x2* rope = (f32x2*)(ws + WS_ROPE);
    for (int i = gt; i < TP * 8; i += NGT) {
        const int pos = i >> 3, k = i & 7;
        const float ang = (float)pos * a.inv[k];
        const double rev = (double)ang * 0.15915494309189535;
        const float fr = (float)(rev - rint(rev));
        rope[i] = (f32x2){__builtin_amdgcn_cosf(fr), __builtin_amdgcn_sinf(fr)};
    }
    bf16_t* KS = (bf16_t*)(ws + WS_KS); bf16_t* VTS = (bf16_t*)(ws + WS_VTS); bf16_t* US = (bf16_t*)(ws + WS_US);
    for (int i = gt; i < NBS * WIN * 128; i += NGT) {
        const int c = i & 127, row = (i >> 7) & (WIN - 1), b = i >> 14;
        const float kv = a.in[3][i], vv = a.in[4][i];
        KS[((size_t)(b * KSROWS + row)) * 128 + c] = f2bf(kv);
        VTS[((size_t)(b * 128 + c)) * KSROWS + row] = f2bf(vv);
        if (row >= TS) { a.out[O_KWS + ((size_t)(b * WIN + row - TS)) * 128 + c] = kv; a.out[O_VWS + ((size_t)(b * WIN + row - TS)) * 128 + c] = vv; }
    }
    for (int i = gt; i < NBS * 128 * 16; i += NGT) { const int k = i & 15, rowd = i >> 4; VTS[(size_t)rowd * KSROWS + WIN + TS + k] = 0; }
    for (int i = gt; i < NBS * HIST * CC; i += NGT) {
        const int c = i & (CC - 1), row = (i >> 9) % HIST, b = (i >> 9) / HIST;
        const float uv = a.in[2][i];
        US[((size_t)(b * USROWS + row)) * CC + c] = f2bf(uv);
        if (row >= TS) a.out[O_CSS + ((size_t)(b * HIST + row - TS)) * CC + c] = uv;
    }
}

constexpr int ATT_VT_OFF = 192 * 128, ATT_VT_STRIDE = 400, ATT_BUF = ATT_VT_OFF + 64 * ATT_VT_STRIDE;
constexpr int ATT_UNITS_P = NBP * (TP / 64) * 2, ATT_UNITS = ATT_UNITS_P + NBS * 2;
constexpr int CONV_UNITS = MP / 16 + NBS;

struct AttUnit { const bf16_t* kb; const bf16_t* vt; int nkt; bool sample; };
__device__ __forceinline__ AttUnit att_decode(unsigned char* ws, int unit) {
    AttUnit u;
    if (unit < ATT_UNITS_P) { const int kh = unit & 1, c = (unit >> 1) & 127, b = unit >> 8, cs = c >= 2 ? c - 2 : 0;
        u.nkt = (c - cs + 1) * 4; u.sample = false;
        u.kb = (const bf16_t*)(ws + WS_KP) + ((size_t)(b * TP + cs * 64)) * 128 + kh * 64;
        u.vt = (const bf16_t*)(ws + WS_VTP) + ((size_t)((b * 2 + kh) * (TP / 64) + cs)) * 4096; }
    else { const int p = unit - ATT_UNITS_P, b = p >> 1, kh = p & 1;
        u.nkt = 9; u.sample = true;
        u.kb = (const bf16_t*)(ws + WS_KS) + ((size_t)(b * KSROWS)) * 128 + kh * 64;
        u.vt = (const bf16_t*)(ws + WS_VTS) + ((size_t)((b * 2 + kh) * 64)) * KSROWS; }
    return u;
}
__device__ __forceinline__ void att_stage_load(const AttUnit& u, int tid, u32x4 (&kp)[3], u32x4 (&vp)[3]) {
    const int nk = u.nkt * 16;
#pragma unroll
    for (int i = 0; i < 3; ++i) {
        const int p = tid + 512 * i; int row = p >> 3; const int ch = p & 7; row = row < nk ? row : nk - 1;
        kp[i] = *(const u32x4*)(u.kb + (size_t)row * 128 + ch * 8);
        if (u.sample) { int pp = p < 1280 ? p : 1279; const int d = pp / 20, q = pp - d * 20; vp[i] = *(const u32x4*)(u.vt + (size_t)d * KSROWS + q * 8); }
        else { const int jmax = (u.nkt >> 2) - 1, j = i < jmax ? i : jmax; vp[i] = *(const u32x4*)(u.vt + (size_t)j * 4096 + (p & 511) * 8); }
    }
}
__device__ __forceinline__ void att_stage_write(const AttUnit& u, int tid, LAS unsigned char* buf, const u32x4 (&kp)[3], const u32x4 (&vp)[3]) {
    const int nk = u.nkt * 16;
#pragma unroll
    for (int i = 0; i < 3; ++i) {
        const int p = tid + 512 * i; int row = p >> 3; const int ch = p & 7; row = row < nk ? row : nk - 1;
        *(LAS u32x4*)(buf + row * 128 + ((ch ^ ((row >> 1) & 7)) << 4)) = kp[i];
        if (u.sample) { int pp = p < 1280 ? p : 1279; const int d = pp / 20, q = pp - d * 20; *(LAS u32x4*)(buf + ATT_VT_OFF + d * ATT_VT_STRIDE + q * 16) = vp[i]; }
        else { const int jmax = (u.nkt >> 2) - 1, j = i < jmax ? i : jmax; const int d = (p & 511) >> 3, q = p & 7; *(LAS u32x4*)(buf + ATT_VT_OFF + d * ATT_VT_STRIDE + j * 128 + q * 16) = vp[i]; }
    }
}
__device__ __forceinline__ void attn_compute(const bf16x8 (&qf)[2][2], LAS const unsigned char* buf, int nkt, float sink0, float sink1, bf16_t* o0, bf16_t* o1, int lane) {
    const int fr = lane & 15, g = lane >> 4;
    f32x4 S[2][12];
    const float NEG = -INFINITY;
#pragma unroll
    for (int kt = 0; kt < 12; ++kt) {
        const int ktc = kt < nkt ? kt : nkt - 1, row = ktc * 16 + fr, sw = (row >> 1) & 7;
        const bf16x8 k0 = *(LAS const bf16x8*)(buf + row * 128 + ((g ^ sw) << 4)), k1 = *(LAS const bf16x8*)(buf + row * 128 + (((g + 4) ^ sw) << 4));
        const bool ok = kt < nkt;
#pragma unroll
        for (int qt = 0; qt < 2; ++qt) {
            f32x4 c = (f32x4){0.f, 0.f, 0.f, 0.f};
            c = __builtin_amdgcn_mfma_f32_16x16x32_bf16(k0, qf[qt][0], c, 0, 0, 0);
            c = __builtin_amdgcn_mfma_f32_16x16x32_bf16(k1, qf[qt][1], c, 0, 0, 0);
            S[qt][kt] = ok ? c : (f32x4){NEG, NEG, NEG, NEG};
        }
    }
    bf16x8 pf[2][6]; float linv[2];
#pragma unroll
    for (int qt = 0; qt < 2; ++qt) {
        const float sink = qt ? sink1 : sink0;
        float mx = sink;
#pragma unroll
        for (int kt = 0; kt < 12; ++kt) mx = fmaxf(mx, fmaxf(fmaxf(S[qt][kt][0], S[qt][kt][1]), fmaxf(S[qt][kt][2], S[qt][kt][3])));
        mx = max_rows4(mx);
        float l = 0.f;
#pragma unroll
        for (int kt = 0; kt < 12; ++kt) {
#pragma unroll
            for (int j = 0; j < 4; ++j) { const float p = __builtin_amdgcn_exp2f(S[qt][kt][j] - mx); S[qt][kt][j] = p; l += p; }
        }
        l = sum_rows4(l);
        l += __builtin_amdgcn_exp2f(sink - mx);
        linv[qt] = 1.0f / l;
#pragma unroll
        for (int kk = 0; kk < 6; ++kk) {
            u32x4 w; w.x = cvt_pk_bf16(S[qt][2 * kk][0], S[qt][2 * kk][1]); w.y = cvt_pk_bf16(S[qt][2 * kk][2], S[qt][2 * kk][3]);
            w.z = cvt_pk_bf16(S[qt][2 * kk + 1][0], S[qt][2 * kk + 1][1]); w.w = cvt_pk_bf16(S[qt][2 * kk + 1][2], S[qt][2 * kk + 1][3]);
            pf[qt][kk] = __builtin_bit_cast(bf16x8, w);
        }
    }
    f32x4 O[2][4];
    const int kkmax = (nkt - 1) >> 1;
    LAS const unsigned char* vb = buf + ATT_VT_OFF + fr * ATT_VT_STRIDE + g * 8;
#pragma unroll
    for (int dt = 0; dt < 4; ++dt) {
        O[0][dt] = (f32x4){0.f, 0.f, 0.f, 0.f}; O[1][dt] = (f32x4){0.f, 0.f, 0.f, 0.f};
#pragma unroll
        for (int kk = 0; kk < 6; ++kk) {
            const int kkc = kk < kkmax ? kk : kkmax;
            const u32x2 a0 = *(LAS const u32x2*)(vb + dt * 16 * ATT_VT_STRIDE + kkc * 64), a1 = *(LAS const u32x2*)(vb + dt * 16 * ATT_VT_STRIDE + kkc * 64 + 32);
            u32x4 aw; aw.x = a0.x; aw.y = a0.y; aw.z = a1.x; aw.w = a1.y;
            const bf16x8 af = __builtin_bit_cast(bf16x8, aw);
            O[0][dt] = __builtin_amdgcn_mfma_f32_16x16x32_bf16(af, pf[0][kk], O[0][dt], 0, 0, 0);
            O[1][dt] = __builtin_amdgcn_mfma_f32_16x16x32_bf16(af, pf[1][kk], O[1][dt], 0, 0, 0);
        }
    }
#pragma unroll
    for (int qt = 0; qt < 2; ++qt) {
        bf16_t* ob = (qt ? o1 : o0) + (size_t)fr * D + 4 * g;
#pragma unroll
        for (int dt = 0; dt < 4; ++dt) {
            const f32x4 v = O[qt][dt] * linv[qt];
            u32x2 w; w.x = cvt_pk_bf16(v[0], v[1]); w.y = cvt_pk_bf16(v[2], v[3]);
            *(u32x2*)(ob + dt * 16) = w;
        }
    }
}

__device__ __forceinline__ void attn_phase(ArgsRef a, LAS unsigned char* lds, int tid, int first, int G) {
    asm volatile("" : "+v"(tid));
    unsigned char* ws = a.ws;
    const int lane = tid & 63, wave = __builtin_amdgcn_readfirstlane(tid >> 6), fr = lane & 15, g = lane >> 4;
    const bf16_t* Q = (const bf16_t*)(ws + WS_Q); bf16_t* MIX = (bf16_t*)(ws + WS_MIX);
    const float* sinks = a.in[12];
    if (first >= ATT_UNITS) return;
    AttUnit cur = att_decode(ws, first);
    u32x4 kp[3], vp[3];
    att_stage_load(cur, tid, kp, vp);
    int par = 0;
    for (int unit = first; unit < ATT_UNITS; unit += G, par ^= 1) {
        LAS unsigned char* buf = lds + par * ATT_BUF;
        att_stage_write(cur, tid, buf, kp, vp);
        const bf16_t* q0; const bf16_t* q1; bf16_t* o0; bf16_t* o1; float sk0, sk1; bool work;
        if (!cur.sample) { const int kh = unit & 1, c = (unit >> 1) & 127, b = unit >> 8, h = kh * 4 + (wave >> 1), tok0 = c * 64 + (wave & 1) * 32;
            q0 = Q + ((size_t)(b * TP + tok0)) * 512 + h * 64; q1 = q0 + 16 * 512;
            o0 = MIX + ((size_t)(b * TP + tok0)) * D + 512 + h * 64; o1 = o0 + 16 * D; sk0 = sk1 = sinks[h] * LOG2E; work = true; }
        else { const int p = unit - ATT_UNITS_P, b = p >> 1, kh = p & 1, h0 = kh * 4 + (wave & 1) * 2;
            q0 = Q + ((size_t)(MP + b * TS)) * 512 + h0 * 64; q1 = q0 + 64;
            o0 = MIX + ((size_t)(MP + b * TS)) * D + 512 + h0 * 64; o1 = o0 + 64; sk0 = sinks[h0] * LOG2E; sk1 = sinks[h0 + 1] * LOG2E; work = wave < 2; }
        bf16x8 qf[2][2];
        qf[0][0] = *(const bf16x8*)(q0 + fr * 512 + g * 8); qf[0][1] = *(const bf16x8*)(q0 + fr * 512 + 32 + g * 8);
        qf[1][0] = *(const bf16x8*)(q1 + fr * 512 + g * 8); qf[1][1] = *(const bf16x8*)(q1 + fr * 512 + 32 + g * 8);
        const int nkt = cur.nkt;
        __syncthreads();
        const int nu = unit + G < ATT_UNITS ? unit + G : unit;
        cur = att_decode(ws, nu);
        att_stage_load(cur, tid, kp, vp);
        if (work) attn_compute(qf, buf, nkt, sk0, sk1, o0, o1, lane);
    }
    __syncthreads();
}

struct ConvUnit { const bf16_t* ub; int jmin; size_t orow; };
__device__ __forceinline__ ConvUnit conv_decode(unsigned char* ws, int cu, int ch) {
    ConvUnit u;
    if (cu < MP / 16) { const int b = cu >> 9, t0 = (cu & 511) * 16; u.ub = (const bf16_t*)(ws + WS_UP) + ((size_t)(b * TP) + t0 - HIST) * CC + ch; u.jmin = HIST - t0; u.orow = (size_t)b * TP + t0; }
    else { const int b = cu - MP / 16; u.ub = (const bf16_t*)(ws + WS_US) + ((size_t)(b * USROWS)) * CC + ch; u.jmin = 0; u.orow = (size_t)MP + b * TS; }
    return u;
}
__device__ __forceinline__ void conv_phase(ArgsRef a, LAS unsigned char* lds, int tid, int first, int G) {
    asm volatile("" : "+v"(tid));
    unsigned char* ws = a.ws;
    const int ch = tid, wave = tid >> 6, lane = tid & 63;
    if (first >= CONV_UNITS) return;
    const float* wdw = a.in[13] + ch;
    float w[CW];
#pragma unroll
    for (int j = 0; j < CW; ++j) w[j] = wdw[j * CC];
    const float bias = a.in[14][ch];
    const f32x4 gc0 = *(const f32x4*)(a.in[15] + 4 * lane), gc1 = *(const f32x4*)(a.in[15] + 256 + 4 * lane);
    const f32x4 bc0 = *(const f32x4*)(a.in[16] + 4 * lane), bc1 = *(const f32x4*)(a.in[16] + 256 + 4 * lane);
    ConvUnit cur = conv_decode(ws, first, ch);
    bf16_t xr[HIST + 16];
#pragma unroll
    for (int j = 0; j < HIST + 16; ++j) { const int jc = j > cur.jmin ? j : cur.jmin; xr[j] = cur.ub[(size_t)jc * CC]; }
    int par = 0;
    for (int cu = first; cu < CONV_UNITS; cu += G, par ^= 1) {
        const int jmin = cur.jmin; const size_t orow = cur.orow;
        float acc[16];
#pragma unroll
        for (int i = 0; i < 16; ++i) acc[i] = bias;
#pragma unroll
        for (int j = 0; j < HIST + 16; ++j) {
            const float xv = (j >= jmin) ? bf2f(xr[j]) : 0.f;
#pragma unroll
            for (int i = 0; i < 16; ++i) { if (j - i >= 0 && j - i < CW) acc[i] += xv * w[j - i]; }
        }
        __builtin_amdgcn_sched_barrier(0);
        { const int nu = cu + G < CONV_UNITS ? cu + G : cu;
          cur = conv_decode(ws, nu, ch);
#pragma unroll
          for (int j = 0; j < HIST + 16; ++j) { const int jc = j > cur.jmin ? j : cur.jmin; xr[j] = cur.ub[(size_t)jc * CC]; } }
        __builtin_amdgcn_sched_barrier(0);
        LAS float* yb = (LAS float*)lds + par * (16 * CC);
#pragma unroll
        for (int i = 0; i < 16; ++i) yb[i * CC + ch] = acc[i];
        __syncthreads();
        bf16_t* MIX = (bf16_t*)(ws + WS_MIX) + orow * D;
        {
            const int tok = 2 * wave;
            f32x4 v0 = *(const LAS f32x4*)(yb + tok * CC + 4 * lane), v1 = *(const LAS f32x4*)(yb + tok * CC + 256 + 4 * lane);
            f32x4 z0 = *(const LAS f32x4*)(yb + (tok + 1) * CC + 4 * lane), z1 = *(const LAS f32x4*)(yb + (tok + 1) * CC + 256 + 4 * lane);
            float sa = (v0[0] + v0[1]) + (v0[2] + v0[3]) + (v1[0] + v1[1]) + (v1[2] + v1[3]);
            float sb = (z0[0] + z0[1]) + (z0[2] + z0[3]) + (z1[0] + z1[1]) + (z1[2] + z1[3]);
            wave_sum2(sa, sb);
            const float ma = sa * (1.0f / CC), mb = sb * (1.0f / CC);
            v0 = v0 - ma; v1 = v1 - ma; z0 = z0 - mb; z1 = z1 - mb;
            float qa = (v0[0] * v0[0] + v0[1] * v0[1]) + (v0[2] * v0[2] + v0[3] * v0[3]) + (v1[0] * v1[0] + v1[1] * v1[1]) + (v1[2] * v1[2] + v1[3] * v1[3]);
            float qb = (z0[0] * z0[0] + z0[1] * z0[1]) + (z0[2] * z0[2] + z0[3] * z0[3]) + (z1[0] * z1[0] + z1[1] * z1[1]) + (z1[2] * z1[2] + z1[3] * z1[3]);
            wave_sum2(qa, qb);
            const float ra = rsqrtf(qa * (1.0f / CC) + EPS), rb = rsqrtf(qb * (1.0f / CC) + EPS);
            v0 = v0 * ra * gc0 + bc0; v1 = v1 * ra * gc1 + bc1; z0 = z0 * rb * gc0 + bc0; z1 = z1 * rb * gc1 + bc1;
            u32x2 o0, o1, p0, p1;
            o0.x = cvt_pk_bf16(silu_f(v0[0]), silu_f(v0[1])); o0.y = cvt_pk_bf16(silu_f(v0[2]), silu_f(v0[3]));
            o1.x = cvt_pk_bf16(silu_f(v1[0]), silu_f(v1[1])); o1.y = cvt_pk_bf16(silu_f(v1[2]), silu_f(v1[3]));
            p0.x = cvt_pk_bf16(silu_f(z0[0]), silu_f(z0[1])); p0.y = cvt_pk_bf16(silu_f(z0[2]), silu_f(z0[3]));
            p1.x = cvt_pk_bf16(silu_f(z1[0]), silu_f(z1[1])); p1.y = cvt_pk_bf16(silu_f(z1[2]), silu_f(z1[3]));
            *(u32x2*)(MIX + (size_t)tok * D + 4 * lane) = o0; *(u32x2*)(MIX + (size_t)tok * D + 256 + 4 * lane) = o1;
            *(u32x2*)(MIX + (size_t)(tok + 1) * D + 4 * lane) = p0; *(u32x2*)(MIX + (size_t)(tok + 1) * D + 256 + 4 * lane) = p1;
        }
    }
    __syncthreads();
}

#define XB_TMO      128
#define XB_XCNT(j)  (256  + 64 * (j))
#define XB_XSUB(j)  (1280 + 64 * (j))
#define XB_XGEN(j)  (2304 + 64 * (j))
#define XB_TOP      3328
#define XB_TOPGEN   3392
#define XCD_BAR_WORDS 3456
#define XB_SPIN_CAP (1u << 18)
__device__ __forceinline__ unsigned xb_ld(unsigned* p)              { return __hip_atomic_load(p, __ATOMIC_RELAXED, __HIP_MEMORY_SCOPE_AGENT); }
__device__ __forceinline__ unsigned xb_add(unsigned* p, unsigned v) { return __hip_atomic_fetch_add(p, v, __ATOMIC_RELAXED, __HIP_MEMORY_SCOPE_AGENT); }
__device__ __forceinline__ unsigned xb_xcc_id() { return (unsigned)__builtin_amdgcn_s_getreg((3 << 11) | 20) & 0xFu; }
#define XB_SPIN(cond, bar) do { unsigned _sp = 0; while (cond) { __builtin_amdgcn_s_sleep(1); \
    if ((++_sp & 255u) == 0u) { if (xb_ld(&(bar)[XB_TMO])) break; if (_sp > XB_SPIN_CAP) { atomicAdd(&(bar)[XB_TMO], 1u); break; } } } } while (0)
struct XcdBarrier { unsigned* bar; unsigned x; volatile LAS unsigned* st; };
__device__ __forceinline__ XcdBarrier xcd_barrier_post(unsigned* bar, volatile LAS unsigned* st, int wave_) {
    XcdBarrier b; b.bar = bar; b.x = (unsigned)__builtin_amdgcn_readfirstlane((int)xb_xcc_id()); b.st = st;
    if (wave_ == 0 && lane_now() == 0) (void)xb_add(&bar[XB_XCNT(b.x)], 1u);
    return b;
}
__device__ __forceinline__ void xcd_barrier_complete(unsigned* bar, unsigned x, unsigned& nloc, unsigned& nx) {
    const unsigned G = gridDim.x * gridDim.y * gridDim.z;
    unsigned sum, cnt, mine, sp = 0u;
    for (;;) {
        sum = 0u; cnt = 0u; mine = 0u;
#pragma unroll
        for (unsigned j = 0; j < 16; ++j) { const unsigned c = xb_ld(&bar[XB_XCNT(j)]); sum += c; cnt += (c > 0u) ? 1u : 0u; mine = (j == x) ? c : mine; }
        if (sum == G) break;
        __builtin_amdgcn_s_sleep(1);
        if ((++sp & 255u) == 0u) { if (xb_ld(&bar[XB_TMO])) break; if (sp > XB_SPIN_CAP) { atomicAdd(&bar[XB_TMO], 1u); break; } }
    }
    nloc = mine > 0u ? mine : 1u; nx = cnt > 0u ? cnt : 1u;
}
__device__ __forceinline__ void xcd_barrier(const XcdBarrier& b, int wave_) {
    asm volatile("s_waitcnt vmcnt(0)" ::: "memory");
    __syncthreads();
    if (wave_ == 0 && lane_now() == 0) {
        unsigned* bar = b.bar; unsigned bx = b.x; asm volatile("" : "+s"(bx));
        __builtin_amdgcn_s_waitcnt(0);
        unsigned nloc = b.st[0], nx = b.st[1];
        if (nloc == 0u) { xcd_barrier_complete(bar, bx, nloc, nx); b.st[0] = nloc; b.st[1] = nx; }
        const unsigned old = xb_add(&bar[XB_XSUB(bx)], 1u);
        const unsigned gen = old / nloc;
        if (old + 1u == (gen + 1u) * nloc) {
            __builtin_amdgcn_fence(__ATOMIC_RELEASE, "agent");
            asm volatile("s_waitcnt vmcnt(0)" ::: "memory");
            const unsigned og = xb_add(&bar[XB_TOP], 1u);
            const unsigned tg = og / nx;
            if (og + 1u == (tg + 1u) * nx) xb_add(&bar[XB_TOPGEN], 1u);
            else XB_SPIN(xb_ld(&bar[XB_TOPGEN]) == tg, bar);
            __builtin_amdgcn_fence(__ATOMIC_ACQUIRE, "agent");
            xb_add(&bar[XB_XGEN(bx)], 1u);
            asm volatile("s_waitcnt vmcnt(0)" ::: "memory");
        } else {
            XB_SPIN(xb_ld(&bar[XB_XGEN(bx)]) == gen, bar);
            __builtin_amdgcn_fence(__ATOMIC_ACQUIRE, "agent");
            asm volatile("s_waitcnt vmcnt(0)" ::: "memory");
        }
    }
    __syncthreads();
}
constexpr int MISC_OFF = 151552;
constexpr size_t CTL_ZERO_BYTES = 65536;
constexpr int CW_BAR = 4096;

__global__ void __launch_bounds__(512, 2) hymba_fwd(Args a_) {
    extern __shared__ __attribute__((aligned(16))) unsigned char lds_raw[];
    LAS unsigned char* lds = (LAS unsigned char*)lds_raw;
    unsigned char* ws = a_.ws;
    const int wave = __builtin_amdgcn_readfirstlane((int)threadIdx.x >> 6);
#define lane lane_now()
#define tid (wave * 64 + lane_now())
    const int G = gridDim.x, bid = blockIdx.x;
    for (int u = wave * 64 + lane_now(); u < (LDS_BYTES - MISC_OFF) / 4; u += 512) ((LAS unsigned*)(lds + MISC_OFF))[u] = 0u;
    __syncthreads();
    const XcdBarrier bar = xcd_barrier_post((unsigned*)ws + CW_BAR, (volatile LAS unsigned*)(lds + MISC_OFF) + 8, wave);
#define GRID_BAR() xcd_barrier(bar, wave)

    bf16_t* AB = (bf16_t*)(ws + WS_AB); bf16_t* ACT = (bf16_t*)(ws + WS_ACT);
    float* ssq0 = (float*)(ws + WS_SSQ0); float* ssq1 = (float*)(ws + WS_SSQ1); float* ssq2 = (float*)(ws + WS_SSQ2);

#ifndef PROBE_DUP
#define PROBE_DUP -1
#endif
#ifndef PHASE_MASK
#define PHASE_MASK 0xff
#endif
#define REPS(k) if (PHASE_MASK & (1 << (k))) for (int rep_ = 0; rep_ < ((PROBE_DUP == (k)) ? 2 : 1); ++rep_)
#define ARGS_HERE() ArgsRef a = *args_now()
    REPS(0) { ARGS_HERE(); p0_prologue(a, lds, wave); GRID_BAR(); }
    REPS(1) {
    { int bs_ = bid, gs_ = G; asm volatile("" : "+s"(bs_), "+s"(gs_));
      pg8::Gemm g{(const bf16_t*)(ws + WS_A8), (const bf16_t*)(ws + WS_W1Q), MP, NUP, D / 2}; pg8::StaticOrder S; S.init(MP, NUP, gs_, bs_);
      EpiSwigluI8 E{ACT, (const float*)(ws + WS_RS), (const float*)(ws + WS_CS1), lds};
      for (int pass = 0; pass < 2; ++pass) { if (((pass ^ (bs_ >> 6)) & 1) == 0) { pg8::gemm_phase<EpiSwigluI8, pg8::StaticOrder, true, true, true>(lds, g, S, E, wave); } else { small_gemm<1, 4, true>((const bf16_t*)(ws + WS_A8), (const bf16_t*)(ws + WS_W1Q), NUP, D / 2, E, lds, bs_, gs_, wave, lane); } } }
    GRID_BAR(); }
    REPS(2) {
    { int bs_ = bid, gs_ = G; asm volatile("" : "+s"(bs_), "+s"(gs_));
      pg8::Gemm g{ACT, (const bf16_t*)(ws + WS_W2T), MP, D, FF}; pg8::StaticOrder S; S.init(MP, D, gs_, bs_);
      ARGS_HERE(); EpiResid<0> E{a.in[0], a.in[1], nullptr, AB, ssq1, 0.5f};
      for (int pass = 0; pass < 2; ++pass) { if (((pass ^ (bs_ >> 6)) & 1) == 0) { pg8::gemm_phase<EpiResid<0>, pg8::StaticOrder, true, true>(lds, g, S, E, wave); } else { small_gemm<8, 2, false>(ACT, (const bf16_t*)(ws + WS_W2T), D, FF, E, lds, bs_, gs_, wave, lane); } } }
    GRID_BAR(); }
    REPS(3) {
    { int bs_ = bid, gs_ = G; asm volatile("" : "+s"(bs_), "+s"(gs_));
      pg8::Gemm g{AB, (const bf16_t*)(ws + WS_WINT), MP, NIN, D}; pg8::StaticOrder S; S.init(MP, NIN, gs_, bs_);
      ARGS_HERE(); EpiInProj E{ws, a.in[10], a.in[11], a.out, lds};
      pg8::gemm_phase<EpiInProj, pg8::StaticOrder, true, true>(lds, g, S, E, wave);
      small_gemm<1, 4, false>(AB, (const bf16_t*)(ws + WS_WINT), NIN, D, E, lds, gs_ - 1 - bs_, gs_, wave, lane, 2);
      if (rep_ == 0 && bid >= G / 2) { int ln = lane; asm volatile("" : "+v"(ln));
        weights_convert(a, lds, NITEMS_EARLY + I_UP, NITEMS, (bid - G / 2) * 8 + wave, (G - G / 2) * 8, wave, ln);
        __syncthreads();
        for (int nb = bid - G / 2; nb < NUP / 32; nb += G - G / 2) w8_strip(a.in[19], a.in[18], (signed char*)(ws + WS_W3Q), (float*)(ws + WS_CS3), nb, lds, wave, ln); } }
    GRID_BAR(); }
    REPS(4) {
#ifndef PROBE_P4SUB
#define PROBE_P4SUB 0
#endif
    ARGS_HERE();
    if (!(rep_ == 1 && PROBE_P4SUB == 2)) attn_phase(a, lds, tid, bid, G);
    if (!(rep_ == 1 && PROBE_P4SUB == 1)) conv_phase(a, lds, tid, G - 1 - bid, G);
    GRID_BAR(); }
    REPS(5) {
    { int bs_ = bid, gs_ = G; asm volatile("" : "+s"(bs_), "+s"(gs_));
      pg8::Gemm g{(const bf16_t*)(ws + WS_MIX), (const bf16_t*)(ws + WS_WOT), MP, D, D}; pg8::StaticOrder S; S.init(MP, D, gs_, bs_);
      EpiResid<1> E{nullptr, nullptr, nullptr, AB, ssq2, 1.0f};
      for (int pass = 0; pass < 2; ++pass) { if (((pass ^ (bs_ >> 6)) & 1) == 0) { pg8::gemm_phase<EpiResid<1>, pg8::StaticOrder, true, true>(lds, g, S, E, wave); } else { small_gemm<8, 2, false>((const bf16_t*)(ws + WS_MIX), (const bf16_t*)(ws + WS_WOT), D, D, E, lds, bs_, gs_, wave, lane); } } }
    GRID_BAR(); }
    { const int gw = bid * 8 + wave, NGW = G * 8; int ln = lane; asm volatile("" : "+v"(ln));
      for (int m0 = gw * 4; m0 < M; m0 += NGW * 4) q8_rows<4>(ws, ssq2, m0, ln);
      GRID_BAR(); }
    REPS(6) {
    { int bs_ = bid, gs_ = G; asm volatile("" : "+s"(bs_), "+s"(gs_));
      pg8::Gemm g{(const bf16_t*)(ws + WS_A8), (const bf16_t*)(ws + WS_W3Q), MP, NUP, D / 2}; pg8::StaticOrder S; S.init(MP, NUP, gs_, bs_);
      EpiSwigluI8 E{ACT, (const float*)(ws + WS_RS), (const float*)(ws + WS_CS3), lds};
      for (int pass = 0; pass < 2; ++pass) { if (((pass ^ (bs_ >> 6)) & 1) == 0) { pg8::gemm_phase<EpiSwigluI8, pg8::StaticOrder, true, true, true>(lds, g, S, E, wave); } else { small_gemm<1, 4, true>((const bf16_t*)(ws + WS_A8), (const bf16_t*)(ws + WS_W3Q), NUP, D / 2, E, lds, bs_, gs_, wave, lane); } } }
    GRID_BAR(); }
    REPS(7) { int bs_ = bid, gs_ = G; asm volatile("" : "+s"(bs_), "+s"(gs_));
      pg8::Gemm g{ACT, (const bf16_t*)(ws + WS_W4T), MP, D, FF}; pg8::StaticOrder S; S.init(MP, D, gs_, bs_);
      ARGS_HERE(); EpiResid<2> E{nullptr, nullptr, a.out, AB, nullptr, 0.5f};
      for (int pass = 0; pass < 2; ++pass) { if (((pass ^ (bs_ >> 6)) & 1) == 0) { pg8::gemm_phase<EpiResid<2>, pg8::StaticOrder, true, true>(lds, g, S, E, wave); } else { small_gemm<8, 2, false>(ACT, (const bf16_t*)(ws + WS_W4T), D, FF, E, lds, bs_, gs_, wave, lane); } } }
}
#undef lane
#undef tid

extern "C" void kernel_launch(void* const* d_in, const int* in_sizes, int n_in, void* d_out, int out_size, void* d_ws, size_t ws_size, hipStream_t stream) {
    static int grid = 0;
    if (grid == 0) {
        if (n_in != 21 || (size_t)out_size != O_END || ws_size < WS_END) { fprintf(stderr, "kernel_launch: unexpected shapes: n_in %d out %d ws %zu (need %zu)\n", n_in, out_size, ws_size, (size_t)WS_END); grid = -1; return; }
        int dev = 0, cus = 0, per_cu = 0;
        (void)hipGetDevice(&dev);
        (void)hipDeviceGetAttribute(&cus, hipDeviceAttributeMultiprocessorCount, dev);
        if (cus != 256) fprintf(stderr, "kernel_launch: note: built for a 256-CU device (one workgroup per CU), this device reports %d\n", cus);
        if (hipFuncSetAttribute((const void*)hymba_fwd, hipFuncAttributeMaxDynamicSharedMemorySize, LDS_BYTES) != hipSuccess) { fprintf(stderr, "kernel_launch: hipFuncSetAttribute failed\n"); grid = -1; return; }
        if (hipOccupancyMaxActiveBlocksPerMultiprocessor(&per_cu, (const void*)hymba_fwd, 512, LDS_BYTES) != hipSuccess || per_cu < 1) { fprintf(stderr, "kernel_launch: occupancy query failed (%d)\n", per_cu); grid = -1; (void)hipGetLastError(); return; }
        grid = cus;
    }
    if (grid < 0) return;
    Args a{};
    for (int i = 0; i < 21; ++i) a.in[i] = (const float*)d_in[i];
    a.out = (float*)d_out; a.ws = (unsigned char*)d_ws;
    for (int i = 0; i < 8; ++i) a.inv[i] = powf(500000.0f, -(float)i / 8.0f);
    if (hipMemsetAsync(d_ws, 0, CTL_ZERO_BYTES, stream) != hipSuccess) { fprintf(stderr, "kernel_launch: memset failed\n"); return; }
    hipLaunchKernelGGL(hymba_fwd, dim3(grid), dim3(512), LDS_BYTES, stream, a);
    const hipError_t e = hipPeekAtLastError();
    if (e != hipSuccess) fprintf(stderr, "kernel_launch: launch failed: %s (grid %d)\n", hipGetErrorString(e), grid);
}
```

```cpp
#include <hip/hip_runtime.h>
#include <cstdio>
#include <cstdint>
#include <cmath>

#define LAS __attribute__((address_space(3)))
typedef unsigned short bf16_t;
typedef short bf16x8 __attribute__((ext_vector_type(8)));
typedef float f32x4 __attribute__((ext_vector_type(4)));
typedef float f32x2 __attribute__((ext_vector_type(2)));
typedef unsigned u32x4 __attribute__((ext_vector_type(4)));
typedef unsigned u32x2 __attribute__((ext_vector_type(2)));
typedef int i32x4 __attribute__((ext_vector_type(4)));

constexpr int D = 1024, TP = 8192, NBP = 4, NBS = 32, TS = 16, MP = NBP * TP, MS = NBS * TS, M = MP + MS;
constexpr int FF = 2816, NUP = 2 * FF, NIN = 1792, CC = 512, HD = 64, PAST = 4096;
constexpr int CW = 31, HIST = CW - 1, WIN = 128;
constexpr int KSROWS = 160;
constexpr int USROWS = HIST + TS;
constexpr float EPS = 1e-6f;
constexpr float LOG2E = 1.4426950408889634f;
constexpr float QSCALE = 0.125f * LOG2E;

constexpr size_t O_YP = 0, O_YS = (size_t)MP * D, O_CSP = O_YS + (size_t)MS * D, O_KWP = O_CSP + (size_t)NBP * HIST * CC,
                 O_VWP = O_KWP + (size_t)NBP * WIN * 128, O_CSS = O_VWP + (size_t)NBP * WIN * 128, O_KWS = O_CSS + (size_t)NBS * HIST * CC,
                 O_VWS = O_KWS + (size_t)NBS * WIN * 128, O_END = O_VWS + (size_t)NBS * WIN * 128;

constexpr size_t al(size_t x) { return (x + 4095) & ~(size_t)4095; }
constexpr size_t WS_CTL = 0;
constexpr size_t WS_W1T = 1u << 20;
constexpr size_t WS_W2T = WS_W1T + al((size_t)NUP * D * 2);
constexpr size_t WS_WINT = WS_W2T + al((size_t)D * FF * 2);
constexpr size_t WS_WOT = WS_WINT + al((size_t)NIN * D * 2);
constexpr size_t WS_W3T = WS_WOT + al((size_t)D * D * 2);
constexpr size_t WS_W4T = WS_W3T + al((size_t)NUP * D * 2);
constexpr size_t WS_ROPE = WS_W4T + al((size_t)D * FF * 2);
constexpr size_t WS_SSQ0 = WS_ROPE + al((size_t)TP * 8 * 8);
constexpr size_t WS_SSQ1 = WS_SSQ0 + al((size_t)M * 16 * 4);
constexpr size_t WS_SSQ2 = WS_SSQ1 + al((size_t)M * 16 * 4);
constexpr size_t WS_KS = WS_SSQ2 + al((size_t)M * 16 * 4);
constexpr size_t WS_VTS = WS_KS + al((size_t)NBS * KSROWS * 128 * 2);
constexpr size_t WS_US = WS_VTS + al((size_t)NBS * 128 * KSROWS * 2);
constexpr size_t WS_AB = WS_US + al((size_t)NBS * USROWS * CC * 2);
constexpr size_t WS_X1 = WS_AB + al((size_t)M * D * 2);
constexpr size_t WS_ACT = WS_X1 + al((size_t)M * D * 4);
constexpr size_t WS_A8 = WS_X1;
constexpr size_t WS_W3Q = WS_A8 + al((size_t)M * D);
constexpr size_t WS_W1Q = WS_W3Q + al((size_t)NUP * D);
constexpr size_t WS_RS = WS_W1Q + al((size_t)NUP * D);
constexpr size_t WS_CS3 = WS_RS + al((size_t)M * 4);
constexpr size_t WS_CS1 = WS_CS3 + al((size_t)NUP * 4);
static_assert(WS_CS1 + (size_t)NUP * 4 <= WS_ACT, "int8 operands fit in the f32 scratch");
constexpr size_t WS_END = WS_ACT + al((size_t)M * FF * 2);
constexpr size_t WS_UP = WS_ACT;
constexpr size_t WS_Q = WS_UP + al((size_t)MP * CC * 2);
constexpr size_t WS_KP = WS_Q + al((size_t)M * 512 * 2);
constexpr size_t WS_VTP = WS_KP + al((size_t)MP * 128 * 2);
constexpr size_t WS_MIX = WS_VTP + al((size_t)MP * 128 * 2);
static_assert(WS_MIX + (size_t)M * D * 2 <= WS_END, "overlay fits");

constexpr int LDS_BYTES = 155648;
constexpr int SSQ_LDS_OFF = 131072;

__device__ __forceinline__ unsigned cvt_pk_bf16(float lo, float hi) { unsigned r; asm volatile("v_cvt_pk_bf16_f32 %0, %1, %2" : "=v"(r) : "v"(lo), "v"(hi)); return r; }
__device__ __forceinline__ float bf2f(bf16_t h) { return __uint_as_float((unsigned)h << 16); }
__device__ __forceinline__ bf16_t f2bf(float f) { return (bf16_t)(cvt_pk_bf16(f, 0.f) & 0xffffu); }
__device__ __forceinline__ float silu_f(float a) { return a * __builtin_amdgcn_rcpf(1.0f + __builtin_amdgcn_exp2f(-a * LOG2E)); }
__device__ __forceinline__ float sigmoid_f(float a) { return __builtin_amdgcn_rcpf(1.0f + __builtin_amdgcn_exp2f(-a * LOG2E)); }
__device__ __forceinline__ float sum_rows4(float x) {
    float a = x, b = x;
    asm volatile("s_nop 1\n\tv_permlane16_swap_b32 %0, %1" : "+v"(a), "+v"(b));
    float t = a + b; a = t; b = t;
    asm volatile("s_nop 1\n\tv_permlane32_swap_b32 %0, %1" : "+v"(a), "+v"(b));
    return a + b;
}
__device__ __forceinline__ float max_rows4(float x) {
    float a = x, b = x;
    asm volatile("s_nop 1\n\tv_permlane16_swap_b32 %0, %1" : "+v"(a), "+v"(b));
    float t = fmaxf(a, b); a = t; b = t;
    asm volatile("s_nop 1\n\tv_permlane32_swap_b32 %0, %1" : "+v"(a), "+v"(b));
    return fmaxf(a, b);
}
__device__ __forceinline__ float dpp_max8(float v) {
    v = fmaxf(v, __builtin_bit_cast(float, __builtin_amdgcn_update_dpp(0, __builtin_bit_cast(int, v), 0xB1, 0xF, 0xF, true)));
    v = fmaxf(v, __builtin_bit_cast(float, __builtin_amdgcn_update_dpp(0, __builtin_bit_cast(int, v), 0x4E, 0xF, 0xF, true)));
    v = fmaxf(v, __builtin_bit_cast(float, __builtin_amdgcn_update_dpp(0, __builtin_bit_cast(int, v), 0x141, 0xF, 0xF, true)));
    return v;
}
__device__ __forceinline__ float dpp_max16(float v) {
    v = dpp_max8(v);
    return fmaxf(v, __builtin_bit_cast(float, __builtin_amdgcn_update_dpp(0, __builtin_bit_cast(int, v), 0x140, 0xF, 0xF, true)));
}
__device__ __forceinline__ float dpp_row_sum(float v) {
    v += __builtin_bit_cast(float, __builtin_amdgcn_update_dpp(0, __builtin_bit_cast(int, v), 0xB1, 0xF, 0xF, true));
    v += __builtin_bit_cast(float, __builtin_amdgcn_update_dpp(0, __builtin_bit_cast(int, v), 0x4E, 0xF, 0xF, true));
    v += __builtin_bit_cast(float, __builtin_amdgcn_update_dpp(0, __builtin_bit_cast(int, v), 0x124, 0xF, 0xF, true));
    v += __builtin_bit_cast(float, __builtin_amdgcn_update_dpp(0, __builtin_bit_cast(int, v), 0x128, 0xF, 0xF, true));
    return v;
}
__device__ __forceinline__ void wave_sum2(float& a, float& b) {
    a = dpp_row_sum(a); b = dpp_row_sum(b);
    a = sum_rows4(a); b = sum_rows4(b);
}
__device__ __forceinline__ float row_rstd(const float* ssq, int r) {
    const f32x4* p = (const f32x4*)(ssq + (size_t)r * 16);
    const f32x4 a = p[0], b = p[1], c = p[2], d = p[3];
    const f32x4 s = (a + b) + (c + d);
    return rsqrtf(((s.x + s.y) + (s.z + s.w)) * (1.0f / D) + EPS);
}

__device__ __forceinline__ int lane_now() { int l; asm volatile("v_mbcnt_lo_u32_b32 %0, -1, 0\n\tv_mbcnt_hi_u32_b32 %0, -1, %0" : "=v"(l)); return l; }
namespace pg8 {
constexpr int BM = 256, BK = 64, HALF = 128, HTB = HALF * BK * 2, STAGE_BYTES = 8 * HTB, NXCD = 8, WGM = 8;
__host__ __device__ __forceinline__ int lds_byte(int r, int c) { const int st = (r >> 4) * 2 + (c >> 5), rr = r & 15, cc = c & 31, ob = rr * 64 + cc * 2; return st * 1024 + (ob ^ (((ob >> 9) & 1) << 5)); }
__host__ __device__ __forceinline__ void stage_rc(int b, int& R, int& C) { const int st = b / 1024, sb = b % 1024, swz = sb ^ (((sb >> 9) & 1) << 5); R = (st >> 1) * 16 + swz / 64; C = (st & 1) * 32 + (swz % 64) / 2; }
__host__ __device__ __forceinline__ int perm32(int rho) { const int n = rho >> 4, i = rho & 15; return 8 * (i >> 2) + 4 * n + (i & 3); }

struct Unit { int pm, pn; };
struct Gemm { const bf16_t* A; const bf16_t* Bt; int M, N, K; };

struct StaticOrder {
    int nM, nN, nwg, G, c;
    __host__ __device__ void init(int M_, int N_, int G_, int c_) { nM = M_ / BM; nN = N_ / BM; nwg = nM * nN; G = G_; c = c_; }
    __host__ __device__ bool next(int i, Unit& u) const {
        const long L = (long)i * G + c; if (L >= nwg) return false;
        int wgid = (int)L; { const int q = nwg / NXCD, r = nwg % NXCD, xcd = wgid % NXCD, off = wgid / NXCD; wgid = (xcd < r ? xcd * (q + 1) : r * (q + 1) + (xcd - r) * q) + off; }
        const int nig = WGM * nN, gid = wgid / nig, fm = gid * WGM, gsz = (nM - fm) < WGM ? (nM - fm) : WGM;
        u.pm = fm + ((wgid % nig) % gsz); u.pn = (wgid % nig) / gsz; return true;
    }
    __device__ __forceinline__ void a_ready(const Unit&) const {}
    __device__ __forceinline__ void done(const Unit&) const {}
};

__device__ __forceinline__ f32x4 mma16(bf16x8 b, bf16x8 a, f32x4 c) { return __builtin_amdgcn_mfma_f32_16x16x32_bf16(b, a, c, 0, 0, 0); }
__device__ __forceinline__ i32x4 mma16(bf16x8 b, bf16x8 a, i32x4 c) { return __builtin_amdgcn_mfma_i32_16x16x64_i8(__builtin_bit_cast(i32x4, b), __builtin_bit_cast(i32x4, a), c, 0, 0, 0); }
template <bool I8> struct AccT { typedef f32x4 type; };
template <> struct AccT<true> { typedef i32x4 type; };
template <class Epi, class Sched, bool ALIGN_EPI, bool SP2, bool I8 = false>
__device__ __forceinline__ void gemm_phase(LAS unsigned char* lds, const Gemm g, const Sched& S, const Epi& E, int wave_) {
    static_assert(ALIGN_EPI && SP2, "only the aligned-epilogue, two-MFMA-cluster schedule is kept");
    const int tid = wave_ * 64 + lane_now();
    const int wid = wave_, lane = tid & 63, wr = wid >> 2, wc = wid & 3, fr = lane & 15, fq = lane >> 4;
    const int K = g.K, nt = K / BK;
    unsigned voffA, voffB;
    { int R, C; stage_rc(tid * 16, R, C); const int Rb = Epi::PERM ? ((R & ~31) + perm32(R & 31)) : R; voffA = (unsigned)(R * K + C) * 2u; voffB = (unsigned)(Rb * K + C) * 2u; }
    const __amdgpu_buffer_rsrc_t srdA = __builtin_amdgcn_make_buffer_rsrc((void*)g.A, (short)0, -1, 0x00020000);
    const __amdgpu_buffer_rsrc_t srdB = __builtin_amdgcn_make_buffer_rsrc((void*)g.Bt, (short)0, -1, 0x00020000);
    const unsigned kstep = BK * 2u, hstep = (unsigned)HALF * (unsigned)K * 2u, tstep = 2u * hstep, pstep = 64u * (unsigned)K * 2u;
    const unsigned ldsb = (unsigned)(size_t)lds + (unsigned)wid * 1024u;
    const int aoff = lds_byte(wr * 64 + fr, fq * 8), boff = lds_byte(wc * 32 + fr, fq * 8);
#define PG8_SA(b, h) (((b) * 2 + (h)) * HTB)
#define PG8_SB(b, h) ((4 + (b) * 2 + (h)) * HTB)
#define PG8_STAGE(bufoff, srd, soff, voff) do { _Pragma("unroll") for (int _i = 0; _i < 2; ++_i) \
        asm volatile("s_add_u32 m0, %0, %4\n\ts_nop 0\n\tbuffer_load_dwordx4 %1, %2, %3 offen lds" :: "s"(ldsb), "v"(voff), "s"(srd), "s"((soff) + _i * pstep), "n"((bufoff) + _i * 8192) : "m0", "scc", "memory"); } while (0)
#define PG8_STA(b, h, soff) PG8_STAGE(PG8_SA(b, h), srdA, soff, voffA)
#define PG8_STB(b, h, soff) PG8_STAGE(PG8_SB(b, h), srdB, soff, voffB)
#define PG8_LDA(dst, b, h) do { _Pragma("unroll") for (int m = 0; m < 4; ++m) _Pragma("unroll") for (int k = 0; k < 2; ++k) dst[m][k] = *(const LAS bf16x8*)(lds + PG8_SA(b, h) + aoff + m * 2048 + k * 1024); } while (0)
#define PG8_LDB(dst, b, h) do { _Pragma("unroll") for (int n = 0; n < 2; ++n) _Pragma("unroll") for (int k = 0; k < 2; ++k) dst[n][k] = *(const LAS bf16x8*)(lds + PG8_SB(b, h) + boff + n * 2048 + k * 1024); } while (0)
#define PG8_MMA(ai, bj, At, Bt) do { __builtin_amdgcn_s_setprio(1); _Pragma("unroll") for (int m = 0; m < 4; ++m) _Pragma("unroll") for (int n = 0; n < 2; ++n) _Pragma("unroll") for (int k = 0; k < 2; ++k) \
        acc[ai][bj][m][n] = mma16(Bt[n][k], At[m][k], acc[ai][bj][m][n]); __builtin_amdgcn_s_setprio(0); } while (0)
#define PG8_MMAZ(ai, bj, At, Bt) do { __builtin_amdgcn_s_setprio(1); _Pragma("unroll") for (int m = 0; m < 4; ++m) _Pragma("unroll") for (int n = 0; n < 2; ++n) { \
        acc[ai][bj][m][n] = mma16(Bt[n][0], At[m][0], acc_t{}); acc[ai][bj][m][n] = mma16(Bt[n][1], At[m][1], acc[ai][bj][m][n]); } __builtin_amdgcn_s_setprio(0); } while (0)
#define PG8_WAIT_V(n) asm volatile("s_waitcnt vmcnt(%0)" :: "n"(n) : "memory")
#define PG8_WAIT_L(n) asm volatile("s_waitcnt lgkmcnt(" #n ")" ::: "memory")
#define PG8_BAR __builtin_amdgcn_s_barrier()
#define PG8_SCHED __builtin_amdgcn_sched_barrier(0)
#ifndef PG8_RELAX
#define PG8_RELAX 1
#endif
#define PG8_WAIT_R(relaxed, nst) do { if (relaxed) PG8_WAIT_V(8 + PG8_RELAX * (nst)); else PG8_WAIT_V(8); } while (0)
#define PG8_TRIP(first, relaxed, nst) do { \
            PG8_LDB(B0, 0, 0); PG8_LDB(B1, 0, 1); PG8_SCHED; PG8_LDA(At, 0, 0); if (!(first)) PG8_STA(1, 1, a1 + hstep); \
            PG8_WAIT_R(relaxed, nst); PG8_WAIT_L(0); PG8_BAR; PG8_MMA(0, 0, At, B0); PG8_MMA(0, 1, At, B1); PG8_BAR; PG8_SCHED; \
            PG8_LDA(At, 0, 1); PG8_STB(0, 0, b2); PG8_STB(0, 1, b2 + hstep); PG8_STA(0, 0, a2); \
            PG8_WAIT_R(relaxed, nst); PG8_WAIT_L(0); PG8_BAR; PG8_MMA(1, 0, At, B0); PG8_MMA(1, 1, At, B1); PG8_BAR; PG8_SCHED; \
            PG8_LDB(B0, 1, 0); PG8_LDB(B1, 1, 1); PG8_SCHED; PG8_LDA(At, 1, 0); PG8_STA(0, 1, a2 + hstep); \
            PG8_WAIT_R(relaxed, nst); PG8_WAIT_L(0); PG8_BAR; PG8_MMA(0, 0, At, B0); PG8_MMA(0, 1, At, B1); PG8_BAR; PG8_SCHED; \
            PG8_LDA(At, 1, 1); PG8_STB(1, 0, b3); PG8_STB(1, 1, b3 + hstep); PG8_STA(1, 0, a3); \
            PG8_WAIT_V(8); PG8_WAIT_L(0); PG8_BAR; PG8_MMA(1, 0, At, B0); PG8_MMA(1, 1, At, B1); PG8_BAR; PG8_SCHED; } while (0)
    constexpr bool EARLY = Epi::NST > 0;
    Unit cur, nxt; int ui = 0;
    if (!S.next(0, cur)) return;
    typedef typename AccT<I8>::type acc_t;
    acc_t acc[2][2][4][2];
    bf16x8 At[4][2], B0[2][2], B1[2][2];
    unsigned cA = (unsigned)cur.pm * tstep, cB = (unsigned)cur.pn * tstep;
    S.a_ready(cur);
    PG8_STB(0, 0, cB); PG8_STB(0, 1, cB + hstep); PG8_STA(0, 0, cA); PG8_STA(0, 1, cA + hstep);
    if (wr == 1) PG8_BAR;
    PG8_WAIT_V(2); PG8_BAR;
    PG8_STB(1, 0, cB + kstep); PG8_STA(1, 0, cA + kstep); PG8_STB(1, 1, cB + hstep + kstep);
    if constexpr (EARLY) { PG8_STA(1, 1, cA + hstep + kstep); PG8_WAIT_V(8); } else { PG8_WAIT_V(6); }
    PG8_BAR;
#pragma unroll
    for (int a = 0; a < 2; ++a)
#pragma unroll
        for (int b = 0; b < 2; ++b)
#pragma unroll
            for (int m = 0; m < 4; ++m)
#pragma unroll
                for (int n = 0; n < 2; ++n) acc[a][b][m][n] = acc_t{};
    for (;;) {
        const bool has_next = S.next(ui + 1, nxt);
        const unsigned nA = has_next ? (unsigned)nxt.pm * tstep : cA, nB = has_next ? (unsigned)nxt.pn * tstep : cB;
        for (int t = 0; t < nt; t += 2) {
            const bool last = (t == nt - 2), first = EARLY && (t == 0), relaxed = first && ui > 0;
            const unsigned a1 = cA + (unsigned)(t + 1) * kstep;
            const unsigned a2 = last ? nA : cA + (unsigned)(t + 2) * kstep, b2 = last ? nB : cB + (unsigned)(t + 2) * kstep;
            const unsigned a3 = a2 + kstep, b3 = b2 + kstep;
            if (last && has_next) S.a_ready(nxt);
            if (last) E.prefetch(cur, wid, lane, lds);
            PG8_TRIP(first, relaxed, Epi::NST);
        }
        if constexpr (EARLY) PG8_STA(1, 1, nA + kstep + hstep);
        if (wr == 0) PG8_BAR;
        E(acc, cur, wr, wc, fr, fq); S.done(cur);
        if (!has_next) break;
#pragma unroll
        for (int a = 0; a < 2; ++a)
#pragma unroll
            for (int b = 0; b < 2; ++b)
#pragma unroll
                for (int m = 0; m < 4; ++m)
#pragma unroll
                    for (int n = 0; n < 2; ++n) acc[a][b][m][n] = acc_t{};
        cur = nxt; cA = nA; cB = nB; ++ui;
        if (wr == 1) PG8_BAR;
    }
    PG8_WAIT_V(0);
    PG8_BAR;
#undef PG8_SA
#undef PG8_SB
#undef PG8_STAGE
#undef PG8_STA
#undef PG8_STB
#undef PG8_LDA
#undef PG8_LDB
#undef PG8_MMA
#undef PG8_MMAZ
#undef PG8_TRIP
#undef PG8_WAIT_R
#undef PG8_WAIT_V
#undef PG8_WAIT_L
#undef PG8_BAR
#undef PG8_SCHED
}
}

typedef const f32x4 (&AccRef)[2][2][4][2];
#define EPI_BIG_CALL() \
    __device__ __forceinline__ void operator()(AccRef acc, const pg8::Unit& u, int wr, int wc, int fr, int fq) const { \
        { const int l_ = lane_now(); fr = l_ & 15; fq = (l_ >> 4) & 3; }     \
        const int row0 = u.pm * 256 + wr * 64 + fr; \
        _Pragma("unroll") for (int gq = 0; gq < 8 / PF; ++gq) { \
            Pre p[PF]; \
            asm volatile("" ::: "memory"); \
            _Pragma("unroll") for (int i = 0; i < PF; ++i) { const int rg = gq * PF + i; p[i] = pre_big(row0 + (rg >> 2) * 128 + (rg & 3) * 16, u.pn, wc, fq); }     \
            asm volatile("" ::: "memory"); \
            _Pragma("unroll") for (int i = 0; i < PF; ++i) { const int rg = gq * PF + i; \
                rows(acc[rg >> 2][0][rg & 3][0], acc[rg >> 2][0][rg & 3][1], acc[rg >> 2][1][rg & 3][0], acc[rg >> 2][1][rg & 3][1], row0 + (rg >> 2) * 128 + (rg & 3) * 16, u.pn, wc, fq, p[i]); } } \
    }
__device__ __forceinline__ f32x4 ssq_quarter(const float* ssq, int r, int fq) { return *(const f32x4*)(ssq + (size_t)r * 16 + 4 * fq); }
__device__ __forceinline__ float rstd_from(const f32x4& q) {
    float s = (q.x + q.y) + (q.z + q.w);
    s = sum_rows4(s);
    return rsqrtf(s * (1.0f / D) + EPS);
}

__device__ __forceinline__ void ssq_prefetch(const float* ssq, int pm, int wid, int lane, LAS unsigned char* lds) {
    asm volatile("" : "+v"(lane));
#pragma unroll
    for (int i = 0; i < 2; ++i)
        __builtin_amdgcn_global_load_lds((const unsigned*)(ssq + ((size_t)pm * 256 + wid * 32 + i * 16) * 16 + lane * 4), (LAS unsigned*)(lds + SSQ_LDS_OFF + (wid * 32 + i * 16) * 64), 16, 0, 0);
}
struct EpiSwiglu {
    static constexpr bool PERM = true; static constexpr int PF = 8; static constexpr int NST = 8;
    bf16_t* O; const float* ssq; LAS unsigned char* lds;
    struct Pre { f32x4 q; };
    __device__ __forceinline__ Pre pre(int r, int pn, int wc, int fq) const { Pre p; p.q = ssq_quarter(ssq, r, fq); return p; }
    __device__ __forceinline__ Pre pre_big(int r, int pn, int wc, int fq) const { Pre p; p.q = *(const LAS f32x4*)(lds + SSQ_LDS_OFF + (r & 255) * 64 + fq * 16); return p; }
    __device__ __forceinline__ void prefetch(const pg8::Unit& u, int wid, int lane, LAS unsigned char* l) const { ssq_prefetch(ssq, u.pm, wid, lane, l); }
    __device__ __forceinline__ void rows(const f32x4& c00, const f32x4& c01, const f32x4& c10, const f32x4& c11, int r, int pn, int wc, int fq, const Pre& p) const {
        const float rs = rstd_from(p.q);
        float o[8];
#pragma unroll
        for (int j = 0; j < 4; ++j) { o[j] = silu_f(c00[j] * rs) * (c10[j] * rs); o[4 + j] = silu_f(c01[j] * rs) * (c11[j] * rs); }
        u32x4 w; w.x = cvt_pk_bf16(o[0], o[1]); w.y = cvt_pk_bf16(o[2], o[3]); w.z = cvt_pk_bf16(o[4], o[5]); w.w = cvt_pk_bf16(o[6], o[7]);
        { bf16_t* dst_ = O + (size_t)r * FF + pn * 128 + wc * 32 + 8 * fq;
          asm volatile("global_store_dwordx4 %0, %1, off sc1\n\ts_nop 1" :: "v"(dst_), "v"(w) : "memory"); }
    }
    EPI_BIG_CALL()
};

struct EpiSwigluI8 {
    static constexpr bool PERM = true; static constexpr int NST = 8;
    bf16_t* O; const float* rs; const float* cs; LAS unsigned char* lds;
    struct Pre { float sa; };
    __device__ __forceinline__ Pre pre(int r, int pn, int wc, int fq) const { Pre p; p.sa = rs[r]; return p; }
    __device__ __forceinline__ void prefetch(const pg8::Unit& u, int wid, int lane, LAS unsigned char* l) const {
        asm volatile("" : "+v"(lane));
        if (wid == 0) __builtin_amdgcn_global_load_lds((const unsigned*)(rs + (size_t)u.pm * 256 + lane * 4), (LAS unsigned*)(l + SSQ_LDS_OFF), 16, 0, 0);
        if (wid == 1) __builtin_amdgcn_global_load_lds((const unsigned*)(cs + (size_t)u.pn * 256 + lane * 4), (LAS unsigned*)(l + SSQ_LDS_OFF + 1024), 16, 0, 0);
    }
    __device__ __forceinline__ void emit(const f32x4& c00, const f32x4& c01, const f32x4& c10, const f32x4& c11, float sa, const f32x4& w00, const f32x4& w01, const f32x4& w10, const f32x4& w11,
                                         int r, int pn, int wc, int fq) const {
        float o[8];
#pragma unroll
        for (int j = 0; j < 4; ++j) { o[j] = silu_f(c00[j] * (sa * w00[j])) * (c10[j] * (sa * w10[j])); o[4 + j] = silu_f(c01[j] * (sa * w01[j])) * (c11[j] * (sa * w11[j])); }
        u32x4 w; w.x = cvt_pk_bf16(o[0], o[1]); w.y = cvt_pk_bf16(o[2], o[3]); w.z = cvt_pk_bf16(o[4], o[5]); w.w = cvt_pk_bf16(o[6], o[7]);
        { bf16_t* dst_ = O + (size_t)r * FF + pn * 128 + wc * 32 + 8 * fq;
          asm volatile("global_store_dwordx4 %0, %1, off sc1\n\ts_nop 1" :: "v"(dst_), "v"(w) : "memory"); }
    }
    __device__ __forceinline__ void rows(const f32x4& c00, const f32x4& c01, const f32x4& c10, const f32x4& c11, int r, int pn, int wc, int fq, const Pre& p) const {
        const float* cp = cs + (size_t)pn * 256 + wc * 32 + 8 * fq;
        emit(c00, c01, c10, c11, p.sa, *(const f32x4*)cp, *(const f32x4*)(cp + 4), *(const f32x4*)(cp + 128), *(const f32x4*)(cp + 132), r, pn, wc, fq);
    }
    template <class AccTy> __device__ __forceinline__ void operator()(const AccTy (&acc)[2][2][4][2], const pg8::Unit& u, int wr, int wc, int fr, int fq) const {
        { const int l_ = lane_now(); fr = l_ & 15; fq = (l_ >> 4) & 3; }
        const int row0 = u.pm * 256 + wr * 64 + fr;
        LAS const float* lr = (LAS const float*)(lds + SSQ_LDS_OFF); LAS const float* lc = lr + 256 + wc * 32 + 8 * fq;
        const f32x4 w00 = *(LAS const f32x4*)lc, w01 = *(LAS const f32x4*)(lc + 4), w10 = *(LAS const f32x4*)(lc + 128), w11 = *(LAS const f32x4*)(lc + 132);
        f32x2 NW[4], WW[4];
        NW[0] = (f32x2){w00[0], w00[1]} * (-LOG2E); NW[1] = (f32x2){w00[2], w00[3]} * (-LOG2E); NW[2] = (f32x2){w01[0], w01[1]} * (-LOG2E); NW[3] = (f32x2){w01[2], w01[3]} * (-LOG2E);
        WW[0] = (f32x2){w00[0], w00[1]} * (f32x2){w10[0], w10[1]}; WW[1] = (f32x2){w00[2], w00[3]} * (f32x2){w10[2], w10[3]};
        WW[2] = (f32x2){w01[0], w01[1]} * (f32x2){w11[0], w11[1]}; WW[3] = (f32x2){w01[2], w01[3]} * (f32x2){w11[2], w11[3]};
#pragma unroll
        for (int rg = 0; rg < 8; ++rg) {
            const int ai = rg >> 2, m = rg & 3, r = row0 + ai * 128 + m * 16;
            const float sa = lr[r & 255], inv = __builtin_amdgcn_rcpf(sa);
            unsigned pk[4];
#pragma unroll
            for (int p = 0; p < 4; ++p) {
                const AccTy& cg = acc[ai][0][m][p >> 1]; const AccTy& cu = acc[ai][1][m][p >> 1]; const int j = (p & 1) * 2;
                const f32x2 G = (f32x2){(float)cg[j], (float)cg[j + 1]} * sa, U = (f32x2){(float)cu[j], (float)cu[j + 1]};
                const f32x2 T = G * NW[p];
                f32x2 E; E.x = __builtin_amdgcn_exp2f(T.x); E.y = __builtin_amdgcn_exp2f(T.y);
                const f32x2 Dn = E * inv + inv;
                f32x2 R; R.x = __builtin_amdgcn_rcpf(Dn.x); R.y = __builtin_amdgcn_rcpf(Dn.y);
                const f32x2 O = ((G * U) * WW[p]) * R;
                pk[p] = cvt_pk_bf16(O.x, O.y);
            }
            u32x4 w; w.x = pk[0]; w.y = pk[1]; w.z = pk[2]; w.w = pk[3];
            { bf16_t* dst_ = O_at(r, u.pn, wc, fq);
              asm volatile("global_store_dwordx4 %0, %1, off sc1\n\ts_nop 1" :: "v"(dst_), "v"(w) : "memory"); }
        }
    }
    __device__ __forceinline__ bf16_t* O_at(int r, int pn, int wc, int fq) const { return O + (size_t)r * FF + pn * 128 + wc * 32 + 8 * fq; }
};

template <int MODE> struct EpiResid {
    static constexpr bool PERM = true; static constexpr int PF = (MODE == 0) ? 2 : 4;
    static constexpr int NST = (MODE == 2) ? 16 : (MODE == 1) ? 8 : 4;
    const float* resP; const float* resS;
    float* out; bf16_t* xb; float* ssq; float scale;
    struct Pre { f32x4 r00, r01, r10, r11; u32x4 a, b; };
    __device__ __forceinline__ Pre pre(int r, int pn, int wc, int fq) const {
        Pre p; const size_t off = (size_t)r * D + pn * 256 + wc * 32 + 8 * fq;
        if (MODE == 0) { const float* rbase = (r >= MP) ? resS - (size_t)MP * D : resP;
            p.r00 = *(const f32x4*)(rbase + off); p.r01 = *(const f32x4*)(rbase + off + 4); p.r10 = *(const f32x4*)(rbase + off + 128); p.r11 = *(const f32x4*)(rbase + off + 132); }
        else { p.a = *(const u32x4*)(xb + off); p.b = *(const u32x4*)(xb + off + 128); }
        return p;
    }
    __device__ __forceinline__ Pre pre_big(int r, int pn, int wc, int fq) const { return pre(r, pn, wc, fq); }
    __device__ __forceinline__ void prefetch(const pg8::Unit&, int, int, LAS unsigned char*) const {}
    __device__ __forceinline__ void rows(const f32x4& c00, const f32x4& c01, const f32x4& c10, const f32x4& c11, int r, int pn, int wc, int fq, const Pre& p) const {
        const size_t off = (size_t)r * D + pn * 256 + wc * 32 + 8 * fq;
        f32x4 r00, r01, r10, r11;
        if (MODE == 0) { r00 = p.r00; r01 = p.r01; r10 = p.r10; r11 = p.r11; }
        else {
            const u32x4 a = p.a, b = p.b;
            r00 = (f32x4){__uint_as_float(a.x << 16), __uint_as_float(a.x & 0xffff0000u), __uint_as_float(a.y << 16), __uint_as_float(a.y & 0xffff0000u)};
            r01 = (f32x4){__uint_as_float(a.z << 16), __uint_as_float(a.z & 0xffff0000u), __uint_as_float(a.w << 16), __uint_as_float(a.w & 0xffff0000u)};
            r10 = (f32x4){__uint_as_float(b.x << 16), __uint_as_float(b.x & 0xffff0000u), __uint_as_float(b.y << 16), __uint_as_float(b.y & 0xffff0000u)};
            r11 = (f32x4){__uint_as_float(b.z << 16), __uint_as_float(b.z & 0xffff0000u), __uint_as_float(b.w << 16), __uint_as_float(b.w & 0xffff0000u)};
        }
        const f32x4 y00 = r00 + c00 * scale, y01 = r01 + c01 * scale, y10 = r10 + c10 * scale, y11 = r11 + c11 * scale;
        if (MODE == 2) {
            __builtin_nontemporal_store(y00, (f32x4*)(out + off)); __builtin_nontemporal_store(y01, (f32x4*)(out + off + 4)); __builtin_nontemporal_store(y10, (f32x4*)(out + off + 128)); __builtin_nontemporal_store(y11, (f32x4*)(out + off + 132));
        } else {
            u32x4 w0, w1;
            w0.x = cvt_pk_bf16(y00[0], y00[1]); w0.y = cvt_pk_bf16(y00[2], y00[3]); w0.z = cvt_pk_bf16(y01[0], y01[1]); w0.w = cvt_pk_bf16(y01[2], y01[3]);
            w1.x = cvt_pk_bf16(y10[0], y10[1]); w1.y = cvt_pk_bf16(y10[2], y10[3]); w1.z = cvt_pk_bf16(y11[0], y11[1]); w1.w = cvt_pk_bf16(y11[2], y11[3]);
            *(u32x4*)(xb + off) = w0; *(u32x4*)(xb + off + 128) = w1;
            float ss = (y00[0] * y00[0] + y00[1] * y00[1]) + (y00[2] * y00[2] + y00[3] * y00[3]) + (y01[0] * y01[0] + y01[1] * y01[1]) + (y01[2] * y01[2] + y01[3] * y01[3])
                     + (y10[0] * y10[0] + y10[1] * y10[1]) + (y10[2] * y10[2] + y10[3] * y10[3]) + (y11[0] * y11[0] + y11[1] * y11[1]) + (y11[2] * y11[2] + y11[3] * y11[3]);
            ss = sum_rows4(ss);
            if (fq == 0) ssq[(size_t)r * 16 + pn * 4 + wc] = ss;
        }
    }
    EPI_BIG_CALL()
};

struct EpiInProj {
    static constexpr bool PERM = true; static constexpr int PF = 1; static constexpr int NST = 0;
    unsigned char* ws; const float* gq; const float* gk; float* out; LAS unsigned char* lds;
    struct Pre { f32x4 q; };
    __device__ __forceinline__ Pre pre(int r, int pn, int wc, int fq) const { Pre p; p.q = ssq_quarter((const float*)(ws + WS_SSQ1), r, fq); return p; }
    __device__ __forceinline__ Pre pre_big(int r, int pn, int wc, int fq) const { Pre p; p.q = *(const LAS f32x4*)(lds + SSQ_LDS_OFF + (r & 255) * 64 + fq * 16); return p; }
    __device__ __forceinline__ void prefetch(const pg8::Unit& u, int wid, int lane, LAS unsigned char* l) const { ssq_prefetch((const float*)(ws + WS_SSQ1), u.pm, wid, lane, l); }
    __device__ __forceinline__ void rows(const f32x4& c00, const f32x4& c01, const f32x4& c10, const f32x4& c11, int r, int pn, int wc, int fq, const Pre& p) const {
        const bool sample = r >= MP;
        int b, t, pos;
        if (sample) { const int rr = r - MP; b = rr >> 4; t = rr & 15; pos = PAST + t; } else { b = r >> 13; t = r & (TP - 1); pos = t; }
        const float rs = rstd_from(p.q);
        if (pn < 4) {
            const int ch0 = pn * 128 + wc * 32 + 8 * fq;
            float o[8];
#pragma unroll
            for (int j = 0; j < 4; ++j) { o[j] = (c00[j] * rs) * sigmoid_f(c10[j] * rs); o[4 + j] = (c01[j] * rs) * sigmoid_f(c11[j] * rs); }
            u32x4 w; w.x = cvt_pk_bf16(o[0], o[1]); w.y = cvt_pk_bf16(o[2], o[3]); w.z = cvt_pk_bf16(o[4], o[5]); w.w = cvt_pk_bf16(o[6], o[7]);
            bf16_t* ud = sample ? (bf16_t*)(ws + WS_US) + ((size_t)(b * USROWS + HIST + t)) * CC + ch0 : (bf16_t*)(ws + WS_UP) + (size_t)r * CC + ch0;
            *(u32x4*)ud = w;
            float* dst = nullptr;
            if (sample) dst = out + O_CSS + ((size_t)(b * HIST + (HIST - TS) + t)) * CC + ch0;
            else if (t >= TP - HIST) dst = out + O_CSP + ((size_t)(b * HIST + (t - (TP - HIST)))) * CC + ch0;
            if (dst) { *(f32x4*)dst = (f32x4){o[0], o[1], o[2], o[3]}; *(f32x4*)(dst + 4) = (f32x4){o[4], o[5], o[6], o[7]}; }
        } else if (pn < 6 || wc < 2) {
            const bool isq = pn < 6;
            const int h = isq ? (pn - 4) * 4 + wc : wc;
            const float* gg = isq ? gq : gk;
            const f32x4 g00 = *(const f32x4*)(gg + 8 * fq), g01 = *(const f32x4*)(gg + 8 * fq + 4), g10 = *(const f32x4*)(gg + 32 + 8 * fq), g11 = *(const f32x4*)(gg + 32 + 8 * fq + 4);
            const float osc = isq ? QSCALE : 1.0f;
            f32x4 v00 = c00 * rs, v01 = c01 * rs, v10 = c10 * rs, v11 = c11 * rs;
            float ss = (v00[0] * v00[0] + v00[1] * v00[1]) + (v00[2] * v00[2] + v00[3] * v00[3]) + (v01[0] * v01[0] + v01[1] * v01[1]) + (v01[2] * v01[2] + v01[3] * v01[3])
                     + (v10[0] * v10[0] + v10[1] * v10[1]) + (v10[2] * v10[2] + v10[3] * v10[3]) + (v11[0] * v11[0] + v11[1] * v11[1]) + (v11[2] * v11[2] + v11[3] * v11[3]);
            ss = sum_rows4(ss);
            const float hn = rsqrtf(ss * (1.0f / HD) + EPS);
            v00 = v00 * hn * g00; v01 = v01 * hn * g01; v10 = v10 * hn * g10; v11 = v11 * hn * g11;
            f32x4 p0, p1;
#pragma unroll
            for (int j = 0; j < 4; ++j) { p0[j] = __shfl_xor(v00[j], 16); p1[j] = __shfl_xor(v01[j], 16);     }
            if (fq < 2) {
                const f32x2* rp = (const f32x2*)(ws + WS_ROPE) + (size_t)pos * 8;
                const float sg = (fq == 0) ? -1.0f : 1.0f;
#pragma unroll
                for (int j = 0; j < 4; ++j) {
                    const f32x2 cs0 = rp[j], cs1 = rp[4 + j];
                    v00[j] = v00[j] * cs0.x + sg * p0[j] * cs0.y;
                    v01[j] = v01[j] * cs1.x + sg * p1[j] * cs1.y;
                }
            }
            u32x4 w0, w1;
            w0.x = cvt_pk_bf16(v00[0] * osc, v00[1] * osc); w0.y = cvt_pk_bf16(v00[2] * osc, v00[3] * osc); w0.z = cvt_pk_bf16(v01[0] * osc, v01[1] * osc); w0.w = cvt_pk_bf16(v01[2] * osc, v01[3] * osc);
            w1.x = cvt_pk_bf16(v10[0] * osc, v10[1] * osc); w1.y = cvt_pk_bf16(v10[2] * osc, v10[3] * osc); w1.z = cvt_pk_bf16(v11[0] * osc, v11[1] * osc); w1.w = cvt_pk_bf16(v11[2] * osc, v11[3] * osc);
            if (isq) {
                bf16_t* dst = (bf16_t*)(ws + WS_Q) + (size_t)r * 512 + h * 64 + 8 * fq;
                *(u32x4*)dst = w0; *(u32x4*)(dst + 32) = w1;
            } else {
                bf16_t* dst = sample ? (bf16_t*)(ws + WS_KS) + ((size_t)(b * KSROWS + WIN + t)) * 128 + h * 64 + 8 * fq : (bf16_t*)(ws + WS_KP) + (size_t)r * 128 + h * 64 + 8 * fq;
                *(u32x4*)dst = w0; *(u32x4*)(dst + 32) = w1;
                float* od = nullptr;
                if (sample) od = out + O_KWS + ((size_t)((b * WIN + (WIN - TS) + t) * 2 + h)) * 64 + 8 * fq;
                else if (t >= TP - WIN) od = out + O_KWP + ((size_t)((b * WIN + (t - (TP - WIN))) * 2 + h)) * 64 + 8 * fq;
                if (od) { *(f32x4*)od = v00; *(f32x4*)(od + 4) = v01; *(f32x4*)(od + 32) = v10; *(f32x4*)(od + 36) = v11; }
            }
        } else {
            const int kh = wc - 2;
            const f32x4 v00 = c00 * rs, v01 = c01 * rs, v10 = c10 * rs, v11 = c11 * rs;
            bf16_t* vt; size_t vs;
            if (sample) { vt = (bf16_t*)(ws + WS_VTS) + ((size_t)((b * 2 + kh) * 64)) * KSROWS + WIN + t; vs = KSROWS; }
            else { vt = (bf16_t*)(ws + WS_VTP) + ((size_t)((b * 2 + kh) * (TP / 64) + (t >> 6))) * 4096 + (t & 63); vs = 64; }
#pragma unroll
            for (int j = 0; j < 4; ++j) {
                vt[(size_t)(8 * fq + j) * vs] = f2bf(v00[j]); vt[(size_t)(8 * fq + 4 + j) * vs] = f2bf(v01[j]);
                vt[(size_t)(32 + 8 * fq + j) * vs] = f2bf(v10[j]); vt[(size_t)(32 + 8 * fq + 4 + j) * vs] = f2bf(v11[j]);
            }
            float* od = nullptr;
            if (sample) od = out + O_VWS + ((size_t)((b * WIN + (WIN - TS) + t) * 2 + kh)) * 64 + 8 * fq;
            else if (t >= TP - WIN) od = out + O_VWP + ((size_t)((b * WIN + (t - (TP - WIN))) * 2 + kh)) * 64 + 8 * fq;
            if (od) { *(f32x4*)od = v00; *(f32x4*)(od + 4) = v01; *(f32x4*)(od + 32) = v10; *(f32x4*)(od + 36) = v11; }
        }
    }
    EPI_BIG_CALL()
};

template <int KS, int MT, bool I8, class Epi>
__device__ __forceinline__ void small_gemm(const bf16_t* A, const bf16_t* Bt, int N, int K, const Epi& E, LAS unsigned char* lds, int bid, int G, int wave, int lane, int wpc_in = 0) {
    constexpr int MTN = MS / (16 * MT);
    const int NT = MTN * (N / 256) * 4, NI = NT * KS, wpc = wpc_in ? wpc_in : (NI + G - 1) / G, nb = K / 64;
    asm volatile("" : "+v"(lane));
    const int fr = lane & 15, g = lane >> 4;
    for (int i0 = 0; i0 < wpc; i0 += 8) {
        const int i = i0 + wave, item = bid * wpc + i;
        const bool active = (i < wpc) && (item < NI);
        const int t = active ? item / KS : 0, ksl = item % KS;
        const int mt = t % MTN, nq = t / MTN, pn = nq >> 2, wc = nq & 3;
        const int r = MP + mt * (16 * MT) + fr;
        typedef typename pg8::AccT<I8>::type acc_t;
        acc_t acc[MT][2][2];
#pragma unroll
        for (int mi = 0; mi < MT; ++mi)
#pragma unroll
            for (int bj = 0; bj < 2; ++bj)
#pragma unroll
                for (int n = 0; n < 2; ++n) acc[mi][bj][n] = acc_t{};
        if (active) {
            const int b0 = (nb * ksl) / KS, b1 = (nb * (ksl + 1)) / KS;
            const bf16_t* ap = A + (size_t)r * K + g * 8;
            const bf16_t* bp = Bt + (size_t)(pn * 256 + wc * 32 + 8 * (fr >> 2) + (fr & 3)) * K + g * 8;
            bf16x8 afA[2][MT], bfA[2][2][2], afB[2][MT], bfB[2][2][2];
#define SG_LOAD(af, bf, kb) do { const int k0_ = (kb) * 64; _Pragma("unroll") for (int s_ = 0; s_ < 2; ++s_) { \
            _Pragma("unroll") for (int mi = 0; mi < MT; ++mi) af[s_][mi] = *(const bf16x8*)(ap + (size_t)(16 * mi) * K + k0_ + s_ * 32); \
            _Pragma("unroll") for (int bj = 0; bj < 2; ++bj) _Pragma("unroll") for (int n = 0; n < 2; ++n) bf[s_][bj][n] = *(const bf16x8*)(bp + (size_t)(4 * n + 128 * bj) * K + k0_ + s_ * 32); } } while (0)
#define SG_MMA(af, bf) do { _Pragma("unroll") for (int s_ = 0; s_ < 2; ++s_) _Pragma("unroll") for (int bj = 0; bj < 2; ++bj) _Pragma("unroll") for (int n = 0; n < 2; ++n) { \
            _Pragma("unroll") for (int mi = 0; mi < MT; ++mi) acc[mi][bj][n] = pg8::mma16(bf[s_][bj][n], af[s_][mi], acc[mi][bj][n]); } } while (0)
            SG_LOAD(afA, bfA, b0);
            for (int kb = b0; kb < b1; kb += 2) {
                const int kb1 = (kb + 1 < b1) ? kb + 1 : b1 - 1, kb2 = (kb + 2 < b1) ? kb + 2 : b1 - 1;
                __builtin_amdgcn_sched_barrier(0);
                SG_LOAD(afB, bfB, kb1);
                __builtin_amdgcn_sched_barrier(0);
                SG_MMA(afA, bfA);
                __builtin_amdgcn_sched_barrier(0);
                SG_LOAD(afA, bfA, kb2);
                __builtin_amdgcn_sched_barrier(0);
                if (kb + 1 < b1) SG_MMA(afB, bfB);
            }
#undef SG_LOAD
#undef SG_MMA
        }
        if constexpr (KS > 1) {
            static_assert(KS == 1 || KS == 8, "KS: 1 or 8 (all eight waves of the workgroup on one tile)");
            LAS acc_t* red = (LAS acc_t*)lds;
            if (ksl != 0) {
#pragma unroll
                for (int mi = 0; mi < MT; ++mi)
#pragma unroll
                    for (int bj = 0; bj < 2; ++bj)
#pragma unroll
                        for (int n = 0; n < 2; ++n) red[(ksl - 1) * (MT * 256) + ((mi * 2 + bj) * 2 + n) * 64 + lane] = acc[mi][bj][n];
            }
            __syncthreads();
            if (ksl == 0) {
#pragma unroll
                for (int q = 0; q < KS - 1; ++q)
#pragma unroll
                    for (int mi = 0; mi < MT; ++mi)
#pragma unroll
                        for (int bj = 0; bj < 2; ++bj)
#pragma unroll
                            for (int n = 0; n < 2; ++n) acc[mi][bj][n] += red[q * (MT * 256) + ((mi * 2 + bj) * 2 + n) * 64 + lane];
            }
            __syncthreads();
        }
        if (active && ksl == 0) {
#pragma unroll
            for (int mi = 0; mi < MT; ++mi) { const typename Epi::Pre p = E.pre(r + 16 * mi, pn, wc, g);
                E.rows(__builtin_convertvector(acc[mi][0][0], f32x4), __builtin_convertvector(acc[mi][0][1], f32x4), __builtin_convertvector(acc[mi][1][0], f32x4), __builtin_convertvector(acc[mi][1][1], f32x4), r + 16 * mi, pn, wc, g, p); }
        }
    }
}

struct TItem { const float* W; const float* g; bf16_t* WT; int Nsrc, srccol0, K, destrow0, k0; };
__device__ __forceinline__ void p0_tload(const TItem& t, float (&v)[32], int lane) {
#pragma unroll
    for (int i = 0; i < 32; ++i) { const int kk = 2 * i + (lane >> 5); v[i] = t.W[(size_t)(t.k0 + kk) * t.Nsrc + t.srccol0 + (lane & 31)]; }
}
__device__ __forceinline__ void p0_tfinish(const TItem& t, const float (&v)[32], LAS float* scr, int lane) {
#pragma unroll
    for (int i = 0; i < 32; ++i) { const int kk = 2 * i + (lane >> 5); scr[kk * 33 + (lane & 31)] = v[i]; }
    asm volatile("s_waitcnt lgkmcnt(0)" ::: "memory");
    const int c = lane & 7;
    f32x4 g0 = (f32x4){1.f, 1.f, 1.f, 1.f}, g1 = g0;
    if (t.g) { g0 = *(const f32x4*)(t.g + t.k0 + 8 * c); g1 = *(const f32x4*)(t.g + t.k0 + 8 * c + 4); }
#pragma unroll
    for (int j = 0; j < 4; ++j) { const int n = (lane >> 3) + 8 * j; const LAS float* sp = scr + (8 * c) * 33 + n;
        u32x4 o; o.x = cvt_pk_bf16(sp[0 * 33] * g0.x, sp[1 * 33] * g0.y); o.y = cvt_pk_bf16(sp[2 * 33] * g0.z, sp[3 * 33] * g0.w); o.z = cvt_pk_bf16(sp[4 * 33] * g1.x, sp[5 * 33] * g1.y); o.w = cvt_pk_bf16(sp[6 * 33] * g1.z, sp[7 * 33] * g1.w);
        *(u32x4*)(t.WT + (size_t)(t.destrow0 + n) * t.K + t.k0 + 8 * c) = o; }
    asm volatile("s_waitcnt lgkmcnt(0)" ::: "memory");
}
__device__ __forceinline__ int src_up(int nb) { const int pn = nb >> 3, p0 = (nb & 7) * 32, bj = p0 >> 7; return bj * FF + pn * 128 + (p0 & 127); }
__device__ __forceinline__ int src_in(int nb) {
    const int pn = nb >> 3, p0 = (nb & 7) * 32, bj = p0 >> 7, wc = (p0 & 127) >> 5;
    if (pn < 4) return bj * CC + pn * 128 + wc * 32;
    if (pn < 6) return 1024 + ((pn - 4) * 4 + wc) * 64 + bj * 32;
    return (wc < 2) ? 1536 + wc * 64 + bj * 32 : 1664 + (wc - 2) * 64 + bj * 32;
}

struct Args { const float* in[21]; float* out; unsigned char* ws; float inv[8]; };
typedef const __attribute__((address_space(4))) Args& ArgsRef;
__device__ __forceinline__ const __attribute__((address_space(4))) Args* args_now() {
#if defined(__HIP_DEVICE_COMPILE__)
    auto p = (const __attribute__((address_space(4))) Args*)__builtin_amdgcn_kernarg_segment_ptr(); asm volatile("" : "+s"(p)); return p;
#else
    return nullptr;
#endif
}

constexpr int I_UP = (D / 64) * (NUP / 32), I_DN = (FF / 64) * (D / 32), I_IN = (D / 64) * (NIN / 32), I_O = (D / 64) * (D / 32);
constexpr int NITEMS = 2 * I_UP + 2 * I_DN + I_IN + I_O;
constexpr int NITEMS_EARLY = I_UP + I_DN + I_IN + I_O;
__device__ __forceinline__ TItem p0_decode(ArgsRef a, int it) {
    unsigned char* ws = a.ws; int r = it < NITEMS ? it : NITEMS - 1; TItem t;
    if (r < I_UP) { const int nblk = NUP / 32, kb = r / nblk, nb = r % nblk; t = TItem{a.in[6], a.in[5], (bf16_t*)(ws + WS_W1T), NUP, src_up(nb), D, nb * 32, kb * 64}; return t; } r -= I_UP;
    if (r < I_DN) { const int nblk = D / 32, kb = r / nblk, nb = r % nblk; t = TItem{a.in[7], nullptr, (bf16_t*)(ws + WS_W2T), D, nb * 32, FF, nb * 32, kb * 64}; return t; } r -= I_DN;
    if (r < I_IN) { const int nblk = NIN / 32, kb = r / nblk, nb = r % nblk; t = TItem{a.in[9], a.in[8], (bf16_t*)(ws + WS_WINT), NIN, src_in(nb), D, nb * 32, kb * 64}; return t; } r -= I_IN;
    if (r < I_O) { const int nblk = D / 32, kb = r / nblk, nb = r % nblk; t = TItem{a.in[17], nullptr, (bf16_t*)(ws + WS_WOT), D, nb * 32, D, nb * 32, kb * 64}; return t; } r -= I_O;
    if (r < I_UP) { const int nblk = NUP / 32, kb = r / nblk, nb = r % nblk; t = TItem{a.in[19], a.in[18], (bf16_t*)(ws + WS_W3T), NUP, src_up(nb), D, nb * 32, kb * 64}; return t; } r -= I_UP;
    { const int nblk = D / 32, kb = r / nblk, nb = r % nblk; t = TItem{a.in[20], nullptr, (bf16_t*)(ws + WS_W4T), D, nb * 32, FF, nb * 32, kb * 64}; return t; }
}
__device__ __forceinline__ void weights_convert(ArgsRef a, LAS unsigned char* lds, int it0, int it1, int gw, int NGW, int wave, int lane) {
    LAS float* scr = (LAS float*)(lds + wave * 16896);
    for (int it = it0 + gw; it < it1; it += 2 * NGW) {
        const TItem t0 = p0_decode(a, it), t1 = p0_decode(a, it + NGW < it1 ? it + NGW : it);
        float v0[32], v1[32];
        p0_tload(t0, v0, lane); p0_tload(t1, v1, lane);
        p0_tfinish(t0, v0, scr, lane);
        if (it + NGW < it1) p0_tfinish(t1, v1, scr + 64 * 33, lane);
    }
}


__device__ __forceinline__ void w8_strip(const float* W, const float* g, signed char* Wq, float* cs, int nb, LAS unsigned char* lds, int wave, int lane) {
    LAS float* scr = (LAS float*)(lds + wave * 16896);
    LAS float* red = (LAS float*)(lds + 139264);
    const int src0 = src_up(nb), k0 = 128 * wave, c = lane & 7;
    TItem t0{W, nullptr, nullptr, NUP, src0, D, 0, k0}, t1{W, nullptr, nullptr, NUP, src0, D, 0, k0 + 64};
    float v0[32], v1[32];
    p0_tload(t0, v0, lane); p0_tload(t1, v1, lane);
#pragma unroll
    for (int i = 0; i < 32; ++i) { const int kk = 2 * i + (lane >> 5); scr[kk * 33 + (lane & 31)] = v0[i]; scr[64 * 33 + kk * 33 + (lane & 31)] = v1[i]; }
    asm volatile("s_waitcnt lgkmcnt(0)" ::: "memory");
    float val[2][4][8]; float mx[4];
#pragma unroll
    for (int h = 0; h < 2; ++h) { const f32x4 ga = *(const f32x4*)(g + k0 + 64 * h + 8 * c), gb = *(const f32x4*)(g + k0 + 64 * h + 8 * c + 4);
#pragma unroll
        for (int j = 0; j < 4; ++j) { const LAS float* sp = scr + h * (64 * 33) + (8 * c) * 33 + (lane >> 3) + 8 * j;
#pragma unroll
            for (int i = 0; i < 8; ++i) val[h][j][i] = sp[i * 33] * (i < 4 ? ga[i] : gb[i - 4]); } }
#pragma unroll
    for (int j = 0; j < 4; ++j) { float m = 0.f;
#pragma unroll
        for (int h = 0; h < 2; ++h)
#pragma unroll
            for (int i = 0; i < 8; ++i) m = fmaxf(m, fabsf(val[h][j][i]));
        m = dpp_max8(m);
        mx[j] = m; }
    if (c == 0) {
#pragma unroll
        for (int j = 0; j < 4; ++j) red[wave * 32 + (lane >> 3) + 8 * j] = mx[j]; }
    __syncthreads();
#pragma unroll
    for (int j = 0; j < 4; ++j) { float m = 0.f;
#pragma unroll
        for (int w = 0; w < 8; ++w) m = fmaxf(m, red[w * 32 + (lane >> 3) + 8 * j]);
        mx[j] = m; }
#pragma unroll
    for (int j = 0; j < 4; ++j) { const int n = (lane >> 3) + 8 * j; const float inv = mx[j] > 0.f ? 127.0f / mx[j] : 0.f;
        if (wave == 0 && c == 0) cs[nb * 32 + n] = mx[j] > 0.f ? mx[j] * (1.0f / 127.0f) : 1.0f;
#pragma unroll
        for (int h = 0; h < 2; ++h) { unsigned lo = 0u, hi = 0u;
#pragma unroll
            for (int i = 0; i < 4; ++i) { lo |= ((unsigned)(int)rintf(val[h][j][i] * inv) & 0xffu) << (8 * i); hi |= ((unsigned)(int)rintf(val[h][j][4 + i] * inv) & 0xffu) << (8 * i); }
            *(u32x2*)(Wq + (size_t)(nb * 32 + n) * D + k0 + 64 * h + 8 * c) = (u32x2){lo, hi}; } }
    __syncthreads();
}
template <int NR> __device__ __forceinline__ void q8_rows(unsigned char* ws, const float* ssq, int m0, int lane) {
    const bf16_t* AB = (const bf16_t*)(ws + WS_AB); signed char* A8 = (signed char*)(ws + WS_A8); float* RS = (float*)(ws + WS_RS);
    u32x4 xa[NR], xb[NR]; float sq[NR];
#pragma unroll
    for (int q = 0; q < NR; ++q) { const bf16_t* row = AB + (size_t)(m0 + q) * D; xa[q] = *(const u32x4*)(row + 8 * lane); xb[q] = *(const u32x4*)(row + 512 + 8 * lane); sq[q] = lane < 16 ? ssq[(size_t)(m0 + q) * 16 + lane] : 0.f; }
#pragma unroll
    for (int q = 0; q < NR; ++q) {
        float s = dpp_row_sum(sq[q]); s = __builtin_bit_cast(float, __builtin_amdgcn_readfirstlane(__builtin_bit_cast(int, s)));
        const float rstd = rsqrtf(s * (1.0f / D) + EPS);
        float v[16];
#pragma unroll
        for (int i = 0; i < 4; ++i) { const unsigned a = xa[q][i], b = xb[q][i];
            v[2 * i] = __uint_as_float(a << 16) * rstd; v[2 * i + 1] = __uint_as_float(a & 0xffff0000u) * rstd; v[8 + 2 * i] = __uint_as_float(b << 16) * rstd; v[8 + 2 * i + 1] = __uint_as_float(b & 0xffff0000u) * rstd; }
        float m = 0.f;
#pragma unroll
        for (int i = 0; i < 16; ++i) m = fmaxf(m, fabsf(v[i]));
        m = dpp_max16(m); m = max_rows4(m);
        const float inv = m > 0.f ? 127.0f / m : 0.f;
        unsigned p[4];
#pragma unroll
        for (int i = 0; i < 4; ++i) { unsigned w = 0u;
#pragma unroll
            for (int e = 0; e < 4; ++e) w |= ((unsigned)(int)rintf(v[4 * i + e] * inv) & 0xffu) << (8 * e);
            p[i] = w; }
        signed char* orow = A8 + (size_t)(m0 + q) * D;
        *(u32x2*)(orow + 8 * lane) = (u32x2){p[0], p[1]}; *(u32x2*)(orow + 512 + 8 * lane) = (u32x2){p[2], p[3]};
        if (lane == 0) RS[m0 + q] = m > 0.f ? m * (1.0f / 127.0f) : 1.0f;
    }
}
template <int NR> __device__ __forceinline__ void x_rows(ArgsRef a, int m0, int lane) {
    bf16_t* AB = (bf16_t*)(a.ws + WS_AB); float* ssq0 = (float*)(a.ws + WS_SSQ0);
    f32x4 v[NR][4];
#pragma unroll
    for (int q = 0; q < NR; ++q) { const int m = m0 + q;
        const float* xrow = (m < MP) ? a.in[0] + (size_t)m * D : a.in[1] + (size_t)(m - MP) * D;
        const f32x4* xr = (const f32x4*)xrow + lane;
#pragma unroll
        for (int j = 0; j < 4; ++j) v[q][j] = xr[64 * j]; }
    float t[NR + 1];
#pragma unroll
    for (int q = 0; q < NR; ++q) { float s = 0.f;
#pragma unroll
        for (int j = 0; j < 4; ++j) s += (v[q][j].x * v[q][j].x + v[q][j].y * v[q][j].y) + (v[q][j].z * v[q][j].z + v[q][j].w * v[q][j].w);
        t[q] = s; }
    t[NR] = 0.f;
#pragma unroll
    for (int q = 0; q < NR; q += 2) wave_sum2(t[q], t[q + 1]);
#pragma unroll
    for (int q = 0; q < NR; ++q) { const int m = m0 + q;
        u32x2* o8 = (u32x2*)(AB + (size_t)m * D) + lane;
#pragma unroll
        for (int j = 0; j < 4; ++j) { u32x2 w; w.x = cvt_pk_bf16(v[q][j].x, v[q][j].y); w.y = cvt_pk_bf16(v[q][j].z, v[q][j].w); o8[64 * j] = w; }
        if (lane < 16) ssq0[(size_t)m * 16 + lane] = (lane == 0) ? t[q] : 0.f; }
}

template <int NR> __device__ __forceinline__ void xq8_rows(ArgsRef a, int m0, int lane) {
    signed char* A8 = (signed char*)(a.ws + WS_A8); float* RS = (float*)(a.ws + WS_RS);
    f32x4 v[NR][4];
#pragma unroll
    for (int q = 0; q < NR; ++q) { const int m = m0 + q;
        const float* xrow = (m < MP) ? a.in[0] + (size_t)m * D : a.in[1] + (size_t)(m - MP) * D;
        const f32x4* xr = (const f32x4*)xrow + lane;
#pragma unroll
        for (int j = 0; j < 4; ++j) v[q][j] = xr[64 * j]; }
    float t[NR + 1], mxv[NR + 1];
#pragma unroll
    for (int q = 0; q < NR; ++q) { float s = 0.f, m = 0.f;
#pragma unroll
        for (int j = 0; j < 4; ++j) { s += (v[q][j].x * v[q][j].x + v[q][j].y * v[q][j].y) + (v[q][j].z * v[q][j].z + v[q][j].w * v[q][j].w);
            m = fmaxf(fmaxf(m, fmaxf(fabsf(v[q][j].x), fabsf(v[q][j].y))), fmaxf(fabsf(v[q][j].z), fabsf(v[q][j].w))); }
        t[q] = s; mxv[q] = m; }
    t[NR] = 0.f;
#pragma unroll
    for (int q = 0; q < NR; q += 2) wave_sum2(t[q], t[q + 1]);
#pragma unroll
    for (int q = 0; q < NR; ++q) { const int m = m0 + q;
        float mx = mxv[q]; mx = dpp_max16(mx); mx = max_rows4(mx);
        const float rstd = rsqrtf(t[q] * (1.0f / D) + EPS), inv = mx > 0.f ? 127.0f / mx : 0.f;
        unsigned* o4 = (unsigned*)(A8 + (size_t)m * D) + lane;
#pragma unroll
        for (int j = 0; j < 4; ++j) { const f32x4 x4 = v[q][j];
            o4[64 * j] = ((unsigned)(int)rintf(x4.x * inv) & 0xffu) | (((unsigned)(int)rintf(x4.y * inv) & 0xffu) << 8) | (((unsigned)(int)rintf(x4.z * inv) & 0xffu) << 16) | (((unsigned)(int)rintf(x4.w * inv) & 0xffu) << 24); }
        if (lane == 0) RS[m] = mx > 0.f ? mx * rstd * (1.0f / 127.0f) : 1.0f; }
}

__device__ __forceinline__ void p0_prologue(ArgsRef a, LAS unsigned char* lds, int wave_) {
    const int tid = wave_ * 64 + lane_now();
    const int lane = tid & 63, wave = tid >> 6;
    const int gw = blockIdx.x * 8 + wave, NGW = gridDim.x * 8;
    unsigned char* ws = a.ws;
    for (int nb = blockIdx.x; nb < NUP / 32; nb += gridDim.x) w8_strip(a.in[6], a.in[5], (signed char*)(ws + WS_W1Q), (float*)(ws + WS_CS1), nb, lds, wave, lane);
    { const int nsw = (NUP / 32) * 8, gwr = gw >= nsw ? gw - nsw : gw + NGW - nsw;
      weights_convert(a, lds, I_UP, NITEMS_EARLY, NGW > nsw ? gwr : gw, NGW, wave, lane); }
    for (int m0 = gw * 8; m0 < MP; m0 += NGW * 8) xq8_rows<8>(a, m0, lane);
    for (int m = MP + gw; m < M; m += NGW) xq8_rows<1>(a, m, lane);
    const int gt = blockIdx.x * 512 + tid, NGT = gridDim.x * 512;
    f32x2* rope = (f32x2*)(ws + WS_ROPE);
    for (int i = gt; i < TP * 8; i += NGT) {
        const int pos = i >> 3, k = i & 7;
        const float ang = (float)pos * a.inv[k];
        const double rev = (double)ang * 0.15915494309189535;
        const float fr = (float)(rev - rint(rev));
        rope[i] = (f32x2){__builtin_amdgcn_cosf(fr), __builtin_amdgcn_sinf(fr)};
    }
    bf16_t* KS = (bf16_t*)(ws + WS_KS); bf16_t* VTS = (bf16_t*)(ws + WS_VTS); bf16_t* US = (bf16_t*)(ws + WS_US);
    for (int i = gt; i < NBS * WIN * 128; i += NGT) {
        const int c = i & 127, row = (i >> 7) & (WIN - 1), b = i >> 14;
        const float kv = a.in[3][i], vv = a.in[4][i];
        KS[((size_t)(b * KSROWS + row)) * 128 + c] = f2bf(kv);
        VTS[((size_t)(b * 128 + c)) * KSROWS + row] = f2bf(vv);
        if (row >= TS) { a.out[O_KWS + ((size_t)(b * WIN + row - TS)) * 128 + c] = kv; a.out[O_VWS + ((size_t)(b * WIN + row - TS)) * 128 + c] = vv; }
    }
    for (int i = gt; i < NBS * 128 * 16; i += NGT) { const int k = i & 15, rowd = i >> 4; VTS[(size_t)rowd * KSROWS + WIN + TS + k] = 0; }
    for (int i = gt; i < NBS * HIST * CC; i += NGT) {
        const int c = i & (CC - 1), row = (i >> 9) % HIST, b = (i >> 9) / HIST;
        const float uv = a.in[2][i];
        US[((size_t)(b * USROWS + row)) * CC + c] = f2bf(uv);
        if (row >= TS) a.out[O_CSS + ((size_t)(b * HIST + row - TS)) * CC + c] = uv;
    }
}

constexpr int ATT_VT_OFF = 192 * 128, ATT_VT_STRIDE = 400, ATT_BUF = ATT_VT_OFF + 64 * ATT_VT_STRIDE;
constexpr int ATT_UNITS_P = NBP * (TP / 64) * 2, ATT_UNITS = ATT_UNITS_P + NBS * 2;
constexpr int CONV_UNITS = MP / 16 + NBS;

struct AttUnit { const bf16_t* kb; const bf16_t* vt; int nkt; bool sample; };
__device__ __forceinline__ AttUnit att_decode(unsigned char* ws, int unit) {
    AttUnit u;
    if (unit < ATT_UNITS_P) { const int kh = unit & 1, c = (unit >> 1) & 127, b = unit >> 8, cs = c >= 2 ? c - 2 : 0;
        u.nkt = (c - cs + 1) * 4; u.sample = false;
        u.kb = (const bf16_t*)(ws + WS_KP) + ((size_t)(b * TP + cs * 64)) * 128 + kh * 64;
        u.vt = (const bf16_t*)(ws + WS_VTP) + ((size_t)((b * 2 + kh) * (TP / 64) + cs)) * 4096; }
    else { const int p = unit - ATT_UNITS_P, b = p >> 1, kh = p & 1;
        u.nkt = 9; u.sample = true;
        u.kb = (const bf16_t*)(ws + WS_KS) + ((size_t)(b * KSROWS)) * 128 + kh * 64;
        u.vt = (const bf16_t*)(ws + WS_VTS) + ((size_t)((b * 2 + kh) * 64)) * KSROWS; }
    return u;
}
__device__ __forceinline__ void att_stage_load(const AttUnit& u, int tid, u32x4 (&kp)[3], u32x4 (&vp)[3]) {
    const int nk = u.nkt * 16;
#pragma unroll
    for (int i = 0; i < 3; ++i) {
        const int p = tid + 512 * i; int row = p >> 3; const int ch = p & 7; row = row < nk ? row : nk - 1;
        kp[i] = *(const u32x4*)(u.kb + (size_t)row * 128 + ch * 8);
        if (u.sample) { int pp = p < 1280 ? p : 1279; const int d = pp / 20, q = pp - d * 20; vp[i] = *(const u32x4*)(u.vt + (size_t)d * KSROWS + q * 8); }
        else { const int jmax = (u.nkt >> 2) - 1, j = i < jmax ? i : jmax; vp[i] = *(const u32x4*)(u.vt + (size_t)j * 4096 + (p & 511) * 8); }
    }
}
__device__ __forceinline__ void att_stage_write(const AttUnit& u, int tid, LAS unsigned char* buf, const u32x4 (&kp)[3], const u32x4 (&vp)[3]) {
    const int nk = u.nkt * 16;
#pragma unroll
    for (int i = 0; i < 3; ++i) {
        const int p = tid + 512 * i; int row = p >> 3; const int ch = p & 7; row = row < nk ? row : nk - 1;
        *(LAS u32x4*)(buf + row * 128 + ((ch ^ ((row >> 1) & 7)) << 4)) = kp[i];
        if (u.sample) { int pp = p < 1280 ? p : 1279; const int d = pp / 20, q = pp - d * 20; *(LAS u32x4*)(buf + ATT_VT_OFF + d * ATT_VT_STRIDE + q * 16) = vp[i]; }
        else { const int jmax = (u.nkt >> 2) - 1, j = i < jmax ? i : jmax; const int d = (p & 511) >> 3, q = p & 7; *(LAS u32x4*)(buf + ATT_VT_OFF + d * ATT_VT_STRIDE + j * 128 + q * 16) = vp[i]; }
    }
}
__device__ __forceinline__ void attn_compute(const bf16x8 (&qf)[2][2], LAS const unsigned char* buf, int nkt, float sink0, float sink1, bf16_t* o0, bf16_t* o1, int lane) {
    const int fr = lane & 15, g = lane >> 4;
    f32x4 S[2][12];
    const float NEG = -INFINITY;
#pragma unroll
    for (int kt = 0; kt < 12; ++kt) {
        const int ktc = kt < nkt ? kt : nkt - 1, row = ktc * 16 + fr, sw = (row >> 1) & 7;
        const bf16x8 k0 = *(LAS const bf16x8*)(buf + row * 128 + ((g ^ sw) << 4)), k1 = *(LAS const bf16x8*)(buf + row * 128 + (((g + 4) ^ sw) << 4));
        const bool ok = kt < nkt;
#pragma unroll
        for (int qt = 0; qt < 2; ++qt) {
            f32x4 c = (f32x4){0.f, 0.f, 0.f, 0.f};
            c = __builtin_amdgcn_mfma_f32_16x16x32_bf16(k0, qf[qt][0], c, 0, 0, 0);
            c = __builtin_amdgcn_mfma_f32_16x16x32_bf16(k1, qf[qt][1], c, 0, 0, 0);
            S[qt][kt] = ok ? c : (f32x4){NEG, NEG, NEG, NEG};
        }
    }
    bf16x8 pf[2][6]; float linv[2];
#pragma unroll
    for (int qt = 0; qt < 2; ++qt) {
        const float sink = qt ? sink1 : sink0;
        float mx = sink;
#pragma unroll
        for (int kt = 0; kt < 12; ++kt) mx = fmaxf(mx, fmaxf(fmaxf(S[qt][kt][0], S[qt][kt][1]), fmaxf(S[qt][kt][2], S[qt][kt][3])));
        mx = max_rows4(mx);
        float l = 0.f;
#pragma unroll
        for (int kt = 0; kt < 12; ++kt) {
#pragma unroll
            for (int j = 0; j < 4; ++j) { const float p = __builtin_amdgcn_exp2f(S[qt][kt][j] - mx); S[qt][kt][j] = p; l += p; }
        }
        l = sum_rows4(l);
        l += __builtin_amdgcn_exp2f(sink - mx);
        linv[qt] = 1.0f / l;
#pragma unroll
        for (int kk = 0; kk < 6; ++kk) {
            u32x4 w; w.x = cvt_pk_bf16(S[qt][2 * kk][0], S[qt][2 * kk][1]); w.y = cvt_pk_bf16(S[qt][2 * kk][2], S[qt][2 * kk][3]);
            w.z = cvt_pk_bf16(S[qt][2 * kk + 1][0], S[qt][2 * kk + 1][1]); w.w = cvt_pk_bf16(S[qt][2 * kk + 1][2], S[qt][2 * kk + 1][3]);
            pf[qt][kk] = __builtin_bit_cast(bf16x8, w);
        }
    }
    f32x4 O[2][4];
    const int kkmax = (nkt - 1) >> 1;
    LAS const unsigned char* vb = buf + ATT_VT_OFF + fr * ATT_VT_STRIDE + g * 8;
#pragma unroll
    for (int dt = 0; dt < 4; ++dt) {
        O[0][dt] = (f32x4){0.f, 0.f, 0.f, 0.f}; O[1][dt] = (f32x4){0.f, 0.f, 0.f, 0.f};
#pragma unroll
        for (int kk = 0; kk < 6; ++kk) {
            const int kkc = kk < kkmax ? kk : kkmax;
            const u32x2 a0 = *(LAS const u32x2*)(vb + dt * 16 * ATT_VT_STRIDE + kkc * 64), a1 = *(LAS const u32x2*)(vb + dt * 16 * ATT_VT_STRIDE + kkc * 64 + 32);
            u32x4 aw; aw.x = a0.x; aw.y = a0.y; aw.z = a1.x; aw.w = a1.y;
            const bf16x8 af = __builtin_bit_cast(bf16x8, aw);
            O[0][dt] = __builtin_amdgcn_mfma_f32_16x16x32_bf16(af, pf[0][kk], O[0][dt], 0, 0, 0);
            O[1][dt] = __builtin_amdgcn_mfma_f32_16x16x32_bf16(af, pf[1][kk], O[1][dt], 0, 0, 0);
        }
    }
#pragma unroll
    for (int qt = 0; qt < 2; ++qt) {
        bf16_t* ob = (qt ? o1 : o0) + (size_t)fr * D + 4 * g;
#pragma unroll
        for (int dt = 0; dt < 4; ++dt) {
            const f32x4 v = O[qt][dt] * linv[qt];
            u32x2 w; w.x = cvt_pk_bf16(v[0], v[1]); w.y = cvt_pk_bf16(v[2], v[3]);
            *(u32x2*)(ob + dt * 16) = w;
        }
    }
}

__device__ __forceinline__ void attn_phase(ArgsRef a, LAS unsigned char* lds, int tid, int first, int G) {
    asm volatile("" : "+v"(tid));
    unsigned char* ws = a.ws;
    const int lane = tid & 63, wave = __builtin_amdgcn_readfirstlane(tid >> 6), fr = lane & 15, g = lane >> 4;
    const bf16_t* Q = (const bf16_t*)(ws + WS_Q); bf16_t* MIX = (bf16_t*)(ws + WS_MIX);
    const float* sinks = a.in[12];
    if (first >= ATT_UNITS) return;
    AttUnit cur = att_decode(ws, first);
    u32x4 kp[3], vp[3];
    att_stage_load(cur, tid, kp, vp);
    int par = 0;
    for (int unit = first; unit < ATT_UNITS; unit += G, par ^= 1) {
        LAS unsigned char* buf = lds + par * ATT_BUF;
        att_stage_write(cur, tid, buf, kp, vp);
        const bf16_t* q0; const bf16_t* q1; bf16_t* o0; bf16_t* o1; float sk0, sk1; bool work;
        if (!cur.sample) { const int kh = unit & 1, c = (unit >> 1) & 127, b = unit >> 8, h = kh * 4 + (wave >> 1), tok0 = c * 64 + (wave & 1) * 32;
            q0 = Q + ((size_t)(b * TP + tok0)) * 512 + h * 64; q1 = q0 + 16 * 512;
            o0 = MIX + ((size_t)(b * TP + tok0)) * D + 512 + h * 64; o1 = o0 + 16 * D; sk0 = sk1 = sinks[h] * LOG2E; work = true; }
        else { const int p = unit - ATT_UNITS_P, b = p >> 1, kh = p & 1, h0 = kh * 4 + (wave & 1) * 2;
            q0 = Q + ((size_t)(MP + b * TS)) * 512 + h0 * 64; q1 = q0 + 64;
            o0 = MIX + ((size_t)(MP + b * TS)) * D + 512 + h0 * 64; o1 = o0 + 64; sk0 = sinks[h0] * LOG2E; sk1 = sinks[h0 + 1] * LOG2E; work = wave < 2; }
        bf16x8 qf[2][2];
        qf[0][0] = *(const bf16x8*)(q0 + fr * 512 + g * 8); qf[0][1] = *(const bf16x8*)(q0 + fr * 512 + 32 + g * 8);
        qf[1][0] = *(const bf16x8*)(q1 + fr * 512 + g * 8); qf[1][1] = *(const bf16x8*)(q1 + fr * 512 + 32 + g * 8);
        const int nkt = cur.nkt;
        __syncthreads();
        const int nu = unit + G < ATT_UNITS ? unit + G : unit;
        cur = att_decode(ws, nu);
        att_stage_load(cur, tid, kp, vp);
        if (work) attn_compute(qf, buf, nkt, sk0, sk1, o0, o1, lane);
    }
    __syncthreads();
}

struct ConvUnit { const bf16_t* ub; int jmin; size_t orow; };
__device__ __forceinline__ ConvUnit conv_decode(unsigned char* ws, int cu, int ch) {
    ConvUnit u;
    if (cu < MP / 16) { const int b = cu >> 9, t0 = (cu & 511) * 16; u.ub = (const bf16_t*)(ws + WS_UP) + ((size_t)(b * TP) + t0 - HIST) * CC + ch; u.jmin = HIST - t0; u.orow = (size_t)b * TP + t0; }
    else { const int b = cu - MP / 16; u.ub = (const bf16_t*)(ws + WS_US) + ((size_t)(b * USROWS)) * CC + ch; u.jmin = 0; u.orow = (size_t)MP + b * TS; }
    return u;
}
__device__ __forceinline__ void conv_phase(ArgsRef a, LAS unsigned char* lds, int tid, int first, int G) {
    asm volatile("" : "+v"(tid));
    unsigned char* ws = a.ws;
    const int ch = tid, wave = tid >> 6, lane = tid & 63;
    if (first >= CONV_UNITS) return;
    const float* wdw = a.in[13] + ch;
    float w[CW];
#pragma unroll
    for (int j = 0; j < CW; ++j) w[j] = wdw[j * CC];
    const float bias = a.in[14][ch];
    const f32x4 gc0 = *(const f32x4*)(a.in[15] + 4 * lane), gc1 = *(const f32x4*)(a.in[15] + 256 + 4 * lane);
    const f32x4 bc0 = *(const f32x4*)(a.in[16] + 4 * lane), bc1 = *(const f32x4*)(a.in[16] + 256 + 4 * lane);
    ConvUnit cur = conv_decode(ws, first, ch);
    bf16_t xr[HIST + 16];
#pragma unroll
    for (int j = 0; j < HIST + 16; ++j) { const int jc = j > cur.jmin ? j : cur.jmin; xr[j] = cur.ub[(size_t)jc * CC]; }
    int par = 0;
    for (int cu = first; cu < CONV_UNITS; cu += G, par ^= 1) {
        const int jmin = cur.jmin; const size_t orow = cur.orow;
        float acc[16];
#pragma unroll
        for (int i = 0; i < 16; ++i) acc[i] = bias;
#pragma unroll
        for (int j = 0; j < HIST + 16; ++j) {
            const float xv = (j >= jmin) ? bf2f(xr[j]) : 0.f;
#pragma unroll
            for (int i = 0; i < 16; ++i) { if (j - i >= 0 && j - i < CW) acc[i] += xv * w[j - i]; }
        }
        __builtin_amdgcn_sched_barrier(0);
        { const int nu = cu + G < CONV_UNITS ? cu + G : cu;
          cur = conv_decode(ws, nu, ch);
#pragma unroll
          for (int j = 0; j < HIST + 16; ++j) { const int jc = j > cur.jmin ? j : cur.jmin; xr[j] = cur.ub[(size_t)jc * CC]; } }
        __builtin_amdgcn_sched_barrier(0);
        LAS float* yb = (LAS float*)lds + par * (16 * CC);
#pragma unroll
        for (int i = 0; i < 16; ++i) yb[i * CC + ch] = acc[i];
        __syncthreads();
        bf16_t* MIX = (bf16_t*)(ws + WS_MIX) + orow * D;
        {
            const int tok = 2 * wave;
            f32x4 v0 = *(const LAS f32x4*)(yb + tok * CC + 4 * lane), v1 = *(const LAS f32x4*)(yb + tok * CC + 256 + 4 * lane);
            f32x4 z0 = *(const LAS f32x4*)(yb + (tok + 1) * CC + 4 * lane), z1 = *(const LAS f32x4*)(yb + (tok + 1) * CC + 256 + 4 * lane);
            float sa = (v0[0] + v0[1]) + (v0[2] + v0[3]) + (v1[0] + v1[1]) + (v1[2] + v1[3]);
            float sb = (z0[0] + z0[1]) + (z0[2] + z0[3]) + (z1[0] + z1[1]) + (z1[2] + z1[3]);
            wave_sum2(sa, sb);
            const float ma = sa * (1.0f / CC), mb = sb * (1.0f / CC);
            v0 = v0 - ma; v1 = v1 - ma; z0 = z0 - mb; z1 = z1 - mb;
            float qa = (v0[0] * v0[0] + v0[1] * v0[1]) + (v0[2] * v0[2] + v0[3] * v0[3]) + (v1[0] * v1[0] + v1[1] * v1[1]) + (v1[2] * v1[2] + v1[3] * v1[3]);
            float qb = (z0[0] * z0[0] + z0[1] * z0[1]) + (z0[2] * z0[2] + z0[3] * z0[3]) + (z1[0] * z1[0] + z1[1] * z1[1]) + (z1[2] * z1[2] + z1[3] * z1[3]);
            wave_sum2(qa, qb);
            const float ra = rsqrtf(qa * (1.0f / CC) + EPS), rb = rsqrtf(qb * (1.0f / CC) + EPS);
            v0 = v0 * ra * gc0 + bc0; v1 = v1 * ra * gc1 + bc1; z0 = z0 * rb * gc0 + bc0; z1 = z1 * rb * gc1 + bc1;
            u32x2 o0, o1, p0, p1;
            o0.x = cvt_pk_bf16(silu_f(v0[0]), silu_f(v0[1])); o0.y = cvt_pk_bf16(silu_f(v0[2]), silu_f(v0[3]));
            o1.x = cvt_pk_bf16(silu_f(v1[0]), silu_f(v1[1])); o1.y = cvt_pk_bf16(silu_f(v1[2]), silu_f(v1[3]));
            p0.x = cvt_pk_bf16(silu_f(z0[0]), silu_f(z0[1])); p0.y = cvt_pk_bf16(silu_f(z0[2]), silu_f(z0[3]));
            p1.x = cvt_pk_bf16(silu_f(z1[0]), silu_f(z1[1])); p1.y = cvt_pk_bf16(silu_f(z1[2]), silu_f(z1[3]));
            *(u32x2*)(MIX + (size_t)tok * D + 4 * lane) = o0; *(u32x2*)(MIX + (size_t)tok * D + 256 + 4 * lane) = o1;
            *(u32x2*)(MIX + (size_t)(tok + 1) * D + 4 * lane) = p0; *(u32x2*)(MIX + (size_t)(tok + 1) * D + 256 + 4 * lane) = p1;
        }
    }
    __syncthreads();
}

#define XB_TMO      128
#define XB_XCNT(j)  (256  + 64 * (j))
#define XB_XSUB(j)  (1280 + 64 * (j))
#define XB_XGEN(j)  (2304 + 64 * (j))
#define XB_TOP      3328
#define XB_TOPGEN   3392
#define XCD_BAR_WORDS 3456
#define XB_SPIN_CAP (1u << 18)
__device__ __forceinline__ unsigned xb_ld(unsigned* p)              { return __hip_atomic_load(p, __ATOMIC_RELAXED, __HIP_MEMORY_SCOPE_AGENT); }
__device__ __forceinline__ unsigned xb_add(unsigned* p, unsigned v) { return __hip_atomic_fetch_add(p, v, __ATOMIC_RELAXED, __HIP_MEMORY_SCOPE_AGENT); }
__device__ __forceinline__ unsigned xb_xcc_id() { return (unsigned)__builtin_amdgcn_s_getreg((3 << 11) | 20) & 0xFu; }
#define XB_SPIN(cond, bar) do { unsigned _sp = 0; while (cond) { __builtin_amdgcn_s_sleep(1); \
    if ((++_sp & 255u) == 0u) { if (xb_ld(&(bar)[XB_TMO])) break; if (_sp > XB_SPIN_CAP) { atomicAdd(&(bar)[XB_TMO], 1u); break; } } } } while (0)
struct XcdBarrier { unsigned* bar; unsigned x; volatile LAS unsigned* st; };
__device__ __forceinline__ XcdBarrier xcd_barrier_post(unsigned* bar, volatile LAS unsigned* st, int wave_) {
    XcdBarrier b; b.bar = bar; b.x = (unsigned)__builtin_amdgcn_readfirstlane((int)xb_xcc_id()); b.st = st;
    if (wave_ == 0 && lane_now() == 0) (void)xb_add(&bar[XB_XCNT(b.x)], 1u);
    return b;
}
__device__ __forceinline__ void xcd_barrier_complete(unsigned* bar, unsigned x, unsigned& nloc, unsigned& nx) {
    const unsigned G = gridDim.x * gridDim.y * gridDim.z;
    unsigned sum, cnt, mine, sp = 0u;
    for (;;) {
        sum = 0u; cnt = 0u; mine = 0u;
#pragma unroll
        for (unsigned j = 0; j < 16; ++j) { const unsigned c = xb_ld(&bar[XB_XCNT(j)]); sum += c; cnt += (c > 0u) ? 1u : 0u; mine = (j == x) ? c : mine; }
        if (sum == G) break;
        __builtin_amdgcn_s_sleep(1);
        if ((++sp & 255u) == 0u) { if (xb_ld(&bar[XB_TMO])) break; if (sp > XB_SPIN_CAP) { atomicAdd(&bar[XB_TMO], 1u); break; } }
    }
    nloc = mine > 0u ? mine : 1u; nx = cnt > 0u ? cnt : 1u;
}
__device__ __forceinline__ void xcd_barrier(const XcdBarrier& b, int wave_) {
    asm volatile("s_waitcnt vmcnt(0)" ::: "memory");
    __syncthreads();
    if (wave_ == 0 && lane_now() == 0) {
        unsigned* bar = b.bar; unsigned bx = b.x; asm volatile("" : "+s"(bx));
        __builtin_amdgcn_s_waitcnt(0);
        unsigned nloc = b.st[0], nx = b.st[1];
        if (nloc == 0u) { xcd_barrier_complete(bar, bx, nloc, nx); b.st[0] = nloc; b.st[1] = nx; }
        const unsigned old = xb_add(&bar[XB_XSUB(bx)], 1u);
        const unsigned gen = old / nloc;
        if (old + 1u == (gen + 1u) * nloc) {
            __builtin_amdgcn_fence(__ATOMIC_RELEASE, "agent");
            asm volatile("s_waitcnt vmcnt(0)" ::: "memory");
            const unsigned og = xb_add(&bar[XB_TOP], 1u);
            const unsigned tg = og / nx;
            if (og + 1u == (tg + 1u) * nx) xb_add(&bar[XB_TOPGEN], 1u);
            else XB_SPIN(xb_ld(&bar[XB_TOPGEN]) == tg, bar);
            __builtin_amdgcn_fence(__ATOMIC_ACQUIRE, "agent");
            xb_add(&bar[XB_XGEN(bx)], 1u);
            asm volatile("s_waitcnt vmcnt(0)" ::: "memory");
        } else {
            XB_SPIN(xb_ld(&bar[XB_XGEN(bx)]) == gen, bar);
            __builtin_amdgcn_fence(__ATOMIC_ACQUIRE, "agent");
            asm volatile("s_waitcnt vmcnt(0)" ::: "memory");
        }
    }
    __syncthreads();
}
constexpr int MISC_OFF = 151552;
constexpr size_t CTL_ZERO_BYTES = 65536;
constexpr int CW_BAR = 4096;

__global__ void __launch_bounds__(512, 2) hymba_fwd(Args a_) {
    extern __shared__ __attribute__((aligned(16))) unsigned char lds_raw[];
    LAS unsigned char* lds = (LAS unsigned char*)lds_raw;
    unsigned char* ws = a_.ws;
    const int wave = __builtin_amdgcn_readfirstlane((int)threadIdx.x >> 6);
#define lane lane_now()
#define tid (wave * 64 + lane_now())
    const int G = gridDim.x, bid = blockIdx.x;
    for (int u = wave * 64 + lane_now(); u < (LDS_BYTES - MISC_OFF) / 4; u += 512) ((LAS unsigned*)(lds + MISC_OFF))[u] = 0u;
    __syncthreads();
    const XcdBarrier bar = xcd_barrier_post((unsigned*)ws + CW_BAR, (volatile LAS unsigned*)(lds + MISC_OFF) + 8, wave);
#define GRID_BAR() xcd_barrier(bar, wave)

    bf16_t* AB = (bf16_t*)(ws + WS_AB); bf16_t* ACT = (bf16_t*)(ws + WS_ACT);
    float* ssq0 = (float*)(ws + WS_SSQ0); float* ssq1 = (float*)(ws + WS_SSQ1); float* ssq2 = (float*)(ws + WS_SSQ2);

#ifndef PROBE_DUP
#define PROBE_DUP -1
#endif
#ifndef PHASE_MASK
#define PHASE_MASK 0xff
#endif
#define REPS(k) if (PHASE_MASK & (1 << (k))) for (int rep_ = 0; rep_ < ((PROBE_DUP == (k)) ? 2 : 1); ++rep_)
#define ARGS_HERE() ArgsRef a = *args_now()
    REPS(0) { ARGS_HERE(); p0_prologue(a, lds, wave); GRID_BAR(); }
    REPS(1) {
    { int bs_ = bid, gs_ = G; asm volatile("" : "+s"(bs_), "+s"(gs_));
      pg8::Gemm g{(const bf16_t*)(ws + WS_A8), (const bf16_t*)(ws + WS_W1Q), MP, NUP, D / 2}; pg8::StaticOrder S; S.init(MP, NUP, gs_, bs_);
      EpiSwigluI8 E{ACT, (const float*)(ws + WS_RS), (const float*)(ws + WS_CS1), lds};
      for (int pass = 0; pass < 2; ++pass) { if (((pass ^ (bs_ >> 6)) & 1) == 0) { pg8::gemm_phase<EpiSwigluI8, pg8::StaticOrder, true, true, true>(lds, g, S, E, wave); } else { small_gemm<1, 4, true>((const bf16_t*)(ws + WS_A8), (const bf16_t*)(ws + WS_W1Q), NUP, D / 2, E, lds, bs_, gs_, wave, lane); } } }
    GRID_BAR(); }
    REPS(2) {
    { int bs_ = bid, gs_ = G; asm volatile("" : "+s"(bs_), "+s"(gs_));
      pg8::Gemm g{ACT, (const bf16_t*)(ws + WS_W2T), MP, D, FF}; pg8::StaticOrder S; S.init(MP, D, gs_, bs_);
      ARGS_HERE(); EpiResid<0> E{a.in[0], a.in[1], nullptr, AB, ssq1, 0.5f};
      for (int pass = 0; pass < 2; ++pass) { if (((pass ^ (bs_ >> 6)) & 1) == 0) { pg8::gemm_phase<EpiResid<0>, pg8::StaticOrder, true, true>(lds, g, S, E, wave); } else { small_gemm<8, 2, false>(ACT, (const bf16_t*)(ws + WS_W2T), D, FF, E, lds, bs_, gs_, wave, lane); } } }
    GRID_BAR(); }
    REPS(3) {
    { int bs_ = bid, gs_ = G; asm volatile("" : "+s"(bs_), "+s"(gs_));
      pg8::Gemm g{AB, (const bf16_t*)(ws + WS_WINT), MP, NIN, D}; pg8::StaticOrder S; S.init(MP, NIN, gs_, bs_);
      ARGS_HERE(); EpiInProj E{ws, a.in[10], a.in[11], a.out, lds};
      pg8::gemm_phase<EpiInProj, pg8::StaticOrder, true, true>(lds, g, S, E, wave);
      small_gemm<1, 4, false>(AB, (const bf16_t*)(ws + WS_WINT), NIN, D, E, lds, gs_ - 1 - bs_, gs_, wave, lane, 2);
      if (rep_ == 0 && bid >= G / 2) { int ln = lane; asm volatile("" : "+v"(ln));
        weights_convert(a, lds, NITEMS_EARLY + I_UP, NITEMS, (bid - G / 2) * 8 + wave, (G - G / 2) * 8, wave, ln);
        __syncthreads();
        for (int nb = bid - G / 2; nb < NUP / 32; nb += G - G / 2) w8_strip(a.in[19], a.in[18], (signed char*)(ws + WS_W3Q), (float*)(ws + WS_CS3), nb, lds, wave, ln); } }
    GRID_BAR(); }
    REPS(4) {
#ifndef PROBE_P4SUB
#define PROBE_P4SUB 0
#endif
    ARGS_HERE();
    if (!(rep_ == 1 && PROBE_P4SUB == 2)) attn_phase(a, lds, tid, bid, G);
    if (!(rep_ == 1 && PROBE_P4SUB == 1)) conv_phase(a, lds, tid, G - 1 - bid, G);
    GRID_BAR(); }
    REPS(5) {
    { int bs_ = bid, gs_ = G; asm volatile("" : "+s"(bs_), "+s"(gs_));
      pg8::Gemm g{(const bf16_t*)(ws + WS_MIX), (const bf16_t*)(ws + WS_WOT), MP, D, D}; pg8::StaticOrder S; S.init(MP, D, gs_, bs_);
      EpiResid<1> E{nullptr, nullptr, nullptr, AB, ssq2, 1.0f};
      for (int pass = 0; pass < 2; ++pass) { if (((pass ^ (bs_ >> 6)) & 1) == 0) { pg8::gemm_phase<EpiResid<1>, pg8::StaticOrder, true, true>(lds, g, S, E, wave); } else { small_gemm<8, 2, false>((const bf16_t*)(ws + WS_MIX), (const bf16_t*)(ws + WS_WOT), D, D, E, lds, bs_, gs_, wave, lane); } } }
    GRID_BAR(); }
    { const int gw = bid * 8 + wave, NGW = G * 8; int ln = lane; asm volatile("" : "+v"(ln));
      for (int m0 = gw * 4; m0 < M; m0 += NGW * 4) q8_rows<4>(ws, ssq2, m0, ln);
      GRID_BAR(); }
    REPS(6) {
    { int bs_ = bid, gs_ = G; asm volatile("" : "+s"(bs_), "+s"(gs_));
      pg8::Gemm g{(const bf16_t*)(ws + WS_A8), (const bf16_t*)(ws + WS_W3Q), MP, NUP, D / 2}; pg8::StaticOrder S; S.init(MP, NUP, gs_, bs_);
      EpiSwigluI8 E{ACT, (const float*)(ws + WS_RS), (const float*)(ws + WS_CS3), lds};
      for (int pass = 0; pass < 2; ++pass) { if (((pass ^ (bs_ >> 6)) & 1) == 0) { pg8::gemm_phase<EpiSwigluI8, pg8::StaticOrder, true, true, true>(lds, g, S, E, wave); } else { small_gemm<1, 4, true>((const bf16_t*)(ws + WS_A8), (const bf16_t*)(ws + WS_W3Q), NUP, D / 2, E, lds, bs_, gs_, wave, lane); } } }
    GRID_BAR(); }
    REPS(7) { int bs_ = bid, gs_ = G; asm volatile("" : "+s"(bs_), "+s"(gs_));
      pg8::Gemm g{ACT, (const bf16_t*)(ws + WS_W4T), MP, D, FF}; pg8::StaticOrder S; S.init(MP, D, gs_, bs_);
      ARGS_HERE(); EpiResid<2> E{nullptr, nullptr, a.out, AB, nullptr, 0.5f};
      for (int pass = 0; pass < 2; ++pass) { if (((pass ^ (bs_ >> 6)) & 1) == 0) { pg8::gemm_phase<EpiResid<2>, pg8::StaticOrder, true, true>(lds, g, S, E, wave); } else { small_gemm<8, 2, false>(ACT, (const bf16_t*)(ws + WS_W4T), D, FF, E, lds, bs_, gs_, wave, lane); } } }
}
#undef lane
#undef tid

extern "C" void kernel_launch(void* const* d_in, const int* in_sizes, int n_in, void* d_out, int out_size, void* d_ws, size_t ws_size, hipStream_t stream) {
    static int grid = 0;
    if (grid == 0) {
        if (n_in != 21 || (size_t)out_size != O_END || ws_size < WS_END) { fprintf(stderr, "kernel_launch: unexpected shapes: n_in %d out %d ws %zu (need %zu)\n", n_in, out_size, ws_size, (size_t)WS_END); grid = -1; return; }
        int dev = 0, cus = 0, per_cu = 0;
        (void)hipGetDevice(&dev);
        (void)hipDeviceGetAttribute(&cus, hipDeviceAttributeMultiprocessorCount, dev);
        if (cus != 256) fprintf(stderr, "kernel_launch: note: built for a 256-CU device (one workgroup per CU), this device reports %d\n", cus);
        if (hipFuncSetAttribute((const void*)hymba_fwd, hipFuncAttributeMaxDynamicSharedMemorySize, LDS_BYTES) != hipSuccess) { fprintf(stderr, "kernel_launch: hipFuncSetAttribute failed\n"); grid = -1; return; }
        if (hipOccupancyMaxActiveBlocksPerMultiprocessor(&per_cu, (const void*)hymba_fwd, 512, LDS_BYTES) != hipSuccess || per_cu < 1) { fprintf(stderr, "kernel_launch: occupancy query failed (%d)\n", per_cu); grid = -1; (void)hipGetLastError(); return; }
        grid = cus;
    }
    if (grid < 0) return;
    Args a{};
    for (int i = 0; i < 21; ++i) a.in[i] = (const float*)d_in[i];
    a.out = (float*)d_out; a.ws = (unsigned char*)d_ws;
    for (int i = 0; i < 8; ++i) a.inv[i] = powf(500000.0f, -(float)i / 8.0f);
    if (hipMemsetAsync(d_ws, 0, CTL_ZERO_BYTES, stream) != hipSuccess) { fprintf(stderr, "kernel_launch: memset failed\n"); return; }
    hipLaunchKernelGGL(hymba_fwd, dim3(grid), dim3(512), LDS_BYTES, stream, a);
    const hipError_t e = hipPeekAtLastError();
    if (e != hipSuccess) fprintf(stderr, "kernel_launch: launch failed: %s (grid %d)\n", hipGetErrorString(e), grid);
}
```

```cpp
#include <hip/hip_runtime.h>
#include <cstdio>
#include <cstdint>
#include <cmath>

#define LAS __attribute__((address_space(3)))
typedef unsigned short bf16_t;
typedef short bf16x8 __attribute__((ext_vector_type(8)));
typedef float f32x4 __attribute__((ext_vector_type(4)));
typedef float f32x2 __attribute__((ext_vector_type(2)));
typedef unsigned u32x4 __attribute__((ext_vector_type(4)));
typedef unsigned u32x2 __attribute__((ext_vector_type(2)));
typedef int i32x4 __attribute__((ext_vector_type(4)));

constexpr int D = 1024, TP = 8192, NBP = 4, NBS = 32, TS = 16, MP = NBP * TP, MS = NBS * TS, M = MP + MS;
constexpr int FF = 2816, NUP = 2 * FF, NIN = 1792, CC = 512, HD = 64, PAST = 4096;
constexpr int CW = 31, HIST = CW - 1, WIN = 128;
constexpr int KSROWS = 160;
constexpr int USROWS = HIST + TS;
constexpr float EPS = 1e-6f;
constexpr float LOG2E = 1.4426950408889634f;
constexpr float QSCALE = 0.125f * LOG2E;

constexpr size_t O_YP = 0, O_YS = (size_t)MP * D, O_CSP = O_YS + (size_t)MS * D, O_KWP = O_CSP + (size_t)NBP * HIST * CC,
                 O_VWP = O_KWP + (size_t)NBP * WIN * 128, O_CSS = O_VWP + (size_t)NBP * WIN * 128, O_KWS = O_CSS + (size_t)NBS * HIST * CC,
                 O_VWS = O_KWS + (size_t)NBS * WIN * 128, O_END = O_VWS + (size_t)NBS * WIN * 128;

constexpr size_t al(size_t x) { return (x + 4095) & ~(size_t)4095; }
constexpr size_t WS_CTL = 0;
constexpr size_t WS_W1T = 1u << 20;
constexpr size_t WS_W2T = WS_W1T + al((size_t)NUP * D * 2);
constexpr size_t WS_WINT = WS_W2T + al((size_t)D * FF * 2);
constexpr size_t WS_WOT = WS_WINT + al((size_t)NIN * D * 2);
constexpr size_t WS_W3T = WS_WOT + al((size_t)D * D * 2);
constexpr size_t WS_W4T = WS_W3T + al((size_t)NUP * D * 2);
constexpr size_t WS_ROPE = WS_W4T + al((size_t)D * FF * 2);
constexpr size_t WS_SSQ0 = WS_ROPE + al((size_t)TP * 8 * 8);
constexpr size_t WS_SSQ1 = WS_SSQ0 + al((size_t)M * 16 * 4);
constexpr size_t WS_SSQ2 = WS_SSQ1 + al((size_t)M * 16 * 4);
constexpr size_t WS_KS = WS_SSQ2 + al((size_t)M * 16 * 4);
constexpr size_t WS_VTS = WS_KS + al((size_t)NBS * KSROWS * 128 * 2);
constexpr size_t WS_US = WS_VTS + al((size_t)NBS * 128 * KSROWS * 2);
constexpr size_t WS_AB = WS_US + al((size_t)NBS * USROWS * CC * 2);
constexpr size_t WS_X1 = WS_AB + al((size_t)M * D * 2);
constexpr size_t WS_ACT = WS_X1 + al((size_t)M * D * 4);
constexpr size_t WS_A8 = WS_X1;
constexpr size_t WS_W3Q = WS_A8 + al((size_t)M * D);
constexpr size_t WS_W1Q = WS_W3Q + al((size_t)NUP * D);
constexpr size_t WS_RS = WS_W1Q + al((size_t)NUP * D);
constexpr size_t WS_CS3 = WS_RS + al((size_t)M * 4);
constexpr size_t WS_CS1 = WS_CS3 + al((size_t)NUP * 4);
static_assert(WS_CS1 + (size_t)NUP * 4 <= WS_ACT, "int8 operands fit in the f32 scratch");
constexpr size_t WS_END = WS_ACT + al((size_t)M * FF * 2);
constexpr size_t WS_UP = WS_ACT;
constexpr size_t WS_Q = WS_UP + al((size_t)MP * CC * 2);
constexpr size_t WS_KP = WS_Q + al((size_t)M * 512 * 2);
constexpr size_t WS_VTP = WS_KP + al((size_t)MP * 128 * 2);
constexpr size_t WS_MIX = WS_VTP + al((size_t)MP * 128 * 2);
static_assert(WS_MIX + (size_t)M * D * 2 <= WS_END, "overlay fits");

constexpr int LDS_BYTES = 155648;
constexpr int SSQ_LDS_OFF = 131072;

__device__ __forceinline__ unsigned cvt_pk_bf16(float lo, float hi) { unsigned r; asm volatile("v_cvt_pk_bf16_f32 %0, %1, %2" : "=v"(r) : "v"(lo), "v"(hi)); return r; }
__device__ __forceinline__ float bf2f(bf16_t h) { return __uint_as_float((unsigned)h << 16); }
__device__ __forceinline__ bf16_t f2bf(float f) { return (bf16_t)(cvt_pk_bf16(f, 0.f) & 0xffffu); }
__device__ __forceinline__ float silu_f(float a) { return a * __builtin_amdgcn_rcpf(1.0f + __builtin_amdgcn_exp2f(-a * LOG2E)); }
__device__ __forceinline__ float sigmoid_f(float a) { return __builtin_amdgcn_rcpf(1.0f + __builtin_amdgcn_exp2f(-a * LOG2E)); }
__device__ __forceinline__ float sum_rows4(float x) {
    float a = x, b = x;
    asm volatile("s_nop 1\n\tv_permlane16_swap_b32 %0, %1" : "+v"(a), "+v"(b));
    float t = a + b; a = t; b = t;
    asm volatile("s_nop 1\n\tv_permlane32_swap_b32 %0, %1" : "+v"(a), "+v"(b));
    return a + b;
}
__device__ __forceinline__ float max_rows4(float x) {
    float a = x, b = x;
    asm volatile("s_nop 1\n\tv_permlane16_swap_b32 %0, %1" : "+v"(a), "+v"(b));
    float t = fmaxf(a, b); a = t; b = t;
    asm volatile("s_nop 1\n\tv_permlane32_swap_b32 %0, %1" : "+v"(a), "+v"(b));
    return fmaxf(a, b);
}
__device__ __forceinline__ float dpp_max8(float v) {
    v = fmaxf(v, __builtin_bit_cast(float, __builtin_amdgcn_update_dpp(0, __builtin_bit_cast(int, v), 0xB1, 0xF, 0xF, true)));
    v = fmaxf(v, __builtin_bit_cast(float, __builtin_amdgcn_update_dpp(0, __builtin_bit_cast(int, v), 0x4E, 0xF, 0xF, true)));
    v = fmaxf(v, __builtin_bit_cast(float, __builtin_amdgcn_update_dpp(0, __builtin_bit_cast(int, v), 0x141, 0xF, 0xF, true)));
    return v;
}
__device__ __forceinline__ float dpp_max16(float v) {
    v = dpp_max8(v);
    return fmaxf(v, __builtin_bit_cast(float, __builtin_amdgcn_update_dpp(0, __builtin_bit_cast(int, v), 0x140, 0xF, 0xF, true)));
}
__device__ __forceinline__ float dpp_row_sum(float v) {
    v += __builtin_bit_cast(float, __builtin_amdgcn_update_dpp(0, __builtin_bit_cast(int, v), 0xB1, 0xF, 0xF, true));
    v += __builtin_bit_cast(float, __builtin_amdgcn_update_dpp(0, __builtin_bit_cast(int, v), 0x4E, 0xF, 0xF, true));
    v += __builtin_bit_cast(float, __builtin_amdgcn_update_dpp(0, __builtin_bit_cast(int, v), 0x124, 0xF, 0xF, true));
    v += __builtin_bit_cast(float, __builtin_amdgcn_update_dpp(0, __builtin_bit_cast(int, v), 0x128, 0xF, 0xF, true));
    return v;
}
__device__ __forceinline__ void wave_sum2(float& a, float& b) {
    a = dpp_row_sum(a); b = dpp_row_sum(b);
    a = sum_rows4(a); b = sum_rows4(b);
}
__device__ __forceinline__ float row_rstd(const float* ssq, int r) {
    const f32x4* p = (const f32x4*)(ssq + (size_t)r * 16);
    const f32x4 a = p[0], b = p[1], c = p[2], d = p[3];
    const f32x4 s = (a + b) + (c + d);
    return rsqrtf(((s.x + s.y) + (s.z + s.w)) * (1.0f / D) + EPS);
}

__device__ __forceinline__ int lane_now() { int l; asm volatile("v_mbcnt_lo_u32_b32 %0, -1, 0\n\tv_mbcnt_hi_u32_b32 %0, -1, %0" : "=v"(l)); return l; }
namespace pg8 {
constexpr int BM = 256, BK = 64, HALF = 128, HTB = HALF * BK * 2, STAGE_BYTES = 8 * HTB, NXCD = 8, WGM = 8;
__host__ __device__ __forceinline__ int lds_byte(int r, int c) { const int st = (r >> 4) * 2 + (c >> 5), rr = r & 15, cc = c & 31, ob = rr * 64 + cc * 2; return st * 1024 + (ob ^ (((ob >> 9) & 1) << 5)); }
__host__ __device__ __forceinline__ void stage_rc(int b, int& R, int& C) { const int st = b / 1024, sb = b % 1024, swz = sb ^ (((sb >> 9) & 1) << 5); R = (st >> 1) * 16 + swz / 64; C = (st & 1) * 32 + (swz % 64) / 2; }
__host__ __device__ __forceinline__ int perm32(int rho) { const int n = rho >> 4, i = rho & 15; return 8 * (i >> 2) + 4 * n + (i & 3); }

struct Unit { int pm, pn; };
struct Gemm { const bf16_t* A; const bf16_t* Bt; int M, N, K; };

struct StaticOrder {
    int nM, nN, nwg, G, c, wgm;
    __host__ __device__ void init(int M_, int N_, int G_, int c_, int wgm_ = WGM) { nM = M_ / BM; nN = N_ / BM; nwg = nM * nN; G = G_; c = c_; wgm = wgm_; }
    __host__ __device__ bool next(int i, Unit& u) const {
        const long L = (long)i * G + c; if (L >= nwg) return false;
        int wgid = (int)L; { const int q = nwg / NXCD, r = nwg % NXCD, xcd = wgid % NXCD, off = wgid / NXCD; wgid = (xcd < r ? xcd * (q + 1) : r * (q + 1) + (xcd - r) * q) + off; }
        const int nig = wgm * nN, gid = wgid / nig, fm = gid * wgm, gsz = (nM - fm) < wgm ? (nM - fm) : wgm;
        u.pm = fm + ((wgid % nig) % gsz); u.pn = (wgid % nig) / gsz; return true;
    }
    __device__ __forceinline__ void a_ready(const Unit&) const {}
    __device__ __forceinline__ void done(const Unit&) const {}
};

__device__ __forceinline__ f32x4 mma16(bf16x8 b, bf16x8 a, f32x4 c) { return __builtin_amdgcn_mfma_f32_16x16x32_bf16(b, a, c, 0, 0, 0); }
__device__ __forceinline__ i32x4 mma16(bf16x8 b, bf16x8 a, i32x4 c) { return __builtin_amdgcn_mfma_i32_16x16x64_i8(__builtin_bit_cast(i32x4, b), __builtin_bit_cast(i32x4, a), c, 0, 0, 0); }
template <bool I8> struct AccT { typedef f32x4 type; };
template <> struct AccT<true> { typedef i32x4 type; };
template <class Epi, class Sched, bool ALIGN_EPI, bool SP2, bool I8 = false>
__device__ __forceinline__ void gemm_phase(LAS unsigned char* lds, const Gemm g, const Sched& S, const Epi& E, int wave_) {
    static_assert(ALIGN_EPI && SP2, "only the aligned-epilogue, two-MFMA-cluster schedule is kept");
    const int tid = wave_ * 64 + lane_now();
    const int wid = wave_, lane = tid & 63, wr = wid >> 2, wc = wid & 3, fr = lane & 15, fq = lane >> 4;
    const int K = g.K, nt = K / BK;
    unsigned voffA, voffB;
    { int R, C; stage_rc(tid * 16, R, C); const int Rb = Epi::PERM ? ((R & ~31) + perm32(R & 31)) : R; voffA = (unsigned)(R * K + C) * 2u; voffB = (unsigned)(Rb * K + C) * 2u; }
    const __amdgpu_buffer_rsrc_t srdA = __builtin_amdgcn_make_buffer_rsrc((void*)g.A, (short)0, -1, 0x00020000);
    const __amdgpu_buffer_rsrc_t srdB = __builtin_amdgcn_make_buffer_rsrc((void*)g.Bt, (short)0, -1, 0x00020000);
    const unsigned kstep = BK * 2u, hstep = (unsigned)HALF * (unsigned)K * 2u, tstep = 2u * hstep, pstep = 64u * (unsigned)K * 2u;
    const unsigned ldsb = (unsigned)(size_t)lds + (unsigned)wid * 1024u;
    const int aoff = lds_byte(wr * 64 + fr, fq * 8), boff = lds_byte(wc * 32 + fr, fq * 8);
#define PG8_SA(b, h) (((b) * 2 + (h)) * HTB)
#define PG8_SB(b, h) ((4 + (b) * 2 + (h)) * HTB)
#define PG8_STAGE(bufoff, srd, soff, voff) do { _Pragma("unroll") for (int _i = 0; _i < 2; ++_i) \
        asm volatile("s_add_u32 m0, %0, %4\n\ts_nop 0\n\tbuffer_load_dwordx4 %1, %2, %3 offen lds" :: "s"(ldsb), "v"(voff), "s"(srd), "s"((soff) + _i * pstep), "n"((bufoff) + _i * 8192) : "m0", "scc", "memory"); } while (0)
#define PG8_STA(b, h, soff) PG8_STAGE(PG8_SA(b, h), srdA, soff, voffA)
#define PG8_STB(b, h, soff) PG8_STAGE(PG8_SB(b, h), srdB, soff, voffB)
#define PG8_LDA(dst, b, h) do { _Pragma("unroll") for (int m = 0; m < 4; ++m) _Pragma("unroll") for (int k = 0; k < 2; ++k) dst[m][k] = *(const LAS bf16x8*)(lds + PG8_SA(b, h) + aoff + m * 2048 + k * 1024); } while (0)
#define PG8_LDB(dst, b, h) do { _Pragma("unroll") for (int n = 0; n < 2; ++n) _Pragma("unroll") for (int k = 0; k < 2; ++k) dst[n][k] = *(const LAS bf16x8*)(lds + PG8_SB(b, h) + boff + n * 2048 + k * 1024); } while (0)
#define PG8_MMA(ai, bj, At, Bt) do { __builtin_amdgcn_s_setprio(1); _Pragma("unroll") for (int m = 0; m < 4; ++m) _Pragma("unroll") for (int n = 0; n < 2; ++n) _Pragma("unroll") for (int k = 0; k < 2; ++k) \
        acc[ai][bj][m][n] = mma16(Bt[n][k], At[m][k], acc[ai][bj][m][n]); __builtin_amdgcn_s_setprio(0); } while (0)
#define PG8_MMAZ(ai, bj, At, Bt) do { __builtin_amdgcn_s_setprio(1); _Pragma("unroll") for (int m = 0; m < 4; ++m) _Pragma("unroll") for (int n = 0; n < 2; ++n) { \
        acc[ai][bj][m][n] = mma16(Bt[n][0], At[m][0], acc_t{}); acc[ai][bj][m][n] = mma16(Bt[n][1], At[m][1], acc[ai][bj][m][n]); } __builtin_amdgcn_s_setprio(0); } while (0)
#define PG8_WAIT_V(n) asm volatile("s_waitcnt vmcnt(%0)" :: "n"(n) : "memory")
#define PG8_WAIT_L(n) asm volatile("s_waitcnt lgkmcnt(" #n ")" ::: "memory")
#define PG8_BAR __builtin_amdgcn_s_barrier()
#define PG8_SCHED __builtin_amdgcn_sched_barrier(0)
#ifndef PG8_RELAX
#define PG8_RELAX 1
#endif
#define PG8_WAIT_R(relaxed, nst) do { if (relaxed) PG8_WAIT_V(8 + PG8_RELAX * (nst)); else PG8_WAIT_V(8); } while (0)
#define PG8_TRIP(first, relaxed, nst) do { \
            PG8_LDB(B0, 0, 0); PG8_LDB(B1, 0, 1); PG8_SCHED; PG8_LDA(At, 0, 0); if (!(first)) PG8_STA(1, 1, a1 + hstep); \
            PG8_WAIT_R(relaxed, nst); PG8_WAIT_L(0); PG8_BAR; PG8_MMA(0, 0, At, B0); PG8_MMA(0, 1, At, B1); PG8_BAR; PG8_SCHED; \
            PG8_LDA(At, 0, 1); PG8_STB(0, 0, b2); PG8_STB(0, 1, b2 + hstep); PG8_STA(0, 0, a2); \
            PG8_WAIT_R(relaxed, nst); PG8_WAIT_L(0); PG8_BAR; PG8_MMA(1, 0, At, B0); PG8_MMA(1, 1, At, B1); PG8_BAR; PG8_SCHED; \
            PG8_LDB(B0, 1, 0); PG8_LDB(B1, 1, 1); PG8_SCHED; PG8_LDA(At, 1, 0); PG8_STA(0, 1, a2 + hstep); \
            PG8_WAIT_R(relaxed, nst); PG8_WAIT_L(0); PG8_BAR; PG8_MMA(0, 0, At, B0); PG8_MMA(0, 1, At, B1); PG8_BAR; PG8_SCHED; \
            PG8_LDA(At, 1, 1); PG8_STB(1, 0, b3); PG8_STB(1, 1, b3 + hstep); PG8_STA(1, 0, a3); \
            PG8_WAIT_V(8); PG8_WAIT_L(0); PG8_BAR; PG8_MMA(1, 0, At, B0); PG8_MMA(1, 1, At, B1); PG8_BAR; PG8_SCHED; } while (0)
    constexpr bool EARLY = Epi::NST > 0;
    Unit cur, nxt; int ui = 0;
    if (!S.next(0, cur)) return;
    typedef typename AccT<I8>::type acc_t;
    acc_t acc[2][2][4][2];
    bf16x8 At[4][2], B0[2][2], B1[2][2];
    unsigned cA = (unsigned)cur.pm * tstep, cB = (unsigned)cur.pn * tstep;
    S.a_ready(cur);
    PG8_STB(0, 0, cB); PG8_STB(0, 1, cB + hstep); PG8_STA(0, 0, cA); PG8_STA(0, 1, cA + hstep);
    if (wr == 1) PG8_BAR;
    PG8_WAIT_V(2); PG8_BAR;
    PG8_STB(1, 0, cB + kstep); PG8_STA(1, 0, cA + kstep); PG8_STB(1, 1, cB + hstep + kstep);
    if constexpr (EARLY) { PG8_STA(1, 1, cA + hstep + kstep); PG8_WAIT_V(8); } else { PG8_WAIT_V(6); }
    PG8_BAR;
#pragma unroll
    for (int a = 0; a < 2; ++a)
#pragma unroll
        for (int b = 0; b < 2; ++b)
#pragma unroll
            for (int m = 0; m < 4; ++m)
#pragma unroll
                for (int n = 0; n < 2; ++n) acc[a][b][m][n] = acc_t{};
    for (;;) {
        const bool has_next = S.next(ui + 1, nxt);
        const unsigned nA = has_next ? (unsigned)nxt.pm * tstep : cA, nB = has_next ? (unsigned)nxt.pn * tstep : cB;
        for (int t = 0; t < nt; t += 2) {
            const bool last = (t == nt - 2), first = EARLY && (t == 0), relaxed = first && ui > 0;
            const unsigned a1 = cA + (unsigned)(t + 1) * kstep;
            const unsigned a2 = last ? nA : cA + (unsigned)(t + 2) * kstep, b2 = last ? nB : cB + (unsigned)(t + 2) * kstep;
            const unsigned a3 = a2 + kstep, b3 = b2 + kstep;
            if (last && has_next) S.a_ready(nxt);
            if (last) E.prefetch(cur, wid, lane, lds);
            PG8_TRIP(first, relaxed, Epi::NST);
        }
        if constexpr (EARLY) PG8_STA(1, 1, nA + kstep + hstep);
        if (wr == 0) PG8_BAR;
        E(acc, cur, wr, wc, fr, fq); S.done(cur);
        if (!has_next) break;
#pragma unroll
        for (int a = 0; a < 2; ++a)
#pragma unroll
            for (int b = 0; b < 2; ++b)
#pragma unroll
                for (int m = 0; m < 4; ++m)
#pragma unroll
                    for (int n = 0; n < 2; ++n) acc[a][b][m][n] = acc_t{};
        cur = nxt; cA = nA; cB = nB; ++ui;
        if (wr == 1) PG8_BAR;
    }
    PG8_WAIT_V(0);
    PG8_BAR;
#undef PG8_SA
#undef PG8_SB
#undef PG8_STAGE
#undef PG8_STA
#undef PG8_STB
#undef PG8_LDA
#undef PG8_LDB
#undef PG8_MMA
#undef PG8_MMAZ
#undef PG8_TRIP
#undef PG8_WAIT_R
#undef PG8_WAIT_V
#undef PG8_WAIT_L
#undef PG8_BAR
#undef PG8_SCHED
}
}

typedef const f32x4 (&AccRef)[2][2][4][2];
#define EPI_BIG_CALL() \
    __device__ __forceinline__ void operator()(AccRef acc, const pg8::Unit& u, int wr, int wc, int fr, int fq) const { \
        { const int l_ = lane_now(); fr = l_ & 15; fq = (l_ >> 4) & 3; }     \
        const int row0 = u.pm * 256 + wr * 64 + fr; \
        _Pragma("unroll") for (int gq = 0; gq < 8 / PF; ++gq) { \
            Pre p[PF]; \
            asm volatile("" ::: "memory"); \
            _Pragma("unroll") for (int i = 0; i < PF; ++i) { const int rg = gq * PF + i; p[i] = pre_big(row0 + (rg >> 2) * 128 + (rg & 3) * 16, u.pn, wc, fq); }     \
            asm volatile("" ::: "memory"); \
            _Pragma("unroll") for (int i = 0; i < PF; ++i) { const int rg = gq * PF + i; \
                rows(acc[rg >> 2][0][rg & 3][0], acc[rg >> 2][0][rg & 3][1], acc[rg >> 2][1][rg & 3][0], acc[rg >> 2][1][rg & 3][1], row0 + (rg >> 2) * 128 + (rg & 3) * 16, u.pn, wc, fq, p[i]); } } \
    }
__device__ __forceinline__ f32x4 ssq_quarter(const float* ssq, int r, int fq) { return *(const f32x4*)(ssq + (size_t)r * 16 + 4 * fq); }
__device__ __forceinline__ float rstd_from(const f32x4& q) {
    float s = (q.x + q.y) + (q.z + q.w);
    s = sum_rows4(s);
    return rsqrtf(s * (1.0f / D) + EPS);
}

__device__ __forceinline__ void ssq_prefetch(const float* ssq, int pm, int wid, int lane, LAS unsigned char* lds) {
    asm volatile("" : "+v"(lane));
#pragma unroll
    for (int i = 0; i < 2; ++i)
        __builtin_amdgcn_global_load_lds((const unsigned*)(ssq + ((size_t)pm * 256 + wid * 32 + i * 16) * 16 + lane * 4), (LAS unsigned*)(lds + SSQ_LDS_OFF + (wid * 32 + i * 16) * 64), 16, 0, 0);
}
struct EpiSwiglu {
    static constexpr bool PERM = true; static constexpr int PF = 8; static constexpr int NST = 8;
    bf16_t* O; const float* ssq; LAS unsigned char* lds;
    struct Pre { f32x4 q; };
    __device__ __forceinline__ Pre pre(int r, int pn, int wc, int fq) const { Pre p; p.q = ssq_quarter(ssq, r, fq); return p; }
    __device__ __forceinline__ Pre pre_big(int r, int pn, int wc, int fq) const { Pre p; p.q = *(const LAS f32x4*)(lds + SSQ_LDS_OFF + (r & 255) * 64 + fq * 16); return p; }
    __device__ __forceinline__ void prefetch(const pg8::Unit& u, int wid, int lane, LAS unsigned char* l) const { ssq_prefetch(ssq, u.pm, wid, lane, l); }
    __device__ __forceinline__ void rows(const f32x4& c00, const f32x4& c01, const f32x4& c10, const f32x4& c11, int r, int pn, int wc, int fq, const Pre& p) const {
        const float rs = rstd_from(p.q);
        float o[8];
#pragma unroll
        for (int j = 0; j < 4; ++j) { o[j] = silu_f(c00[j] * rs) * (c10[j] * rs); o[4 + j] = silu_f(c01[j] * rs) * (c11[j] * rs); }
        u32x4 w; w.x = cvt_pk_bf16(o[0], o[1]); w.y = cvt_pk_bf16(o[2], o[3]); w.z = cvt_pk_bf16(o[4], o[5]); w.w = cvt_pk_bf16(o[6], o[7]);
        { bf16_t* dst_ = O + (size_t)r * FF + pn * 128 + wc * 32 + 8 * fq;
          asm volatile("global_store_dwordx4 %0, %1, off sc1\n\ts_nop 1" :: "v"(dst_), "v"(w) : "memory"); }
    }
    EPI_BIG_CALL()
};

struct EpiSwigluI8 {
    static constexpr bool PERM = true; static constexpr int NST = 8;
    bf16_t* O; const float* rs; const float* cs; LAS unsigned char* lds;
    struct Pre { float sa; };
    __device__ __forceinline__ Pre pre(int r, int pn, int wc, int fq) const { Pre p; p.sa = rs[r]; return p; }
    __device__ __forceinline__ void prefetch(const pg8::Unit& u, int wid, int lane, LAS unsigned char* l) const {
        asm volatile("" : "+v"(lane));
        if (wid == 0) __builtin_amdgcn_global_load_lds((const unsigned*)(rs + (size_t)u.pm * 256 + lane * 4), (LAS unsigned*)(l + SSQ_LDS_OFF), 16, 0, 0);
        if (wid == 1) __builtin_amdgcn_global_load_lds((const unsigned*)(cs + (size_t)u.pn * 256 + lane * 4), (LAS unsigned*)(l + SSQ_LDS_OFF + 1024), 16, 0, 0);
    }
    __device__ __forceinline__ void emit(const f32x4& c00, const f32x4& c01, const f32x4& c10, const f32x4& c11, float sa, const f32x4& w00, const f32x4& w01, const f32x4& w10, const f32x4& w11,
                                         int r, int pn, int wc, int fq) const {
        float o[8];
#pragma unroll
        for (int j = 0; j < 4; ++j) { o[j] = silu_f(c00[j] * (sa * w00[j])) * (c10[j] * (sa * w10[j])); o[4 + j] = silu_f(c01[j] * (sa * w01[j])) * (c11[j] * (sa * w11[j])); }
        u32x4 w; w.x = cvt_pk_bf16(o[0], o[1]); w.y = cvt_pk_bf16(o[2], o[3]); w.z = cvt_pk_bf16(o[4], o[5]); w.w = cvt_pk_bf16(o[6], o[7]);
        { bf16_t* dst_ = O + (size_t)r * FF + pn * 128 + wc * 32 + 8 * fq;
          asm volatile("global_store_dwordx4 %0, %1, off sc1\n\ts_nop 1" :: "v"(dst_), "v"(w) : "memory"); }
    }
    __device__ __forceinline__ void rows(const f32x4& c00, const f32x4& c01, const f32x4& c10, const f32x4& c11, int r, int pn, int wc, int fq, const Pre& p) const {
        const float* cp = cs + (size_t)pn * 256 + wc * 32 + 8 * fq;
        emit(c00, c01, c10, c11, p.sa, *(const f32x4*)cp, *(const f32x4*)(cp + 4), *(const f32x4*)(cp + 128), *(const f32x4*)(cp + 132), r, pn, wc, fq);
    }
    template <class AccTy> __device__ __forceinline__ void operator()(const AccTy (&acc)[2][2][4][2], const pg8::Unit& u, int wr, int wc, int fr, int fq) const {
        { const int l_ = lane_now(); fr = l_ & 15; fq = (l_ >> 4) & 3; }
        const int row0 = u.pm * 256 + wr * 64 + fr;
        LAS const float* lr = (LAS const float*)(lds + SSQ_LDS_OFF); LAS const float* lc = lr + 256 + wc * 32 + 8 * fq;
        const f32x4 w00 = *(LAS const f32x4*)lc, w01 = *(LAS const f32x4*)(lc + 4), w10 = *(LAS const f32x4*)(lc + 128), w11 = *(LAS const f32x4*)(lc + 132);
        f32x2 NW[4], WW[4];
        NW[0] = (f32x2){w00[0], w00[1]} * (-LOG2E); NW[1] = (f32x2){w00[2], w00[3]} * (-LOG2E); NW[2] = (f32x2){w01[0], w01[1]} * (-LOG2E); NW[3] = (f32x2){w01[2], w01[3]} * (-LOG2E);
        WW[0] = (f32x2){w00[0], w00[1]} * (f32x2){w10[0], w10[1]}; WW[1] = (f32x2){w00[2], w00[3]} * (f32x2){w10[2], w10[3]};
        WW[2] = (f32x2){w01[0], w01[1]} * (f32x2){w11[0], w11[1]}; WW[3] = (f32x2){w01[2], w01[3]} * (f32x2){w11[2], w11[3]};
#pragma unroll
        for (int rg = 0; rg < 8; ++rg) {
            const int ai = rg >> 2, m = rg & 3, r = row0 + ai * 128 + m * 16;
            const float sa = lr[r & 255], inv = __builtin_amdgcn_rcpf(sa);
            unsigned pk[4];
#pragma unroll
            for (int p = 0; p < 4; ++p) {
                const AccTy& cg = acc[ai][0][m][p >> 1]; const AccTy& cu = acc[ai][1][m][p >> 1]; const int j = (p & 1) * 2;
                const f32x2 G = (f32x2){(float)cg[j], (float)cg[j + 1]} * sa, U = (f32x2){(float)cu[j], (float)cu[j + 1]};
                const f32x2 T = G * NW[p];
                f32x2 E; E.x = __builtin_amdgcn_exp2f(T.x); E.y = __builtin_amdgcn_exp2f(T.y);
                const f32x2 Dn = E * inv + inv;
                f32x2 R; R.x = __builtin_amdgcn_rcpf(Dn.x); R.y = __builtin_amdgcn_rcpf(Dn.y);
                const f32x2 O = ((G * U) * WW[p]) * R;
                pk[p] = cvt_pk_bf16(O.x, O.y);
            }
            u32x4 w; w.x = pk[0]; w.y = pk[1]; w.z = pk[2]; w.w = pk[3];
            { bf16_t* dst_ = O_at(r, u.pn, wc, fq);
              asm volatile("global_store_dwordx4 %0, %1, off sc1\n\ts_nop 1" :: "v"(dst_), "v"(w) : "memory"); }
        }
    }
    __device__ __forceinline__ bf16_t* O_at(int r, int pn, int wc, int fq) const { return O + (size_t)r * FF + pn * 128 + wc * 32 + 8 * fq; }
};

template <int MODE> struct EpiResid {
    static constexpr bool PERM = true; static constexpr int PF = (MODE == 0) ? 2 : 4;
    static constexpr int NST = (MODE == 2) ? 16 : (MODE == 1) ? 12 : 6;
    const float* resP; const float* resS;
    float* out; bf16_t* xb; float* ssq; float scale;
    struct Pre { f32x4 r00, r01, r10, r11; u32x4 a, b; };
    __device__ __forceinline__ Pre pre(int r, int pn, int wc, int fq) const {
        Pre p; const size_t off = (size_t)r * D + pn * 256 + wc * 32 + 8 * fq;
        if (MODE == 0) { const float* rbase = (r >= MP) ? resS - (size_t)MP * D : resP;
            p.r00 = *(const f32x4*)(rbase + off); p.r01 = *(const f32x4*)(rbase + off + 4); p.r10 = *(const f32x4*)(rbase + off + 128); p.r11 = *(const f32x4*)(rbase + off + 132); }
        else { p.a = *(const u32x4*)(xb + off); p.b = *(const u32x4*)(xb + off + 128); }
        return p;
    }
    __device__ __forceinline__ Pre pre_big(int r, int pn, int wc, int fq) const { return pre(r, pn, wc, fq); }
    __device__ __forceinline__ void prefetch(const pg8::Unit&, int, int, LAS unsigned char*) const {}
    __device__ __forceinline__ void rows(const f32x4& c00, const f32x4& c01, const f32x4& c10, const f32x4& c11, int r, int pn, int wc, int fq, const Pre& p) const {
        const size_t off = (size_t)r * D + pn * 256 + wc * 32 + 8 * fq;
        f32x4 r00, r01, r10, r11;
        if (MODE == 0) { r00 = p.r00; r01 = p.r01; r10 = p.r10; r11 = p.r11; }
        else {
            const u32x4 a = p.a, b = p.b;
            r00 = (f32x4){__uint_as_float(a.x << 16), __uint_as_float(a.x & 0xffff0000u), __uint_as_float(a.y << 16), __uint_as_float(a.y & 0xffff0000u)};
            r01 = (f32x4){__uint_as_float(a.z << 16), __uint_as_float(a.z & 0xffff0000u), __uint_as_float(a.w << 16), __uint_as_float(a.w & 0xffff0000u)};
            r10 = (f32x4){__uint_as_float(b.x << 16), __uint_as_float(b.x & 0xffff0000u), __uint_as_float(b.y << 16), __uint_as_float(b.y & 0xffff0000u)};
            r11 = (f32x4){__uint_as_float(b.z << 16), __uint_as_float(b.z & 0xffff0000u), __uint_as_float(b.w << 16), __uint_as_float(b.w & 0xffff0000u)};
        }
        const f32x4 y00 = r00 + c00 * scale, y01 = r01 + c01 * scale, y10 = r10 + c10 * scale, y11 = r11 + c11 * scale;
        if (MODE == 2) {
            __builtin_nontemporal_store(y00, (f32x4*)(out + off)); __builtin_nontemporal_store(y01, (f32x4*)(out + off + 4)); __builtin_nontemporal_store(y10, (f32x4*)(out + off + 128)); __builtin_nontemporal_store(y11, (f32x4*)(out + off + 132));
        } else {
            u32x4 w0, w1;
            w0.x = cvt_pk_bf16(y00[0], y00[1]); w0.y = cvt_pk_bf16(y00[2], y00[3]); w0.z = cvt_pk_bf16(y01[0], y01[1]); w0.w = cvt_pk_bf16(y01[2], y01[3]);
            w1.x = cvt_pk_bf16(y10[0], y10[1]); w1.y = cvt_pk_bf16(y10[2], y10[3]); w1.z = cvt_pk_bf16(y11[0], y11[1]); w1.w = cvt_pk_bf16(y11[2], y11[3]);
            *(u32x4*)(xb + off) = w0; *(u32x4*)(xb + off + 128) = w1;
            float ss = (y00[0] * y00[0] + y00[1] * y00[1]) + (y00[2] * y00[2] + y00[3] * y00[3]) + (y01[0] * y01[0] + y01[1] * y01[1]) + (y01[2] * y01[2] + y01[3] * y01[3])
                     + (y10[0] * y10[0] + y10[1] * y10[1]) + (y10[2] * y10[2] + y10[3] * y10[3]) + (y11[0] * y11[0] + y11[1] * y11[1]) + (y11[2] * y11[2] + y11[3] * y11[3]);
            ss = sum_rows4(ss);
            if (fq == 0) ssq[(size_t)r * 16 + pn * 4 + wc] = ss;
        }
    }
    EPI_BIG_CALL()
};

struct EpiInProj {
    static constexpr bool PERM = true; static constexpr int PF = 1; static constexpr int NST = 0;
    unsigned char* ws; const float* gq; const float* gk; float* out; LAS unsigned char* lds;
    struct Pre { f32x4 q; };
    __device__ __forceinline__ Pre pre(int r, int pn, int wc, int fq) const { Pre p; p.q = ssq_quarter((const float*)(ws + WS_SSQ1), r, fq); return p; }
    __device__ __forceinline__ Pre pre_big(int r, int pn, int wc, int fq) const { Pre p; p.q = *(const LAS f32x4*)(lds + SSQ_LDS_OFF + (r & 255) * 64 + fq * 16); return p; }
    __device__ __forceinline__ void prefetch(const pg8::Unit& u, int wid, int lane, LAS unsigned char* l) const { ssq_prefetch((const float*)(ws + WS_SSQ1), u.pm, wid, lane, l); }
    __device__ __forceinline__ void rows(const f32x4& c00, const f32x4& c01, const f32x4& c10, const f32x4& c11, int r, int pn, int wc, int fq, const Pre& p) const {
        const bool sample = r >= MP;
        int b, t, pos;
        if (sample) { const int rr = r - MP; b = rr >> 4; t = rr & 15; pos = PAST + t; } else { b = r >> 13; t = r & (TP - 1); pos = t; }
        const float rs = rstd_from(p.q);
        if (pn < 4) {
            const int ch0 = pn * 128 + wc * 32 + 8 * fq;
            float o[8];
#pragma unroll
            for (int j = 0; j < 4; ++j) { o[j] = (c00[j] * rs) * sigmoid_f(c10[j] * rs); o[4 + j] = (c01[j] * rs) * sigmoid_f(c11[j] * rs); }
            u32x4 w; w.x = cvt_pk_bf16(o[0], o[1]); w.y = cvt_pk_bf16(o[2], o[3]); w.z = cvt_pk_bf16(o[4], o[5]); w.w = cvt_pk_bf16(o[6], o[7]);
            bf16_t* ud = sample ? (bf16_t*)(ws + WS_US) + ((size_t)(b * USROWS + HIST + t)) * CC + ch0 : (bf16_t*)(ws + WS_UP) + (size_t)r * CC + ch0;
            *(u32x4*)ud = w;
            float* dst = nullptr;
            if (sample) dst = out + O_CSS + ((size_t)(b * HIST + (HIST - TS) + t)) * CC + ch0;
            else if (t >= TP - HIST) dst = out + O_CSP + ((size_t)(b * HIST + (t - (TP - HIST)))) * CC + ch0;
            if (dst) { *(f32x4*)dst = (f32x4){o[0], o[1], o[2], o[3]}; *(f32x4*)(dst + 4) = (f32x4){o[4], o[5], o[6], o[7]}; }
        } else if (pn < 6 || wc < 2) {
            const bool isq = pn < 6;
            const int h = isq ? (pn - 4) * 4 + wc : wc;
            const float* gg = isq ? gq : gk;
            const f32x4 g00 = *(const f32x4*)(gg + 8 * fq), g01 = *(const f32x4*)(gg + 8 * fq + 4), g10 = *(const f32x4*)(gg + 32 + 8 * fq), g11 = *(const f32x4*)(gg + 32 + 8 * fq + 4);
            const float osc = isq ? QSCALE : 1.0f;
            f32x4 v00 = c00 * rs, v01 = c01 * rs, v10 = c10 * rs, v11 = c11 * rs;
            float ss = (v00[0] * v00[0] + v00[1] * v00[1]) + (v00[2] * v00[2] + v00[3] * v00[3]) + (v01[0] * v01[0] + v01[1] * v01[1]) + (v01[2] * v01[2] + v01[3] * v01[3])
                     + (v10[0] * v10[0] + v10[1] * v10[1]) + (v10[2] * v10[2] + v10[3] * v10[3]) + (v11[0] * v11[0] + v11[1] * v11[1]) + (v11[2] * v11[2] + v11[3] * v11[3]);
            ss = sum_rows4(ss);
            const float hn = rsqrtf(ss * (1.0f / HD) + EPS);
            v00 = v00 * hn * g00; v01 = v01 * hn * g01; v10 = v10 * hn * g10; v11 = v11 * hn * g11;
            f32x4 p0, p1;
#pragma unroll
            for (int j = 0; j < 4; ++j) { p0[j] = __shfl_xor(v00[j], 16); p1[j] = __shfl_xor(v01[j], 16);     }
            if (fq < 2) {
                const f32x2* rp = (const f32x2*)(ws + WS_ROPE) + (size_t)pos * 8;
                const float sg = (fq == 0) ? -1.0f : 1.0f;
#pragma unroll
                for (int j = 0; j < 4; ++j) {
                    const f32x2 cs0 = rp[j], cs1 = rp[4 + j];
                    v00[j] = v00[j] * cs0.x + sg * p0[j] * cs0.y;
                    v01[j] = v01[j] * cs1.x + sg * p1[j] * cs1.y;
                }
            }
            u32x4 w0, w1;
            w0.x = cvt_pk_bf16(v00[0] * osc, v00[1] * osc); w0.y = cvt_pk_bf16(v00[2] * osc, v00[3] * osc); w0.z = cvt_pk_bf16(v01[0] * osc, v01[1] * osc); w0.w = cvt_pk_bf16(v01[2] * osc, v01[3] * osc);
            w1.x = cvt_pk_bf16(v10[0] * osc, v10[1] * osc); w1.y = cvt_pk_bf16(v10[2] * osc, v10[3] * osc); w1.z = cvt_pk_bf16(v11[0] * osc, v11[1] * osc); w1.w = cvt_pk_bf16(v11[2] * osc, v11[3] * osc);
            if (isq) {
                bf16_t* dst = (bf16_t*)(ws + WS_Q) + (size_t)r * 512 + h * 64 + 8 * fq;
                *(u32x4*)dst = w0; *(u32x4*)(dst + 32) = w1;
            } else {
                bf16_t* dst = sample ? (bf16_t*)(ws + WS_KS) + ((size_t)(b * KSROWS + WIN + t)) * 128 + h * 64 + 8 * fq : (bf16_t*)(ws + WS_KP) + (size_t)r * 128 + h * 64 + 8 * fq;
                *(u32x4*)dst = w0; *(u32x4*)(dst + 32) = w1;
                float* od = nullptr;
                if (sample) od = out + O_KWS + ((size_t)((b * WIN + (WIN - TS) + t) * 2 + h)) * 64 + 8 * fq;
                else if (t >= TP - WIN) od = out + O_KWP + ((size_t)((b * WIN + (t - (TP - WIN))) * 2 + h)) * 64 + 8 * fq;
                if (od) { *(f32x4*)od = v00; *(f32x4*)(od + 4) = v01; *(f32x4*)(od + 32) = v10; *(f32x4*)(od + 36) = v11; }
            }
        } else {
            const int kh = wc - 2;
            const f32x4 v00 = c00 * rs, v01 = c01 * rs, v10 = c10 * rs, v11 = c11 * rs;
            bf16_t* vt; size_t vs;
            if (sample) { vt = (bf16_t*)(ws + WS_VTS) + ((size_t)((b * 2 + kh) * 64)) * KSROWS + WIN + t; vs = KSROWS; }
            else { vt = (bf16_t*)(ws + WS_VTP) + ((size_t)((b * 2 + kh) * (TP / 64) + (t >> 6))) * 4096 + (t & 63); vs = 64; }
#pragma unroll
            for (int j = 0; j < 4; ++j) {
                vt[(size_t)(8 * fq + j) * vs] = f2bf(v00[j]); vt[(size_t)(8 * fq + 4 + j) * vs] = f2bf(v01[j]);
                vt[(size_t)(32 + 8 * fq + j) * vs] = f2bf(v10[j]); vt[(size_t)(32 + 8 * fq + 4 + j) * vs] = f2bf(v11[j]);
            }
            float* od = nullptr;
            if (sample) od = out + O_VWS + ((size_t)((b * WIN + (WIN - TS) + t) * 2 + kh)) * 64 + 8 * fq;
            else if (t >= TP - WIN) od = out + O_VWP + ((size_t)((b * WIN + (t - (TP - WIN))) * 2 + kh)) * 64 + 8 * fq;
            if (od) { *(f32x4*)od = v00; *(f32x4*)(od + 4) = v01; *(f32x4*)(od + 32) = v10; *(f32x4*)(od + 36) = v11; }
        }
    }
    EPI_BIG_CALL()
};

template <int KS, int MT, bool I8, class Epi>
__device__ __forceinline__ void small_gemm(const bf16_t* A, const bf16_t* Bt, int N, int K, const Epi& E, LAS unsigned char* lds, int bid, int G, int wave, int lane, int wpc_in = 0) {
    constexpr int MTN = MS / (16 * MT);
    const int NT = MTN * (N / 256) * 4, NI = NT * KS, wpc = wpc_in ? wpc_in : (NI + G - 1) / G, nb = K / 64;
    asm volatile("" : "+v"(lane));
    const int fr = lane & 15, g = lane >> 4;
    for (int i0 = 0; i0 < wpc; i0 += 8) {
        const int i = i0 + wave, item = bid * wpc + i;
        const bool active = (i < wpc) && (item < NI);
        const int t = active ? item / KS : 0, ksl = item % KS;
        const int mt = t % MTN, nq = t / MTN, pn = nq >> 2, wc = nq & 3;
        const int r = MP + mt * (16 * MT) + fr;
        typedef typename pg8::AccT<I8>::type acc_t;
        acc_t acc[MT][2][2];
#pragma unroll
        for (int mi = 0; mi < MT; ++mi)
#pragma unroll
            for (int bj = 0; bj < 2; ++bj)
#pragma unroll
                for (int n = 0; n < 2; ++n) acc[mi][bj][n] = acc_t{};
        if (active) {
            const int b0 = (nb * ksl) / KS, b1 = (nb * (ksl + 1)) / KS;
            const bf16_t* ap = A + (size_t)r * K + g * 8;
            const bf16_t* bp = Bt + (size_t)(pn * 256 + wc * 32 + 8 * (fr >> 2) + (fr & 3)) * K + g * 8;
            bf16x8 afA[2][MT], bfA[2][2][2], afB[2][MT], bfB[2][2][2];
#define SG_LOAD(af, bf, kb) do { const int k0_ = (kb) * 64; _Pragma("unroll") for (int s_ = 0; s_ < 2; ++s_) { \
            _Pragma("unroll") for (int mi = 0; mi < MT; ++mi) af[s_][mi] = *(const bf16x8*)(ap + (size_t)(16 * mi) * K + k0_ + s_ * 32); \
            _Pragma("unroll") for (int bj = 0; bj < 2; ++bj) _Pragma("unroll") for (int n = 0; n < 2; ++n) bf[s_][bj][n] = *(const bf16x8*)(bp + (size_t)(4 * n + 128 * bj) * K + k0_ + s_ * 32); } } while (0)
#define SG_MMA(af, bf) do { _Pragma("unroll") for (int s_ = 0; s_ < 2; ++s_) _Pragma("unroll") for (int bj = 0; bj < 2; ++bj) _Pragma("unroll") for (int n = 0; n < 2; ++n) { \
            _Pragma("unroll") for (int mi = 0; mi < MT; ++mi) acc[mi][bj][n] = pg8::mma16(bf[s_][bj][n], af[s_][mi], acc[mi][bj][n]); } } while (0)
            SG_LOAD(afA, bfA, b0);
            for (int kb = b0; kb < b1; kb += 2) {
                const int kb1 = (kb + 1 < b1) ? kb + 1 : b1 - 1, kb2 = (kb + 2 < b1) ? kb + 2 : b1 - 1;
                __builtin_amdgcn_sched_barrier(0);
                SG_LOAD(afB, bfB, kb1);
                __builtin_amdgcn_sched_barrier(0);
                SG_MMA(afA, bfA);
                __builtin_amdgcn_sched_barrier(0);
                SG_LOAD(afA, bfA, kb2);
                __builtin_amdgcn_sched_barrier(0);
                if (kb + 1 < b1) SG_MMA(afB, bfB);
            }
#undef SG_LOAD
#undef SG_MMA
        }
        if constexpr (KS > 1) {
            static_assert(KS == 1 || KS == 8, "KS: 1 or 8 (all eight waves of the workgroup on one tile)");
            LAS acc_t* red = (LAS acc_t*)lds;
            if (ksl != 0) {
#pragma unroll
                for (int mi = 0; mi < MT; ++mi)
#pragma unroll
                    for (int bj = 0; bj < 2; ++bj)
#pragma unroll
                        for (int n = 0; n < 2; ++n) red[(ksl - 1) * (MT * 256) + ((mi * 2 + bj) * 2 + n) * 64 + lane] = acc[mi][bj][n];
            }
            __syncthreads();
            if (ksl == 0) {
#pragma unroll
                for (int q = 0; q < KS - 1; ++q)
#pragma unroll
                    for (int mi = 0; mi < MT; ++mi)
#pragma unroll
                        for (int bj = 0; bj < 2; ++bj)
#pragma unroll
                            for (int n = 0; n < 2; ++n) acc[mi][bj][n] += red[q * (MT * 256) + ((mi * 2 + bj) * 2 + n) * 64 + lane];
            }
            __syncthreads();
        }
        if (active && ksl == 0) {
#pragma unroll
            for (int mi = 0; mi < MT; ++mi) { const typename Epi::Pre p = E.pre(r + 16 * mi, pn, wc, g);
                E.rows(__builtin_convertvector(acc[mi][0][0], f32x4), __builtin_convertvector(acc[mi][0][1], f32x4), __builtin_convertvector(acc[mi][1][0], f32x4), __builtin_convertvector(acc[mi][1][1], f32x4), r + 16 * mi, pn, wc, g, p); }
        }
    }
}

struct TItem { const float* W; const float* g; bf16_t* WT; int Nsrc, srccol0, K, destrow0, k0; };
__device__ __forceinline__ void p0_tload(const TItem& t, float (&v)[32], int lane) {
#pragma unroll
    for (int i = 0; i < 32; ++i) { const int kk = 2 * i + (lane >> 5); v[i] = t.W[(size_t)(t.k0 + kk) * t.Nsrc + t.srccol0 + (lane & 31)]; }
}
__device__ __forceinline__ void p0_tfinish(const TItem& t, const float (&v)[32], LAS float* scr, int lane) {
#pragma unroll
    for (int i = 0; i < 32; ++i) { const int kk = 2 * i + (lane >> 5); scr[kk * 33 + (lane & 31)] = v[i]; }
    asm volatile("s_waitcnt lgkmcnt(0)" ::: "memory");
    const int c = lane & 7;
    f32x4 g0 = (f32x4){1.f, 1.f, 1.f, 1.f}, g1 = g0;
    if (t.g) { g0 = *(const f32x4*)(t.g + t.k0 + 8 * c); g1 = *(const f32x4*)(t.g + t.k0 + 8 * c + 4); }
#pragma unroll
    for (int j = 0; j < 4; ++j) { const int n = (lane >> 3) + 8 * j; const LAS float* sp = scr + (8 * c) * 33 + n;
        u32x4 o; o.x = cvt_pk_bf16(sp[0 * 33] * g0.x, sp[1 * 33] * g0.y); o.y = cvt_pk_bf16(sp[2 * 33] * g0.z, sp[3 * 33] * g0.w); o.z = cvt_pk_bf16(sp[4 * 33] * g1.x, sp[5 * 33] * g1.y); o.w = cvt_pk_bf16(sp[6 * 33] * g1.z, sp[7 * 33] * g1.w);
        *(u32x4*)(t.WT + (size_t)(t.destrow0 + n) * t.K + t.k0 + 8 * c) = o; }
    asm volatile("s_waitcnt lgkmcnt(0)" ::: "memory");
}
__device__ __forceinline__ int src_up(int nb) { const int pn = nb >> 3, p0 = (nb & 7) * 32, bj = p0 >> 7; return bj * FF + pn * 128 + (p0 & 127); }
__device__ __forceinline__ int src_in(int nb) {
    const int pn = nb >> 3, p0 = (nb & 7) * 32, bj = p0 >> 7, wc = (p0 & 127) >> 5;
    if (pn < 4) return bj * CC + pn * 128 + wc * 32;
    if (pn < 6) return 1024 + ((pn - 4) * 4 + wc) * 64 + bj * 32;
    return (wc < 2) ? 1536 + wc * 64 + bj * 32 : 1664 + (wc - 2) * 64 + bj * 32;
}

struct Args { const float* in[21]; float* out; unsigned char* ws; float inv[8]; };
typedef const __attribute__((address_space(4))) Args& ArgsRef;
__device__ __forceinline__ const __attribute__((address_space(4))) Args* args_now() {
#if defined(__HIP_DEVICE_COMPILE__)
    auto p = (const __attribute__((address_space(4))) Args*)__builtin_amdgcn_kernarg_segment_ptr(); asm volatile("" : "+s"(p)); return p;
#else
    return nullptr;
#endif
}

constexpr int I_UP = (D / 64) * (NUP / 32), I_DN = (FF / 64) * (D / 32), I_IN = (D / 64) * (NIN / 32), I_O = (D / 64) * (D / 32);
constexpr int NITEMS = 2 * I_UP + 2 * I_DN + I_IN + I_O;
constexpr int NITEMS_EARLY = I_UP + I_DN + I_IN + I_O;
__device__ __forceinline__ TItem p0_decode(ArgsRef a, int it) {
    unsigned char* ws = a.ws; int r = it < NITEMS ? it : NITEMS - 1; TItem t;
    if (r < I_UP) { const int nblk = NUP / 32, kb = r / nblk, nb = r % nblk; t = TItem{a.in[6], a.in[5], (bf16_t*)(ws + WS_W1T), NUP, src_up(nb), D, nb * 32, kb * 64}; return t; } r -= I_UP;
    if (r < I_DN) { const int nblk = D / 32, kb = r / nblk, nb = r % nblk; t = TItem{a.in[7], nullptr, (bf16_t*)(ws + WS_W2T), D, nb * 32, FF, nb * 32, kb * 64}; return t; } r -= I_DN;
    if (r < I_IN) { const int nblk = NIN / 32, kb = r / nblk, nb = r % nblk; t = TItem{a.in[9], a.in[8], (bf16_t*)(ws + WS_WINT), NIN, src_in(nb), D, nb * 32, kb * 64}; return t; } r -= I_IN;
    if (r < I_O) { const int nblk = D / 32, kb = r / nblk, nb = r % nblk; t = TItem{a.in[17], nullptr, (bf16_t*)(ws + WS_WOT), D, nb * 32, D, nb * 32, kb * 64}; return t; } r -= I_O;
    if (r < I_UP) { const int nblk = NUP / 32, kb = r / nblk, nb = r % nblk; t = TItem{a.in[19], a.in[18], (bf16_t*)(ws + WS_W3T), NUP, src_up(nb), D, nb * 32, kb * 64}; return t; } r -= I_UP;
    { const int nblk = D / 32, kb = r / nblk, nb = r % nblk; t = TItem{a.in[20], nullptr, (bf16_t*)(ws + WS_W4T), D, nb * 32, FF, nb * 32, kb * 64}; return t; }
}
__device__ __forceinline__ void weights_convert(ArgsRef a, LAS unsigned char* lds, int it0, int it1, int gw, int NGW, int wave, int lane) {
    LAS float* scr = (LAS float*)(lds + wave * 16896);
    for (int it = it0 + gw; it < it1; it += 2 * NGW) {
        const TItem t0 = p0_decode(a, it), t1 = p0_decode(a, it + NGW < it1 ? it + NGW : it);
        float v0[32], v1[32];
        p0_tload(t0, v0, lane); p0_tload(t1, v1, lane);
        p0_tfinish(t0, v0, scr, lane);
        if (it + NGW < it1) p0_tfinish(t1, v1, scr + 64 * 33, lane);
    }
}


__device__ __forceinline__ void w8_strip(const float* W, const float* g, signed char* Wq, float* cs, int nb, LAS unsigned char* lds, int wave, int lane) {
    LAS float* scr = (LAS float*)(lds + wave * 16896);
    LAS float* red = (LAS float*)(lds + 139264);
    const int src0 = src_up(nb), k0 = 128 * wave, c = lane & 7;
    TItem t0{W, nullptr, nullptr, NUP, src0, D, 0, k0}, t1{W, nullptr, nullptr, NUP, src0, D, 0, k0 + 64};
    float v0[32], v1[32];
    p0_tload(t0, v0, lane); p0_tload(t1, v1, lane);
#pragma unroll
    for (int i = 0; i < 32; ++i) { const int kk = 2 * i + (lane >> 5); scr[kk * 33 + (lane & 31)] = v0[i]; scr[64 * 33 + kk * 33 + (lane & 31)] = v1[i]; }
    asm volatile("s_waitcnt lgkmcnt(0)" ::: "memory");
    float val[2][4][8]; float mx[4];
#pragma unroll
    for (int h = 0; h < 2; ++h) { const f32x4 ga = *(const f32x4*)(g + k0 + 64 * h + 8 * c), gb = *(const f32x4*)(g + k0 + 64 * h + 8 * c + 4);
#pragma unroll
        for (int j = 0; j < 4; ++j) { const LAS float* sp = scr + h * (64 * 33) + (8 * c) * 33 + (lane >> 3) + 8 * j;
#pragma unroll
            for (int i = 0; i < 8; ++i) val[h][j][i] = sp[i * 33] * (i < 4 ? ga[i] : gb[i - 4]); } }
#pragma unroll
    for (int j = 0; j < 4; ++j) { float m = 0.f;
#pragma unroll
        for (int h = 0; h < 2; ++h)
#pragma unroll
            for (int i = 0; i < 8; ++i) m = fmaxf(m, fabsf(val[h][j][i]));
        m = dpp_max8(m);
        mx[j] = m; }
    if (c == 0) {
#pragma unroll
        for (int j = 0; j < 4; ++j) red[wave * 32 + (lane >> 3) + 8 * j] = mx[j]; }
    __syncthreads();
#pragma unroll
    for (int j = 0; j < 4; ++j) { float m = 0.f;
#pragma unroll
        for (int w = 0; w < 8; ++w) m = fmaxf(m, red[w * 32 + (lane >> 3) + 8 * j]);
        mx[j] = m; }
#pragma unroll
    for (int j = 0; j < 4; ++j) { const int n = (lane >> 3) + 8 * j; const float inv = mx[j] > 0.f ? 127.0f / mx[j] : 0.f;
        if (wave == 0 && c == 0) cs[nb * 32 + n] = mx[j] > 0.f ? mx[j] * (1.0f / 127.0f) : 1.0f;
#pragma unroll
        for (int h = 0; h < 2; ++h) { unsigned lo = 0u, hi = 0u;
#pragma unroll
            for (int i = 0; i < 4; ++i) { lo |= ((unsigned)(int)rintf(val[h][j][i] * inv) & 0xffu) << (8 * i); hi |= ((unsigned)(int)rintf(val[h][j][4 + i] * inv) & 0xffu) << (8 * i); }
            *(u32x2*)(Wq + (size_t)(nb * 32 + n) * D + k0 + 64 * h + 8 * c) = (u32x2){lo, hi}; } }
    __syncthreads();
}
template <int NR> __device__ __forceinline__ void q8_rows(unsigned char* ws, const float* ssq, int m0, int lane) {
    const bf16_t* AB = (const bf16_t*)(ws + WS_AB); signed char* A8 = (signed char*)(ws + WS_A8); float* RS = (float*)(ws + WS_RS);
    u32x4 xa[NR], xb[NR]; float sq[NR];
#pragma unroll
    for (int q = 0; q < NR; ++q) { const bf16_t* row = AB + (size_t)(m0 + q) * D; xa[q] = *(const u32x4*)(row + 8 * lane); xb[q] = *(const u32x4*)(row + 512 + 8 * lane); sq[q] = lane < 16 ? ssq[(size_t)(m0 + q) * 16 + lane] : 0.f; }
#pragma unroll
    for (int q = 0; q < NR; ++q) {
        float s = dpp_row_sum(sq[q]); s = __builtin_bit_cast(float, __builtin_amdgcn_readfirstlane(__builtin_bit_cast(int, s)));
        const float rstd = rsqrtf(s * (1.0f / D) + EPS);
        float v[16];
#pragma unroll
        for (int i = 0; i < 4; ++i) { const unsigned a = xa[q][i], b = xb[q][i];
            v[2 * i] = __uint_as_float(a << 16) * rstd; v[2 * i + 1] = __uint_as_float(a & 0xffff0000u) * rstd; v[8 + 2 * i] = __uint_as_float(b << 16) * rstd; v[8 + 2 * i + 1] = __uint_as_float(b & 0xffff0000u) * rstd; }
        float m = 0.f;
#pragma unroll
        for (int i = 0; i < 16; ++i) m = fmaxf(m, fabsf(v[i]));
        m = dpp_max16(m); m = max_rows4(m);
        const float inv = m > 0.f ? 127.0f / m : 0.f;
        unsigned p[4];
#pragma unroll
        for (int i = 0; i < 4; ++i) { unsigned w = 0u;
#pragma unroll
            for (int e = 0; e < 4; ++e) w |= ((unsigned)(int)rintf(v[4 * i + e] * inv) & 0xffu) << (8 * e);
            p[i] = w; }
        signed char* orow = A8 + (size_t)(m0 + q) * D;
        *(u32x2*)(orow + 8 * lane) = (u32x2){p[0], p[1]}; *(u32x2*)(orow + 512 + 8 * lane) = (u32x2){p[2], p[3]};
        if (lane == 0) RS[m0 + q] = m > 0.f ? m * (1.0f / 127.0f) : 1.0f;
    }
}
template <int NR> __device__ __forceinline__ void x_rows(ArgsRef a, int m0, int lane) {
    bf16_t* AB = (bf16_t*)(a.ws + WS_AB); float* ssq0 = (float*)(a.ws + WS_SSQ0);
    f32x4 v[NR][4];
#pragma unroll
    for (int q = 0; q < NR; ++q) { const int m = m0 + q;
        const float* xrow = (m < MP) ? a.in[0] + (size_t)m * D : a.in[1] + (size_t)(m - MP) * D;
        const f32x4* xr = (const f32x4*)xrow + lane;
#pragma unroll
        for (int j = 0; j < 4; ++j) v[q][j] = xr[64 * j]; }
    float t[NR + 1];
#pragma unroll
    for (int q = 0; q < NR; ++q) { float s = 0.f;
#pragma unroll
        for (int j = 0; j < 4; ++j) s += (v[q][j].x * v[q][j].x + v[q][j].y * v[q][j].y) + (v[q][j].z * v[q][j].z + v[q][j].w * v[q][j].w);
        t[q] = s; }
    t[NR] = 0.f;
#pragma unroll
    for (int q = 0; q < NR; q += 2) wave_sum2(t[q], t[q + 1]);
#pragma unroll
    for (int q = 0; q < NR; ++q) { const int m = m0 + q;
        u32x2* o8 = (u32x2*)(AB + (size_t)m * D) + lane;
#pragma unroll
        for (int j = 0; j < 4; ++j) { u32x2 w; w.x = cvt_pk_bf16(v[q][j].x, v[q][j].y); w.y = cvt_pk_bf16(v[q][j].z, v[q][j].w); o8[64 * j] = w; }
        if (lane < 16) ssq0[(size_t)m * 16 + lane] = (lane == 0) ? t[q] : 0.f; }
}

template <int NR> __device__ __forceinline__ void xq8_rows(ArgsRef a, int m0, int lane) {
    signed char* A8 = (signed char*)(a.ws + WS_A8); float* RS = (float*)(a.ws + WS_RS);
    f32x4 v[NR][4];
#pragma unroll
    for (int q = 0; q < NR; ++q) { const int m = m0 + q;
        const float* xrow = (m < MP) ? a.in[0] + (size_t)m * D : a.in[1] + (size_t)(m - MP) * D;
        const f32x4* xr = (const f32x4*)xrow + lane;
#pragma unroll
        for (int j = 0; j < 4; ++j) v[q][j] = xr[64 * j]; }
    float t[NR + 1], mxv[NR + 1];
#pragma unroll
    for (int q = 0; q < NR; ++q) { float s = 0.f, m = 0.f;
#pragma unroll
        for (int j = 0; j < 4; ++j) { s += (v[q][j].x * v[q][j].x + v[q][j].y * v[q][j].y) + (v[q][j].z * v[q][j].z + v[q][j].w * v[q][j].w);
            m = fmaxf(fmaxf(m, fmaxf(fabsf(v[q][j].x), fabsf(v[q][j].y))), fmaxf(fabsf(v[q][j].z), fabsf(v[q][j].w))); }
        t[q] = s; mxv[q] = m; }
    t[NR] = 0.f;
#pragma unroll
    for (int q = 0; q < NR; q += 2) wave_sum2(t[q], t[q + 1]);
#pragma unroll
    for (int q = 0; q < NR; ++q) { const int m = m0 + q;
        float mx = mxv[q]; mx = dpp_max16(mx); mx = max_rows4(mx);
        const float rstd = rsqrtf(t[q] * (1.0f / D) + EPS), inv = mx > 0.f ? 127.0f / mx : 0.f;
        unsigned* o4 = (unsigned*)(A8 + (size_t)m * D) + lane;
#pragma unroll
        for (int j = 0; j < 4; ++j) { const f32x4 x4 = v[q][j];
            o4[64 * j] = ((unsigned)(int)rintf(x4.x * inv) & 0xffu) | (((unsigned)(int)rintf(x4.y * inv) & 0xffu) << 8) | (((unsigned)(int)rintf(x4.z * inv) & 0xffu) << 16) | (((unsigned)(int)rintf(x4.w * inv) & 0xffu) << 24); }
        if (lane == 0) RS[m] = mx > 0.f ? mx * rstd * (1.0f / 127.0f) : 1.0f; }
}

__device__ __forceinline__ void p0_prologue(ArgsRef a, LAS unsigned char* lds, int wave_) {
    const int tid = wave_ * 64 + lane_now();
    const int lane = tid & 63, wave = tid >> 6;
    const int gw = blockIdx.x * 8 + wave, NGW = gridDim.x * 8;
    unsigned char* ws = a.ws;
    for (int nb = blockIdx.x; nb < NUP / 32; nb += gridDim.x) w8_strip(a.in[6], a.in[5], (signed char*)(ws + WS_W1Q), (float*)(ws + WS_CS1), nb, lds, wave, lane);
    { const int nsw = (NUP / 32) * 8, gwr = gw >= nsw ? gw - nsw : gw + NGW - nsw;
      weights_convert(a, lds, I_UP, NITEMS_EARLY, NGW > nsw ? gwr : gw, NGW, wave, lane); }
    for (int m0 = gw * 8; m0 < MP; m0 += NGW * 8) xq8_rows<8>(a, m0, lane);
    for (int m = MP + gw; m < M; m += NGW) xq8_rows<1>(a, m, lane);
    const int gt = blockIdx.x * 512 + tid, NGT = gridDim.x * 512;
    f32x2* rope = (f32x2*)(ws + WS_ROPE);
    for (int i = gt; i < TP * 8; i += NGT) {
        const int pos = i >> 3, k = i & 7;
        const float ang = (float)pos * a.inv[k];
        const double rev = (double)ang * 0.15915494309189535;
        const float fr = (float)(rev - rint(rev));
        rope[i] = (f32x2){__builtin_amdgcn_cosf(fr), __builtin_amdgcn_sinf(fr)};
    }
    bf16_t* KS = (bf16_t*)(ws + WS_KS); bf16_t* VTS = (bf16_t*)(ws + WS_VTS); bf16_t* US = (bf16_t*)(ws + WS_US);
    for (int i = gt; i < NBS * WIN * 128; i += NGT) {
        const int c = i & 127, row = (i >> 7) & (WIN - 1), b = i >> 14;
        const float kv = a.in[3][i], vv = a.in[4][i];
        KS[((size_t)(b * KSROWS + row)) * 128 + c] = f2bf(kv);
        VTS[((size_t)(b * 128 + c)) * KSROWS + row] = f2bf(vv);
        if (row >= TS) { a.out[O_KWS + ((size_t)(b * WIN + row - TS)) * 128 + c] = kv; a.out[O_VWS + ((size_t)(b * WIN + row - TS)) * 128 + c] = vv; }
    }
    for (int i = gt; i < NBS * 128 * 16; i += NGT) { const int k = i & 15, rowd = i >> 4; VTS[(size_t)rowd * KSROWS + WIN + TS + k] = 0; }
    for (int i = gt; i < NBS * HIST * CC; i += NGT) {
        const int c = i & (CC - 1), row = (i >> 9) % HIST, b = (i >> 9) / HIST;
        const float uv = a.in[2][i];
        US[((size_t)(b * USROWS + row)) * CC + c] = f2bf(uv);
        if (row >= TS) a.out[O_CSS + ((size_t)(b * HIST + row - TS)) * CC + c] = uv;
    }
}

constexpr int ATT_VT_OFF = 192 * 128, ATT_VT_STRIDE = 400, ATT_BUF = ATT_VT_OFF + 64 * ATT_VT_STRIDE;
constexpr int ATT_UNITS_P = NBP * (TP / 64) * 2, ATT_UNITS = ATT_UNITS_P + NBS * 2;
constexpr int CONV_UNITS = MP / 16 + NBS;

struct AttUnit { const bf16_t* kb; const bf16_t* vt; int nkt; bool sample; };
__device__ __forceinline__ AttUnit att_decode(unsigned char* ws, int unit) {
    AttUnit u;
    if (unit < ATT_UNITS_P) { const int kh = unit & 1, c = (unit >> 1) & 127, b = unit >> 8, cs = c >= 2 ? c - 2 : 0;
        u.nkt = (c - cs + 1) * 4; u.sample = false;
        u.kb = (const bf16_t*)(ws + WS_KP) + ((size_t)(b * TP + cs * 64)) * 128 + kh * 64;
        u.vt = (const bf16_t*)(ws + WS_VTP) + ((size_t)((b * 2 + kh) * (TP / 64) + cs)) * 4096; }
    else { const int p = unit - ATT_UNITS_P, b = p >> 1, kh = p & 1;
        u.nkt = 9; u.sample = true;
        u.kb = (const bf16_t*)(ws + WS_KS) + ((size_t)(b * KSROWS)) * 128 + kh * 64;
        u.vt = (const bf16_t*)(ws + WS_VTS) + ((size_t)((b * 2 + kh) * 64)) * KSROWS; }
    return u;
}
__device__ __forceinline__ void att_stage_load(const AttUnit& u, int tid, u32x4 (&kp)[3], u32x4 (&vp)[3]) {
    const int nk = u.nkt * 16;
#pragma unroll
    for (int i = 0; i < 3; ++i) {
        const int p = tid + 512 * i; int row = p >> 3; const int ch = p & 7; row = row < nk ? row : nk - 1;
        kp[i] = *(const u32x4*)(u.kb + (size_t)row * 128 + ch * 8);
        if (u.sample) { int pp = p < 1280 ? p : 1279; const int d = pp / 20, q = pp - d * 20; vp[i] = *(const u32x4*)(u.vt + (size_t)d * KSROWS + q * 8); }
        else { const int jmax = (u.nkt >> 2) - 1, j = i < jmax ? i : jmax; vp[i] = *(const u32x4*)(u.vt + (size_t)j * 4096 + (p & 511) * 8); }
    }
}
__device__ __forceinline__ void att_stage_write(const AttUnit& u, int tid, LAS unsigned char* buf, const u32x4 (&kp)[3], const u32x4 (&vp)[3]) {
    const int nk = u.nkt * 16;
#pragma unroll
    for (int i = 0; i < 3; ++i) {
        const int p = tid + 512 * i; int row = p >> 3; const int ch = p & 7; row = row < nk ? row : nk - 1;
        *(LAS u32x4*)(buf + row * 128 + ((ch ^ ((row >> 1) & 7)) << 4)) = kp[i];
        if (u.sample) { int pp = p < 1280 ? p : 1279; const int d = pp / 20, q = pp - d * 20; *(LAS u32x4*)(buf + ATT_VT_OFF + d * ATT_VT_STRIDE + q * 16) = vp[i]; }
        else { const int jmax = (u.nkt >> 2) - 1, j = i < jmax ? i : jmax; const int d = (p & 511) >> 3, q = p & 7; *(LAS u32x4*)(buf + ATT_VT_OFF + d * ATT_VT_STRIDE + j * 128 + q * 16) = vp[i]; }
    }
}
__device__ __forceinline__ void attn_compute(const bf16x8 (&qf)[2][2], LAS const unsigned char* buf, int nkt, float sink0, float sink1, bf16_t* o0, bf16_t* o1, int lane) {
    const int fr = lane & 15, g = lane >> 4;
    f32x4 S[2][12];
    const float NEG = -INFINITY;
#pragma unroll
    for (int kt = 0; kt < 12; ++kt) {
        const int ktc = kt < nkt ? kt : nkt - 1, row = ktc * 16 + fr, sw = (row >> 1) & 7;
        const bf16x8 k0 = *(LAS const bf16x8*)(buf + row * 128 + ((g ^ sw) << 4)), k1 = *(LAS const bf16x8*)(buf + row * 128 + (((g + 4) ^ sw) << 4));
        const bool ok = kt < nkt;
#pragma unroll
        for (int qt = 0; qt < 2; ++qt) {
            f32x4 c = (f32x4){0.f, 0.f, 0.f, 0.f};
            c = __builtin_amdgcn_mfma_f32_16x16x32_bf16(k0, qf[qt][0], c, 0, 0, 0);
            c = __builtin_amdgcn_mfma_f32_16x16x32_bf16(k1, qf[qt][1], c, 0, 0, 0);
            S[qt][kt] = ok ? c : (f32x4){NEG, NEG, NEG, NEG};
        }
    }
    bf16x8 pf[2][6]; float linv[2];
#pragma unroll
    for (int qt = 0; qt < 2; ++qt) {
        const float sink = qt ? sink1 : sink0;
        float mx = sink;
#pragma unroll
        for (int kt = 0; kt < 12; ++kt) mx = fmaxf(mx, fmaxf(fmaxf(S[qt][kt][0], S[qt][kt][1]), fmaxf(S[qt][kt][2], S[qt][kt][3])));
        mx = max_rows4(mx);
        float l = 0.f;
#pragma unroll
        for (int kt = 0; kt < 12; ++kt) {
#pragma unroll
            for (int j = 0; j < 4; ++j) { const float p = __builtin_amdgcn_exp2f(S[qt][kt][j] - mx); S[qt][kt][j] = p; l += p; }
        }
        l = sum_rows4(l);
        l += __builtin_amdgcn_exp2f(sink - mx);
        linv[qt] = 1.0f / l;
#pragma unroll
        for (int kk = 0; kk < 6; ++kk) {
            u32x4 w; w.x = cvt_pk_bf16(S[qt][2 * kk][0], S[qt][2 * kk][1]); w.y = cvt_pk_bf16(S[qt][2 * kk][2], S[qt][2 * kk][3]);
            w.z = cvt_pk_bf16(S[qt][2 * kk + 1][0], S[qt][2 * kk + 1][1]); w.w = cvt_pk_bf16(S[qt][2 * kk + 1][2], S[qt][2 * kk + 1][3]);
            pf[qt][kk] = __builtin_bit_cast(bf16x8, w);
        }
    }
    f32x4 O[2][4];
    const int kkmax = (nkt - 1) >> 1;
    LAS const unsigned char* vb = buf + ATT_VT_OFF + fr * ATT_VT_STRIDE + g * 8;
#pragma unroll
    for (int dt = 0; dt < 4; ++dt) {
        O[0][dt] = (f32x4){0.f, 0.f, 0.f, 0.f}; O[1][dt] = (f32x4){0.f, 0.f, 0.f, 0.f};
#pragma unroll
        for (int kk = 0; kk < 6; ++kk) {
            const int kkc = kk < kkmax ? kk : kkmax;
            const u32x2 a0 = *(LAS const u32x2*)(vb + dt * 16 * ATT_VT_STRIDE + kkc * 64), a1 = *(LAS const u32x2*)(vb + dt * 16 * ATT_VT_STRIDE + kkc * 64 + 32);
            u32x4 aw; aw.x = a0.x; aw.y = a0.y; aw.z = a1.x; aw.w = a1.y;
            const bf16x8 af = __builtin_bit_cast(bf16x8, aw);
            O[0][dt] = __builtin_amdgcn_mfma_f32_16x16x32_bf16(af, pf[0][kk], O[0][dt], 0, 0, 0);
            O[1][dt] = __builtin_amdgcn_mfma_f32_16x16x32_bf16(af, pf[1][kk], O[1][dt], 0, 0, 0);
        }
    }
#pragma unroll
    for (int qt = 0; qt < 2; ++qt) {
        bf16_t* ob = (qt ? o1 : o0) + (size_t)fr * D + 4 * g;
#pragma unroll
        for (int dt = 0; dt < 4; ++dt) {
            const f32x4 v = O[qt][dt] * linv[qt];
            u32x2 w; w.x = cvt_pk_bf16(v[0], v[1]); w.y = cvt_pk_bf16(v[2], v[3]);
            *(u32x2*)(ob + dt * 16) = w;
        }
    }
}

__device__ __forceinline__ void attn_phase(ArgsRef a, LAS unsigned char* lds, int tid, int first, int G) {
    asm volatile("" : "+v"(tid));
    unsigned char* ws = a.ws;
    const int lane = tid & 63, wave = __builtin_amdgcn_readfirstlane(tid >> 6), fr = lane & 15, g = lane >> 4;
    const bf16_t* Q = (const bf16_t*)(ws + WS_Q); bf16_t* MIX = (bf16_t*)(ws + WS_MIX);
    const float* sinks = a.in[12];
    if (first >= ATT_UNITS) return;
    AttUnit cur = att_decode(ws, first);
    u32x4 kp[3], vp[3];
    att_stage_load(cur, tid, kp, vp);
    int par = 0;
    for (int unit = first; unit < ATT_UNITS; unit += G, par ^= 1) {
        LAS unsigned char* buf = lds + par * ATT_BUF;
        att_stage_write(cur, tid, buf, kp, vp);
        const bf16_t* q0; const bf16_t* q1; bf16_t* o0; bf16_t* o1; float sk0, sk1; bool work;
        if (!cur.sample) { const int kh = unit & 1, c = (unit >> 1) & 127, b = unit >> 8, h = kh * 4 + (wave >> 1), tok0 = c * 64 + (wave & 1) * 32;
            q0 = Q + ((size_t)(b * TP + tok0)) * 512 + h * 64; q1 = q0 + 16 * 512;
            o0 = MIX + ((size_t)(b * TP + tok0)) * D + 512 + h * 64; o1 = o0 + 16 * D; sk0 = sk1 = sinks[h] * LOG2E; work = true; }
        else { const int p = unit - ATT_UNITS_P, b = p >> 1, kh = p & 1, h0 = kh * 4 + (wave & 1) * 2;
            q0 = Q + ((size_t)(MP + b * TS)) * 512 + h0 * 64; q1 = q0 + 64;
            o0 = MIX + ((size_t)(MP + b * TS)) * D + 512 + h0 * 64; o1 = o0 + 64; sk0 = sinks[h0] * LOG2E; sk1 = sinks[h0 + 1] * LOG2E; work = wave < 2; }
        bf16x8 qf[2][2];
        qf[0][0] = *(const bf16x8*)(q0 + fr * 512 + g * 8); qf[0][1] = *(const bf16x8*)(q0 + fr * 512 + 32 + g * 8);
        qf[1][0] = *(const bf16x8*)(q1 + fr * 512 + g * 8); qf[1][1] = *(const bf16x8*)(q1 + fr * 512 + 32 + g * 8);
        const int nkt = cur.nkt;
        __syncthreads();
        const int nu = unit + G < ATT_UNITS ? unit + G : unit;
        cur = att_decode(ws, nu);
        att_stage_load(cur, tid, kp, vp);
        if (work) attn_compute(qf, buf, nkt, sk0, sk1, o0, o1, lane);
    }
    __syncthreads();
}

struct ConvUnit { const bf16_t* ub; int jmin; size_t orow; };
__device__ __forceinline__ ConvUnit conv_decode(unsigned char* ws, int cu, int ch) {
    ConvUnit u;
    if (cu < MP / 16) { const int b = cu >> 9, t0 = (cu & 511) * 16; u.ub = (const bf16_t*)(ws + WS_UP) + ((size_t)(b * TP) + t0 - HIST) * CC + ch; u.jmin = HIST - t0; u.orow = (size_t)b * TP + t0; }
    else { const int b = cu - MP / 16; u.ub = (const bf16_t*)(ws + WS_US) + ((size_t)(b * USROWS)) * CC + ch; u.jmin = 0; u.orow = (size_t)MP + b * TS; }
    return u;
}
__device__ __forceinline__ void conv_phase(ArgsRef a, LAS unsigned char* lds, int tid, int first, int G) {
    asm volatile("" : "+v"(tid));
    unsigned char* ws = a.ws;
    const int ch = tid, wave = tid >> 6, lane = tid & 63;
    if (first >= CONV_UNITS) return;
    const float* wdw = a.in[13] + ch;
    float w[CW];
#pragma unroll
    for (int j = 0; j < CW; ++j) w[j] = wdw[j * CC];
    const float bias = a.in[14][ch];
    const f32x4 gc0 = *(const f32x4*)(a.in[15] + 4 * lane), gc1 = *(const f32x4*)(a.in[15] + 256 + 4 * lane);
    const f32x4 bc0 = *(const f32x4*)(a.in[16] + 4 * lane), bc1 = *(const f32x4*)(a.in[16] + 256 + 4 * lane);
    ConvUnit cur = conv_decode(ws, first, ch);
    bf16_t xr[HIST + 16];
#pragma unroll
    for (int j = 0; j < HIST + 16; ++j) { const int jc = j > cur.jmin ? j : cur.jmin; xr[j] = cur.ub[(size_t)jc * CC]; }
    int par = 0;
    for (int cu = first; cu < CONV_UNITS; cu += G, par ^= 1) {
        const int jmin = cur.jmin; const size_t orow = cur.orow;
        float acc[16];
#pragma unroll
        for (int i = 0; i < 16; ++i) acc[i] = bias;
#pragma unroll
        for (int j = 0; j < HIST + 16; ++j) {
            const float xv = (j >= jmin) ? bf2f(xr[j]) : 0.f;
#pragma unroll
            for (int i = 0; i < 16; ++i) { if (j - i >= 0 && j - i < CW) acc[i] += xv * w[j - i]; }
        }
        __builtin_amdgcn_sched_barrier(0);
        { const int nu = cu + G < CONV_UNITS ? cu + G : cu;
          cur = conv_decode(ws, nu, ch);
#pragma unroll
          for (int j = 0; j < HIST + 16; ++j) { const int jc = j > cur.jmin ? j : cur.jmin; xr[j] = cur.ub[(size_t)jc * CC]; } }
        __builtin_amdgcn_sched_barrier(0);
        LAS float* yb = (LAS float*)lds + par * (16 * CC);
#pragma unroll
        for (int i = 0; i < 16; ++i) yb[i * CC + ch] = acc[i];
        __syncthreads();
        bf16_t* MIX = (bf16_t*)(ws + WS_MIX) + orow * D;
        {
            const int tok = 2 * wave;
            f32x4 v0 = *(const LAS f32x4*)(yb + tok * CC + 4 * lane), v1 = *(const LAS f32x4*)(yb + tok * CC + 256 + 4 * lane);
            f32x4 z0 = *(const LAS f32x4*)(yb + (tok + 1) * CC + 4 * lane), z1 = *(const LAS f32x4*)(yb + (tok + 1) * CC + 256 + 4 * lane);
            float sa = (v0[0] + v0[1]) + (v0[2] + v0[3]) + (v1[0] + v1[1]) + (v1[2] + v1[3]);
            float sb = (z0[0] + z0[1]) + (z0[2] + z0[3]) + (z1[0] + z1[1]) + (z1[2] + z1[3]);
            wave_sum2(sa, sb);
            const float ma = sa * (1.0f / CC), mb = sb * (1.0f / CC);
            v0 = v0 - ma; v1 = v1 - ma; z0 = z0 - mb; z1 = z1 - mb;
            float qa = (v0[0] * v0[0] + v0[1] * v0[1]) + (v0[2] * v0[2] + v0[3] * v0[3]) + (v1[0] * v1[0] + v1[1] * v1[1]) + (v1[2] * v1[2] + v1[3] * v1[3]);
            float qb = (z0[0] * z0[0] + z0[1] * z0[1]) + (z0[2] * z0[2] + z0[3] * z0[3]) + (z1[0] * z1[0] + z1[1] * z1[1]) + (z1[2] * z1[2] + z1[3] * z1[3]);
            wave_sum2(qa, qb);
            const float ra = rsqrtf(qa * (1.0f / CC) + EPS), rb = rsqrtf(qb * (1.0f / CC) + EPS);
            v0 = v0 * ra * gc0 + bc0; v1 = v1 * ra * gc1 + bc1; z0 = z0 * rb * gc0 + bc0; z1 = z1 * rb * gc1 + bc1;
            u32x2 o0, o1, p0, p1;
            o0.x = cvt_pk_bf16(silu_f(v0[0]), silu_f(v0[1])); o0.y = cvt_pk_bf16(silu_f(v0[2]), silu_f(v0[3]));
            o1.x = cvt_pk_bf16(silu_f(v1[0]), silu_f(v1[1])); o1.y = cvt_pk_bf16(silu_f(v1[2]), silu_f(v1[3]));
            p0.x = cvt_pk_bf16(silu_f(z0[0]), silu_f(z0[1])); p0.y = cvt_pk_bf16(silu_f(z0[2]), silu_f(z0[3]));
            p1.x = cvt_pk_bf16(silu_f(z1[0]), silu_f(z1[1])); p1.y = cvt_pk_bf16(silu_f(z1[2]), silu_f(z1[3]));
            *(u32x2*)(MIX + (size_t)tok * D + 4 * lane) = o0; *(u32x2*)(MIX + (size_t)tok * D + 256 + 4 * lane) = o1;
            *(u32x2*)(MIX + (size_t)(tok + 1) * D + 4 * lane) = p0; *(u32x2*)(MIX + (size_t)(tok + 1) * D + 256 + 4 * lane) = p1;
        }
    }
    __syncthreads();
}

#define XB_TMO      128
#define XB_XCNT(j)  (256  + 64 * (j))
#define XB_XSUB(j)  (1280 + 64 * (j))
#define XB_XGEN(j)  (2304 + 64 * (j))
#define XB_TOP      3328
#define XB_TOPGEN   3392
#define XCD_BAR_WORDS 3456
#define XB_SPIN_CAP (1u << 18)
__device__ __forceinline__ unsigned xb_ld(unsigned* p)              { return __hip_atomic_load(p, __ATOMIC_RELAXED, __HIP_MEMORY_SCOPE_AGENT); }
__device__ __forceinline__ unsigned xb_add(unsigned* p, unsigned v) { return __hip_atomic_fetch_add(p, v, __ATOMIC_RELAXED, __HIP_MEMORY_SCOPE_AGENT); }
__device__ __forceinline__ unsigned xb_xcc_id() { return (unsigned)__builtin_amdgcn_s_getreg((3 << 11) | 20) & 0xFu; }
#define XB_SPIN(cond, bar) do { unsigned _sp = 0; while (cond) { __builtin_amdgcn_s_sleep(1); \
    if ((++_sp & 255u) == 0u) { if (xb_ld(&(bar)[XB_TMO])) break; if (_sp > XB_SPIN_CAP) { atomicAdd(&(bar)[XB_TMO], 1u); break; } } } } while (0)
struct XcdBarrier { unsigned* bar; unsigned x; volatile LAS unsigned* st; };
__device__ __forceinline__ XcdBarrier xcd_barrier_post(unsigned* bar, volatile LAS unsigned* st, int wave_) {
    XcdBarrier b; b.bar = bar; b.x = (unsigned)__builtin_amdgcn_readfirstlane((int)xb_xcc_id()); b.st = st;
    if (wave_ == 0 && lane_now() == 0) (void)xb_add(&bar[XB_XCNT(b.x)], 1u);
    return b;
}
__device__ __forceinline__ void xcd_barrier_complete(unsigned* bar, unsigned x, unsigned& nloc, unsigned& nx) {
    const unsigned G = gridDim.x * gridDim.y * gridDim.z;
    unsigned sum, cnt, mine, sp = 0u;
    for (;;) {
        sum = 0u; cnt = 0u; mine = 0u;
#pragma unroll
        for (unsigned j = 0; j < 16; ++j) { const unsigned c = xb_ld(&bar[XB_XCNT(j)]); sum += c; cnt += (c > 0u) ? 1u : 0u; mine = (j == x) ? c : mine; }
        if (sum == G) break;
        __builtin_amdgcn_s_sleep(1);
        if ((++sp & 255u) == 0u) { if (xb_ld(&bar[XB_TMO])) break; if (sp > XB_SPIN_CAP) { atomicAdd(&bar[XB_TMO], 1u); break; } }
    }
    nloc = mine > 0u ? mine : 1u; nx = cnt > 0u ? cnt : 1u;
}
__device__ __forceinline__ void xcd_barrier(const XcdBarrier& b, int wave_) {
    asm volatile("s_waitcnt vmcnt(0)" ::: "memory");
    __syncthreads();
    if (wave_ == 0 && lane_now() == 0) {
        unsigned* bar = b.bar; unsigned bx = b.x; asm volatile("" : "+s"(bx));
        __builtin_amdgcn_s_waitcnt(0);
        unsigned nloc = b.st[0], nx = b.st[1];
        if (nloc == 0u) { xcd_barrier_complete(bar, bx, nloc, nx); b.st[0] = nloc; b.st[1] = nx; }
        const unsigned old = xb_add(&bar[XB_XSUB(bx)], 1u);
        const unsigned gen = old / nloc;
        if (old + 1u == (gen + 1u) * nloc) {
            __builtin_amdgcn_fence(__ATOMIC_RELEASE, "agent");
            asm volatile("s_waitcnt vmcnt(0)" ::: "memory");
            const unsigned og = xb_add(&bar[XB_TOP], 1u);
            const unsigned tg = og / nx;
            if (og + 1u == (tg + 1u) * nx) xb_add(&bar[XB_TOPGEN], 1u);
            else XB_SPIN(xb_ld(&bar[XB_TOPGEN]) == tg, bar);
            __builtin_amdgcn_fence(__ATOMIC_ACQUIRE, "agent");
            xb_add(&bar[XB_XGEN(bx)], 1u);
            asm volatile("s_waitcnt vmcnt(0)" ::: "memory");
        } else {
            XB_SPIN(xb_ld(&bar[XB_XGEN(bx)]) == gen, bar);
            __builtin_amdgcn_fence(__ATOMIC_ACQUIRE, "agent");
            asm volatile("s_waitcnt vmcnt(0)" ::: "memory");
        }
    }
    __syncthreads();
}
constexpr int MISC_OFF = 151552;
constexpr size_t CTL_ZERO_BYTES = 65536;
constexpr int CW_BAR = 4096;

__global__ void __launch_bounds__(512, 2) hymba_fwd(Args a_) {
    extern __shared__ __attribute__((aligned(16))) unsigned char lds_raw[];
    LAS unsigned char* lds = (LAS unsigned char*)lds_raw;
    unsigned char* ws = a_.ws;
    const int wave = __builtin_amdgcn_readfirstlane((int)threadIdx.x >> 6);
#define lane lane_now()
#define tid (wave * 64 + lane_now())
    const int G = gridDim.x, bid = blockIdx.x;
    for (int u = wave * 64 + lane_now(); u < (LDS_BYTES - MISC_OFF) / 4; u += 512) ((LAS unsigned*)(lds + MISC_OFF))[u] = 0u;
    __syncthreads();
    const XcdBarrier bar = xcd_barrier_post((unsigned*)ws + CW_BAR, (volatile LAS unsigned*)(lds + MISC_OFF) + 8, wave);
#define GRID_BAR() xcd_barrier(bar, wave)

    bf16_t* AB = (bf16_t*)(ws + WS_AB); bf16_t* ACT = (bf16_t*)(ws + WS_ACT);
    float* ssq0 = (float*)(ws + WS_SSQ0); float* ssq1 = (float*)(ws + WS_SSQ1); float* ssq2 = (float*)(ws + WS_SSQ2);

#ifndef PROBE_DUP
#define PROBE_DUP -1
#endif
#ifndef PHASE_MASK
#define PHASE_MASK 0xff
#endif
#define REPS(k) if (PHASE_MASK & (1 << (k))) for (int rep_ = 0; rep_ < ((PROBE_DUP == (k)) ? 2 : 1); ++rep_)
#define ARGS_HERE() ArgsRef a = *args_now()
    REPS(0) { ARGS_HERE(); p0_prologue(a, lds, wave); GRID_BAR(); }
    REPS(1) {
    { int bs_ = bid, gs_ = G; asm volatile("" : "+s"(bs_), "+s"(gs_));
      pg8::Gemm g{(const bf16_t*)(ws + WS_A8), (const bf16_t*)(ws + WS_W1Q), MP, NUP, D / 2}; pg8::StaticOrder S; S.init(MP, NUP, gs_, bs_, 16);
      EpiSwigluI8 E{ACT, (const float*)(ws + WS_RS), (const float*)(ws + WS_CS1), lds};
      for (int pass = 0; pass < 2; ++pass) { if (((pass ^ (bs_ >> 6)) & 1) == 0) { pg8::gemm_phase<EpiSwigluI8, pg8::StaticOrder, true, true, true>(lds, g, S, E, wave); } else { small_gemm<1, 4, true>((const bf16_t*)(ws + WS_A8), (const bf16_t*)(ws + WS_W1Q), NUP, D / 2, E, lds, bs_, gs_, wave, lane); } } }
    GRID_BAR(); }
    REPS(2) {
    { int bs_ = bid, gs_ = G; asm volatile("" : "+s"(bs_), "+s"(gs_));
      pg8::Gemm g{ACT, (const bf16_t*)(ws + WS_W2T), MP, D, FF}; pg8::StaticOrder S; S.init(MP, D, gs_, bs_);
      ARGS_HERE(); EpiResid<0> E{a.in[0], a.in[1], nullptr, AB, ssq1, 0.5f};
      for (int pass = 0; pass < 2; ++pass) { if (((pass ^ (bs_ >> 6)) & 1) == 0) { pg8::gemm_phase<EpiResid<0>, pg8::StaticOrder, true, true>(lds, g, S, E, wave); } else { small_gemm<8, 2, false>(ACT, (const bf16_t*)(ws + WS_W2T), D, FF, E, lds, bs_, gs_, wave, lane); } } }
    GRID_BAR(); }
    REPS(3) {
    { int bs_ = bid, gs_ = G; asm volatile("" : "+s"(bs_), "+s"(gs_));
      pg8::Gemm g{AB, (const bf16_t*)(ws + WS_WINT), MP, NIN, D}; pg8::StaticOrder S; S.init(MP, NIN, gs_, bs_);
      ARGS_HERE(); EpiInProj E{ws, a.in[10], a.in[11], a.out, lds};
      pg8::gemm_phase<EpiInProj, pg8::StaticOrder, true, true>(lds, g, S, E, wave);
      small_gemm<1, 4, false>(AB, (const bf16_t*)(ws + WS_WINT), NIN, D, E, lds, gs_ - 1 - bs_, gs_, wave, lane, 2);
      if (rep_ == 0 && bid >= G / 2) { int ln = lane; asm volatile("" : "+v"(ln));
        weights_convert(a, lds, NITEMS_EARLY + I_UP, NITEMS, (bid - G / 2) * 8 + wave, (G - G / 2) * 8, wave, ln);
        __syncthreads();
        for (int nb = bid - G / 2; nb < NUP / 32; nb += G - G / 2) w8_strip(a.in[19], a.in[18], (signed char*)(ws + WS_W3Q), (float*)(ws + WS_CS3), nb, lds, wave, ln); } }
    GRID_BAR(); }
    REPS(4) {
#ifndef PROBE_P4SUB
#define PROBE_P4SUB 0
#endif
    ARGS_HERE();
    if (!(rep_ == 1 && PROBE_P4SUB == 2)) attn_phase(a, lds, tid, bid, G);
    if (!(rep_ == 1 && PROBE_P4SUB == 1)) conv_phase(a, lds, tid, G - 1 - bid, G);
    GRID_BAR(); }
    REPS(5) {
    { int bs_ = bid, gs_ = G; asm volatile("" : "+s"(bs_), "+s"(gs_));
      pg8::Gemm g{(const bf16_t*)(ws + WS_MIX), (const bf16_t*)(ws + WS_WOT), MP, D, D}; pg8::StaticOrder S; S.init(MP, D, gs_, bs_);
      EpiResid<1> E{nullptr, nullptr, nullptr, AB, ssq2, 1.0f};
      for (int pass = 0; pass < 2; ++pass) { if (((pass ^ (bs_ >> 6)) & 1) == 0) { pg8::gemm_phase<EpiResid<1>, pg8::StaticOrder, true, true>(lds, g, S, E, wave); } else { small_gemm<8, 2, false>((const bf16_t*)(ws + WS_MIX), (const bf16_t*)(ws + WS_WOT), D, D, E, lds, bs_, gs_, wave, lane); } } }
    GRID_BAR(); }
    { const int gw = bid * 8 + wave, NGW = G * 8; int ln = lane; asm volatile("" : "+v"(ln));
      for (int m0 = gw * 4; m0 < M; m0 += NGW * 4) q8_rows<4>(ws, ssq2, m0, ln);
      GRID_BAR(); }
    REPS(6) {
    { int bs_ = bid, gs_ = G; asm volatile("" : "+s"(bs_), "+s"(gs_));
      pg8::Gemm g{(const bf16_t*)(ws + WS_A8), (const bf16_t*)(ws + WS_W3Q), MP, NUP, D / 2}; pg8::StaticOrder S; S.init(MP, NUP, gs_, bs_, 16);
      EpiSwigluI8 E{ACT, (const float*)(ws + WS_RS), (const float*)(ws + WS_CS3), lds};
      for (int pass = 0; pass < 2; ++pass) { if (((pass ^ (bs_ >> 6)) & 1) == 0) { pg8::gemm_phase<EpiSwigluI8, pg8::StaticOrder, true, true, true>(lds, g, S, E, wave); } else { small_gemm<1, 4, true>((const bf16_t*)(ws + WS_A8), (const bf16_t*)(ws + WS_W3Q), NUP, D / 2, E, lds, bs_, gs_, wave, lane); } } }
    GRID_BAR(); }
    REPS(7) { int bs_ = bid, gs_ = G; asm volatile("" : "+s"(bs_), "+s"(gs_));
      pg8::Gemm g{ACT, (const bf16_t*)(ws + WS_W4T), MP, D, FF}; pg8::StaticOrder S; S.init(MP, D, gs_, bs_);
      ARGS_HERE(); EpiResid<2> E{nullptr, nullptr, a.out, AB, nullptr, 0.5f};
      for (int pass = 0; pass < 2; ++pass) { if (((pass ^ (bs_ >> 6)) & 1) == 0) { pg8::gemm_phase<EpiResid<2>, pg8::StaticOrder, true, true>(lds, g, S, E, wave); } else { small_gemm<8, 2, false>(ACT, (const bf16_t*)(ws + WS_W4T), D, FF, E, lds, bs_, gs_, wave, lane); } } }
}
#undef lane
#undef tid

extern "C" void kernel_launch(void* const* d_in, const int* in_sizes, int n_in, void* d_out, int out_size, void* d_ws, size_t ws_size, hipStream_t stream) {
    static int grid = 0;
    if (grid == 0) {
        if (n_in != 21 || (size_t)out_size != O_END || ws_size < WS_END) { fprintf(stderr, "kernel_launch: unexpected shapes: n_in %d out %d ws %zu (need %zu)\n", n_in, out_size, ws_size, (size_t)WS_END); grid = -1; return; }
        int dev = 0, cus = 0, per_cu = 0;
        (void)hipGetDevice(&dev);
        (void)hipDeviceGetAttribute(&cus, hipDeviceAttributeMultiprocessorCount, dev);
        if (cus != 256) fprintf(stderr, "kernel_launch: note: built for a 256-CU device (one workgroup per CU), this device reports %d\n", cus);
        if (hipFuncSetAttribute((const void*)hymba_fwd, hipFuncAttributeMaxDynamicSharedMemorySize, LDS_BYTES) != hipSuccess) { fprintf(stderr, "kernel_launch: hipFuncSetAttribute failed\n"); grid = -1; return; }
        if (hipOccupancyMaxActiveBlocksPerMultiprocessor(&per_cu, (const void*)hymba_fwd, 512, LDS_BYTES) != hipSuccess || per_cu < 1) { fprintf(stderr, "kernel_launch: occupancy query failed (%d)\n", per_cu); grid = -1; (void)hipGetLastError(); return; }
        grid = cus;
    }
    if (grid < 0) return;
    Args a{};
    for (int i = 0; i < 21; ++i) a.in[i] = (const float*)d_in[i];
    a.out = (float*)d_out; a.ws = (unsigned char*)d_ws;
    for (int i = 0; i < 8; ++i) a.inv[i] = powf(500000.0f, -(float)i / 8.0f);
    if (hipMemsetAsync(d_ws, 0, CTL_ZERO_BYTES, stream) != hipSuccess) { fprintf(stderr, "kernel_launch: memset failed\n"); return; }
    hipLaunchKernelGGL(hymba_fwd, dim3(grid), dim3(512), LDS_BYTES, stream, a);
    const hipError_t e = hipPeekAtLastError();
    if (e != hipSuccess) fprintf(stderr, "kernel_launch: launch failed: %s (grid %d)\n", hipGetErrorString(e), grid);
}
```

```cpp
#include <hip/hip_runtime.h>
#include <cstdio>
#include <cstdint>
#include <cmath>

#define LAS __attribute__((address_space(3)))
typedef unsigned short bf16_t;
typedef short bf16x8 __attribute__((ext_vector_type(8)));
typedef float f32x4 __attribute__((ext_vector_type(4)));
typedef float f32x2 __attribute__((ext_vector_type(2)));
typedef unsigned u32x4 __attribute__((ext_vector_type(4)));
typedef unsigned u32x2 __attribute__((ext_vector_type(2)));
typedef int i32x4 __attribute__((ext_vector_type(4)));

constexpr int D = 1024, TP = 8192, NBP = 4, NBS = 32, TS = 16, MP = NBP * TP, MS = NBS * TS, M = MP + MS;
constexpr int FF = 2816, NUP = 2 * FF, NIN = 1792, CC = 512, HD = 64, PAST = 4096;
constexpr int CW = 31, HIST = CW - 1, WIN = 128;
constexpr int KSROWS = 160;
constexpr int USROWS = HIST + TS;
constexpr float EPS = 1e-6f;
constexpr float LOG2E = 1.4426950408889634f;
constexpr float QSCALE = 0.125f * LOG2E;

constexpr size_t O_YP = 0, O_YS = (size_t)MP * D, O_CSP = O_YS + (size_t)MS * D, O_KWP = O_CSP + (size_t)NBP * HIST * CC,
                 O_VWP = O_KWP + (size_t)NBP * WIN * 128, O_CSS = O_VWP + (size_t)NBP * WIN * 128, O_KWS = O_CSS + (size_t)NBS * HIST * CC,
                 O_VWS = O_KWS + (size_t)NBS * WIN * 128, O_END = O_VWS + (size_t)NBS * WIN * 128;

constexpr size_t al(size_t x) { return (x + 4095) & ~(size_t)4095; }
constexpr size_t WS_CTL = 0;
constexpr size_t WS_W1T = 1u << 20;
constexpr size_t WS_W2T = WS_W1T + al((size_t)NUP * D * 2);
constexpr size_t WS_WINT = WS_W2T + al((size_t)D * FF * 2);
constexpr size_t WS_WOT = WS_WINT + al((size_t)NIN * D * 2);
constexpr size_t WS_W3T = WS_WOT + al((size_t)D * D * 2);
constexpr size_t WS_W4T = WS_W3T + al((size_t)NUP * D * 2);
constexpr size_t WS_ROPE = WS_W4T + al((size_t)D * FF * 2);
constexpr size_t WS_SSQ0 = WS_ROPE + al((size_t)TP * 8 * 8);
constexpr size_t WS_SSQ1 = WS_SSQ0 + al((size_t)M * 16 * 4);
constexpr size_t WS_SSQ2 = WS_SSQ1 + al((size_t)M * 16 * 4);
constexpr size_t WS_KS = WS_SSQ2 + al((size_t)M * 16 * 4);
constexpr size_t WS_VTS = WS_KS + al((size_t)NBS * KSROWS * 128 * 2);
constexpr size_t WS_US = WS_VTS + al((size_t)NBS * 128 * KSROWS * 2);
constexpr size_t WS_AB = WS_US + al((size_t)NBS * USROWS * CC * 2);
constexpr size_t WS_X1 = WS_AB + al((size_t)M * D * 2);
constexpr size_t WS_ACT = WS_X1 + al((size_t)M * D * 4);
constexpr size_t WS_A8 = WS_X1;
constexpr size_t WS_W3Q = WS_A8 + al((size_t)M * D);
constexpr size_t WS_W1Q = WS_W3Q + al((size_t)NUP * D);
constexpr size_t WS_RS = WS_W1Q + al((size_t)NUP * D);
constexpr size_t WS_CS3 = WS_RS + al((size_t)M * 4);
constexpr size_t WS_CS1 = WS_CS3 + al((size_t)NUP * 4);
static_assert(WS_CS1 + (size_t)NUP * 4 <= WS_ACT, "int8 operands fit in the f32 scratch");
constexpr size_t WS_END = WS_ACT + al((size_t)M * FF * 2);
constexpr size_t WS_UP = WS_ACT;
constexpr size_t WS_Q = WS_UP + al((size_t)MP * CC * 2);
constexpr size_t WS_KP = WS_Q + al((size_t)M * 512 * 2);
constexpr size_t WS_VTP = WS_KP + al((size_t)MP * 128 * 2);
constexpr size_t WS_MIX = WS_VTP + al((size_t)MP * 128 * 2);
static_assert(WS_MIX + (size_t)M * D * 2 <= WS_END, "overlay fits");

constexpr int LDS_BYTES = 155648;
constexpr int SSQ_LDS_OFF = 131072;

__device__ __forceinline__ unsigned cvt_pk_bf16(float lo, float hi) { unsigned r; asm volatile("v_cvt_pk_bf16_f32 %0, %1, %2" : "=v"(r) : "v"(lo), "v"(hi)); return r; }
__device__ __forceinline__ float bf2f(bf16_t h) { return __uint_as_float((unsigned)h << 16); }
__device__ __forceinline__ bf16_t f2bf(float f) { return (bf16_t)(cvt_pk_bf16(f, 0.f) & 0xffffu); }
__device__ __forceinline__ float silu_f(float a) { return a * __builtin_amdgcn_rcpf(1.0f + __builtin_amdgcn_exp2f(-a * LOG2E)); }
__device__ __forceinline__ float sigmoid_f(float a) { return __builtin_amdgcn_rcpf(1.0f + __builtin_amdgcn_exp2f(-a * LOG2E)); }
__device__ __forceinline__ float sum_rows4(float x) {
    float a = x, b = x;
    asm volatile("s_nop 1\n\tv_permlane16_swap_b32 %0, %1" : "+v"(a), "+v"(b));
    float t = a + b; a = t; b = t;
    asm volatile("s_nop 1\n\tv_permlane32_swap_b32 %0, %1" : "+v"(a), "+v"(b));
    return a + b;
}
__device__ __forceinline__ float max_rows4(float x) {
    float a = x, b = x;
    asm volatile("s_nop 1\n\tv_permlane16_swap_b32 %0, %1" : "+v"(a), "+v"(b));
    float t = fmaxf(a, b); a = t; b = t;
    asm volatile("s_nop 1\n\tv_permlane32_swap_b32 %0, %1" : "+v"(a), "+v"(b));
    return fmaxf(a, b);
}
__device__ __forceinline__ float dpp_max8(float v) {
    v = fmaxf(v, __builtin_bit_cast(float, __builtin_amdgcn_update_dpp(0, __builtin_bit_cast(int, v), 0xB1, 0xF, 0xF, true)));
    v = fmaxf(v, __builtin_bit_cast(float, __builtin_amdgcn_update_dpp(0, __builtin_bit_cast(int, v), 0x4E, 0xF, 0xF, true)));
    v = fmaxf(v, __builtin_bit_cast(float, __builtin_amdgcn_update_dpp(0, __builtin_bit_cast(int, v), 0x141, 0xF, 0xF, true)));
    return v;
}
__device__ __forceinline__ float dpp_max16(float v) {
    v = dpp_max8(v);
    return fmaxf(v, __builtin_bit_cast(float, __builtin_amdgcn_update_dpp(0, __builtin_bit_cast(int, v), 0x140, 0xF, 0xF, true)));
}
__device__ __forceinline__ float dpp_row_sum(float v) {
    v += __builtin_bit_cast(float, __builtin_amdgcn_update_dpp(0, __builtin_bit_cast(int, v), 0xB1, 0xF, 0xF, true));
    v += __builtin_bit_cast(float, __builtin_amdgcn_update_dpp(0, __builtin_bit_cast(int, v), 0x4E, 0xF, 0xF, true));
    v += __builtin_bit_cast(float, __builtin_amdgcn_update_dpp(0, __builtin_bit_cast(int, v), 0x124, 0xF, 0xF, true));
    v += __builtin_bit_cast(float, __builtin_amdgcn_update_dpp(0, __builtin_bit_cast(int, v), 0x128, 0xF, 0xF, true));
    return v;
}
__device__ __forceinline__ void wave_sum2(float& a, float& b) {
    a = dpp_row_sum(a); b = dpp_row_sum(b);
    a = sum_rows4(a); b = sum_rows4(b);
}
__device__ __forceinline__ float row_rstd(const float* ssq, int r) {
    const f32x4* p = (const f32x4*)(ssq + (size_t)r * 16);
    const f32x4 a = p[0], b = p[1], c = p[2], d = p[3];
    const f32x4 s = (a + b) + (c + d);
    return rsqrtf(((s.x + s.y) + (s.z + s.w)) * (1.0f / D) + EPS);
}

__device__ __forceinline__ int lane_now() { int l; asm volatile("v_mbcnt_lo_u32_b32 %0, -1, 0\n\tv_mbcnt_hi_u32_b32 %0, -1, %0" : "=v"(l)); return l; }
namespace pg8 {
constexpr int BM = 256, BK = 64, HALF = 128, HTB = HALF * BK * 2, STAGE_BYTES = 8 * HTB, NXCD = 8, WGM = 8;
__host__ __device__ __forceinline__ int lds_byte(int r, int c) { const int st = (r >> 4) * 2 + (c >> 5), rr = r & 15, cc = c & 31, ob = rr * 64 + cc * 2; return st * 1024 + (ob ^ (((ob >> 9) & 1) << 5)); }
__host__ __device__ __forceinline__ void stage_rc(int b, int& R, int& C) { const int st = b / 1024, sb = b % 1024, swz = sb ^ (((sb >> 9) & 1) << 5); R = (st >> 1) * 16 + swz / 64; C = (st & 1) * 32 + (swz % 64) / 2; }
__host__ __device__ __forceinline__ int perm32(int rho) { const int n = rho >> 4, i = rho & 15; return 8 * (i >> 2) + 4 * n + (i & 3); }

struct Unit { int pm, pn; };
struct Gemm { const bf16_t* A; const bf16_t* Bt; int M, N, K; };

struct StaticOrder {
    int nM, nN, nwg, G, c, wgm;
    __host__ __device__ void init(int M_, int N_, int G_, int c_, int wgm_ = WGM) { nM = M_ / BM; nN = N_ / BM; nwg = nM * nN; G = G_; c = c_; wgm = wgm_; }
    __host__ __device__ bool next(int i, Unit& u) const {
        const long L = (long)i * G + c; if (L >= nwg) return false;
        int wgid = (int)L; { const int q = nwg / NXCD, r = nwg % NXCD, xcd = wgid % NXCD, off = wgid / NXCD; wgid = (xcd < r ? xcd * (q + 1) : r * (q + 1) + (xcd - r) * q) + off; }
        const int nig = wgm * nN, gid = wgid / nig, fm = gid * wgm, gsz = (nM - fm) < wgm ? (nM - fm) : wgm;
        u.pm = fm + ((wgid % nig) % gsz); u.pn = (wgid % nig) / gsz; return true;
    }
    __device__ __forceinline__ void a_ready(const Unit&) const {}
    __device__ __forceinline__ void done(const Unit&) const {}
};

__device__ __forceinline__ f32x4 mma16(bf16x8 b, bf16x8 a, f32x4 c) { return __builtin_amdgcn_mfma_f32_16x16x32_bf16(b, a, c, 0, 0, 0); }
__device__ __forceinline__ i32x4 mma16(bf16x8 b, bf16x8 a, i32x4 c) { return __builtin_amdgcn_mfma_i32_16x16x64_i8(__builtin_bit_cast(i32x4, b), __builtin_bit_cast(i32x4, a), c, 0, 0, 0); }
template <bool I8> struct AccT { typedef f32x4 type; };
template <> struct AccT<true> { typedef i32x4 type; };
template <class Epi, class Sched, bool ALIGN_EPI, bool SP2, bool I8 = false>
__device__ __forceinline__ void gemm_phase(LAS unsigned char* lds, const Gemm g, const Sched& S, const Epi& E, int wave_) {
    static_assert(ALIGN_EPI && SP2, "only the aligned-epilogue, two-MFMA-cluster schedule is kept");
    const int tid = wave_ * 64 + lane_now();
    const int wid = wave_, lane = tid & 63, wr = wid >> 2, wc = wid & 3, fr = lane & 15, fq = lane >> 4;
    const int K = g.K, nt = K / BK;
    unsigned voffA, voffB;
    { int R, C; stage_rc(tid * 16, R, C); const int Rb = Epi::PERM ? ((R & ~31) + perm32(R & 31)) : R; voffA = (unsigned)(R * K + C) * 2u; voffB = (unsigned)(Rb * K + C) * 2u; }
    const __amdgpu_buffer_rsrc_t srdA = __builtin_amdgcn_make_buffer_rsrc((void*)g.A, (short)0, -1, 0x00020000);
    const __amdgpu_buffer_rsrc_t srdB = __builtin_amdgcn_make_buffer_rsrc((void*)g.Bt, (short)0, -1, 0x00020000);
    const unsigned kstep = BK * 2u, hstep = (unsigned)HALF * (unsigned)K * 2u, tstep = 2u * hstep, pstep = 64u * (unsigned)K * 2u;
    const unsigned ldsb = (unsigned)(size_t)lds + (unsigned)wid * 1024u;
    const int aoff = lds_byte(wr * 64 + fr, fq * 8), boff = lds_byte(wc * 32 + fr, fq * 8);
#define PG8_SA(b, h) (((b) * 2 + (h)) * HTB)
#define PG8_SB(b, h) ((4 + (b) * 2 + (h)) * HTB)
#define PG8_STAGE(bufoff, srd, soff, voff) do { _Pragma("unroll") for (int _i = 0; _i < 2; ++_i) \
        asm volatile("s_add_u32 m0, %0, %4\n\ts_nop 0\n\tbuffer_load_dwordx4 %1, %2, %3 offen lds" :: "s"(ldsb), "v"(voff), "s"(srd), "s"((soff) + _i * pstep), "n"((bufoff) + _i * 8192) : "m0", "scc", "memory"); } while (0)
#define PG8_STA(b, h, soff) PG8_STAGE(PG8_SA(b, h), srdA, soff, voffA)
#define PG8_STB(b, h, soff) PG8_STAGE(PG8_SB(b, h), srdB, soff, voffB)
#define PG8_LDA(dst, b, h) do { _Pragma("unroll") for (int m = 0; m < 4; ++m) _Pragma("unroll") for (int k = 0; k < 2; ++k) dst[m][k] = *(const LAS bf16x8*)(lds + PG8_SA(b, h) + aoff + m * 2048 + k * 1024); } while (0)
#define PG8_LDB(dst, b, h) do { _Pragma("unroll") for (int n = 0; n < 2; ++n) _Pragma("unroll") for (int k = 0; k < 2; ++k) dst[n][k] = *(const LAS bf16x8*)(lds + PG8_SB(b, h) + boff + n * 2048 + k * 1024); } while (0)
#define PG8_MMA(ai, bj, At, Bt) do { __builtin_amdgcn_s_setprio(1); _Pragma("unroll") for (int m = 0; m < 4; ++m) _Pragma("unroll") for (int n = 0; n < 2; ++n) _Pragma("unroll") for (int k = 0; k < 2; ++k) \
        acc[ai][bj][m][n] = mma16(Bt[n][k], At[m][k], acc[ai][bj][m][n]); __builtin_amdgcn_s_setprio(0); } while (0)
#define PG8_MMAZ(ai, bj, At, Bt) do { __builtin_amdgcn_s_setprio(1); _Pragma("unroll") for (int m = 0; m < 4; ++m) _Pragma("unroll") for (int n = 0; n < 2; ++n) { \
        acc[ai][bj][m][n] = mma16(Bt[n][0], At[m][0], acc_t{}); acc[ai][bj][m][n] = mma16(Bt[n][1], At[m][1], acc[ai][bj][m][n]); } __builtin_amdgcn_s_setprio(0); } while (0)
#define PG8_WAIT_V(n) asm volatile("s_waitcnt vmcnt(%0)" :: "n"(n) : "memory")
#define PG8_WAIT_L(n) asm volatile("s_waitcnt lgkmcnt(" #n ")" ::: "memory")
#define PG8_BAR __builtin_amdgcn_s_barrier()
#define PG8_SCHED __builtin_amdgcn_sched_barrier(0)
#ifndef PG8_RELAX
#define PG8_RELAX 1
#endif
#define PG8_WAIT_R(relaxed, nst) do { if (relaxed) PG8_WAIT_V(8 + PG8_RELAX * (nst)); else PG8_WAIT_V(8); } while (0)
#define PG8_TRIP(first, relaxed, nst) do { \
            PG8_LDB(B0, 0, 0); PG8_LDB(B1, 0, 1); PG8_SCHED; PG8_LDA(At, 0, 0); if (!(first)) PG8_STA(1, 1, a1 + hstep); \
            PG8_WAIT_R(relaxed, nst); PG8_WAIT_L(0); PG8_BAR; PG8_MMA(0, 0, At, B0); PG8_MMA(0, 1, At, B1); PG8_BAR; PG8_SCHED; \
            PG8_LDA(At, 0, 1); PG8_STB(0, 0, b2); PG8_STB(0, 1, b2 + hstep); PG8_STA(0, 0, a2); \
            PG8_WAIT_R(relaxed, nst); PG8_WAIT_L(0); PG8_BAR; PG8_MMA(1, 0, At, B0); PG8_MMA(1, 1, At, B1); PG8_BAR; PG8_SCHED; \
            PG8_LDB(B0, 1, 0); PG8_LDB(B1, 1, 1); PG8_SCHED; PG8_LDA(At, 1, 0); PG8_STA(0, 1, a2 + hstep); \
            PG8_WAIT_R(relaxed, nst); PG8_WAIT_L(0); PG8_BAR; PG8_MMA(0, 0, At, B0); PG8_MMA(0, 1, At, B1); PG8_BAR; PG8_SCHED; \
            PG8_LDA(At, 1, 1); PG8_STB(1, 0, b3); PG8_STB(1, 1, b3 + hstep); PG8_STA(1, 0, a3); \
            PG8_WAIT_V(8); PG8_WAIT_L(0); PG8_BAR; PG8_MMA(1, 0, At, B0); PG8_MMA(1, 1, At, B1); PG8_BAR; PG8_SCHED; } while (0)
    constexpr bool EARLY = Epi::NST > 0;
    Unit cur, nxt; int ui = 0;
    if (!S.next(0, cur)) return;
    typedef typename AccT<I8>::type acc_t;
    acc_t acc[2][2][4][2];
    bf16x8 At[4][2], B0[2][2], B1[2][2];
    unsigned cA = (unsigned)cur.pm * tstep, cB = (unsigned)cur.pn * tstep;
    S.a_ready(cur);
    PG8_STB(0, 0, cB); PG8_STB(0, 1, cB + hstep); PG8_STA(0, 0, cA); PG8_STA(0, 1, cA + hstep);
    if (wr == 1) PG8_BAR;
    PG8_WAIT_V(2); PG8_BAR;
    PG8_STB(1, 0, cB + kstep); PG8_STA(1, 0, cA + kstep); PG8_STB(1, 1, cB + hstep + kstep);
    if constexpr (EARLY) { PG8_STA(1, 1, cA + hstep + kstep); PG8_WAIT_V(8); } else { PG8_WAIT_V(6); }
    PG8_BAR;
#pragma unroll
    for (int a = 0; a < 2; ++a)
#pragma unroll
        for (int b = 0; b < 2; ++b)
#pragma unroll
            for (int m = 0; m < 4; ++m)
#pragma unroll
                for (int n = 0; n < 2; ++n) acc[a][b][m][n] = acc_t{};
    for (;;) {
        const bool has_next = S.next(ui + 1, nxt);
        const unsigned nA = has_next ? (unsigned)nxt.pm * tstep : cA, nB = has_next ? (unsigned)nxt.pn * tstep : cB;
        for (int t = 0; t < nt; t += 2) {
            const bool last = (t == nt - 2), first = EARLY && (t == 0), relaxed = first && ui > 0;
            const unsigned a1 = cA + (unsigned)(t + 1) * kstep;
            const unsigned a2 = last ? nA : cA + (unsigned)(t + 2) * kstep, b2 = last ? nB : cB + (unsigned)(t + 2) * kstep;
            const unsigned a3 = a2 + kstep, b3 = b2 + kstep;
            if (last && has_next) S.a_ready(nxt);
            if (last) E.prefetch(cur, wid, lane, lds);
            PG8_TRIP(first, relaxed, Epi::NST);
        }
        if constexpr (EARLY) PG8_STA(1, 1, nA + kstep + hstep);
        if (wr == 0) PG8_BAR;
        E(acc, cur, wr, wc, fr, fq); S.done(cur);
        if (!has_next) break;
#pragma unroll
        for (int a = 0; a < 2; ++a)
#pragma unroll
            for (int b = 0; b < 2; ++b)
#pragma unroll
                for (int m = 0; m < 4; ++m)
#pragma unroll
                    for (int n = 0; n < 2; ++n) acc[a][b][m][n] = acc_t{};
        cur = nxt; cA = nA; cB = nB; ++ui;
        if (wr == 1) PG8_BAR;
    }
    PG8_WAIT_V(0);
    PG8_BAR;
#undef PG8_SA
#undef PG8_SB
#undef PG8_STAGE
#undef PG8_STA
#undef PG8_STB
#undef PG8_LDA
#undef PG8_LDB
#undef PG8_MMA
#undef PG8_MMAZ
#undef PG8_TRIP
#undef PG8_WAIT_R
#undef PG8_WAIT_V
#undef PG8_WAIT_L
#undef PG8_BAR
#undef PG8_SCHED
}
}

typedef const f32x4 (&AccRef)[2][2][4][2];
#define EPI_BIG_CALL() \
    __device__ __forceinline__ void operator()(AccRef acc, const pg8::Unit& u, int wr, int wc, int fr, int fq) const { \
        { const int l_ = lane_now(); fr = l_ & 15; fq = (l_ >> 4) & 3; }     \
        const int row0 = u.pm * 256 + wr * 64 + fr; \
        _Pragma("unroll") for (int gq = 0; gq < 8 / PF; ++gq) { \
            Pre p[PF]; \
            asm volatile("" ::: "memory"); \
            _Pragma("unroll") for (int i = 0; i < PF; ++i) { const int rg = gq * PF + i; p[i] = pre_big(row0 + (rg >> 2) * 128 + (rg & 3) * 16, u.pn, wc, fq); }     \
            asm volatile("" ::: "memory"); \
            _Pragma("unroll") for (int i = 0; i < PF; ++i) { const int rg = gq * PF + i; \
                rows(acc[rg >> 2][0][rg & 3][0], acc[rg >> 2][0][rg & 3][1], acc[rg >> 2][1][rg & 3][0], acc[rg >> 2][1][rg & 3][1], row0 + (rg >> 2) * 128 + (rg & 3) * 16, u.pn, wc, fq, p[i]); } } \
    }
__device__ __forceinline__ f32x4 ssq_quarter(const float* ssq, int r, int fq) { return *(const f32x4*)(ssq + (size_t)r * 16 + 4 * fq); }
__device__ __forceinline__ float rstd_from(const f32x4& q) {
    float s = (q.x + q.y) + (q.z + q.w);
    s = sum_rows4(s);
    return rsqrtf(s * (1.0f / D) + EPS);
}

__device__ __forceinline__ void ssq_prefetch(const float* ssq, int pm, int wid, int lane, LAS unsigned char* lds) {
    asm volatile("" : "+v"(lane));
#pragma unroll
    for (int i = 0; i < 2; ++i)
        __builtin_amdgcn_global_load_lds((const unsigned*)(ssq + ((size_t)pm * 256 + wid * 32 + i * 16) * 16 + lane * 4), (LAS unsigned*)(lds + SSQ_LDS_OFF + (wid * 32 + i * 16) * 64), 16, 0, 0);
}
struct EpiSwiglu {
    static constexpr bool PERM = true; static constexpr int PF = 8; static constexpr int NST = 8;
    bf16_t* O; const float* ssq; LAS unsigned char* lds;
    struct Pre { f32x4 q; };
    __device__ __forceinline__ Pre pre(int r, int pn, int wc, int fq) const { Pre p; p.q = ssq_quarter(ssq, r, fq); return p; }
    __device__ __forceinline__ Pre pre_big(int r, int pn, int wc, int fq) const { Pre p; p.q = *(const LAS f32x4*)(lds + SSQ_LDS_OFF + (r & 255) * 64 + fq * 16); return p; }
    __device__ __forceinline__ void prefetch(const pg8::Unit& u, int wid, int lane, LAS unsigned char* l) const { ssq_prefetch(ssq, u.pm, wid, lane, l); }
    __device__ __forceinline__ void rows(const f32x4& c00, const f32x4& c01, const f32x4& c10, const f32x4& c11, int r, int pn, int wc, int fq, const Pre& p) const {
        const float rs = rstd_from(p.q);
        float o[8];
#pragma unroll
        for (int j = 0; j < 4; ++j) { o[j] = silu_f(c00[j] * rs) * (c10[j] * rs); o[4 + j] = silu_f(c01[j] * rs) * (c11[j] * rs); }
        u32x4 w; w.x = cvt_pk_bf16(o[0], o[1]); w.y = cvt_pk_bf16(o[2], o[3]); w.z = cvt_pk_bf16(o[4], o[5]); w.w = cvt_pk_bf16(o[6], o[7]);
        { bf16_t* dst_ = O + (size_t)r * FF + pn * 128 + wc * 32 + 8 * fq;
          asm volatile("global_store_dwordx4 %0, %1, off sc1\n\ts_nop 1" :: "v"(dst_), "v"(w) : "memory"); }
    }
    EPI_BIG_CALL()
};

struct EpiSwigluI8 {
    static constexpr bool PERM = true; static constexpr int NST = 8;
    bf16_t* O; const float* rs; const float* cs; LAS unsigned char* lds;
    struct Pre { float sa; };
    __device__ __forceinline__ Pre pre(int r, int pn, int wc, int fq) const { Pre p; p.sa = rs[r]; return p; }
    __device__ __forceinline__ void prefetch(const pg8::Unit& u, int wid, int lane, LAS unsigned char* l) const {
        asm volatile("" : "+v"(lane));
        if (wid == 0) __builtin_amdgcn_global_load_lds((const unsigned*)(rs + (size_t)u.pm * 256 + lane * 4), (LAS unsigned*)(l + SSQ_LDS_OFF), 16, 0, 0);
        if (wid == 1) __builtin_amdgcn_global_load_lds((const unsigned*)(cs + (size_t)u.pn * 256 + lane * 4), (LAS unsigned*)(l + SSQ_LDS_OFF + 1024), 16, 0, 0);
    }
    __device__ __forceinline__ void emit(const f32x4& c00, const f32x4& c01, const f32x4& c10, const f32x4& c11, float sa, const f32x4& w00, const f32x4& w01, const f32x4& w10, const f32x4& w11,
                                         int r, int pn, int wc, int fq) const {
        float o[8];
#pragma unroll
        for (int j = 0; j < 4; ++j) { o[j] = silu_f(c00[j] * (sa * w00[j])) * (c10[j] * (sa * w10[j])); o[4 + j] = silu_f(c01[j] * (sa * w01[j])) * (c11[j] * (sa * w11[j])); }
        u32x4 w; w.x = cvt_pk_bf16(o[0], o[1]); w.y = cvt_pk_bf16(o[2], o[3]); w.z = cvt_pk_bf16(o[4], o[5]); w.w = cvt_pk_bf16(o[6], o[7]);
        { bf16_t* dst_ = O + (size_t)r * FF + pn * 128 + wc * 32 + 8 * fq;
          asm volatile("global_store_dwordx4 %0, %1, off sc1\n\ts_nop 1" :: "v"(dst_), "v"(w) : "memory"); }
    }
    __device__ __forceinline__ void rows(const f32x4& c00, const f32x4& c01, const f32x4& c10, const f32x4& c11, int r, int pn, int wc, int fq, const Pre& p) const {
        const float* cp = cs + (size_t)pn * 256 + wc * 32 + 8 * fq;
        emit(c00, c01, c10, c11, p.sa, *(const f32x4*)cp, *(const f32x4*)(cp + 4), *(const f32x4*)(cp + 128), *(const f32x4*)(cp + 132), r, pn, wc, fq);
    }
    template <class AccTy> __device__ __forceinline__ void operator()(const AccTy (&acc)[2][2][4][2], const pg8::Unit& u, int wr, int wc, int fr, int fq) const {
        { const int l_ = lane_now(); fr = l_ & 15; fq = (l_ >> 4) & 3; }
        const int row0 = u.pm * 256 + wr * 64 + fr;
        LAS const float* lr = (LAS const float*)(lds + SSQ_LDS_OFF); LAS const float* lc = lr + 256 + wc * 32 + 8 * fq;
        const f32x4 w00 = *(LAS const f32x4*)lc, w01 = *(LAS const f32x4*)(lc + 4), w10 = *(LAS const f32x4*)(lc + 128), w11 = *(LAS const f32x4*)(lc + 132);
        f32x2 NW[4], WW[4];
        NW[0] = (f32x2){w00[0], w00[1]} * (-LOG2E); NW[1] = (f32x2){w00[2], w00[3]} * (-LOG2E); NW[2] = (f32x2){w01[0], w01[1]} * (-LOG2E); NW[3] = (f32x2){w01[2], w01[3]} * (-LOG2E);
        WW[0] = (f32x2){w00[0], w00[1]} * (f32x2){w10[0], w10[1]}; WW[1] = (f32x2){w00[2], w00[3]} * (f32x2){w10[2], w10[3]};
        WW[2] = (f32x2){w01[0], w01[1]} * (f32x2){w11[0], w11[1]}; WW[3] = (f32x2){w01[2], w01[3]} * (f32x2){w11[2], w11[3]};
#pragma unroll
        for (int rg = 0; rg < 8; ++rg) {
            const int ai = rg >> 2, m = rg & 3, r = row0 + ai * 128 + m * 16;
            const float sa = lr[r & 255], inv = __builtin_amdgcn_rcpf(sa);
            unsigned pk[4];
#pragma unroll
            for (int p = 0; p < 4; ++p) {
                const AccTy& cg = acc[ai][0][m][p >> 1]; const AccTy& cu = acc[ai][1][m][p >> 1]; const int j = (p & 1) * 2;
                const f32x2 G = (f32x2){(float)cg[j], (float)cg[j + 1]} * sa, U = (f32x2){(float)cu[j], (float)cu[j + 1]};
                const f32x2 T = G * NW[p];
                f32x2 E; E.x = __builtin_amdgcn_exp2f(T.x); E.y = __builtin_amdgcn_exp2f(T.y);
                const f32x2 Dn = E * inv + inv;
                f32x2 R; R.x = __builtin_amdgcn_rcpf(Dn.x); R.y = __builtin_amdgcn_rcpf(Dn.y);
                const f32x2 O = ((G * U) * WW[p]) * R;
                pk[p] = cvt_pk_bf16(O.x, O.y);
            }
            u32x4 w; w.x = pk[0]; w.y = pk[1]; w.z = pk[2]; w.w = pk[3];
            { bf16_t* dst_ = O_at(r, u.pn, wc, fq);
              asm volatile("global_store_dwordx4 %0, %1, off sc1\n\ts_nop 1" :: "v"(dst_), "v"(w) : "memory"); }
        }
    }
    __device__ __forceinline__ bf16_t* O_at(int r, int pn, int wc, int fq) const { return O + (size_t)r * FF + pn * 128 + wc * 32 + 8 * fq; }
};

template <int MODE> struct EpiResid {
    static constexpr bool PERM = true; static constexpr int PF = (MODE == 0) ? 2 : 4;
    static constexpr int NST = (MODE == 2) ? 16 : (MODE == 1) ? 12 : 6;
    const float* resP; const float* resS;
    float* out; bf16_t* xb; float* ssq; float scale;
    struct Pre { f32x4 r00, r01, r10, r11; u32x4 a, b; };
    __device__ __forceinline__ Pre pre(int r, int pn, int wc, int fq) const {
        Pre p; const size_t off = (size_t)r * D + pn * 256 + wc * 32 + 8 * fq;
        if (MODE == 0) { const float* rbase = (r >= MP) ? resS - (size_t)MP * D : resP;
            p.r00 = *(const f32x4*)(rbase + off); p.r01 = *(const f32x4*)(rbase + off + 4); p.r10 = *(const f32x4*)(rbase + off + 128); p.r11 = *(const f32x4*)(rbase + off + 132); }
        else { p.a = *(const u32x4*)(xb + off); p.b = *(const u32x4*)(xb + off + 128); }
        return p;
    }
    __device__ __forceinline__ Pre pre_big(int r, int pn, int wc, int fq) const { return pre(r, pn, wc, fq); }
    __device__ __forceinline__ void prefetch(const pg8::Unit&, int, int, LAS unsigned char*) const {}
    __device__ __forceinline__ void rows(const f32x4& c00, const f32x4& c01, const f32x4& c10, const f32x4& c11, int r, int pn, int wc, int fq, const Pre& p) const {
        const size_t off = (size_t)r * D + pn * 256 + wc * 32 + 8 * fq;
        f32x4 r00, r01, r10, r11;
        if (MODE == 0) { r00 = p.r00; r01 = p.r01; r10 = p.r10; r11 = p.r11; }
        else {
            const u32x4 a = p.a, b = p.b;
            r00 = (f32x4){__uint_as_float(a.x << 16), __uint_as_float(a.x & 0xffff0000u), __uint_as_float(a.y << 16), __uint_as_float(a.y & 0xffff0000u)};
            r01 = (f32x4){__uint_as_float(a.z << 16), __uint_as_float(a.z & 0xffff0000u), __uint_as_float(a.w << 16), __uint_as_float(a.w & 0xffff0000u)};
            r10 = (f32x4){__uint_as_float(b.x << 16), __uint_as_float(b.x & 0xffff0000u), __uint_as_float(b.y << 16), __uint_as_float(b.y & 0xffff0000u)};
            r11 = (f32x4){__uint_as_float(b.z << 16), __uint_as_float(b.z & 0xffff0000u), __uint_as_float(b.w << 16), __uint_as_float(b.w & 0xffff0000u)};
        }
        const f32x4 y00 = r00 + c00 * scale, y01 = r01 + c01 * scale, y10 = r10 + c10 * scale, y11 = r11 + c11 * scale;
        if (MODE == 2) {
            __builtin_nontemporal_store(y00, (f32x4*)(out + off)); __builtin_nontemporal_store(y01, (f32x4*)(out + off + 4)); __builtin_nontemporal_store(y10, (f32x4*)(out + off + 128)); __builtin_nontemporal_store(y11, (f32x4*)(out + off + 132));
        } else {
            u32x4 w0, w1;
            w0.x = cvt_pk_bf16(y00[0], y00[1]); w0.y = cvt_pk_bf16(y00[2], y00[3]); w0.z = cvt_pk_bf16(y01[0], y01[1]); w0.w = cvt_pk_bf16(y01[2], y01[3]);
            w1.x = cvt_pk_bf16(y10[0], y10[1]); w1.y = cvt_pk_bf16(y10[2], y10[3]); w1.z = cvt_pk_bf16(y11[0], y11[1]); w1.w = cvt_pk_bf16(y11[2], y11[3]);
            *(u32x4*)(xb + off) = w0; *(u32x4*)(xb + off + 128) = w1;
            float ss = (y00[0] * y00[0] + y00[1] * y00[1]) + (y00[2] * y00[2] + y00[3] * y00[3]) + (y01[0] * y01[0] + y01[1] * y01[1]) + (y01[2] * y01[2] + y01[3] * y01[3])
                     + (y10[0] * y10[0] + y10[1] * y10[1]) + (y10[2] * y10[2] + y10[3] * y10[3]) + (y11[0] * y11[0] + y11[1] * y11[1]) + (y11[2] * y11[2] + y11[3] * y11[3]);
            ss = sum_rows4(ss);
            if (fq == 0) ssq[(size_t)r * 16 + pn * 4 + wc] = ss;
        }
    }
    EPI_BIG_CALL()
};

struct EpiInProj {
    static constexpr bool PERM = true; static constexpr int PF = 1; static constexpr int NST = 0;
    unsigned char* ws; const float* gq; const float* gk; float* out; LAS unsigned char* lds;
    struct Pre { f32x4 q; };
    __device__ __forceinline__ Pre pre(int r, int pn, int wc, int fq) const { Pre p; p.q = ssq_quarter((const float*)(ws + WS_SSQ1), r, fq); return p; }
    __device__ __forceinline__ Pre pre_big(int r, int pn, int wc, int fq) const { Pre p; p.q = *(const LAS f32x4*)(lds + SSQ_LDS_OFF + (r & 255) * 64 + fq * 16); return p; }
    __device__ __forceinline__ void prefetch(const pg8::Unit& u, int wid, int lane, LAS unsigned char* l) const { ssq_prefetch((const float*)(ws + WS_SSQ1), u.pm, wid, lane, l); }
    __device__ __forceinline__ void rows(const f32x4& c00, const f32x4& c01, const f32x4& c10, const f32x4& c11, int r, int pn, int wc, int fq, const Pre& p) const {
        const bool sample = r >= MP;
        int b, t, pos;
        if (sample) { const int rr = r - MP; b = rr >> 4; t = rr & 15; pos = PAST + t; } else { b = r >> 13; t = r & (TP - 1); pos = t; }
        const float rs = rstd_from(p.q);
        if (pn < 4) {
            const int ch0 = pn * 128 + wc * 32 + 8 * fq;
            float o[8];
#pragma unroll
            for (int j = 0; j < 4; ++j) { o[j] = (c00[j] * rs) * sigmoid_f(c10[j] * rs); o[4 + j] = (c01[j] * rs) * sigmoid_f(c11[j] * rs); }
            u32x4 w; w.x = cvt_pk_bf16(o[0], o[1]); w.y = cvt_pk_bf16(o[2], o[3]); w.z = cvt_pk_bf16(o[4], o[5]); w.w = cvt_pk_bf16(o[6], o[7]);
            bf16_t* ud = sample ? (bf16_t*)(ws + WS_US) + ((size_t)(b * USROWS + HIST + t)) * CC + ch0 : (bf16_t*)(ws + WS_UP) + (size_t)r * CC + ch0;
            *(u32x4*)ud = w;
            float* dst = nullptr;
            if (sample) dst = out + O_CSS + ((size_t)(b * HIST + (HIST - TS) + t)) * CC + ch0;
            else if (t >= TP - HIST) dst = out + O_CSP + ((size_t)(b * HIST + (t - (TP - HIST)))) * CC + ch0;
            if (dst) { *(f32x4*)dst = (f32x4){o[0], o[1], o[2], o[3]}; *(f32x4*)(dst + 4) = (f32x4){o[4], o[5], o[6], o[7]}; }
        } else if (pn < 6 || wc < 2) {
            const bool isq = pn < 6;
            const int h = isq ? (pn - 4) * 4 + wc : wc;
            const float* gg = isq ? gq : gk;
            const f32x4 g00 = *(const f32x4*)(gg + 8 * fq), g01 = *(const f32x4*)(gg + 8 * fq + 4), g10 = *(const f32x4*)(gg + 32 + 8 * fq), g11 = *(const f32x4*)(gg + 32 + 8 * fq + 4);
            const float osc = isq ? QSCALE : 1.0f;
            f32x4 v00 = c00 * rs, v01 = c01 * rs, v10 = c10 * rs, v11 = c11 * rs;
            float ss = (v00[0] * v00[0] + v00[1] * v00[1]) + (v00[2] * v00[2] + v00[3] * v00[3]) + (v01[0] * v01[0] + v01[1] * v01[1]) + (v01[2] * v01[2] + v01[3] * v01[3])
                     + (v10[0] * v10[0] + v10[1] * v10[1]) + (v10[2] * v10[2] + v10[3] * v10[3]) + (v11[0] * v11[0] + v11[1] * v11[1]) + (v11[2] * v11[2] + v11[3] * v11[3]);
            ss = sum_rows4(ss);
            const float hn = rsqrtf(ss * (1.0f / HD) + EPS);
            v00 = v00 * hn * g00; v01 = v01 * hn * g01; v10 = v10 * hn * g10; v11 = v11 * hn * g11;
            f32x4 p0, p1;
#pragma unroll
            for (int j = 0; j < 4; ++j) { p0[j] = __shfl_xor(v00[j], 16); p1[j] = __shfl_xor(v01[j], 16);     }
            if (fq < 2) {
                const f32x2* rp = (const f32x2*)(ws + WS_ROPE) + (size_t)pos * 8;
                const float sg = (fq == 0) ? -1.0f : 1.0f;
#pragma unroll
                for (int j = 0; j < 4; ++j) {
                    const f32x2 cs0 = rp[j], cs1 = rp[4 + j];
                    v00[j] = v00[j] * cs0.x + sg * p0[j] * cs0.y;
                    v01[j] = v01[j] * cs1.x + sg * p1[j] * cs1.y;
                }
            }
            u32x4 w0, w1;
            w0.x = cvt_pk_bf16(v00[0] * osc, v00[1] * osc); w0.y = cvt_pk_bf16(v00[2] * osc, v00[3] * osc); w0.z = cvt_pk_bf16(v01[0] * osc, v01[1] * osc); w0.w = cvt_pk_bf16(v01[2] * osc, v01[3] * osc);
            w1.x = cvt_pk_bf16(v10[0] * osc, v10[1] * osc); w1.y = cvt_pk_bf16(v10[2] * osc, v10[3] * osc); w1.z = cvt_pk_bf16(v11[0] * osc, v11[1] * osc); w1.w = cvt_pk_bf16(v11[2] * osc, v11[3] * osc);
            if (isq) {
                bf16_t* dst = (bf16_t*)(ws + WS_Q) + (size_t)r * 512 + h * 64 + 8 * fq;
                *(u32x4*)dst = w0; *(u32x4*)(dst + 32) = w1;
            } else {
                bf16_t* dst = sample ? (bf16_t*)(ws + WS_KS) + ((size_t)(b * KSROWS + WIN + t)) * 128 + h * 64 + 8 * fq : (bf16_t*)(ws + WS_KP) + (size_t)r * 128 + h * 64 + 8 * fq;
                *(u32x4*)dst = w0; *(u32x4*)(dst + 32) = w1;
                float* od = nullptr;
                if (sample) od = out + O_KWS + ((size_t)((b * WIN + (WIN - TS) + t) * 2 + h)) * 64 + 8 * fq;
                else if (t >= TP - WIN) od = out + O_KWP + ((size_t)((b * WIN + (t - (TP - WIN))) * 2 + h)) * 64 + 8 * fq;
                if (od) { *(f32x4*)od = v00; *(f32x4*)(od + 4) = v01; *(f32x4*)(od + 32) = v10; *(f32x4*)(od + 36) = v11; }
            }
        } else {
            const int kh = wc - 2;
            const f32x4 v00 = c00 * rs, v01 = c01 * rs, v10 = c10 * rs, v11 = c11 * rs;
            bf16_t* vt; size_t vs;
            if (sample) { vt = (bf16_t*)(ws + WS_VTS) + ((size_t)((b * 2 + kh) * 64)) * KSROWS + WIN + t; vs = KSROWS; }
            else { vt = (bf16_t*)(ws + WS_VTP) + ((size_t)((b * 2 + kh) * (TP / 64) + (t >> 6))) * 4096 + (t & 63); vs = 64; }
#pragma unroll
            for (int j = 0; j < 4; ++j) {
                vt[(size_t)(8 * fq + j) * vs] = f2bf(v00[j]); vt[(size_t)(8 * fq + 4 + j) * vs] = f2bf(v01[j]);
                vt[(size_t)(32 + 8 * fq + j) * vs] = f2bf(v10[j]); vt[(size_t)(32 + 8 * fq + 4 + j) * vs] = f2bf(v11[j]);
            }
            float* od = nullptr;
            if (sample) od = out + O_VWS + ((size_t)((b * WIN + (WIN - TS) + t) * 2 + kh)) * 64 + 8 * fq;
            else if (t >= TP - WIN) od = out + O_VWP + ((size_t)((b * WIN + (t - (TP - WIN))) * 2 + kh)) * 64 + 8 * fq;
            if (od) { *(f32x4*)od = v00; *(f32x4*)(od + 4) = v01; *(f32x4*)(od + 32) = v10; *(f32x4*)(od + 36) = v11; }
        }
    }
    EPI_BIG_CALL()
};

template <int KS, int MT, bool I8, class Epi>
__device__ __forceinline__ void small_gemm(const bf16_t* A, const bf16_t* Bt, int N, int K, const Epi& E, LAS unsigned char* lds, int bid, int G, int wave, int lane, int wpc_in = 0) {
    constexpr int MTN = MS / (16 * MT);
    const int NT = MTN * (N / 256) * 4, NI = NT * KS, wpc = wpc_in ? wpc_in : (NI + G - 1) / G, nb = K / 64;
    asm volatile("" : "+v"(lane));
    const int fr = lane & 15, g = lane >> 4;
    for (int i0 = 0; i0 < wpc; i0 += 8) {
        const int i = i0 + wave, item = bid * wpc + i;
        const bool active = (i < wpc) && (item < NI);
        const int t = active ? item / KS : 0, ksl = item % KS;
        const int mt = t % MTN, nq = t / MTN, pn = nq >> 2, wc = nq & 3;
        const int r = MP + mt * (16 * MT) + fr;
        typedef typename pg8::AccT<I8>::type acc_t;
        acc_t acc[MT][2][2];
#pragma unroll
        for (int mi = 0; mi < MT; ++mi)
#pragma unroll
            for (int bj = 0; bj < 2; ++bj)
#pragma unroll
                for (int n = 0; n < 2; ++n) acc[mi][bj][n] = acc_t{};
        if (active) {
            const int b0 = (nb * ksl) / KS, b1 = (nb * (ksl + 1)) / KS;
            const bf16_t* ap = A + (size_t)r * K + g * 8;
            const bf16_t* bp = Bt + (size_t)(pn * 256 + wc * 32 + 8 * (fr >> 2) + (fr & 3)) * K + g * 8;
            bf16x8 afA[2][MT], bfA[2][2][2], afB[2][MT], bfB[2][2][2];
#define SG_LOAD(af, bf, kb) do { const int k0_ = (kb) * 64; _Pragma("unroll") for (int s_ = 0; s_ < 2; ++s_) { \
            _Pragma("unroll") for (int mi = 0; mi < MT; ++mi) af[s_][mi] = *(const bf16x8*)(ap + (size_t)(16 * mi) * K + k0_ + s_ * 32); \
            _Pragma("unroll") for (int bj = 0; bj < 2; ++bj) _Pragma("unroll") for (int n = 0; n < 2; ++n) bf[s_][bj][n] = *(const bf16x8*)(bp + (size_t)(4 * n + 128 * bj) * K + k0_ + s_ * 32); } } while (0)
#define SG_MMA(af, bf) do { _Pragma("unroll") for (int s_ = 0; s_ < 2; ++s_) _Pragma("unroll") for (int bj = 0; bj < 2; ++bj) _Pragma("unroll") for (int n = 0; n < 2; ++n) { \
            _Pragma("unroll") for (int mi = 0; mi < MT; ++mi) acc[mi][bj][n] = pg8::mma16(bf[s_][bj][n], af[s_][mi], acc[mi][bj][n]); } } while (0)
            SG_LOAD(afA, bfA, b0);
            for (int kb = b0; kb < b1; kb += 2) {
                const int kb1 = (kb + 1 < b1) ? kb + 1 : b1 - 1, kb2 = (kb + 2 < b1) ? kb + 2 : b1 - 1;
                __builtin_amdgcn_sched_barrier(0);
                SG_LOAD(afB, bfB, kb1);
                __builtin_amdgcn_sched_barrier(0);
                SG_MMA(afA, bfA);
                __builtin_amdgcn_sched_barrier(0);
                SG_LOAD(afA, bfA, kb2);
                __builtin_amdgcn_sched_barrier(0);
                if (kb + 1 < b1) SG_MMA(afB, bfB);
            }
#undef SG_LOAD
#undef SG_MMA
        }
        if constexpr (KS > 1) {
            static_assert(KS == 1 || KS == 8, "KS: 1 or 8 (all eight waves of the workgroup on one tile)");
            LAS acc_t* red = (LAS acc_t*)lds;
            if (ksl != 0) {
#pragma unroll
                for (int mi = 0; mi < MT; ++mi)
#pragma unroll
                    for (int bj = 0; bj < 2; ++bj)
#pragma unroll
                        for (int n = 0; n < 2; ++n) red[(ksl - 1) * (MT * 256) + ((mi * 2 + bj) * 2 + n) * 64 + lane] = acc[mi][bj][n];
            }
            __syncthreads();
            if (ksl == 0) {
#pragma unroll
                for (int q = 0; q < KS - 1; ++q)
#pragma unroll
                    for (int mi = 0; mi < MT; ++mi)
#pragma unroll
                        for (int bj = 0; bj < 2; ++bj)
#pragma unroll
                            for (int n = 0; n < 2; ++n) acc[mi][bj][n] += red[q * (MT * 256) + ((mi * 2 + bj) * 2 + n) * 64 + lane];
            }
            __syncthreads();
        }
        if (active && ksl == 0) {
#pragma unroll
            for (int mi = 0; mi < MT; ++mi) { const typename Epi::Pre p = E.pre(r + 16 * mi, pn, wc, g);
                E.rows(__builtin_convertvector(acc[mi][0][0], f32x4), __builtin_convertvector(acc[mi][0][1], f32x4), __builtin_convertvector(acc[mi][1][0], f32x4), __builtin_convertvector(acc[mi][1][1], f32x4), r + 16 * mi, pn, wc, g, p); }
        }
    }
}

struct TItem { const float* W; const float* g; bf16_t* WT; int Nsrc, srccol0, K, destrow0, k0; };
__device__ __forceinline__ void p0_tload(const TItem& t, float (&v)[32], int lane) {
#pragma unroll
    for (int i = 0; i < 32; ++i) { const int kk = 2 * i + (lane >> 5); v[i] = t.W[(size_t)(t.k0 + kk) * t.Nsrc + t.srccol0 + (lane & 31)]; }
}
__device__ __forceinline__ void p0_tfinish(const TItem& t, const float (&v)[32], LAS float* scr, int lane) {
#pragma unroll
    for (int i = 0; i < 32; ++i) { const int kk = 2 * i + (lane >> 5); scr[kk * 33 + (lane & 31)] = v[i]; }
    asm volatile("s_waitcnt lgkmcnt(0)" ::: "memory");
    const int c = lane & 7;
    f32x4 g0 = (f32x4){1.f, 1.f, 1.f, 1.f}, g1 = g0;
    if (t.g) { g0 = *(const f32x4*)(t.g + t.k0 + 8 * c); g1 = *(const f32x4*)(t.g + t.k0 + 8 * c + 4); }
#pragma unroll
    for (int j = 0; j < 4; ++j) { const int n = (lane >> 3) + 8 * j; const LAS float* sp = scr + (8 * c) * 33 + n;
        u32x4 o; o.x = cvt_pk_bf16(sp[0 * 33] * g0.x, sp[1 * 33] * g0.y); o.y = cvt_pk_bf16(sp[2 * 33] * g0.z, sp[3 * 33] * g0.w); o.z = cvt_pk_bf16(sp[4 * 33] * g1.x, sp[5 * 33] * g1.y); o.w = cvt_pk_bf16(sp[6 * 33] * g1.z, sp[7 * 33] * g1.w);
        *(u32x4*)(t.WT + (size_t)(t.destrow0 + n) * t.K + t.k0 + 8 * c) = o; }
    asm volatile("s_waitcnt lgkmcnt(0)" ::: "memory");
}
__device__ __forceinline__ int src_up(int nb) { const int pn = nb >> 3, p0 = (nb & 7) * 32, bj = p0 >> 7; return bj * FF + pn * 128 + (p0 & 127); }
__device__ __forceinline__ int src_in(int nb) {
    const int pn = nb >> 3, p0 = (nb & 7) * 32, bj = p0 >> 7, wc = (p0 & 127) >> 5;
    if (pn < 4) return bj * CC + pn * 128 + wc * 32;
    if (pn < 6) return 1024 + ((pn - 4) * 4 + wc) * 64 + bj * 32;
    return (wc < 2) ? 1536 + wc * 64 + bj * 32 : 1664 + (wc - 2) * 64 + bj * 32;
}

struct Args { const float* in[21]; float* out; unsigned char* ws; float inv[8]; };
typedef const __attribute__((address_space(4))) Args& ArgsRef;
__device__ __forceinline__ const __attribute__((address_space(4))) Args* args_now() {
#if defined(__HIP_DEVICE_COMPILE__)
    auto p = (const __attribute__((address_space(4))) Args*)__builtin_amdgcn_kernarg_segment_ptr(); asm volatile("" : "+s"(p)); return p;
#else
    return nullptr;
#endif
}

constexpr int I_UP = (D / 64) * (NUP / 32), I_DN = (FF / 64) * (D / 32), I_IN = (D / 64) * (NIN / 32), I_O = (D / 64) * (D / 32);
constexpr int NITEMS = 2 * I_UP + 2 * I_DN + I_IN + I_O;
constexpr int NITEMS_EARLY = I_UP + I_DN + I_IN + I_O;
__device__ __forceinline__ TItem p0_decode(ArgsRef a, int it) {
    unsigned char* ws = a.ws; int r = it < NITEMS ? it : NITEMS - 1; TItem t;
    if (r < I_UP) { const int nblk = NUP / 32, kb = r / nblk, nb = r % nblk; t = TItem{a.in[6], a.in[5], (bf16_t*)(ws + WS_W1T), NUP, src_up(nb), D, nb * 32, kb * 64}; return t; } r -= I_UP;
    if (r < I_DN) { const int nblk = D / 32, kb = r / nblk, nb = r % nblk; t = TItem{a.in[7], nullptr, (bf16_t*)(ws + WS_W2T), D, nb * 32, FF, nb * 32, kb * 64}; return t; } r -= I_DN;
    if (r < I_IN) { const int nblk = NIN / 32, kb = r / nblk, nb = r % nblk; t = TItem{a.in[9], a.in[8], (bf16_t*)(ws + WS_WINT), NIN, src_in(nb), D, nb * 32, kb * 64}; return t; } r -= I_IN;
    if (r < I_O) { const int nblk = D / 32, kb = r / nblk, nb = r % nblk; t = TItem{a.in[17], nullptr, (bf16_t*)(ws + WS_WOT), D, nb * 32, D, nb * 32, kb * 64}; return t; } r -= I_O;
    if (r < I_UP) { const int nblk = NUP / 32, kb = r / nblk, nb = r % nblk; t = TItem{a.in[19], a.in[18], (bf16_t*)(ws + WS_W3T), NUP, src_up(nb), D, nb * 32, kb * 64}; return t; } r -= I_UP;
    { const int nblk = D / 32, kb = r / nblk, nb = r % nblk; t = TItem{a.in[20], nullptr, (bf16_t*)(ws + WS_W4T), D, nb * 32, FF, nb * 32, kb * 64}; return t; }
}
__device__ __forceinline__ void weights_convert(ArgsRef a, LAS unsigned char* lds, int it0, int it1, int gw, int NGW, int wave, int lane) {
    LAS float* scr = (LAS float*)(lds + wave * 16896);
    for (int it = it0 + gw; it < it1; it += 2 * NGW) {
        const TItem t0 = p0_decode(a, it), t1 = p0_decode(a, it + NGW < it1 ? it + NGW : it);
        float v0[32], v1[32];
        p0_tload(t0, v0, lane); p0_tload(t1, v1, lane);
        p0_tfinish(t0, v0, scr, lane);
        if (it + NGW < it1) p0_tfinish(t1, v1, scr + 64 * 33, lane);
    }
}


__device__ __forceinline__ void w8_strip(const float* W, const float* g, signed char* Wq, float* cs, int nb, LAS unsigned char* lds, int wave, int lane) {
    LAS float* scr = (LAS float*)(lds + wave * 16896);
    LAS float* red = (LAS float*)(lds + 139264);
    const int src0 = src_up(nb), k0 = 128 * wave, c = lane & 7;
    TItem t0{W, nullptr, nullptr, NUP, src0, D, 0, k0}, t1{W, nullptr, nullptr, NUP, src0, D, 0, k0 + 64};
    float v0[32], v1[32];
    p0_tload(t0, v0, lane); p0_tload(t1, v1, lane);
#pragma unroll
    for (int i = 0; i < 32; ++i) { const int kk = 2 * i + (lane >> 5); scr[kk * 33 + (lane & 31)] = v0[i]; scr[64 * 33 + kk * 33 + (lane & 31)] = v1[i]; }
    asm volatile("s_waitcnt lgkmcnt(0)" ::: "memory");
    float val[2][4][8]; float mx[4];
#pragma unroll
    for (int h = 0; h < 2; ++h) { const f32x4 ga = *(const f32x4*)(g + k0 + 64 * h + 8 * c), gb = *(const f32x4*)(g + k0 + 64 * h + 8 * c + 4);
#pragma unroll
        for (int j = 0; j < 4; ++j) { const LAS float* sp = scr + h * (64 * 33) + (8 * c) * 33 + (lane >> 3) + 8 * j;
#pragma unroll
            for (int i = 0; i < 8; ++i) val[h][j][i] = sp[i * 33] * (i < 4 ? ga[i] : gb[i - 4]); } }
#pragma unroll
    for (int j = 0; j < 4; ++j) { float m = 0.f;
#pragma unroll
        for (int h = 0; h < 2; ++h)
#pragma unroll
            for (int i = 0; i < 8; ++i) m = fmaxf(m, fabsf(val[h][j][i]));
        m = dpp_max8(m);
        mx[j] = m; }
    if (c == 0) {
#pragma unroll
        for (int j = 0; j < 4; ++j) red[wave * 32 + (lane >> 3) + 8 * j] = mx[j]; }
    __syncthreads();
#pragma unroll
    for (int j = 0; j < 4; ++j) { float m = 0.f;
#pragma unroll
        for (int w = 0; w < 8; ++w) m = fmaxf(m, red[w * 32 + (lane >> 3) + 8 * j]);
        mx[j] = m; }
#pragma unroll
    for (int j = 0; j < 4; ++j) { const int n = (lane >> 3) + 8 * j; const float inv = mx[j] > 0.f ? 127.0f / mx[j] : 0.f;
        if (wave == 0 && c == 0) cs[nb * 32 + n] = mx[j] > 0.f ? mx[j] * (1.0f / 127.0f) : 1.0f;
#pragma unroll
        for (int h = 0; h < 2; ++h) { unsigned lo = 0u, hi = 0u;
#pragma unroll
            for (int i = 0; i < 4; ++i) { lo |= ((unsigned)(int)rintf(val[h][j][i] * inv) & 0xffu) << (8 * i); hi |= ((unsigned)(int)rintf(val[h][j][4 + i] * inv) & 0xffu) << (8 * i); }
            *(u32x2*)(Wq + (size_t)(nb * 32 + n) * D + k0 + 64 * h + 8 * c) = (u32x2){lo, hi}; } }
    __syncthreads();
}
template <int NR> __device__ __forceinline__ void q8_rows(unsigned char* ws, const float* ssq, int m0, int lane) {
    const bf16_t* AB = (const bf16_t*)(ws + WS_AB); signed char* A8 = (signed char*)(ws + WS_A8); float* RS = (float*)(ws + WS_RS);
    u32x4 xa[NR], xb[NR]; float sq[NR];
#pragma unroll
    for (int q = 0; q < NR; ++q) { const bf16_t* row = AB + (size_t)(m0 + q) * D; xa[q] = *(const u32x4*)(row + 8 * lane); xb[q] = *(const u32x4*)(row + 512 + 8 * lane); sq[q] = lane < 16 ? ssq[(size_t)(m0 + q) * 16 + lane] : 0.f; }
#pragma unroll
    for (int q = 0; q < NR; ++q) {
        float s = dpp_row_sum(sq[q]); s = __builtin_bit_cast(float, __builtin_amdgcn_readfirstlane(__builtin_bit_cast(int, s)));
        const float rstd = rsqrtf(s * (1.0f / D) + EPS);
        float v[16];
#pragma unroll
        for (int i = 0; i < 4; ++i) { const unsigned a = xa[q][i], b = xb[q][i];
            v[2 * i] = __uint_as_float(a << 16) * rstd; v[2 * i + 1] = __uint_as_float(a & 0xffff0000u) * rstd; v[8 + 2 * i] = __uint_as_float(b << 16) * rstd; v[8 + 2 * i + 1] = __uint_as_float(b & 0xffff0000u) * rstd; }
        float m = 0.f;
#pragma unroll
        for (int i = 0; i < 16; ++i) m = fmaxf(m, fabsf(v[i]));
        m = dpp_max16(m); m = max_rows4(m);
        const float inv = m > 0.f ? 127.0f / m : 0.f;
        unsigned p[4];
#pragma unroll
        for (int i = 0; i < 4; ++i) { unsigned w = 0u;
#pragma unroll
            for (int e = 0; e < 4; ++e) w |= ((unsigned)(int)rintf(v[4 * i + e] * inv) & 0xffu) << (8 * e);
            p[i] = w; }
        signed char* orow = A8 + (size_t)(m0 + q) * D;
        *(u32x2*)(orow + 8 * lane) = (u32x2){p[0], p[1]}; *(u32x2*)(orow + 512 + 8 * lane) = (u32x2){p[2], p[3]};
        if (lane == 0) RS[m0 + q] = m > 0.f ? m * (1.0f / 127.0f) : 1.0f;
    }
}
template <int NR> __device__ __forceinline__ void x_rows(ArgsRef a, int m0, int lane) {
    bf16_t* AB = (bf16_t*)(a.ws + WS_AB); float* ssq0 = (float*)(a.ws + WS_SSQ0);
    f32x4 v[NR][4];
#pragma unroll
    for (int q = 0; q < NR; ++q) { const int m = m0 + q;
        const float* xrow = (m < MP) ? a.in[0] + (size_t)m * D : a.in[1] + (size_t)(m - MP) * D;
        const f32x4* xr = (const f32x4*)xrow + lane;
#pragma unroll
        for (int j = 0; j < 4; ++j) v[q][j] = xr[64 * j]; }
    float t[NR + 1];
#pragma unroll
    for (int q = 0; q < NR; ++q) { float s = 0.f;
#pragma unroll
        for (int j = 0; j < 4; ++j) s += (v[q][j].x * v[q][j].x + v[q][j].y * v[q][j].y) + (v[q][j].z * v[q][j].z + v[q][j].w * v[q][j].w);
        t[q] = s; }
    t[NR] = 0.f;
#pragma unroll
    for (int q = 0; q < NR; q += 2) wave_sum2(t[q], t[q + 1]);
#pragma unroll
    for (int q = 0; q < NR; ++q) { const int m = m0 + q;
        u32x2* o8 = (u32x2*)(AB + (size_t)m * D) + lane;
#pragma unroll
        for (int j = 0; j < 4; ++j) { u32x2 w; w.x = cvt_pk_bf16(v[q][j].x, v[q][j].y); w.y = cvt_pk_bf16(v[q][j].z, v[q][j].w); o8[64 * j] = w; }
        if (lane < 16) ssq0[(size_t)m * 16 + lane] = (lane == 0) ? t[q] : 0.f; }
}

template <int NR> __device__ __forceinline__ void xq8_rows(ArgsRef a, int m0, int lane) {
    signed char* A8 = (signed char*)(a.ws + WS_A8); float* RS = (float*)(a.ws + WS_RS);
    f32x4 v[NR][4];
#pragma unroll
    for (int q = 0; q < NR; ++q) { const int m = m0 + q;
        const float* xrow = (m < MP) ? a.in[0] + (size_t)m * D : a.in[1] + (size_t)(m - MP) * D;
        const f32x4* xr = (const f32x4*)xrow + lane;
#pragma unroll
        for (int j = 0; j < 4; ++j) v[q][j] = xr[64 * j]; }
    float t[NR + 1], mxv[NR + 1];
#pragma unroll
    for (int q = 0; q < NR; ++q) { float s = 0.f, m = 0.f;
#pragma unroll
        for (int j = 0; j < 4; ++j) { s += (v[q][j].x * v[q][j].x + v[q][j].y * v[q][j].y) + (v[q][j].z * v[q][j].z + v[q][j].w * v[q][j].w);
            m = fmaxf(fmaxf(m, fmaxf(fabsf(v[q][j].x), fabsf(v[q][j].y))), fmaxf(fabsf(v[q][j].z), fabsf(v[q][j].w))); }
        t[q] = s; mxv[q] = m; }
    t[NR] = 0.f;
#pragma unroll
    for (int q = 0; q < NR; q += 2) wave_sum2(t[q], t[q + 1]);
#pragma unroll
    for (int q = 0; q < NR; ++q) { const int m = m0 + q;
        float mx = mxv[q]; mx = dpp_max16(mx); mx = max_rows4(mx);
        const float rstd = rsqrtf(t[q] * (1.0f / D) + EPS), inv = mx > 0.f ? 127.0f / mx : 0.f;
        unsigned* o4 = (unsigned*)(A8 + (size_t)m * D) + lane;
#pragma unroll
        for (int j = 0; j < 4; ++j) { const f32x4 x4 = v[q][j];
            o4[64 * j] = ((unsigned)(int)rintf(x4.x * inv) & 0xffu) | (((unsigned)(int)rintf(x4.y * inv) & 0xffu) << 8) | (((unsigned)(int)rintf(x4.z * inv) & 0xffu) << 16) | (((unsigned)(int)rintf(x4.w * inv) & 0xffu) << 24); }
        if (lane == 0) RS[m] = mx > 0.f ? mx * rstd * (1.0f / 127.0f) : 1.0f; }
}

__device__ __forceinline__ void p0_prologue(ArgsRef a, LAS unsigned char* lds, int wave_) {
    const int tid = wave_ * 64 + lane_now();
    const int lane = tid & 63, wave = tid >> 6;
    const int gw = blockIdx.x * 8 + wave, NGW = gridDim.x * 8;
    unsigned char* ws = a.ws;
    for (int nb = blockIdx.x; nb < NUP / 32; nb += gridDim.x) w8_strip(a.in[6], a.in[5], (signed char*)(ws + WS_W1Q), (float*)(ws + WS_CS1), nb, lds, wave, lane);
    { const int nsw = (NUP / 32) * 8, gwr = gw >= nsw ? gw - nsw : gw + NGW - nsw;
      weights_convert(a, lds, I_UP, NITEMS_EARLY, NGW > nsw ? gwr : gw, NGW, wave, lane); }
    for (int m0 = gw * 8; m0 < MP; m0 += NGW * 8) xq8_rows<8>(a, m0, lane);
    for (int m = MP + gw; m < M; m += NGW) xq8_rows<1>(a, m, lane);
    const int gt = blockIdx.x * 512 + tid, NGT = gridDim.x * 512;
    f32x2* rope = (f32x2*)(ws + WS_ROPE);
    for (int i = gt; i < TP * 8; i += NGT) {
        const int pos = i >> 3, k = i & 7;
        const float ang = (float)pos * a.inv[k];
        const double rev = (double)ang * 0.15915494309189535;
        const float fr = (float)(rev - rint(rev));
        rope[i] = (f32x2){__builtin_amdgcn_cosf(fr), __builtin_amdgcn_sinf(fr)};
    }
    bf16_t* KS = (bf16_t*)(ws + WS_KS); bf16_t* VTS = (bf16_t*)(ws + WS_VTS); bf16_t* US = (bf16_t*)(ws + WS_US);
    for (int i = gt; i < NBS * WIN * 128; i += NGT) {
        const int c = i & 127, row = (i >> 7) & (WIN - 1), b = i >> 14;
        const float kv = a.in[3][i], vv = a.in[4][i];
        KS[((size_t)(b * KSROWS + row)) * 128 + c] = f2bf(kv);
        VTS[((size_t)(b * 128 + c)) * KSROWS + row] = f2bf(vv);
        if (row >= TS) { a.out[O_KWS + ((size_t)(b * WIN + row - TS)) * 128 + c] = kv; a.out[O_VWS + ((size_t)(b * WIN + row - TS)) * 128 + c] = vv; }
    }
    for (int i = gt; i < NBS * 128 * 16; i += NGT) { const int k = i & 15, rowd = i >> 4; VTS[(size_t)rowd * KSROWS + WIN + TS + k] = 0; }
    for (int i = gt; i < NBS * HIST * CC; i += NGT) {
        const int c = i & (CC - 1), row = (i >> 9) % HIST, b = (i >> 9) / HIST;
        const float uv = a.in[2][i];
        US[((size_t)(b * USROWS + row)) * CC + c] = f2bf(uv);
        if (row >= TS) a.out[O_CSS + ((size_t)(b * HIST + row - TS)) * CC + c] = uv;
    }
}

constexpr int ATT_VT_OFF = 192 * 128, ATT_VT_STRIDE = 400, ATT_BUF = ATT_VT_OFF + 64 * ATT_VT_STRIDE;
constexpr int ATT_UNITS_P = NBP * (TP / 64) * 2, ATT_UNITS = ATT_UNITS_P + NBS * 2;
constexpr int CONV_UNITS = MP / 16 + NBS;

struct AttUnit { const bf16_t* kb; const bf16_t* vt; int nkt; bool sample; };
__device__ __forceinline__ AttUnit att_decode(unsigned char* ws, int unit) {
    AttUnit u;
    if (unit < ATT_UNITS_P) { const int kh = unit & 1, c = (unit >> 1) & 127, b = unit >> 8, cs = c >= 2 ? c - 2 : 0;
        u.nkt = (c - cs + 1) * 4; u.sample = false;
        u.kb = (const bf16_t*)(ws + WS_KP) + ((size_t)(b * TP + cs * 64)) * 128 + kh * 64;
        u.vt = (const bf16_t*)(ws + WS_VTP) + ((size_t)((b * 2 + kh) * (TP / 64) + cs)) * 4096; }
    else { const int p = unit - ATT_UNITS_P, b = p >> 1, kh = p & 1;
        u.nkt = 9; u.sample = true;
        u.kb = (const bf16_t*)(ws + WS_KS) + ((size_t)(b * KSROWS)) * 128 + kh * 64;
        u.vt = (const bf16_t*)(ws + WS_VTS) + ((size_t)((b * 2 + kh) * 64)) * KSROWS; }
    return u;
}
__device__ __forceinline__ void att_stage_load(const AttUnit& u, int tid, u32x4 (&kp)[3], u32x4 (&vp)[3]) {
    const int nk = u.nkt * 16;
#pragma unroll
    for (int i = 0; i < 3; ++i) {
        const int p = tid + 512 * i; int row = p >> 3; const int ch = p & 7; row = row < nk ? row : nk - 1;
        kp[i] = *(const u32x4*)(u.kb + (size_t)row * 128 + ch * 8);
        if (u.sample) { int pp = p < 1280 ? p : 1279; const int d = pp / 20, q = pp - d * 20; vp[i] = *(const u32x4*)(u.vt + (size_t)d * KSROWS + q * 8); }
        else { const int jmax = (u.nkt >> 2) - 1, j = i < jmax ? i : jmax; vp[i] = *(const u32x4*)(u.vt + (size_t)j * 4096 + (p & 511) * 8); }
    }
}
__device__ __forceinline__ void att_stage_write(const AttUnit& u, int tid, LAS unsigned char* buf, const u32x4 (&kp)[3], const u32x4 (&vp)[3]) {
    const int nk = u.nkt * 16;
#pragma unroll
    for (int i = 0; i < 3; ++i) {
        const int p = tid + 512 * i; int row = p >> 3; const int ch = p & 7; row = row < nk ? row : nk - 1;
        *(LAS u32x4*)(buf + row * 128 + ((ch ^ ((row >> 1) & 7)) << 4)) = kp[i];
        if (u.sample) { int pp = p < 1280 ? p : 1279; const int d = pp / 20, q = pp - d * 20; *(LAS u32x4*)(buf + ATT_VT_OFF + d * ATT_VT_STRIDE + q * 16) = vp[i]; }
        else { const int jmax = (u.nkt >> 2) - 1, j = i < jmax ? i : jmax; const int d = (p & 511) >> 3, q = p & 7; *(LAS u32x4*)(buf + ATT_VT_OFF + d * ATT_VT_STRIDE + j * 128 + q * 16) = vp[i]; }
    }
}
__device__ __forceinline__ void attn_compute(const bf16x8 (&qf)[2][2], LAS const unsigned char* buf, int nkt, float sink0, float sink1, bf16_t* o0, bf16_t* o1, int lane) {
    const int fr = lane & 15, g = lane >> 4;
    f32x4 S[2][12];
    const float NEG = -INFINITY;
#pragma unroll
    for (int kt = 0; kt < 12; ++kt) {
        const int ktc = kt < nkt ? kt : nkt - 1, row = ktc * 16 + fr, sw = (row >> 1) & 7;
        const bf16x8 k0 = *(LAS const bf16x8*)(buf + row * 128 + ((g ^ sw) << 4)), k1 = *(LAS const bf16x8*)(buf + row * 128 + (((g + 4) ^ sw) << 4));
        const bool ok = kt < nkt;
#pragma unroll
        for (int qt = 0; qt < 2; ++qt) {
            f32x4 c = (f32x4){0.f, 0.f, 0.f, 0.f};
            c = __builtin_amdgcn_mfma_f32_16x16x32_bf16(k0, qf[qt][0], c, 0, 0, 0);
            c = __builtin_amdgcn_mfma_f32_16x16x32_bf16(k1, qf[qt][1], c, 0, 0, 0);
            S[qt][kt] = ok ? c : (f32x4){NEG, NEG, NEG, NEG};
        }
    }
    bf16x8 pf[2][6]; float linv[2];
#pragma unroll
    for (int qt = 0; qt < 2; ++qt) {
        const float sink = qt ? sink1 : sink0;
        float mx = sink;
#pragma unroll
        for (int kt = 0; kt < 12; ++kt) mx = fmaxf(mx, fmaxf(fmaxf(S[qt][kt][0], S[qt][kt][1]), fmaxf(S[qt][kt][2], S[qt][kt][3])));
        mx = max_rows4(mx);
        float l = 0.f;
#pragma unroll
        for (int kt = 0; kt < 12; ++kt) {
#pragma unroll
            for (int j = 0; j < 4; ++j) { const float p = __builtin_amdgcn_exp2f(S[qt][kt][j] - mx); S[qt][kt][j] = p; l += p; }
        }
        l = sum_rows4(l);
        l += __builtin_amdgcn_exp2f(sink - mx);
        linv[qt] = 1.0f / l;
#pragma unroll
        for (int kk = 0; kk < 6; ++kk) {
            u32x4 w; w.x = cvt_pk_bf16(S[qt][2 * kk][0], S[qt][2 * kk][1]); w.y = cvt_pk_bf16(S[qt][2 * kk][2], S[qt][2 * kk][3]);
            w.z = cvt_pk_bf16(S[qt][2 * kk + 1][0], S[qt][2 * kk + 1][1]); w.w = cvt_pk_bf16(S[qt][2 * kk + 1][2], S[qt][2 * kk + 1][3]);
            pf[qt][kk] = __builtin_bit_cast(bf16x8, w);
        }
    }
    f32x4 O[2][4];
    const int kkmax = (nkt - 1) >> 1;
    LAS const unsigned char* vb = buf + ATT_VT_OFF + fr * ATT_VT_STRIDE + g * 8;
#pragma unroll
    for (int dt = 0; dt < 4; ++dt) {
        O[0][dt] = (f32x4){0.f, 0.f, 0.f, 0.f}; O[1][dt] = (f32x4){0.f, 0.f, 0.f, 0.f};
#pragma unroll
        for (int kk = 0; kk < 6; ++kk) {
            const int kkc = kk < kkmax ? kk : kkmax;
            const u32x2 a0 = *(LAS const u32x2*)(vb + dt * 16 * ATT_VT_STRIDE + kkc * 64), a1 = *(LAS const u32x2*)(vb + dt * 16 * ATT_VT_STRIDE + kkc * 64 + 32);
            u32x4 aw; aw.x = a0.x; aw.y = a0.y; aw.z = a1.x; aw.w = a1.y;
            const bf16x8 af = __builtin_bit_cast(bf16x8, aw);
            O[0][dt] = __builtin_amdgcn_mfma_f32_16x16x32_bf16(af, pf[0][kk], O[0][dt], 0, 0, 0);
            O[1][dt] = __builtin_amdgcn_mfma_f32_16x16x32_bf16(af, pf[1][kk], O[1][dt], 0, 0, 0);
        }
    }
#pragma unroll
    for (int qt = 0; qt < 2; ++qt) {
        bf16_t* ob = (qt ? o1 : o0) + (size_t)fr * D + 4 * g;
#pragma unroll
        for (int dt = 0; dt < 4; ++dt) {
            const f32x4 v = O[qt][dt] * linv[qt];
            u32x2 w; w.x = cvt_pk_bf16(v[0], v[1]); w.y = cvt_pk_bf16(v[2], v[3]);
            *(u32x2*)(ob + dt * 16) = w;
        }
    }
}

__device__ __forceinline__ void attn_phase(ArgsRef a, LAS unsigned char* lds, int tid, int first, int G) {
    asm volatile("" : "+v"(tid));
    unsigned char* ws = a.ws;
    const int lane = tid & 63, wave = __builtin_amdgcn_readfirstlane(tid >> 6), fr = lane & 15, g = lane >> 4;
    const bf16_t* Q = (const bf16_t*)(ws + WS_Q); bf16_t* MIX = (bf16_t*)(ws + WS_MIX);
    const float* sinks = a.in[12];
    if (first >= ATT_UNITS) return;
    AttUnit cur = att_decode(ws, first);
    u32x4 kp[3], vp[3];
    att_stage_load(cur, tid, kp, vp);
    int par = 0;
    for (int unit = first; unit < ATT_UNITS; unit += G, par ^= 1) {
        LAS unsigned char* buf = lds + par * ATT_BUF;
        att_stage_write(cur, tid, buf, kp, vp);
        const bf16_t* q0; const bf16_t* q1; bf16_t* o0; bf16_t* o1; float sk0, sk1; bool work;
        if (!cur.sample) { const int kh = unit & 1, c = (unit >> 1) & 127, b = unit >> 8, h = kh * 4 + (wave >> 1), tok0 = c * 64 + (wave & 1) * 32;
            q0 = Q + ((size_t)(b * TP + tok0)) * 512 + h * 64; q1 = q0 + 16 * 512;
            o0 = MIX + ((size_t)(b * TP + tok0)) * D + 512 + h * 64; o1 = o0 + 16 * D; sk0 = sk1 = sinks[h] * LOG2E; work = true; }
        else { const int p = unit - ATT_UNITS_P, b = p >> 1, kh = p & 1, h0 = kh * 4 + (wave & 1) * 2;
            q0 = Q + ((size_t)(MP + b * TS)) * 512 + h0 * 64; q1 = q0 + 64;
            o0 = MIX + ((size_t)(MP + b * TS)) * D + 512 + h0 * 64; o1 = o0 + 64; sk0 = sinks[h0] * LOG2E; sk1 = sinks[h0 + 1] * LOG2E; work = wave < 2; }
        bf16x8 qf[2][2];
        qf[0][0] = *(const bf16x8*)(q0 + fr * 512 + g * 8); qf[0][1] = *(const bf16x8*)(q0 + fr * 512 + 32 + g * 8);
        qf[1][0] = *(const bf16x8*)(q1 + fr * 512 + g * 8); qf[1][1] = *(const bf16x8*)(q1 + fr * 512 + 32 + g * 8);
        const int nkt = cur.nkt;
        __syncthreads();
        const int nu = unit + G < ATT_UNITS ? unit + G : unit;
        cur = att_decode(ws, nu);
        att_stage_load(cur, tid, kp, vp);
        if (work) attn_compute(qf, buf, nkt, sk0, sk1, o0, o1, lane);
    }
    __syncthreads();
}

struct ConvUnit { const bf16_t* ub; int jmin; size_t orow; };
__device__ __forceinline__ ConvUnit conv_decode(unsigned char* ws, int cu, int ch) {
    ConvUnit u;
    if (cu < MP / 16) { const int b = cu >> 9, t0 = (cu & 511) * 16; u.ub = (const bf16_t*)(ws + WS_UP) + ((size_t)(b * TP) + t0 - HIST) * CC + ch; u.jmin = HIST - t0; u.orow = (size_t)b * TP + t0; }
    else { const int b = cu - MP / 16; u.ub = (const bf16_t*)(ws + WS_US) + ((size_t)(b * USROWS)) * CC + ch; u.jmin = 0; u.orow = (size_t)MP + b * TS; }
    return u;
}
__device__ __forceinline__ void conv_phase(ArgsRef a, LAS unsigned char* lds, int tid, int first, int G) {
    asm volatile("" : "+v"(tid));
    unsigned char* ws = a.ws;
    const int ch = tid, wave = tid >> 6, lane = tid & 63;
    if (first >= CONV_UNITS) return;
    const float* wdw = a.in[13] + ch;
    float w[CW];
#pragma unroll
    for (int j = 0; j < CW; ++j) w[j] = wdw[j * CC];
    const float bias = a.in[14][ch];
    const f32x4 gc0 = *(const f32x4*)(a.in[15] + 4 * lane), gc1 = *(const f32x4*)(a.in[15] + 256 + 4 * lane);
    const f32x4 bc0 = *(const f32x4*)(a.in[16] + 4 * lane), bc1 = *(const f32x4*)(a.in[16] + 256 + 4 * lane);
    ConvUnit cur = conv_decode(ws, first, ch);
    bf16_t xr[HIST + 16];
#pragma unroll
    for (int j = 0; j < HIST + 16; ++j) { const int jc = j > cur.jmin ? j : cur.jmin; xr[j] = cur.ub[(size_t)jc * CC]; }
    int par = 0;
    for (int cu = first; cu < CONV_UNITS; cu += G, par ^= 1) {
        const int jmin = cur.jmin; const size_t orow = cur.orow;
        float acc[16];
#pragma unroll
        for (int i = 0; i < 16; ++i) acc[i] = bias;
#pragma unroll
        for (int j = 0; j < HIST + 16; ++j) {
            const float xv = (j >= jmin) ? bf2f(xr[j]) : 0.f;
#pragma unroll
            for (int i = 0; i < 16; ++i) { if (j - i >= 0 && j - i < CW) acc[i] += xv * w[j - i]; }
        }
        __builtin_amdgcn_sched_barrier(0);
        { const int nu = cu + G < CONV_UNITS ? cu + G : cu;
          cur = conv_decode(ws, nu, ch);
#pragma unroll
          for (int j = 0; j < HIST + 16; ++j) { const int jc = j > cur.jmin ? j : cur.jmin; xr[j] = cur.ub[(size_t)jc * CC]; } }
        __builtin_amdgcn_sched_barrier(0);
        LAS float* yb = (LAS float*)lds + par * (16 * CC);
#pragma unroll
        for (int i = 0; i < 16; ++i) yb[i * CC + ch] = acc[i];
        __syncthreads();
        bf16_t* MIX = (bf16_t*)(ws + WS_MIX) + orow * D;
        {
            const int tok = 2 * wave;
            f32x4 v0 = *(const LAS f32x4*)(yb + tok * CC + 4 * lane), v1 = *(const LAS f32x4*)(yb + tok * CC + 256 + 4 * lane);
            f32x4 z0 = *(const LAS f32x4*)(yb + (tok + 1) * CC + 4 * lane), z1 = *(const LAS f32x4*)(yb + (tok + 1) * CC + 256 + 4 * lane);
            float sa = (v0[0] + v0[1]) + (v0[2] + v0[3]) + (v1[0] + v1[1]) + (v1[2] + v1[3]);
            float sb = (z0[0] + z0[1]) + (z0[2] + z0[3]) + (z1[0] + z1[1]) + (z1[2] + z1[3]);
            wave_sum2(sa, sb);
            const float ma = sa * (1.0f / CC), mb = sb * (1.0f / CC);
            v0 = v0 - ma; v1 = v1 - ma; z0 = z0 - mb; z1 = z1 - mb;
            float qa = (v0[0] * v0[0] + v0[1] * v0[1]) + (v0[2] * v0[2] + v0[3] * v0[3]) + (v1[0] * v1[0] + v1[1] * v1[1]) + (v1[2] * v1[2] + v1[3] * v1[3]);
            float qb = (z0[0] * z0[0] + z0[1] * z0[1]) + (z0[2] * z0[2] + z0[3] * z0[3]) + (z1[0] * z1[0] + z1[1] * z1[1]) + (z1[2] * z1[2] + z1[3] * z1[3]);
            wave_sum2(qa, qb);
            const float ra = rsqrtf(qa * (1.0f / CC) + EPS), rb = rsqrtf(qb * (1.0f / CC) + EPS);
            v0 = v0 * ra * gc0 + bc0; v1 = v1 * ra * gc1 + bc1; z0 = z0 * rb * gc0 + bc0; z1 = z1 * rb * gc1 + bc1;
            u32x2 o0, o1, p0, p1;
            o0.x = cvt_pk_bf16(silu_f(v0[0]), silu_f(v0[1])); o0.y = cvt_pk_bf16(silu_f(v0[2]), silu_f(v0[3]));
            o1.x = cvt_pk_bf16(silu_f(v1[0]), silu_f(v1[1])); o1.y = cvt_pk_bf16(silu_f(v1[2]), silu_f(v1[3]));
            p0.x = cvt_pk_bf16(silu_f(z0[0]), silu_f(z0[1])); p0.y = cvt_pk_bf16(silu_f(z0[2]), silu_f(z0[3]));
            p1.x = cvt_pk_bf16(silu_f(z1[0]), silu_f(z1[1])); p1.y = cvt_pk_bf16(silu_f(z1[2]), silu_f(z1[3]));
            *(u32x2*)(MIX + (size_t)tok * D + 4 * lane) = o0; *(u32x2*)(MIX + (size_t)tok * D + 256 + 4 * lane) = o1;
            *(u32x2*)(MIX + (size_t)(tok + 1) * D + 4 * lane) = p0; *(u32x2*)(MIX + (size_t)(tok + 1) * D + 256 + 4 * lane) = p1;
        }
    }
    __syncthreads();
}

#define XB_TMO      128
#define XB_XCNT(j)  (256  + 64 * (j))
#define XB_XSUB(j)  (1280 + 64 * (j))
#define XB_XGEN(j)  (2304 + 64 * (j))
#define XB_TOP      3328
#define XB_TOPGEN   3392
#define XCD_BAR_WORDS 3456
#define XB_SPIN_CAP (1u << 18)
__device__ __forceinline__ unsigned xb_ld(unsigned* p)              { return __hip_atomic_load(p, __ATOMIC_RELAXED, __HIP_MEMORY_SCOPE_AGENT); }
__device__ __forceinline__ unsigned xb_add(unsigned* p, unsigned v) { return __hip_atomic_fetch_add(p, v, __ATOMIC_RELAXED, __HIP_MEMORY_SCOPE_AGENT); }
__device__ __forceinline__ unsigned xb_xcc_id() { return (unsigned)__builtin_amdgcn_s_getreg((3 << 11) | 20) & 0xFu; }
#define XB_SPIN(cond, bar) do { unsigned _sp = 0; while (cond) { __builtin_amdgcn_s_sleep(1); \
    if ((++_sp & 255u) == 0u) { if (xb_ld(&(bar)[XB_TMO])) break; if (_sp > XB_SPIN_CAP) { atomicAdd(&(bar)[XB_TMO], 1u); break; } } } } while (0)
struct XcdBarrier { unsigned* bar; unsigned x; volatile LAS unsigned* st; };
__device__ __forceinline__ XcdBarrier xcd_barrier_post(unsigned* bar, volatile LAS unsigned* st, int wave_) {
    XcdBarrier b; b.bar = bar; b.x = (unsigned)__builtin_amdgcn_readfirstlane((int)xb_xcc_id()); b.st = st;
    if (wave_ == 0 && lane_now() == 0) (void)xb_add(&bar[XB_XCNT(b.x)], 1u);
    return b;
}
__device__ __forceinline__ void xcd_barrier_complete(unsigned* bar, unsigned x, unsigned& nloc, unsigned& nx) {
    const unsigned G = gridDim.x * gridDim.y * gridDim.z;
    unsigned sum, cnt, mine, sp = 0u;
    for (;;) {
        sum = 0u; cnt = 0u; mine = 0u;
#pragma unroll
        for (unsigned j = 0; j < 16; ++j) { const unsigned c = xb_ld(&bar[XB_XCNT(j)]); sum += c; cnt += (c > 0u) ? 1u : 0u; mine = (j == x) ? c : mine; }
        if (sum == G) break;
        __builtin_amdgcn_s_sleep(1);
        if ((++sp & 255u) == 0u) { if (xb_ld(&bar[XB_TMO])) break; if (sp > XB_SPIN_CAP) { atomicAdd(&bar[XB_TMO], 1u); break; } }
    }
    nloc = mine > 0u ? mine : 1u; nx = cnt > 0u ? cnt : 1u;
}
__device__ __forceinline__ void xcd_barrier(const XcdBarrier& b, int wave_) {
    asm volatile("s_waitcnt vmcnt(0)" ::: "memory");
    __syncthreads();
    if (wave_ == 0 && lane_now() == 0) {
        unsigned* bar = b.bar; unsigned bx = b.x; asm volatile("" : "+s"(bx));
        __builtin_amdgcn_s_waitcnt(0);
        unsigned nloc = b.st[0], nx = b.st[1];
        if (nloc == 0u) { xcd_barrier_complete(bar, bx, nloc, nx); b.st[0] = nloc; b.st[1] = nx; }
        const unsigned old = xb_add(&bar[XB_XSUB(bx)], 1u);
        const unsigned gen = old / nloc;
        if (old + 1u == (gen + 1u) * nloc) {
            __builtin_amdgcn_fence(__ATOMIC_RELEASE, "agent");
            asm volatile("s_waitcnt vmcnt(0)" ::: "memory");
            const unsigned og = xb_add(&bar[XB_TOP], 1u);
            const unsigned tg = og / nx;
            if (og + 1u == (tg + 1u) * nx) xb_add(&bar[XB_TOPGEN], 1u);
            else XB_SPIN(xb_ld(&bar[XB_TOPGEN]) == tg, bar);
            __builtin_amdgcn_fence(__ATOMIC_ACQUIRE, "agent");
            xb_add(&bar[XB_XGEN(bx)], 1u);
            asm volatile("s_waitcnt vmcnt(0)" ::: "memory");
        } else {
            XB_SPIN(xb_ld(&bar[XB_XGEN(bx)]) == gen, bar);
            __builtin_amdgcn_fence(__ATOMIC_ACQUIRE, "agent");
            asm volatile("s_waitcnt vmcnt(0)" ::: "memory");
        }
    }
    __syncthreads();
}
constexpr int MISC_OFF = 151552;
constexpr size_t CTL_ZERO_BYTES = 65536;
constexpr int CW_BAR = 4096;

__global__ void __launch_bounds__(512, 2) hymba_fwd(Args a_) {
    extern __shared__ __attribute__((aligned(16))) unsigned char lds_raw[];
    LAS unsigned char* lds = (LAS unsigned char*)lds_raw;
    unsigned char* ws = a_.ws;
    const int wave = __builtin_amdgcn_readfirstlane((int)threadIdx.x >> 6);
#define lane lane_now()
#define tid (wave * 64 + lane_now())
    const int G = gridDim.x, bid = blockIdx.x;
    for (int u = wave * 64 + lane_now(); u < (LDS_BYTES - MISC_OFF) / 4; u += 512) ((LAS unsigned*)(lds + MISC_OFF))[u] = 0u;
    __syncthreads();
    const XcdBarrier bar = xcd_barrier_post((unsigned*)ws + CW_BAR, (volatile LAS unsigned*)(lds + MISC_OFF) + 8, wave);
#define GRID_BAR() xcd_barrier(bar, wave)

    bf16_t* AB = (bf16_t*)(ws + WS_AB); bf16_t* ACT = (bf16_t*)(ws + WS_ACT);
    float* ssq0 = (float*)(ws + WS_SSQ0); float* ssq1 = (float*)(ws + WS_SSQ1); float* ssq2 = (float*)(ws + WS_SSQ2);

#ifndef PROBE_DUP
#define PROBE_DUP -1
#endif
#ifndef PHASE_MASK
#define PHASE_MASK 0xff
#endif
#define REPS(k) if (PHASE_MASK & (1 << (k))) for (int rep_ = 0; rep_ < ((PROBE_DUP == (k)) ? 2 : 1); ++rep_)
#define ARGS_HERE() ArgsRef a = *args_now()
    REPS(0) { ARGS_HERE(); p0_prologue(a, lds, wave); GRID_BAR(); }
    REPS(1) {
    { int bs_ = bid, gs_ = G; asm volatile("" : "+s"(bs_), "+s"(gs_));
      pg8::Gemm g{(const bf16_t*)(ws + WS_A8), (const bf16_t*)(ws + WS_W1Q), MP, NUP, D / 2}; pg8::StaticOrder S; S.init(MP, NUP, gs_, bs_, 16);
      EpiSwigluI8 E{ACT, (const float*)(ws + WS_RS), (const float*)(ws + WS_CS1), lds};
      for (int pass = 0; pass < 2; ++pass) { if (((pass ^ (bs_ >> 6)) & 1) == 0) { pg8::gemm_phase<EpiSwigluI8, pg8::StaticOrder, true, true, true>(lds, g, S, E, wave); } else { small_gemm<1, 4, true>((const bf16_t*)(ws + WS_A8), (const bf16_t*)(ws + WS_W1Q), NUP, D / 2, E, lds, bs_, gs_, wave, lane); } } }
    GRID_BAR(); }
    REPS(2) {
    { int bs_ = bid, gs_ = G; asm volatile("" : "+s"(bs_), "+s"(gs_));
      pg8::Gemm g{ACT, (const bf16_t*)(ws + WS_W2T), MP, D, FF}; pg8::StaticOrder S; S.init(MP, D, gs_, bs_);
      ARGS_HERE(); EpiResid<0> E{a.in[0], a.in[1], nullptr, AB, ssq1, 0.5f};
      for (int pass = 0; pass < 2; ++pass) { if (((pass ^ (bs_ >> 6)) & 1) == 0) { pg8::gemm_phase<EpiResid<0>, pg8::StaticOrder, true, true>(lds, g, S, E, wave); } else { small_gemm<8, 2, false>(ACT, (const bf16_t*)(ws + WS_W2T), D, FF, E, lds, bs_, gs_, wave, lane); } } }
    GRID_BAR(); }
    REPS(3) {
    { int bs_ = bid, gs_ = G; asm volatile("" : "+s"(bs_), "+s"(gs_));
      pg8::Gemm g{AB, (const bf16_t*)(ws + WS_WINT), MP, NIN, D}; pg8::StaticOrder S; S.init(MP, NIN, gs_, bs_);
      ARGS_HERE(); EpiInProj E{ws, a.in[10], a.in[11], a.out, lds};
      pg8::gemm_phase<EpiInProj, pg8::StaticOrder, true, true>(lds, g, S, E, wave);
      const bool side = (rep_ == 0) && (bid >= G / 2);
      if (side) { int ln = lane; asm volatile("" : "+v"(ln));
        for (int nb = bid - G / 2; nb < NUP / 32; nb += G - G / 2) w8_strip(a.in[19], a.in[18], (signed char*)(ws + WS_W3Q), (float*)(ws + WS_CS3), nb, lds, wave, ln); }
      small_gemm<1, 4, false>(AB, (const bf16_t*)(ws + WS_WINT), NIN, D, E, lds, gs_ - 1 - bs_, gs_, wave, lane, 2);
      if (side) { int ln = lane; asm volatile("" : "+v"(ln));
        const int idx = bid - G / 2, nsm = G - 112 - G / 2;
        const int nconv = nsm * 8 + (G - G / 2 - nsm) * 6;
        const int rank = idx < nsm ? idx * 8 + wave : (wave >= 2 ? nsm * 8 + (idx - nsm) * 6 + (wave - 2) : (1 << 28));
        weights_convert(a, lds, NITEMS_EARLY + I_UP, NITEMS, rank, nconv, wave, ln); } }
    GRID_BAR(); }
    REPS(4) {
#ifndef PROBE_P4SUB
#define PROBE_P4SUB 0
#endif
    ARGS_HERE();
    if (!(rep_ == 1 && PROBE_P4SUB == 2)) attn_phase(a, lds, tid, bid, G);
    if (!(rep_ == 1 && PROBE_P4SUB == 1)) conv_phase(a, lds, tid, G - 1 - bid, G);
    GRID_BAR(); }
    REPS(5) {
    { int bs_ = bid, gs_ = G; asm volatile("" : "+s"(bs_), "+s"(gs_));
      pg8::Gemm g{(const bf16_t*)(ws + WS_MIX), (const bf16_t*)(ws + WS_WOT), MP, D, D}; pg8::StaticOrder S; S.init(MP, D, gs_, bs_);
      EpiResid<1> E{nullptr, nullptr, nullptr, AB, ssq2, 1.0f};
      for (int pass = 0; pass < 2; ++pass) { if (((pass ^ (bs_ >> 6)) & 1) == 0) { pg8::gemm_phase<EpiResid<1>, pg8::StaticOrder, true, true>(lds, g, S, E, wave); } else { small_gemm<8, 2, false>((const bf16_t*)(ws + WS_MIX), (const bf16_t*)(ws + WS_WOT), D, D, E, lds, bs_, gs_, wave, lane); } } }
    GRID_BAR(); }
    { const int gw = bid * 8 + wave, NGW = G * 8; int ln = lane; asm volatile("" : "+v"(ln));
      for (int m0 = gw * 4; m0 < M; m0 += NGW * 4) q8_rows<4>(ws, ssq2, m0, ln);
      GRID_BAR(); }
    REPS(6) {
    { int bs_ = bid, gs_ = G; asm volatile("" : "+s"(bs_), "+s"(gs_));
      pg8::Gemm g{(const bf16_t*)(ws + WS_A8), (const bf16_t*)(ws + WS_W3Q), MP, NUP, D / 2}; pg8::StaticOrder S; S.init(MP, NUP, gs_, bs_, 16);
      EpiSwigluI8 E{ACT, (const float*)(ws + WS_RS), (const float*)(ws + WS_CS3), lds};
      for (int pass = 0; pass < 2; ++pass) { if (((pass ^ (bs_ >> 6)) & 1) == 0) { pg8::gemm_phase<EpiSwigluI8, pg8::StaticOrder, true, true, true>(lds, g, S, E, wave); } else { small_gemm<1, 4, true>((const bf16_t*)(ws + WS_A8), (const bf16_t*)(ws + WS_W3Q), NUP, D / 2, E, lds, bs_, gs_, wave, lane); } } }
    GRID_BAR(); }
    REPS(7) { int bs_ = bid, gs_ = G; asm volatile("" : "+s"(bs_), "+s"(gs_));
      pg8::Gemm g{ACT, (const bf16_t*)(ws + WS_W4T), MP, D, FF}; pg8::StaticOrder S; S.init(MP, D, gs_, bs_);
      ARGS_HERE(); EpiResid<2> E{nullptr, nullptr, a.out, AB, nullptr, 0.5f};
      for (int pass = 0; pass < 2; ++pass) { if (((pass ^ (bs_ >> 6)) & 1) == 0) { pg8::gemm_phase<EpiResid<2>, pg8::StaticOrder, true, true>(lds, g, S, E, wave); } else { small_gemm<8, 2, false>(ACT, (const bf16_t*)(ws + WS_W4T), D, FF, E, lds, bs_, gs_, wave, lane); } } }
}
#undef lane
#undef tid

extern "C" void kernel_launch(void* const* d_in, const int* in_sizes, int n_in, void* d_out, int out_size, void* d_ws, size_t ws_size, hipStream_t stream) {
    static int grid = 0;
    if (grid == 0) {
        if (n_in != 21 || (size_t)out_size != O_END || ws_size < WS_END) { fprintf(stderr, "kernel_launch: unexpected shapes: n_in %d out %d ws %zu (need %zu)\n", n_in, out_size, ws_size, (size_t)WS_END); grid = -1; return; }
        int dev = 0, cus = 0, per_cu = 0;
        (void)hipGetDevice(&dev);
        (void)hipDeviceGetAttribute(&cus, hipDeviceAttributeMultiprocessorCount, dev);
        if (cus != 256) fprintf(stderr, "kernel_launch: note: built for a 256-CU device (one workgroup per CU), this device reports %d\n", cus);
        if (hipFuncSetAttribute((const void*)hymba_fwd, hipFuncAttributeMaxDynamicSharedMemorySize, LDS_BYTES) != hipSuccess) { fprintf(stderr, "kernel_launch: hipFuncSetAttribute failed\n"); grid = -1; return; }
        if (hipOccupancyMaxActiveBlocksPerMultiprocessor(&per_cu, (const void*)hymba_fwd, 512, LDS_BYTES) != hipSuccess || per_cu < 1) { fprintf(stderr, "kernel_launch: occupancy query failed (%d)\n", per_cu); grid = -1; (void)hipGetLastError(); return; }
        grid = cus;
    }
    if (grid < 0) return;
    Args a{};
    for (int i = 0; i < 21; ++i) a.in[i] = (const float*)d_in[i];
    a.out = (float*)d_out; a.ws = (unsigned char*)d_ws;
    for (int i = 0; i < 8; ++i) a.inv[i] = powf(500000.0f, -(float)i / 8.0f);
    if (hipMemsetAsync(d_ws, 0, CTL_ZERO_BYTES, stream) != hipSuccess) { fprintf(stderr, "kernel_launch: memset failed\n"); return; }
    hipLaunchKernelGGL(hymba_fwd, dim3(grid), dim3(512), LDS_BYTES, stream, a);
    const hipError_t e = hipPeekAtLastError();
    if (e != hipSuccess) fprintf(stderr, "kernel_launch: launch failed: %s (grid %d)\n", hipGetErrorString(e), grid);
}
```

```cpp
#include <hip/hip_runtime.h>
#include <cstdio>
#include <cstdint>
#include <cmath>

#define LAS __attribute__((address_space(3)))
typedef unsigned short bf16_t;
typedef short bf16x8 __attribute__((ext_vector_type(8)));
typedef float f32x4 __attribute__((ext_vector_type(4)));
typedef float f32x2 __attribute__((ext_vector_type(2)));
typedef unsigned u32x4 __attribute__((ext_vector_type(4)));
typedef unsigned u32x2 __attribute__((ext_vector_type(2)));
typedef int i32x4 __attribute__((ext_vector_type(4)));

constexpr int D = 1024, TP = 8192, NBP = 4, NBS = 32, TS = 16, MP = NBP * TP, MS = NBS * TS, M = MP + MS;
constexpr int FF = 2816, NUP = 2 * FF, NIN = 1792, CC = 512, HD = 64, PAST = 4096;
constexpr int CW = 31, HIST = CW - 1, WIN = 128;
constexpr int KSROWS = 160;
constexpr int USROWS = HIST + TS;
constexpr float EPS = 1e-6f;
constexpr float LOG2E = 1.4426950408889634f;
constexpr float QSCALE = 0.125f * LOG2E;

constexpr size_t O_YP = 0, O_YS = (size_t)MP * D, O_CSP = O_YS + (size_t)MS * D, O_KWP = O_CSP + (size_t)NBP * HIST * CC,
                 O_VWP = O_KWP + (size_t)NBP * WIN * 128, O_CSS = O_VWP + (size_t)NBP * WIN * 128, O_KWS = O_CSS + (size_t)NBS * HIST * CC,
                 O_VWS = O_KWS + (size_t)NBS * WIN * 128, O_END = O_VWS + (size_t)NBS * WIN * 128;

constexpr size_t al(size_t x) { return (x + 4095) & ~(size_t)4095; }
constexpr size_t WS_CTL = 0;
constexpr size_t WS_W1T = 1u << 20;
constexpr size_t WS_W2T = WS_W1T + al((size_t)NUP * D * 2);
constexpr size_t WS_WINT = WS_W2T + al((size_t)D * FF * 2);
constexpr size_t WS_WOT = WS_WINT + al((size_t)NIN * D * 2);
constexpr size_t WS_W3T = WS_WOT + al((size_t)D * D * 2);
constexpr size_t WS_W4T = WS_W3T + al((size_t)NUP * D * 2);
constexpr size_t WS_ROPE = WS_W4T + al((size_t)D * FF * 2);
constexpr size_t WS_SSQ0 = WS_ROPE + al((size_t)TP * 8 * 8);
constexpr size_t WS_SSQ1 = WS_SSQ0 + al((size_t)M * 16 * 4);
constexpr size_t WS_SSQ2 = WS_SSQ1 + al((size_t)M * 16 * 4);
constexpr size_t WS_KS = WS_SSQ2 + al((size_t)M * 16 * 4);
constexpr size_t WS_VTS = WS_KS + al((size_t)NBS * KSROWS * 128 * 2);
constexpr size_t WS_US = WS_VTS + al((size_t)NBS * 128 * KSROWS * 2);
constexpr size_t WS_AB = WS_US + al((size_t)NBS * USROWS * CC * 2);
constexpr size_t WS_X1 = WS_AB + al((size_t)M * D * 2);
constexpr size_t WS_ACT = WS_X1 + al((size_t)M * D * 4);
constexpr size_t WS_A8 = WS_X1;
constexpr size_t WS_W3Q = WS_A8 + al((size_t)M * D);
constexpr size_t WS_W1Q = WS_W3Q + al((size_t)NUP * D);
constexpr size_t WS_RS = WS_W1Q + al((size_t)NUP * D);
constexpr size_t WS_CS3 = WS_RS + al((size_t)M * 4);
constexpr size_t WS_CS1 = WS_CS3 + al((size_t)NUP * 4);
static_assert(WS_CS1 + (size_t)NUP * 4 <= WS_ACT, "int8 operands fit in the f32 scratch");
constexpr size_t WS_END = WS_ACT + al((size_t)M * FF * 2);
constexpr size_t WS_UP = WS_ACT;
constexpr size_t WS_Q = WS_UP + al((size_t)MP * CC * 2);
constexpr size_t WS_KP = WS_Q + al((size_t)M * 512 * 2);
constexpr size_t WS_VTP = WS_KP + al((size_t)MP * 128 * 2);
constexpr size_t WS_MIX = WS_VTP + al((size_t)MP * 128 * 2);
static_assert(WS_MIX + (size_t)M * D * 2 <= WS_END, "overlay fits");

constexpr int LDS_BYTES = 155648;
constexpr int SSQ_LDS_OFF = 131072;

__device__ __forceinline__ unsigned cvt_pk_bf16(float lo, float hi) { unsigned r; asm volatile("v_cvt_pk_bf16_f32 %0, %1, %2" : "=v"(r) : "v"(lo), "v"(hi)); return r; }
__device__ __forceinline__ float bf2f(bf16_t h) { return __uint_as_float((unsigned)h << 16); }
__device__ __forceinline__ bf16_t f2bf(float f) { return (bf16_t)(cvt_pk_bf16(f, 0.f) & 0xffffu); }
__device__ __forceinline__ float silu_f(float a) { return a * __builtin_amdgcn_rcpf(1.0f + __builtin_amdgcn_exp2f(-a * LOG2E)); }
__device__ __forceinline__ float sigmoid_f(float a) { return __builtin_amdgcn_rcpf(1.0f + __builtin_amdgcn_exp2f(-a * LOG2E)); }
__device__ __forceinline__ float sum_rows4(float x) {
    float a = x, b = x;
    asm volatile("s_nop 1\n\tv_permlane16_swap_b32 %0, %1" : "+v"(a), "+v"(b));
    float t = a + b; a = t; b = t;
    asm volatile("s_nop 1\n\tv_permlane32_swap_b32 %0, %1" : "+v"(a), "+v"(b));
    return a + b;
}
__device__ __forceinline__ float max_rows4(float x) {
    float a = x, b = x;
    asm volatile("s_nop 1\n\tv_permlane16_swap_b32 %0, %1" : "+v"(a), "+v"(b));
    float t = fmaxf(a, b); a = t; b = t;
    asm volatile("s_nop 1\n\tv_permlane32_swap_b32 %0, %1" : "+v"(a), "+v"(b));
    return fmaxf(a, b);
}
__device__ __forceinline__ float dpp_max8(float v) {
    v = fmaxf(v, __builtin_bit_cast(float, __builtin_amdgcn_update_dpp(0, __builtin_bit_cast(int, v), 0xB1, 0xF, 0xF, true)));
    v = fmaxf(v, __builtin_bit_cast(float, __builtin_amdgcn_update_dpp(0, __builtin_bit_cast(int, v), 0x4E, 0xF, 0xF, true)));
    v = fmaxf(v, __builtin_bit_cast(float, __builtin_amdgcn_update_dpp(0, __builtin_bit_cast(int, v), 0x141, 0xF, 0xF, true)));
    return v;
}
__device__ __forceinline__ float dpp_max16(float v) {
    v = dpp_max8(v);
    return fmaxf(v, __builtin_bit_cast(float, __builtin_amdgcn_update_dpp(0, __builtin_bit_cast(int, v), 0x140, 0xF, 0xF, true)));
}
__device__ __forceinline__ float dpp_row_sum(float v) {
    v += __builtin_bit_cast(float, __builtin_amdgcn_update_dpp(0, __builtin_bit_cast(int, v), 0xB1, 0xF, 0xF, true));
    v += __builtin_bit_cast(float, __builtin_amdgcn_update_dpp(0, __builtin_bit_cast(int, v), 0x4E, 0xF, 0xF, true));
    v += __builtin_bit_cast(float, __builtin_amdgcn_update_dpp(0, __builtin_bit_cast(int, v), 0x124, 0xF, 0xF, true));
    v += __builtin_bit_cast(float, __builtin_amdgcn_update_dpp(0, __builtin_bit_cast(int, v), 0x128, 0xF, 0xF, true));
    return v;
}
__device__ __forceinline__ void wave_sum2(float& a, float& b) {
    a = dpp_row_sum(a); b = dpp_row_sum(b);
    a = sum_rows4(a); b = sum_rows4(b);
}
__device__ __forceinline__ float row_rstd(const float* ssq, int r) {
    const f32x4* p = (const f32x4*)(ssq + (size_t)r * 16);
    const f32x4 a = p[0], b = p[1], c = p[2], d = p[3];
    const f32x4 s = (a + b) + (c + d);
    return rsqrtf(((s.x + s.y) + (s.z + s.w)) * (1.0f / D) + EPS);
}

__device__ __forceinline__ int lane_now() { int l; asm volatile("v_mbcnt_lo_u32_b32 %0, -1, 0\n\tv_mbcnt_hi_u32_b32 %0, -1, %0" : "=v"(l)); return l; }
namespace pg8 {
constexpr int BM = 256, BK = 64, HALF = 128, HTB = HALF * BK * 2, STAGE_BYTES = 8 * HTB, NXCD = 8, WGM = 8;
__host__ __device__ __forceinline__ int lds_byte(int r, int c) { const int st = (r >> 4) * 2 + (c >> 5), rr = r & 15, cc = c & 31, ob = rr * 64 + cc * 2; return st * 1024 + (ob ^ (((ob >> 9) & 1) << 5)); }
__host__ __device__ __forceinline__ void stage_rc(int b, int& R, int& C) { const int st = b / 1024, sb = b % 1024, swz = sb ^ (((sb >> 9) & 1) << 5); R = (st >> 1) * 16 + swz / 64; C = (st & 1) * 32 + (swz % 64) / 2; }
__host__ __device__ __forceinline__ int perm32(int rho) { const int n = rho >> 4, i = rho & 15; return 8 * (i >> 2) + 4 * n + (i & 3); }

struct Unit { int pm, pn; };
struct Gemm { const bf16_t* A; const bf16_t* Bt; int M, N, K; };

struct StaticOrder {
    int nM, nN, nwg, G, c, wgm;
    __host__ __device__ void init(int M_, int N_, int G_, int c_, int wgm_ = WGM) { nM = M_ / BM; nN = N_ / BM; nwg = nM * nN; G = G_; c = c_; wgm = wgm_; }
    __host__ __device__ bool next(int i, Unit& u) const {
        const long L = (long)i * G + c; if (L >= nwg) return false;
        int wgid = (int)L; { const int q = nwg / NXCD, r = nwg % NXCD, xcd = wgid % NXCD, off = wgid / NXCD; wgid = (xcd < r ? xcd * (q + 1) : r * (q + 1) + (xcd - r) * q) + off; }
        const int nig = wgm * nN, gid = wgid / nig, fm = gid * wgm, gsz = (nM - fm) < wgm ? (nM - fm) : wgm;
        u.pm = fm + ((wgid % nig) % gsz); u.pn = (wgid % nig) / gsz; return true;
    }
    __device__ __forceinline__ void a_ready(const Unit&) const {}
    __device__ __forceinline__ void done(const Unit&) const {}
};

__device__ __forceinline__ f32x4 mma16(bf16x8 b, bf16x8 a, f32x4 c) { return __builtin_amdgcn_mfma_f32_16x16x32_bf16(b, a, c, 0, 0, 0); }
__device__ __forceinline__ i32x4 mma16(bf16x8 b, bf16x8 a, i32x4 c) { return __builtin_amdgcn_mfma_i32_16x16x64_i8(__builtin_bit_cast(i32x4, b), __builtin_bit_cast(i32x4, a), c, 0, 0, 0); }
template <bool I8> struct AccT { typedef f32x4 type; };
template <> struct AccT<true> { typedef i32x4 type; };
template <class Epi, class Sched, bool ALIGN_EPI, bool SP2, bool I8 = false>
__device__ __forceinline__ void gemm_phase(LAS unsigned char* lds, const Gemm g, const Sched& S, const Epi& E, int wave_) {
    static_assert(ALIGN_EPI && SP2, "only the aligned-epilogue, two-MFMA-cluster schedule is kept");
    const int tid = wave_ * 64 + lane_now();
    const int wid = wave_, lane = tid & 63, wr = wid >> 2, wc = wid & 3, fr = lane & 15, fq = lane >> 4;
    const int K = g.K, nt = K / BK;
    unsigned voffA, voffB;
    { int R, C; stage_rc(tid * 16, R, C); const int Rb = Epi::PERM ? ((R & ~31) + perm32(R & 31)) : R; voffA = (unsigned)(R * K + C) * 2u; voffB = (unsigned)(Rb * K + C) * 2u; }
    const __amdgpu_buffer_rsrc_t srdA = __builtin_amdgcn_make_buffer_rsrc((void*)g.A, (short)0, -1, 0x00020000);
    const __amdgpu_buffer_rsrc_t srdB = __builtin_amdgcn_make_buffer_rsrc((void*)g.Bt, (short)0, -1, 0x00020000);
    const unsigned kstep = BK * 2u, hstep = (unsigned)HALF * (unsigned)K * 2u, tstep = 2u * hstep, pstep = 64u * (unsigned)K * 2u;
    const unsigned ldsb = (unsigned)(size_t)lds + (unsigned)wid * 1024u;
    const int aoff = lds_byte(wr * 64 + fr, fq * 8), boff = lds_byte(wc * 32 + fr, fq * 8);
#define PG8_SA(b, h) (((b) * 2 + (h)) * HTB)
#define PG8_SB(b, h) ((4 + (b) * 2 + (h)) * HTB)
#define PG8_STAGE(bufoff, srd, soff, voff) do { _Pragma("unroll") for (int _i = 0; _i < 2; ++_i) \
        asm volatile("s_add_u32 m0, %0, %4\n\ts_nop 0\n\tbuffer_load_dwordx4 %1, %2, %3 offen lds" :: "s"(ldsb), "v"(voff), "s"(srd), "s"((soff) + _i * pstep), "n"((bufoff) + _i * 8192) : "m0", "scc", "memory"); } while (0)
#define PG8_STA(b, h, soff) PG8_STAGE(PG8_SA(b, h), srdA, soff, voffA)
#define PG8_STB(b, h, soff) PG8_STAGE(PG8_SB(b, h), srdB, soff, voffB)
#define PG8_LDA(dst, b, h) do { _Pragma("unroll") for (int m = 0; m < 4; ++m) _Pragma("unroll") for (int k = 0; k < 2; ++k) dst[m][k] = *(const LAS bf16x8*)(lds + PG8_SA(b, h) + aoff + m * 2048 + k * 1024); } while (0)
#define PG8_LDB(dst, b, h) do { _Pragma("unroll") for (int n = 0; n < 2; ++n) _Pragma("unroll") for (int k = 0; k < 2; ++k) dst[n][k] = *(const LAS bf16x8*)(lds + PG8_SB(b, h) + boff + n * 2048 + k * 1024); } while (0)
#define PG8_MMA(ai, bj, At, Bt) do { __builtin_amdgcn_s_setprio(1); _Pragma("unroll") for (int m = 0; m < 4; ++m) _Pragma("unroll") for (int n = 0; n < 2; ++n) _Pragma("unroll") for (int k = 0; k < 2; ++k) \
        acc[ai][bj][m][n] = mma16(Bt[n][k], At[m][k], acc[ai][bj][m][n]); __builtin_amdgcn_s_setprio(0); } while (0)
#define PG8_MMAZ(ai, bj, At, Bt) do { __builtin_amdgcn_s_setprio(1); _Pragma("unroll") for (int m = 0; m < 4; ++m) _Pragma("unroll") for (int n = 0; n < 2; ++n) { \
        acc[ai][bj][m][n] = mma16(Bt[n][0], At[m][0], acc_t{}); acc[ai][bj][m][n] = mma16(Bt[n][1], At[m][1], acc[ai][bj][m][n]); } __builtin_amdgcn_s_setprio(0); } while (0)
#define PG8_WAIT_V(n) asm volatile("s_waitcnt vmcnt(%0)" :: "n"(n) : "memory")
#define PG8_WAIT_L(n) asm volatile("s_waitcnt lgkmcnt(" #n ")" ::: "memory")
#define PG8_BAR __builtin_amdgcn_s_barrier()
#define PG8_SCHED __builtin_amdgcn_sched_barrier(0)
#ifndef PG8_RELAX
#define PG8_RELAX 1
#endif
#define PG8_WAIT_R(relaxed, nst) do { if (relaxed) PG8_WAIT_V(8 + PG8_RELAX * (nst)); else PG8_WAIT_V(8); } while (0)
#define PG8_TRIP(first, relaxed, nst) do { \
            PG8_LDB(B0, 0, 0); PG8_LDB(B1, 0, 1); PG8_SCHED; PG8_LDA(At, 0, 0); if (!(first)) PG8_STA(1, 1, a1 + hstep); \
            PG8_WAIT_R(relaxed, nst); PG8_WAIT_L(0); PG8_BAR; PG8_MMA(0, 0, At, B0); PG8_MMA(0, 1, At, B1); PG8_BAR; PG8_SCHED; \
            PG8_LDA(At, 0, 1); PG8_STB(0, 0, b2); PG8_STB(0, 1, b2 + hstep); PG8_STA(0, 0, a2); \
            PG8_WAIT_R(relaxed, nst); PG8_WAIT_L(0); PG8_BAR; PG8_MMA(1, 0, At, B0); PG8_MMA(1, 1, At, B1); PG8_BAR; PG8_SCHED; \
            PG8_LDB(B0, 1, 0); PG8_LDB(B1, 1, 1); PG8_SCHED; PG8_LDA(At, 1, 0); PG8_STA(0, 1, a2 + hstep); \
            PG8_WAIT_R(relaxed, nst); PG8_WAIT_L(0); PG8_BAR; PG8_MMA(0, 0, At, B0); PG8_MMA(0, 1, At, B1); PG8_BAR; PG8_SCHED; \
            PG8_LDA(At, 1, 1); PG8_STB(1, 0, b3); PG8_STB(1, 1, b3 + hstep); PG8_STA(1, 0, a3); \
            PG8_WAIT_V(8); PG8_WAIT_L(0); PG8_BAR; PG8_MMA(1, 0, At, B0); PG8_MMA(1, 1, At, B1); PG8_BAR; PG8_SCHED; } while (0)
    constexpr bool EARLY = Epi::NST > 0;
    Unit cur, nxt; int ui = 0;
    if (!S.next(0, cur)) return;
    typedef typename AccT<I8>::type acc_t;
    acc_t acc[2][2][4][2];
    bf16x8 At[4][2], B0[2][2], B1[2][2];
    unsigned cA = (unsigned)cur.pm * tstep, cB = (unsigned)cur.pn * tstep;
    S.a_ready(cur);
    PG8_STB(0, 0, cB); PG8_STB(0, 1, cB + hstep); PG8_STA(0, 0, cA); PG8_STA(0, 1, cA + hstep);
    if (wr == 1) PG8_BAR;
    PG8_WAIT_V(2); PG8_BAR;
    PG8_STB(1, 0, cB + kstep); PG8_STA(1, 0, cA + kstep); PG8_STB(1, 1, cB + hstep + kstep);
    if constexpr (EARLY) { PG8_STA(1, 1, cA + hstep + kstep); PG8_WAIT_V(8); } else { PG8_WAIT_V(6); }
    PG8_BAR;
#pragma unroll
    for (int a = 0; a < 2; ++a)
#pragma unroll
        for (int b = 0; b < 2; ++b)
#pragma unroll
            for (int m = 0; m < 4; ++m)
#pragma unroll
                for (int n = 0; n < 2; ++n) acc[a][b][m][n] = acc_t{};
    for (;;) {
        const bool has_next = S.next(ui + 1, nxt);
        const unsigned nA = has_next ? (unsigned)nxt.pm * tstep : cA, nB = has_next ? (unsigned)nxt.pn * tstep : cB;
        for (int t = 0; t < nt; t += 2) {
            const bool last = (t == nt - 2), first = EARLY && (t == 0), relaxed = first && ui > 0;
            const unsigned a1 = cA + (unsigned)(t + 1) * kstep;
            const unsigned a2 = last ? nA : cA + (unsigned)(t + 2) * kstep, b2 = last ? nB : cB + (unsigned)(t + 2) * kstep;
            const unsigned a3 = a2 + kstep, b3 = b2 + kstep;
            if (last && has_next) S.a_ready(nxt);
            if (last) E.prefetch(cur, wid, lane, lds);
            PG8_TRIP(first, relaxed, Epi::NST);
        }
        if constexpr (EARLY) PG8_STA(1, 1, nA + kstep + hstep);
        if (wr == 0) PG8_BAR;
        E(acc, cur, wr, wc, fr, fq); S.done(cur);
        if (!has_next) break;
#pragma unroll
        for (int a = 0; a < 2; ++a)
#pragma unroll
            for (int b = 0; b < 2; ++b)
#pragma unroll
                for (int m = 0; m < 4; ++m)
#pragma unroll
                    for (int n = 0; n < 2; ++n) acc[a][b][m][n] = acc_t{};
        cur = nxt; cA = nA; cB = nB; ++ui;
        if (wr == 1) PG8_BAR;
    }
    PG8_WAIT_V(0);
    PG8_BAR;
#undef PG8_SA
#undef PG8_SB
#undef PG8_STAGE
#undef PG8_STA
#undef PG8_STB
#undef PG8_LDA
#undef PG8_LDB
#undef PG8_MMA
#undef PG8_MMAZ
#undef PG8_TRIP
#undef PG8_WAIT_R
#undef PG8_WAIT_V
#undef PG8_WAIT_L
#undef PG8_BAR
#undef PG8_SCHED
}
}

typedef const f32x4 (&AccRef)[2][2][4][2];
#define EPI_BIG_CALL() \
    __device__ __forceinline__ void operator()(AccRef acc, const pg8::Unit& u, int wr, int wc, int fr, int fq) const { \
        { const int l_ = lane_now(); fr = l_ & 15; fq = (l_ >> 4) & 3; }     \
        const int row0 = u.pm * 256 + wr * 64 + fr; \
        _Pragma("unroll") for (int gq = 0; gq < 8 / PF; ++gq) { \
            Pre p[PF]; \
            asm volatile("" ::: "memory"); \
            _Pragma("unroll") for (int i = 0; i < PF; ++i) { const int rg = gq * PF + i; p[i] = pre_big(row0 + (rg >> 2) * 128 + (rg & 3) * 16, u.pn, wc, fq); }     \
            asm volatile("" ::: "memory"); \
            _Pragma("unroll") for (int i = 0; i < PF; ++i) { const int rg = gq * PF + i; \
                rows(acc[rg >> 2][0][rg & 3][0], acc[rg >> 2][0][rg & 3][1], acc[rg >> 2][1][rg & 3][0], acc[rg >> 2][1][rg & 3][1], row0 + (rg >> 2) * 128 + (rg & 3) * 16, u.pn, wc, fq, p[i]); } } \
    }
__device__ __forceinline__ f32x4 ssq_quarter(const float* ssq, int r, int fq) { return *(const f32x4*)(ssq + (size_t)r * 16 + 4 * fq); }
__device__ __forceinline__ float rstd_from(const f32x4& q) {
    float s = (q.x + q.y) + (q.z + q.w);
    s = sum_rows4(s);
    return rsqrtf(s * (1.0f / D) + EPS);
}

__device__ __forceinline__ void ssq_prefetch(const float* ssq, int pm, int wid, int lane, LAS unsigned char* lds) {
    asm volatile("" : "+v"(lane));
#pragma unroll
    for (int i = 0; i < 2; ++i)
        __builtin_amdgcn_global_load_lds((const unsigned*)(ssq + ((size_t)pm * 256 + wid * 32 + i * 16) * 16 + lane * 4), (LAS unsigned*)(lds + SSQ_LDS_OFF + (wid * 32 + i * 16) * 64), 16, 0, 0);
}
struct EpiSwiglu {
    static constexpr bool PERM = true; static constexpr int PF = 8; static constexpr int NST = 8;
    bf16_t* O; const float* ssq; LAS unsigned char* lds;
    struct Pre { f32x4 q; };
    __device__ __forceinline__ Pre pre(int r, int pn, int wc, int fq) const { Pre p; p.q = ssq_quarter(ssq, r, fq); return p; }
    __device__ __forceinline__ Pre pre_big(int r, int pn, int wc, int fq) const { Pre p; p.q = *(const LAS f32x4*)(lds + SSQ_LDS_OFF + (r & 255) * 64 + fq * 16); return p; }
    __device__ __forceinline__ void prefetch(const pg8::Unit& u, int wid, int lane, LAS unsigned char* l) const { ssq_prefetch(ssq, u.pm, wid, lane, l); }
    __device__ __forceinline__ void rows(const f32x4& c00, const f32x4& c01, const f32x4& c10, const f32x4& c11, int r, int pn, int wc, int fq, const Pre& p) const {
        const float rs = rstd_from(p.q);
        float o[8];
#pragma unroll
        for (int j = 0; j < 4; ++j) { o[j] = silu_f(c00[j] * rs) * (c10[j] * rs); o[4 + j] = silu_f(c01[j] * rs) * (c11[j] * rs); }
        u32x4 w; w.x = cvt_pk_bf16(o[0], o[1]); w.y = cvt_pk_bf16(o[2], o[3]); w.z = cvt_pk_bf16(o[4], o[5]); w.w = cvt_pk_bf16(o[6], o[7]);
        { bf16_t* dst_ = O + (size_t)r * FF + pn * 128 + wc * 32 + 8 * fq;
          asm volatile("global_store_dwordx4 %0, %1, off sc1\n\ts_nop 1" :: "v"(dst_), "v"(w) : "memory"); }
    }
    EPI_BIG_CALL()
};

struct EpiSwigluI8 {
    static constexpr bool PERM = true; static constexpr int NST = 8;
    bf16_t* O; const float* rs; const float* cs; LAS unsigned char* lds;
    struct Pre { float sa; };
    __device__ __forceinline__ Pre pre(int r, int pn, int wc, int fq) const { Pre p; p.sa = rs[r]; return p; }
    __device__ __forceinline__ void prefetch(const pg8::Unit& u, int wid, int lane, LAS unsigned char* l) const {
        asm volatile("" : "+v"(lane));
        if (wid == 0) __builtin_amdgcn_global_load_lds((const unsigned*)(rs + (size_t)u.pm * 256 + lane * 4), (LAS unsigned*)(l + SSQ_LDS_OFF), 16, 0, 0);
        if (wid == 1) __builtin_amdgcn_global_load_lds((const unsigned*)(cs + (size_t)u.pn * 256 + lane * 4), (LAS unsigned*)(l + SSQ_LDS_OFF + 1024), 16, 0, 0);
    }
    __device__ __forceinline__ void emit(const f32x4& c00, const f32x4& c01, const f32x4& c10, const f32x4& c11, float sa, const f32x4& w00, const f32x4& w01, const f32x4& w10, const f32x4& w11,
                                         int r, int pn, int wc, int fq) const {
        float o[8];
#pragma unroll
        for (int j = 0; j < 4; ++j) { o[j] = silu_f(c00[j] * (sa * w00[j])) * (c10[j] * (sa * w10[j])); o[4 + j] = silu_f(c01[j] * (sa * w01[j])) * (c11[j] * (sa * w11[j])); }
        u32x4 w; w.x = cvt_pk_bf16(o[0], o[1]); w.y = cvt_pk_bf16(o[2], o[3]); w.z = cvt_pk_bf16(o[4], o[5]); w.w = cvt_pk_bf16(o[6], o[7]);
        { bf16_t* dst_ = O + (size_t)r * FF + pn * 128 + wc * 32 + 8 * fq;
          asm volatile("global_store_dwordx4 %0, %1, off sc1\n\ts_nop 1" :: "v"(dst_), "v"(w) : "memory"); }
    }
    __device__ __forceinline__ void rows(const f32x4& c00, const f32x4& c01, const f32x4& c10, const f32x4& c11, int r, int pn, int wc, int fq, const Pre& p) const {
        const float* cp = cs + (size_t)pn * 256 + wc * 32 + 8 * fq;
        emit(c00, c01, c10, c11, p.sa, *(const f32x4*)cp, *(const f32x4*)(cp + 4), *(const f32x4*)(cp + 128), *(const f32x4*)(cp + 132), r, pn, wc, fq);
    }
    template <class AccTy> __device__ __forceinline__ void operator()(const AccTy (&acc)[2][2][4][2], const pg8::Unit& u, int wr, int wc, int fr, int fq) const {
        { const int l_ = lane_now(); fr = l_ & 15; fq = (l_ >> 4) & 3; }
        const int row0 = u.pm * 256 + wr * 64 + fr;
        LAS const float* lr = (LAS const float*)(lds + SSQ_LDS_OFF); LAS const float* lc = lr + 256 + wc * 32 + 8 * fq;
        const f32x4 w00 = *(LAS const f32x4*)lc, w01 = *(LAS const f32x4*)(lc + 4), w10 = *(LAS const f32x4*)(lc + 128), w11 = *(LAS const f32x4*)(lc + 132);
        f32x2 NW[4], WW[4];
        NW[0] = (f32x2){w00[0], w00[1]} * (-LOG2E); NW[1] = (f32x2){w00[2], w00[3]} * (-LOG2E); NW[2] = (f32x2){w01[0], w01[1]} * (-LOG2E); NW[3] = (f32x2){w01[2], w01[3]} * (-LOG2E);
        WW[0] = (f32x2){w00[0], w00[1]} * (f32x2){w10[0], w10[1]}; WW[1] = (f32x2){w00[2], w00[3]} * (f32x2){w10[2], w10[3]};
        WW[2] = (f32x2){w01[0], w01[1]} * (f32x2){w11[0], w11[1]}; WW[3] = (f32x2){w01[2], w01[3]} * (f32x2){w11[2], w11[3]};
#pragma unroll
        for (int rg = 0; rg < 8; ++rg) {
            const int ai = rg >> 2, m = rg & 3, r = row0 + ai * 128 + m * 16;
            const float sa = lr[r & 255], inv = __builtin_amdgcn_rcpf(sa);
            unsigned pk[4];
#pragma unroll
            for (int p = 0; p < 4; ++p) {
                const AccTy& cg = acc[ai][0][m][p >> 1]; const AccTy& cu = acc[ai][1][m][p >> 1]; const int j = (p & 1) * 2;
                const f32x2 G = (f32x2){(float)cg[j], (float)cg[j + 1]} * sa, U = (f32x2){(float)cu[j], (float)cu[j + 1]};
                const f32x2 T = G * NW[p];
                f32x2 E; E.x = __builtin_amdgcn_exp2f(T.x); E.y = __builtin_amdgcn_exp2f(T.y);
                const f32x2 Dn = E * inv + inv;
                f32x2 R; R.x = __builtin_amdgcn_rcpf(Dn.x); R.y = __builtin_amdgcn_rcpf(Dn.y);
                const f32x2 O = ((G * U) * WW[p]) * R;
                pk[p] = cvt_pk_bf16(O.x, O.y);
            }
            u32x4 w; w.x = pk[0]; w.y = pk[1]; w.z = pk[2]; w.w = pk[3];
            { bf16_t* dst_ = O_at(r, u.pn, wc, fq);
              asm volatile("global_store_dwordx4 %0, %1, off sc1\n\ts_nop 1" :: "v"(dst_), "v"(w) : "memory"); }
        }
    }
    __device__ __forceinline__ bf16_t* O_at(int r, int pn, int wc, int fq) const { return O + (size_t)r * FF + pn * 128 + wc * 32 + 8 * fq; }
};

template <int MODE> struct EpiResid {
    static constexpr bool PERM = true; static constexpr int PF = (MODE == 0) ? 2 : 4;
    static constexpr int NST = (MODE == 2) ? 16 : (MODE == 1) ? 12 : 6;
    const float* resP; const float* resS;
    float* out; bf16_t* xb; float* ssq; float scale;
    struct Pre { f32x4 r00, r01, r10, r11; u32x4 a, b; };
    __device__ __forceinline__ Pre pre(int r, int pn, int wc, int fq) const {
        Pre p; const size_t off = (size_t)r * D + pn * 256 + wc * 32 + 8 * fq;
        if (MODE == 0) { const float* rbase = (r >= MP) ? resS - (size_t)MP * D : resP;
            p.r00 = *(const f32x4*)(rbase + off); p.r01 = *(const f32x4*)(rbase + off + 4); p.r10 = *(const f32x4*)(rbase + off + 128); p.r11 = *(const f32x4*)(rbase + off + 132); }
        else { p.a = *(const u32x4*)(xb + off); p.b = *(const u32x4*)(xb + off + 128); }
        return p;
    }
    __device__ __forceinline__ Pre pre_big(int r, int pn, int wc, int fq) const { return pre(r, pn, wc, fq); }
    __device__ __forceinline__ void prefetch(const pg8::Unit&, int, int, LAS unsigned char*) const {}
    __device__ __forceinline__ void rows(const f32x4& c00, const f32x4& c01, const f32x4& c10, const f32x4& c11, int r, int pn, int wc, int fq, const Pre& p) const {
        const size_t off = (size_t)r * D + pn * 256 + wc * 32 + 8 * fq;
        f32x4 r00, r01, r10, r11;
        if (MODE == 0) { r00 = p.r00; r01 = p.r01; r10 = p.r10; r11 = p.r11; }
        else {
            const u32x4 a = p.a, b = p.b;
            r00 = (f32x4){__uint_as_float(a.x << 16), __uint_as_float(a.x & 0xffff0000u), __uint_as_float(a.y << 16), __uint_as_float(a.y & 0xffff0000u)};
            r01 = (f32x4){__uint_as_float(a.z << 16), __uint_as_float(a.z & 0xffff0000u), __uint_as_float(a.w << 16), __uint_as_float(a.w & 0xffff0000u)};
            r10 = (f32x4){__uint_as_float(b.x << 16), __uint_as_float(b.x & 0xffff0000u), __uint_as_float(b.y << 16), __uint_as_float(b.y & 0xffff0000u)};
            r11 = (f32x4){__uint_as_float(b.z << 16), __uint_as_float(b.z & 0xffff0000u), __uint_as_float(b.w << 16), __uint_as_float(b.w & 0xffff0000u)};
        }
        const f32x4 y00 = r00 + c00 * scale, y01 = r01 + c01 * scale, y10 = r10 + c10 * scale, y11 = r11 + c11 * scale;
        if (MODE == 2) {
            __builtin_nontemporal_store(y00, (f32x4*)(out + off)); __builtin_nontemporal_store(y01, (f32x4*)(out + off + 4)); __builtin_nontemporal_store(y10, (f32x4*)(out + off + 128)); __builtin_nontemporal_store(y11, (f32x4*)(out + off + 132));
        } else {
            u32x4 w0, w1;
            w0.x = cvt_pk_bf16(y00[0], y00[1]); w0.y = cvt_pk_bf16(y00[2], y00[3]); w0.z = cvt_pk_bf16(y01[0], y01[1]); w0.w = cvt_pk_bf16(y01[2], y01[3]);
            w1.x = cvt_pk_bf16(y10[0], y10[1]); w1.y = cvt_pk_bf16(y10[2], y10[3]); w1.z = cvt_pk_bf16(y11[0], y11[1]); w1.w = cvt_pk_bf16(y11[2], y11[3]);
            *(u32x4*)(xb + off) = w0; *(u32x4*)(xb + off + 128) = w1;
            float ss = (y00[0] * y00[0] + y00[1] * y00[1]) + (y00[2] * y00[2] + y00[3] * y00[3]) + (y01[0] * y01[0] + y01[1] * y01[1]) + (y01[2] * y01[2] + y01[3] * y01[3])
                     + (y10[0] * y10[0] + y10[1] * y10[1]) + (y10[2] * y10[2] + y10[3] * y10[3]) + (y11[0] * y11[0] + y11[1] * y11[1]) + (y11[2] * y11[2] + y11[3] * y11[3]);
            ss = sum_rows4(ss);
            if (fq == 0) ssq[(size_t)r * 16 + pn * 4 + wc] = ss;
        }
    }
    EPI_BIG_CALL()
};

struct EpiInProj {
    static constexpr bool PERM = true; static constexpr int PF = 1; static constexpr int NST = 0;
    unsigned char* ws; const float* gq; const float* gk; float* out; LAS unsigned char* lds;
    struct Pre { f32x4 q; };
    __device__ __forceinline__ Pre pre(int r, int pn, int wc, int fq) const { Pre p; p.q = ssq_quarter((const float*)(ws + WS_SSQ1), r, fq); return p; }
    __device__ __forceinline__ Pre pre_big(int r, int pn, int wc, int fq) const { Pre p; p.q = *(const LAS f32x4*)(lds + SSQ_LDS_OFF + (r & 255) * 64 + fq * 16); return p; }
    __device__ __forceinline__ void prefetch(const pg8::Unit& u, int wid, int lane, LAS unsigned char* l) const { ssq_prefetch((const float*)(ws + WS_SSQ1), u.pm, wid, lane, l); }
    __device__ __forceinline__ void rows(const f32x4& c00, const f32x4& c01, const f32x4& c10, const f32x4& c11, int r, int pn, int wc, int fq, const Pre& p) const {
        const bool sample = r >= MP;
        int b, t, pos;
        if (sample) { const int rr = r - MP; b = rr >> 4; t = rr & 15; pos = PAST + t; } else { b = r >> 13; t = r & (TP - 1); pos = t; }
        const float rs = rstd_from(p.q);
        if (pn < 4) {
            const int ch0 = pn * 128 + wc * 32 + 8 * fq;
            float o[8];
#pragma unroll
            for (int j = 0; j < 4; ++j) { o[j] = (c00[j] * rs) * sigmoid_f(c10[j] * rs); o[4 + j] = (c01[j] * rs) * sigmoid_f(c11[j] * rs); }
            u32x4 w; w.x = cvt_pk_bf16(o[0], o[1]); w.y = cvt_pk_bf16(o[2], o[3]); w.z = cvt_pk_bf16(o[4], o[5]); w.w = cvt_pk_bf16(o[6], o[7]);
            bf16_t* ud = sample ? (bf16_t*)(ws + WS_US) + ((size_t)(b * USROWS + HIST + t)) * CC + ch0 : (bf16_t*)(ws + WS_UP) + (size_t)r * CC + ch0;
            *(u32x4*)ud = w;
            float* dst = nullptr;
            if (sample) dst = out + O_CSS + ((size_t)(b * HIST + (HIST - TS) + t)) * CC + ch0;
            else if (t >= TP - HIST) dst = out + O_CSP + ((size_t)(b * HIST + (t - (TP - HIST)))) * CC + ch0;
            if (dst) { *(f32x4*)dst = (f32x4){o[0], o[1], o[2], o[3]}; *(f32x4*)(dst + 4) = (f32x4){o[4], o[5], o[6], o[7]}; }
        } else if (pn < 6 || wc < 2) {
            const bool isq = pn < 6;
            const int h = isq ? (pn - 4) * 4 + wc : wc;
            const float* gg = isq ? gq : gk;
            const f32x4 g00 = *(const f32x4*)(gg + 8 * fq), g01 = *(const f32x4*)(gg + 8 * fq + 4), g10 = *(const f32x4*)(gg + 32 + 8 * fq), g11 = *(const f32x4*)(gg + 32 + 8 * fq + 4);
            const float osc = isq ? QSCALE : 1.0f;
            f32x4 v00 = c00 * rs, v01 = c01 * rs, v10 = c10 * rs, v11 = c11 * rs;
            float ss = (v00[0] * v00[0] + v00[1] * v00[1]) + (v00[2] * v00[2] + v00[3] * v00[3]) + (v01[0] * v01[0] + v01[1] * v01[1]) + (v01[2] * v01[2] + v01[3] * v01[3])
                     + (v10[0] * v10[0] + v10[1] * v10[1]) + (v10[2] * v10[2] + v10[3] * v10[3]) + (v11[0] * v11[0] + v11[1] * v11[1]) + (v11[2] * v11[2] + v11[3] * v11[3]);
            ss = sum_rows4(ss);
            const float hn = rsqrtf(ss * (1.0f / HD) + EPS);
            v00 = v00 * hn * g00; v01 = v01 * hn * g01; v10 = v10 * hn * g10; v11 = v11 * hn * g11;
            f32x4 p0, p1;
#pragma unroll
            for (int j = 0; j < 4; ++j) { p0[j] = __shfl_xor(v00[j], 16); p1[j] = __shfl_xor(v01[j], 16);     }
            if (fq < 2) {
                const f32x2* rp = (const f32x2*)(ws + WS_ROPE) + (size_t)pos * 8;
                const float sg = (fq == 0) ? -1.0f : 1.0f;
#pragma unroll
                for (int j = 0; j < 4; ++j) {
                    const f32x2 cs0 = rp[j], cs1 = rp[4 + j];
                    v00[j] = v00[j] * cs0.x + sg * p0[j] * cs0.y;
                    v01[j] = v01[j] * cs1.x + sg * p1[j] * cs1.y;
                }
            }
            u32x4 w0, w1;
            w0.x = cvt_pk_bf16(v00[0] * osc, v00[1] * osc); w0.y = cvt_pk_bf16(v00[2] * osc, v00[3] * osc); w0.z = cvt_pk_bf16(v01[0] * osc, v01[1] * osc); w0.w = cvt_pk_bf16(v01[2] * osc, v01[3] * osc);
            w1.x = cvt_pk_bf16(v10[0] * osc, v10[1] * osc); w1.y = cvt_pk_bf16(v10[2] * osc, v10[3] * osc); w1.z = cvt_pk_bf16(v11[0] * osc, v11[1] * osc); w1.w = cvt_pk_bf16(v11[2] * osc, v11[3] * osc);
            if (isq) {
                bf16_t* dst = (bf16_t*)(ws + WS_Q) + (size_t)r * 512 + h * 64 + 8 * fq;
                *(u32x4*)dst = w0; *(u32x4*)(dst + 32) = w1;
            } else {
                bf16_t* dst = sample ? (bf16_t*)(ws + WS_KS) + ((size_t)(b * KSROWS + WIN + t)) * 128 + h * 64 + 8 * fq : (bf16_t*)(ws + WS_KP) + (size_t)r * 128 + h * 64 + 8 * fq;
                *(u32x4*)dst = w0; *(u32x4*)(dst + 32) = w1;
                float* od = nullptr;
                if (sample) od = out + O_KWS + ((size_t)((b * WIN + (WIN - TS) + t) * 2 + h)) * 64 + 8 * fq;
                else if (t >= TP - WIN) od = out + O_KWP + ((size_t)((b * WIN + (t - (TP - WIN))) * 2 + h)) * 64 + 8 * fq;
                if (od) { *(f32x4*)od = v00; *(f32x4*)(od + 4) = v01; *(f32x4*)(od + 32) = v10; *(f32x4*)(od + 36) = v11; }
            }
        } else {
            const int kh = wc - 2;
            const f32x4 v00 = c00 * rs, v01 = c01 * rs, v10 = c10 * rs, v11 = c11 * rs;
            bf16_t* vt; size_t vs;
            if (sample) { vt = (bf16_t*)(ws + WS_VTS) + ((size_t)((b * 2 + kh) * 64)) * KSROWS + WIN + t; vs = KSROWS; }
            else { vt = (bf16_t*)(ws + WS_VTP) + ((size_t)((b * 2 + kh) * (TP / 64) + (t >> 6))) * 4096 + (t & 63); vs = 64; }
#pragma unroll
            for (int j = 0; j < 4; ++j) {
                vt[(size_t)(8 * fq + j) * vs] = f2bf(v00[j]); vt[(size_t)(8 * fq + 4 + j) * vs] = f2bf(v01[j]);
                vt[(size_t)(32 + 8 * fq + j) * vs] = f2bf(v10[j]); vt[(size_t)(32 + 8 * fq + 4 + j) * vs] = f2bf(v11[j]);
            }
            float* od = nullptr;
            if (sample) od = out + O_VWS + ((size_t)((b * WIN + (WIN - TS) + t) * 2 + kh)) * 64 + 8 * fq;
            else if (t >= TP - WIN) od = out + O_VWP + ((size_t)((b * WIN + (t - (TP - WIN))) * 2 + kh)) * 64 + 8 * fq;
            if (od) { *(f32x4*)od = v00; *(f32x4*)(od + 4) = v01; *(f32x4*)(od + 32) = v10; *(f32x4*)(od + 36) = v11; }
        }
    }
    EPI_BIG_CALL()
};

template <int KS, int MT, bool I8, class Epi>
__device__ __forceinline__ void small_gemm(const bf16_t* A, const bf16_t* Bt, int N, int K, const Epi& E, LAS unsigned char* lds, int bid, int G, int wave, int lane, int wpc_in = 0) {
    constexpr int MTN = MS / (16 * MT);
    const int NT = MTN * (N / 256) * 4, NI = NT * KS, wpc = wpc_in ? wpc_in : (NI + G - 1) / G, nb = K / 64;
    asm volatile("" : "+v"(lane));
    const int fr = lane & 15, g = lane >> 4;
    for (int i0 = 0; i0 < wpc; i0 += 8) {
        const int i = i0 + wave, item = bid * wpc + i;
        const bool active = (i < wpc) && (item < NI);
        const int t = active ? item / KS : 0, ksl = item % KS;
        const int mt = t % MTN, nq = t / MTN, pn = nq >> 2, wc = nq & 3;
        const int r = MP + mt * (16 * MT) + fr;
        typedef typename pg8::AccT<I8>::type acc_t;
        acc_t acc[MT][2][2];
#pragma unroll
        for (int mi = 0; mi < MT; ++mi)
#pragma unroll
            for (int bj = 0; bj < 2; ++bj)
#pragma unroll
                for (int n = 0; n < 2; ++n) acc[mi][bj][n] = acc_t{};
        if (active) {
            const int b0 = (nb * ksl) / KS, b1 = (nb * (ksl + 1)) / KS;
            const bf16_t* ap = A + (size_t)r * K + g * 8;
            const bf16_t* bp = Bt + (size_t)(pn * 256 + wc * 32 + 8 * (fr >> 2) + (fr & 3)) * K + g * 8;
            bf16x8 afA[2][MT], bfA[2][2][2], afB[2][MT], bfB[2][2][2];
#define SG_LOAD(af, bf, kb) do { const int k0_ = (kb) * 64; _Pragma("unroll") for (int s_ = 0; s_ < 2; ++s_) { \
            _Pragma("unroll") for (int mi = 0; mi < MT; ++mi) af[s_][mi] = *(const bf16x8*)(ap + (size_t)(16 * mi) * K + k0_ + s_ * 32); \
            _Pragma("unroll") for (int bj = 0; bj < 2; ++bj) _Pragma("unroll") for (int n = 0; n < 2; ++n) bf[s_][bj][n] = *(const bf16x8*)(bp + (size_t)(4 * n + 128 * bj) * K + k0_ + s_ * 32); } } while (0)
#define SG_MMA(af, bf) do { _Pragma("unroll") for (int s_ = 0; s_ < 2; ++s_) _Pragma("unroll") for (int bj = 0; bj < 2; ++bj) _Pragma("unroll") for (int n = 0; n < 2; ++n) { \
            _Pragma("unroll") for (int mi = 0; mi < MT; ++mi) acc[mi][bj][n] = pg8::mma16(bf[s_][bj][n], af[s_][mi], acc[mi][bj][n]); } } while (0)
            SG_LOAD(afA, bfA, b0);
            for (int kb = b0; kb < b1; kb += 2) {
                const int kb1 = (kb + 1 < b1) ? kb + 1 : b1 - 1, kb2 = (kb + 2 < b1) ? kb + 2 : b1 - 1;
                __builtin_amdgcn_sched_barrier(0);
                SG_LOAD(afB, bfB, kb1);
                __builtin_amdgcn_sched_barrier(0);
                SG_MMA(afA, bfA);
                __builtin_amdgcn_sched_barrier(0);
                SG_LOAD(afA, bfA, kb2);
                __builtin_amdgcn_sched_barrier(0);
                if (kb + 1 < b1) SG_MMA(afB, bfB);
            }
#undef SG_LOAD
#undef SG_MMA
        }
        if constexpr (KS > 1) {
            static_assert(KS == 1 || KS == 8, "KS: 1 or 8 (all eight waves of the workgroup on one tile)");
            LAS acc_t* red = (LAS acc_t*)lds;
            if (ksl != 0) {
#pragma unroll
                for (int mi = 0; mi < MT; ++mi)
#pragma unroll
                    for (int bj = 0; bj < 2; ++bj)
#pragma unroll
                        for (int n = 0; n < 2; ++n) red[(ksl - 1) * (MT * 256) + ((mi * 2 + bj) * 2 + n) * 64 + lane] = acc[mi][bj][n];
            }
            __syncthreads();
            if (ksl == 0) {
#pragma unroll
                for (int q = 0; q < KS - 1; ++q)
#pragma unroll
                    for (int mi = 0; mi < MT; ++mi)
#pragma unroll
                        for (int bj = 0; bj < 2; ++bj)
#pragma unroll
                            for (int n = 0; n < 2; ++n) acc[mi][bj][n] += red[q * (MT * 256) + ((mi * 2 + bj) * 2 + n) * 64 + lane];
            }
            __syncthreads();
        }
        if (active && ksl == 0) {
#pragma unroll
            for (int mi = 0; mi < MT; ++mi) { const typename Epi::Pre p = E.pre(r + 16 * mi, pn, wc, g);
                E.rows(__builtin_convertvector(acc[mi][0][0], f32x4), __builtin_convertvector(acc[mi][0][1], f32x4), __builtin_convertvector(acc[mi][1][0], f32x4), __builtin_convertvector(acc[mi][1][1], f32x4), r + 16 * mi, pn, wc, g, p); }
        }
    }
}

struct TItem { const float* W; const float* g; bf16_t* WT; int Nsrc, srccol0, K, destrow0, k0; };
__device__ __forceinline__ void p0_tload(const TItem& t, float (&v)[32], int lane) {
#pragma unroll
    for (int i = 0; i < 32; ++i) { const int kk = 2 * i + (lane >> 5); v[i] = t.W[(size_t)(t.k0 + kk) * t.Nsrc + t.srccol0 + (lane & 31)]; }
}
__device__ __forceinline__ void p0_tfinish(const TItem& t, const float (&v)[32], LAS float* scr, int lane) {
#pragma unroll
    for (int i = 0; i < 32; ++i) { const int kk = 2 * i + (lane >> 5); scr[kk * 33 + (lane & 31)] = v[i]; }
    asm volatile("s_waitcnt lgkmcnt(0)" ::: "memory");
    const int c = lane & 7;
    f32x4 g0 = (f32x4){1.f, 1.f, 1.f, 1.f}, g1 = g0;
    if (t.g) { g0 = *(const f32x4*)(t.g + t.k0 + 8 * c); g1 = *(const f32x4*)(t.g + t.k0 + 8 * c + 4); }
#pragma unroll
    for (int j = 0; j < 4; ++j) { const int n = (lane >> 3) + 8 * j; const LAS float* sp = scr + (8 * c) * 33 + n;
        u32x4 o; o.x = cvt_pk_bf16(sp[0 * 33] * g0.x, sp[1 * 33] * g0.y); o.y = cvt_pk_bf16(sp[2 * 33] * g0.z, sp[3 * 33] * g0.w); o.z = cvt_pk_bf16(sp[4 * 33] * g1.x, sp[5 * 33] * g1.y); o.w = cvt_pk_bf16(sp[6 * 33] * g1.z, sp[7 * 33] * g1.w);
        *(u32x4*)(t.WT + (size_t)(t.destrow0 + n) * t.K + t.k0 + 8 * c) = o; }
    asm volatile("s_waitcnt lgkmcnt(0)" ::: "memory");
}
__device__ __forceinline__ int src_up(int nb) { const int pn = nb >> 3, p0 = (nb & 7) * 32, bj = p0 >> 7; return bj * FF + pn * 128 + (p0 & 127); }
__device__ __forceinline__ int src_in(int nb) {
    const int pn = nb >> 3, p0 = (nb & 7) * 32, bj = p0 >> 7, wc = (p0 & 127) >> 5;
    if (pn < 4) return bj * CC + pn * 128 + wc * 32;
    if (pn < 6) return 1024 + ((pn - 4) * 4 + wc) * 64 + bj * 32;
    return (wc < 2) ? 1536 + wc * 64 + bj * 32 : 1664 + (wc - 2) * 64 + bj * 32;
}

struct Args { const float* in[21]; float* out; unsigned char* ws; float inv[8]; };
typedef const __attribute__((address_space(4))) Args& ArgsRef;
__device__ __forceinline__ const __attribute__((address_space(4))) Args* args_now() {
#if defined(__HIP_DEVICE_COMPILE__)
    auto p = (const __attribute__((address_space(4))) Args*)__builtin_amdgcn_kernarg_segment_ptr(); asm volatile("" : "+s"(p)); return p;
#else
    return nullptr;
#endif
}

constexpr int I_UP = (D / 64) * (NUP / 32), I_DN = (FF / 64) * (D / 32), I_IN = (D / 64) * (NIN / 32), I_O = (D / 64) * (D / 32);
constexpr int NITEMS = 2 * I_UP + 2 * I_DN + I_IN + I_O;
constexpr int NITEMS_EARLY = I_UP + I_DN + I_IN + I_O;
__device__ __forceinline__ TItem p0_decode(ArgsRef a, int it) {
    unsigned char* ws = a.ws; int r = it < NITEMS ? it : NITEMS - 1; TItem t;
    if (r < I_UP) { const int nblk = NUP / 32, kb = r / nblk, nb = r % nblk; t = TItem{a.in[6], a.in[5], (bf16_t*)(ws + WS_W1T), NUP, src_up(nb), D, nb * 32, kb * 64}; return t; } r -= I_UP;
    if (r < I_DN) { const int nblk = D / 32, kb = r / nblk, nb = r % nblk; t = TItem{a.in[7], nullptr, (bf16_t*)(ws + WS_W2T), D, nb * 32, FF, nb * 32, kb * 64}; return t; } r -= I_DN;
    if (r < I_IN) { const int nblk = NIN / 32, kb = r / nblk, nb = r % nblk; t = TItem{a.in[9], a.in[8], (bf16_t*)(ws + WS_WINT), NIN, src_in(nb), D, nb * 32, kb * 64}; return t; } r -= I_IN;
    if (r < I_O) { const int nblk = D / 32, kb = r / nblk, nb = r % nblk; t = TItem{a.in[17], nullptr, (bf16_t*)(ws + WS_WOT), D, nb * 32, D, nb * 32, kb * 64}; return t; } r -= I_O;
    if (r < I_UP) { const int nblk = NUP / 32, kb = r / nblk, nb = r % nblk; t = TItem{a.in[19], a.in[18], (bf16_t*)(ws + WS_W3T), NUP, src_up(nb), D, nb * 32, kb * 64}; return t; } r -= I_UP;
    { const int nblk = D / 32, kb = r / nblk, nb = r % nblk; t = TItem{a.in[20], nullptr, (bf16_t*)(ws + WS_W4T), D, nb * 32, FF, nb * 32, kb * 64}; return t; }
}
__device__ __forceinline__ void weights_convert(ArgsRef a, LAS unsigned char* lds, int it0, int it1, int gw, int NGW, int wave, int lane) {
    LAS float* scr = (LAS float*)(lds + wave * 16896);
    for (int it = it0 + gw; it < it1; it += 2 * NGW) {
        const TItem t0 = p0_decode(a, it), t1 = p0_decode(a, it + NGW < it1 ? it + NGW : it);
        float v0[32], v1[32];
        p0_tload(t0, v0, lane); p0_tload(t1, v1, lane);
        p0_tfinish(t0, v0, scr, lane);
        if (it + NGW < it1) p0_tfinish(t1, v1, scr + 64 * 33, lane);
    }
}


__device__ __forceinline__ void w8_strip(const float* W, const float* g, signed char* Wq, float* cs, int nb, LAS unsigned char* lds, int wave, int lane) {
    LAS float* scr = (LAS float*)(lds + wave * 16896);
    LAS float* red = (LAS float*)(lds + 139264);
    const int src0 = src_up(nb), k0 = 128 * wave, c = lane & 7;
    TItem t0{W, nullptr, nullptr, NUP, src0, D, 0, k0}, t1{W, nullptr, nullptr, NUP, src0, D, 0, k0 + 64};
    float v0[32], v1[32];
    p0_tload(t0, v0, lane); p0_tload(t1, v1, lane);
#pragma unroll
    for (int i = 0; i < 32; ++i) { const int kk = 2 * i + (lane >> 5); scr[kk * 33 + (lane & 31)] = v0[i]; scr[64 * 33 + kk * 33 + (lane & 31)] = v1[i]; }
    asm volatile("s_waitcnt lgkmcnt(0)" ::: "memory");
    float val[2][4][8]; float mx[4];
#pragma unroll
    for (int h = 0; h < 2; ++h) { const f32x4 ga = *(const f32x4*)(g + k0 + 64 * h + 8 * c), gb = *(const f32x4*)(g + k0 + 64 * h + 8 * c + 4);
#pragma unroll
        for (int j = 0; j < 4; ++j) { const LAS float* sp = scr + h * (64 * 33) + (8 * c) * 33 + (lane >> 3) + 8 * j;
#pragma unroll
            for (int i = 0; i < 8; ++i) val[h][j][i] = sp[i * 33] * (i < 4 ? ga[i] : gb[i - 4]); } }
#pragma unroll
    for (int j = 0; j < 4; ++j) { float m = 0.f;
#pragma unroll
        for (int h = 0; h < 2; ++h)
#pragma unroll
            for (int i = 0; i < 8; ++i) m = fmaxf(m, fabsf(val[h][j][i]));
        m = dpp_max8(m);
        mx[j] = m; }
    if (c == 0) {
#pragma unroll
        for (int j = 0; j < 4; ++j) red[wave * 32 + (lane >> 3) + 8 * j] = mx[j]; }
    __syncthreads();
#pragma unroll
    for (int j = 0; j < 4; ++j) { float m = 0.f;
#pragma unroll
        for (int w = 0; w < 8; ++w) m = fmaxf(m, red[w * 32 + (lane >> 3) + 8 * j]);
        mx[j] = m; }
#pragma unroll
    for (int j = 0; j < 4; ++j) { const int n = (lane >> 3) + 8 * j; const float inv = mx[j] > 0.f ? 127.0f / mx[j] : 0.f;
        if (wave == 0 && c == 0) cs[nb * 32 + n] = mx[j] > 0.f ? mx[j] * (1.0f / 127.0f) : 1.0f;
#pragma unroll
        for (int h = 0; h < 2; ++h) { unsigned lo = 0u, hi = 0u;
#pragma unroll
            for (int i = 0; i < 4; ++i) { lo |= ((unsigned)(int)rintf(val[h][j][i] * inv) & 0xffu) << (8 * i); hi |= ((unsigned)(int)rintf(val[h][j][4 + i] * inv) & 0xffu) << (8 * i); }
            *(u32x2*)(Wq + (size_t)(nb * 32 + n) * D + k0 + 64 * h + 8 * c) = (u32x2){lo, hi}; } }
    __syncthreads();
}
template <int NR> __device__ __forceinline__ void q8_rows(unsigned char* ws, const float* ssq, int m0, int lane) {
    const bf16_t* AB = (const bf16_t*)(ws + WS_AB); signed char* A8 = (signed char*)(ws + WS_A8); float* RS = (float*)(ws + WS_RS);
    u32x4 xa[NR], xb[NR]; float sq[NR];
#pragma unroll
    for (int q = 0; q < NR; ++q) { const bf16_t* row = AB + (size_t)(m0 + q) * D; xa[q] = *(const u32x4*)(row + 8 * lane); xb[q] = *(const u32x4*)(row + 512 + 8 * lane); sq[q] = lane < 16 ? ssq[(size_t)(m0 + q) * 16 + lane] : 0.f; }
#pragma unroll
    for (int q = 0; q < NR; ++q) {
        float s = dpp_row_sum(sq[q]); s = __builtin_bit_cast(float, __builtin_amdgcn_readfirstlane(__builtin_bit_cast(int, s)));
        const float rstd = rsqrtf(s * (1.0f / D) + EPS);
        float v[16];
#pragma unroll
        for (int i = 0; i < 4; ++i) { const unsigned a = xa[q][i], b = xb[q][i];
            v[2 * i] = __uint_as_float(a << 16) * rstd; v[2 * i + 1] = __uint_as_float(a & 0xffff0000u) * rstd; v[8 + 2 * i] = __uint_as_float(b << 16) * rstd; v[8 + 2 * i + 1] = __uint_as_float(b & 0xffff0000u) * rstd; }
        float m = 0.f;
#pragma unroll
        for (int i = 0; i < 16; ++i) m = fmaxf(m, fabsf(v[i]));
        m = dpp_max16(m); m = max_rows4(m);
        const float inv = m > 0.f ? 127.0f / m : 0.f;
        unsigned p[4];
#pragma unroll
        for (int i = 0; i < 4; ++i) { unsigned w = 0u;
#pragma unroll
            for (int e = 0; e < 4; ++e) w |= ((unsigned)(int)rintf(v[4 * i + e] * inv) & 0xffu) << (8 * e);
            p[i] = w; }
        signed char* orow = A8 + (size_t)(m0 + q) * D;
        *(u32x2*)(orow + 8 * lane) = (u32x2){p[0], p[1]}; *(u32x2*)(orow + 512 + 8 * lane) = (u32x2){p[2], p[3]};
        if (lane == 0) RS[m0 + q] = m > 0.f ? m * (1.0f / 127.0f) : 1.0f;
    }
}
template <int NR> __device__ __forceinline__ void x_rows(ArgsRef a, int m0, int lane) {
    bf16_t* AB = (bf16_t*)(a.ws + WS_AB); float* ssq0 = (float*)(a.ws + WS_SSQ0);
    f32x4 v[NR][4];
#pragma unroll
    for (int q = 0; q < NR; ++q) { const int m = m0 + q;
        const float* xrow = (m < MP) ? a.in[0] + (size_t)m * D : a.in[1] + (size_t)(m - MP) * D;
        const f32x4* xr = (const f32x4*)xrow + lane;
#pragma unroll
        for (int j = 0; j < 4; ++j) v[q][j] = xr[64 * j]; }
    float t[NR + 1];
#pragma unroll
    for (int q = 0; q < NR; ++q) { float s = 0.f;
#pragma unroll
        for (int j = 0; j < 4; ++j) s += (v[q][j].x * v[q][j].x + v[q][j].y * v[q][j].y) + (v[q][j].z * v[q][j].z + v[q][j].w * v[q][j].w);
        t[q] = s; }
    t[NR] = 0.f;
#pragma unroll
    for (int q = 0; q < NR; q += 2) wave_sum2(t[q], t[q + 1]);
#pragma unroll
    for (int q = 0; q < NR; ++q) { const int m = m0 + q;
        u32x2* o8 = (u32x2*)(AB + (size_t)m * D) + lane;
#pragma unroll
        for (int j = 0; j < 4; ++j) { u32x2 w; w.x = cvt_pk_bf16(v[q][j].x, v[q][j].y); w.y = cvt_pk_bf16(v[q][j].z, v[q][j].w); o8[64 * j] = w; }
        if (lane < 16) ssq0[(size_t)m * 16 + lane] = (lane == 0) ? t[q] : 0.f; }
}

template <int NR> __device__ __forceinline__ void xq8_rows(ArgsRef a, int m0, int lane) {
    signed char* A8 = (signed char*)(a.ws + WS_A8); float* RS = (float*)(a.ws + WS_RS);
    f32x4 v[NR][4];
#pragma unroll
    for (int q = 0; q < NR; ++q) { const int m = m0 + q;
        const float* xrow = (m < MP) ? a.in[0] + (size_t)m * D : a.in[1] + (size_t)(m - MP) * D;
        const f32x4* xr = (const f32x4*)xrow + lane;
#pragma unroll
        for (int j = 0; j < 4; ++j) v[q][j] = xr[64 * j]; }
    float t[NR + 1], mxv[NR + 1];
#pragma unroll
    for (int q = 0; q < NR; ++q) { float s = 0.f, m = 0.f;
#pragma unroll
        for (int j = 0; j < 4; ++j) { s += (v[q][j].x * v[q][j].x + v[q][j].y * v[q][j].y) + (v[q][j].z * v[q][j].z + v[q][j].w * v[q][j].w);
            m = fmaxf(fmaxf(m, fmaxf(fabsf(v[q][j].x), fabsf(v[q][j].y))), fmaxf(fabsf(v[q][j].z), fabsf(v[q][j].w))); }
        t[q] = s; mxv[q] = m; }
    t[NR] = 0.f;
#pragma unroll
    for (int q = 0; q < NR; q += 2) wave_sum2(t[q], t[q + 1]);
#pragma unroll
    for (int q = 0; q < NR; ++q) { const int m = m0 + q;
        float mx = mxv[q]; mx = dpp_max16(mx); mx = max_rows4(mx);
        const float rstd = rsqrtf(t[q] * (1.0f / D) + EPS), inv = mx > 0.f ? 127.0f / mx : 0.f;
        unsigned* o4 = (unsigned*)(A8 + (size_t)m * D) + lane;
#pragma unroll
        for (int j = 0; j < 4; ++j) { const f32x4 x4 = v[q][j];
            o4[64 * j] = ((unsigned)(int)rintf(x4.x * inv) & 0xffu) | (((unsigned)(int)rintf(x4.y * inv) & 0xffu) << 8) | (((unsigned)(int)rintf(x4.z * inv) & 0xffu) << 16) | (((unsigned)(int)rintf(x4.w * inv) & 0xffu) << 24); }
        if (lane == 0) RS[m] = mx > 0.f ? mx * rstd * (1.0f / 127.0f) : 1.0f; }
}

__device__ __forceinline__ void p0_prologue(ArgsRef a, LAS unsigned char* lds, int wave_) {
    const int tid = wave_ * 64 + lane_now();
    const int lane = tid & 63, wave = tid >> 6;
    const int gw = blockIdx.x * 8 + wave, NGW = gridDim.x * 8;
    unsigned char* ws = a.ws;
    for (int nb = blockIdx.x; nb < NUP / 32; nb += gridDim.x) w8_strip(a.in[6], a.in[5], (signed char*)(ws + WS_W1Q), (float*)(ws + WS_CS1), nb, lds, wave, lane);
    { const int nsw = (NUP / 32) * 8, gwr = gw >= nsw ? gw - nsw : gw + NGW - nsw;
      weights_convert(a, lds, I_UP, NITEMS_EARLY, NGW > nsw ? gwr : gw, NGW, wave, lane); }
    for (int m0 = gw * 8; m0 < MP; m0 += NGW * 8) xq8_rows<8>(a, m0, lane);
    for (int m = MP + gw; m < M; m += NGW) xq8_rows<1>(a, m, lane);
    const int gt = blockIdx.x * 512 + tid, NGT = gridDim.x * 512;
    f32x2* rope = (f32x2*)(ws + WS_ROPE);
    for (int i = gt; i < TP * 8; i += NGT) {
        const int pos = i >> 3, k = i & 7;
        const float ang = (float)pos * a.inv[k];
        const double rev = (double)ang * 0.15915494309189535;
        const float fr = (float)(rev - rint(rev));
        rope[i] = (f32x2){__builtin_amdgcn_cosf(fr), __builtin_amdgcn_sinf(fr)};
    }
    bf16_t* KS = (bf16_t*)(ws + WS_KS); bf16_t* VTS = (bf16_t*)(ws + WS_VTS); bf16_t* US = (bf16_t*)(ws + WS_US);
    for (int i = gt; i < NBS * WIN * 128; i += NGT) {
        const int c = i & 127, row = (i >> 7) & (WIN - 1), b = i >> 14;
        const float kv = a.in[3][i], vv = a.in[4][i];
        KS[((size_t)(b * KSROWS + row)) * 128 + c] = f2bf(kv);
        VTS[((size_t)(b * 128 + c)) * KSROWS + row] = f2bf(vv);
        if (row >= TS) { a.out[O_KWS + ((size_t)(b * WIN + row - TS)) * 128 + c] = kv; a.out[O_VWS + ((size_t)(b * WIN + row - TS)) * 128 + c] = vv; }
    }
    for (int i = gt; i < NBS * 128 * 16; i += NGT) { const int k = i & 15, rowd = i >> 4; VTS[(size_t)rowd * KSROWS + WIN + TS + k] = 0; }
    for (int i = gt; i < NBS * HIST * CC; i += NGT) {
        const int c = i & (CC - 1), row = (i >> 9) % HIST, b = (i >> 9) / HIST;
        const float uv = a.in[2][i];
        US[((size_t)(b * USROWS + row)) * CC + c] = f2bf(uv);
        if (row >= TS) a.out[O_CSS + ((size_t)(b * HIST + row - TS)) * CC + c] = uv;
    }
}

constexpr int ATT_VT_OFF = 192 * 128, ATT_VT_STRIDE = 400, ATT_BUF = ATT_VT_OFF + 64 * ATT_VT_STRIDE;
constexpr int ATT_UNITS_P = NBP * (TP / 64) * 2, ATT_UNITS = ATT_UNITS_P + NBS * 2;
constexpr int CONV_UNITS = MP / 16 + NBS;

struct AttUnit { const bf16_t* kb; const bf16_t* vt; int nkt; bool sample; };
__device__ __forceinline__ AttUnit att_decode(unsigned char* ws, int unit) {
    AttUnit u;
    if (unit < ATT_UNITS_P) { const int kh = unit & 1, c = (unit >> 1) & 127, b = unit >> 8, cs = c >= 2 ? c - 2 : 0;
        u.nkt = (c - cs + 1) * 4; u.sample = false;
        u.kb = (const bf16_t*)(ws + WS_KP) + ((size_t)(b * TP + cs * 64)) * 128 + kh * 64;
        u.vt = (const bf16_t*)(ws + WS_VTP) + ((size_t)((b * 2 + kh) * (TP / 64) + cs)) * 4096; }
    else { const int p = unit - ATT_UNITS_P, b = p >> 1, kh = p & 1;
        u.nkt = 9; u.sample = true;
        u.kb = (const bf16_t*)(ws + WS_KS) + ((size_t)(b * KSROWS)) * 128 + kh * 64;
        u.vt = (const bf16_t*)(ws + WS_VTS) + ((size_t)((b * 2 + kh) * 64)) * KSROWS; }
    return u;
}
__device__ __forceinline__ void att_stage_load(const AttUnit& u, int tid, u32x4 (&kp)[3], u32x4 (&vp)[3]) {
    const int nk = u.nkt * 16;
#pragma unroll
    for (int i = 0; i < 3; ++i) {
        const int p = tid + 512 * i; int row = p >> 3; const int ch = p & 7; row = row < nk ? row : nk - 1;
        kp[i] = *(const u32x4*)(u.kb + (size_t)row * 128 + ch * 8);
        if (u.sample) { int pp = p < 1280 ? p : 1279; const int d = pp / 20, q = pp - d * 20; vp[i] = *(const u32x4*)(u.vt + (size_t)d * KSROWS + q * 8); }
        else { const int jmax = (u.nkt >> 2) - 1, j = i < jmax ? i : jmax; vp[i] = *(const u32x4*)(u.vt + (size_t)j * 4096 + (p & 511) * 8); }
    }
}
__device__ __forceinline__ void att_stage_write(const AttUnit& u, int tid, LAS unsigned char* buf, const u32x4 (&kp)[3], const u32x4 (&vp)[3]) {
    const int nk = u.nkt * 16;
#pragma unroll
    for (int i = 0; i < 3; ++i) {
        const int p = tid + 512 * i; int row = p >> 3; const int ch = p & 7; row = row < nk ? row : nk - 1;
        *(LAS u32x4*)(buf + row * 128 + ((ch ^ ((row >> 1) & 7)) << 4)) = kp[i];
        if (u.sample) { int pp = p < 1280 ? p : 1279; const int d = pp / 20, q = pp - d * 20; *(LAS u32x4*)(buf + ATT_VT_OFF + d * ATT_VT_STRIDE + q * 16) = vp[i]; }
        else { const int jmax = (u.nkt >> 2) - 1, j = i < jmax ? i : jmax; const int d = (p & 511) >> 3, q = p & 7; *(LAS u32x4*)(buf + ATT_VT_OFF + d * ATT_VT_STRIDE + j * 128 + q * 16) = vp[i]; }
    }
}
__device__ __forceinline__ void attn_compute(const bf16x8 (&qf)[2][2], LAS const unsigned char* buf, int nkt, float sink0, float sink1, bf16_t* o0, bf16_t* o1, int lane) {
    const int fr = lane & 15, g = lane >> 4;
    f32x4 S[2][12];
    const float NEG = -INFINITY;
#pragma unroll
    for (int kt = 0; kt < 12; ++kt) {
        const int ktc = kt < nkt ? kt : nkt - 1, row = ktc * 16 + fr, sw = (row >> 1) & 7;
        const bf16x8 k0 = *(LAS const bf16x8*)(buf + row * 128 + ((g ^ sw) << 4)), k1 = *(LAS const bf16x8*)(buf + row * 128 + (((g + 4) ^ sw) << 4));
        const bool ok = kt < nkt;
#pragma unroll
        for (int qt = 0; qt < 2; ++qt) {
            f32x4 c = (f32x4){0.f, 0.f, 0.f, 0.f};
            c = __builtin_amdgcn_mfma_f32_16x16x32_bf16(k0, qf[qt][0], c, 0, 0, 0);
            c = __builtin_amdgcn_mfma_f32_16x16x32_bf16(k1, qf[qt][1], c, 0, 0, 0);
            S[qt][kt] = ok ? c : (f32x4){NEG, NEG, NEG, NEG};
        }
    }
    bf16x8 pf[2][6]; float linv[2];
#pragma unroll
    for (int qt = 0; qt < 2; ++qt) {
        const float sink = qt ? sink1 : sink0;
        float mx = sink;
#pragma unroll
        for (int kt = 0; kt < 12; ++kt) mx = fmaxf(mx, fmaxf(fmaxf(S[qt][kt][0], S[qt][kt][1]), fmaxf(S[qt][kt][2], S[qt][kt][3])));
        mx = max_rows4(mx);
        float l = 0.f;
#pragma unroll
        for (int kt = 0; kt < 12; ++kt) {
#pragma unroll
            for (int j = 0; j < 4; ++j) { const float p = __builtin_amdgcn_exp2f(S[qt][kt][j] - mx); S[qt][kt][j] = p; l += p; }
        }
        l = sum_rows4(l);
        l += __builtin_amdgcn_exp2f(sink - mx);
        linv[qt] = 1.0f / l;
#pragma unroll
        for (int kk = 0; kk < 6; ++kk) {
            u32x4 w; w.x = cvt_pk_bf16(S[qt][2 * kk][0], S[qt][2 * kk][1]); w.y = cvt_pk_bf16(S[qt][2 * kk][2], S[qt][2 * kk][3]);
            w.z = cvt_pk_bf16(S[qt][2 * kk + 1][0], S[qt][2 * kk + 1][1]); w.w = cvt_pk_bf16(S[qt][2 * kk + 1][2], S[qt][2 * kk + 1][3]);
            pf[qt][kk] = __builtin_bit_cast(bf16x8, w);
        }
    }
    f32x4 O[2][4];
    const int kkmax = (nkt - 1) >> 1;
    LAS const unsigned char* vb = buf + ATT_VT_OFF + fr * ATT_VT_STRIDE + g * 8;
#pragma unroll
    for (int dt = 0; dt < 4; ++dt) {
        O[0][dt] = (f32x4){0.f, 0.f, 0.f, 0.f}; O[1][dt] = (f32x4){0.f, 0.f, 0.f, 0.f};
#pragma unroll
        for (int kk = 0; kk < 6; ++kk) {
            const int kkc = kk < kkmax ? kk : kkmax;
            const u32x2 a0 = *(LAS const u32x2*)(vb + dt * 16 * ATT_VT_STRIDE + kkc * 64), a1 = *(LAS const u32x2*)(vb + dt * 16 * ATT_VT_STRIDE + kkc * 64 + 32);
            u32x4 aw; aw.x = a0.x; aw.y = a0.y; aw.z = a1.x; aw.w = a1.y;
            const bf16x8 af = __builtin_bit_cast(bf16x8, aw);
            O[0][dt] = __builtin_amdgcn_mfma_f32_16x16x32_bf16(af, pf[0][kk], O[0][dt], 0, 0, 0);
            O[1][dt] = __builtin_amdgcn_mfma_f32_16x16x32_bf16(af, pf[1][kk], O[1][dt], 0, 0, 0);
        }
    }
#pragma unroll
    for (int qt = 0; qt < 2; ++qt) {
        bf16_t* ob = (qt ? o1 : o0) + (size_t)fr * D + 4 * g;
#pragma unroll
        for (int dt = 0; dt < 4; ++dt) {
            const f32x4 v = O[qt][dt] * linv[qt];
            u32x2 w; w.x = cvt_pk_bf16(v[0], v[1]); w.y = cvt_pk_bf16(v[2], v[3]);
            *(u32x2*)(ob + dt * 16) = w;
        }
    }
}

__device__ __forceinline__ void attn_phase(ArgsRef a, LAS unsigned char* lds, int tid, int first, int G) {
    asm volatile("" : "+v"(tid));
    unsigned char* ws = a.ws;
    const int lane = tid & 63, wave = __builtin_amdgcn_readfirstlane(tid >> 6), fr = lane & 15, g = lane >> 4;
    const bf16_t* Q = (const bf16_t*)(ws + WS_Q); bf16_t* MIX = (bf16_t*)(ws + WS_MIX);
    const float* sinks = a.in[12];
    if (first >= ATT_UNITS) return;
    AttUnit cur = att_decode(ws, first);
    u32x4 kp[3], vp[3];
    att_stage_load(cur, tid, kp, vp);
    int par = 0;
    for (int unit = first; unit < ATT_UNITS; unit += G, par ^= 1) {
        LAS unsigned char* buf = lds + par * ATT_BUF;
        att_stage_write(cur, tid, buf, kp, vp);
        const bf16_t* q0; const bf16_t* q1; bf16_t* o0; bf16_t* o1; float sk0, sk1; bool work;
        if (!cur.sample) { const int kh = unit & 1, c = (unit >> 1) & 127, b = unit >> 8, h = kh * 4 + (wave >> 1), tok0 = c * 64 + (wave & 1) * 32;
            q0 = Q + ((size_t)(b * TP + tok0)) * 512 + h * 64; q1 = q0 + 16 * 512;
            o0 = MIX + ((size_t)(b * TP + tok0)) * D + 512 + h * 64; o1 = o0 + 16 * D; sk0 = sk1 = sinks[h] * LOG2E; work = true; }
        else { const int p = unit - ATT_UNITS_P, b = p >> 1, kh = p & 1, h0 = kh * 4 + (wave & 1) * 2;
            q0 = Q + ((size_t)(MP + b * TS)) * 512 + h0 * 64; q1 = q0 + 64;
            o0 = MIX + ((size_t)(MP + b * TS)) * D + 512 + h0 * 64; o1 = o0 + 64; sk0 = sinks[h0] * LOG2E; sk1 = sinks[h0 + 1] * LOG2E; work = wave < 2; }
        bf16x8 qf[2][2];
        qf[0][0] = *(const bf16x8*)(q0 + fr * 512 + g * 8); qf[0][1] = *(const bf16x8*)(q0 + fr * 512 + 32 + g * 8);
        qf[1][0] = *(const bf16x8*)(q1 + fr * 512 + g * 8); qf[1][1] = *(const bf16x8*)(q1 + fr * 512 + 32 + g * 8);
        const int nkt = cur.nkt;
        __syncthreads();
        const int nu = unit + G < ATT_UNITS ? unit + G : unit;
        cur = att_decode(ws, nu);
        att_stage_load(cur, tid, kp, vp);
        if (work) attn_compute(qf, buf, nkt, sk0, sk1, o0, o1, lane);
    }
    __syncthreads();
}

struct ConvUnit { const bf16_t* ub; int jmin; size_t orow; };
__device__ __forceinline__ ConvUnit conv_decode(unsigned char* ws, int cu, int ch) {
    ConvUnit u;
    if (cu < MP / 16) { const int b = cu >> 9, t0 = (cu & 511) * 16; u.ub = (const bf16_t*)(ws + WS_UP) + ((size_t)(b * TP) + t0 - HIST) * CC + ch; u.jmin = HIST - t0; u.orow = (size_t)b * TP + t0; }
    else { const int b = cu - MP / 16; u.ub = (const bf16_t*)(ws + WS_US) + ((size_t)(b * USROWS)) * CC + ch; u.jmin = 0; u.orow = (size_t)MP + b * TS; }
    return u;
}
__device__ __forceinline__ void conv_phase(ArgsRef a, LAS unsigned char* lds, int tid, int first, int G) {
    asm volatile("" : "+v"(tid));
    unsigned char* ws = a.ws;
    const int ch = tid, wave = tid >> 6, lane = tid & 63;
    if (first >= CONV_UNITS) return;
    const float* wdw = a.in[13] + ch;
    float w[CW];
#pragma unroll
    for (int j = 0; j < CW; ++j) w[j] = wdw[j * CC];
    const float bias = a.in[14][ch];
    const f32x4 gc0 = *(const f32x4*)(a.in[15] + 4 * lane), gc1 = *(const f32x4*)(a.in[15] + 256 + 4 * lane);
    const f32x4 bc0 = *(const f32x4*)(a.in[16] + 4 * lane), bc1 = *(const f32x4*)(a.in[16] + 256 + 4 * lane);
    ConvUnit cur = conv_decode(ws, first, ch);
    bf16_t xr[HIST + 16];
#pragma unroll
    for (int j = 0; j < HIST + 16; ++j) { const int jc = j > cur.jmin ? j : cur.jmin; xr[j] = cur.ub[(size_t)jc * CC]; }
    int par = 0;
    for (int cu = first; cu < CONV_UNITS; cu += G, par ^= 1) {
        const int jmin = cur.jmin; const size_t orow = cur.orow;
        float acc[16];
#pragma unroll
        for (int i = 0; i < 16; ++i) acc[i] = bias;
#pragma unroll
        for (int j = 0; j < HIST + 16; ++j) {
            const float xv = (j >= jmin) ? bf2f(xr[j]) : 0.f;
#pragma unroll
            for (int i = 0; i < 16; ++i) { if (j - i >= 0 && j - i < CW) acc[i] += xv * w[j - i]; }
        }
        __builtin_amdgcn_sched_barrier(0);
        { const int nu = cu + G < CONV_UNITS ? cu + G : cu;
          cur = conv_decode(ws, nu, ch);
#pragma unroll
          for (int j = 0; j < HIST + 16; ++j) { const int jc = j > cur.jmin ? j : cur.jmin; xr[j] = cur.ub[(size_t)jc * CC]; } }
        __builtin_amdgcn_sched_barrier(0);
        LAS float* yb = (LAS float*)lds + par * (16 * CC);
#pragma unroll
        for (int i = 0; i < 16; ++i) yb[i * CC + ch] = acc[i];
        __syncthreads();
        bf16_t* MIX = (bf16_t*)(ws + WS_MIX) + orow * D;
        {
            const int tok = 2 * wave;
            f32x4 v0 = *(const LAS f32x4*)(yb + tok * CC + 4 * lane), v1 = *(const LAS f32x4*)(yb + tok * CC + 256 + 4 * lane);
            f32x4 z0 = *(const LAS f32x4*)(yb + (tok + 1) * CC + 4 * lane), z1 = *(const LAS f32x4*)(yb + (tok + 1) * CC + 256 + 4 * lane);
            float sa = (v0[0] + v0[1]) + (v0[2] + v0[3]) + (v1[0] + v1[1]) + (v1[2] + v1[3]);
            float sb = (z0[0] + z0[1]) + (z0[2] + z0[3]) + (z1[0] + z1[1]) + (z1[2] + z1[3]);
            wave_sum2(sa, sb);
            const float ma = sa * (1.0f / CC), mb = sb * (1.0f / CC);
            v0 = v0 - ma; v1 = v1 - ma; z0 = z0 - mb; z1 = z1 - mb;
            float qa = (v0[0] * v0[0] + v0[1] * v0[1]) + (v0[2] * v0[2] + v0[3] * v0[3]) + (v1[0] * v1[0] + v1[1] * v1[1]) + (v1[2] * v1[2] + v1[3] * v1[3]);
            float qb = (z0[0] * z0[0] + z0[1] * z0[1]) + (z0[2] * z0[2] + z0[3] * z0[3]) + (z1[0] * z1[0] + z1[1] * z1[1]) + (z1[2] * z1[2] + z1[3] * z1[3]);
            wave_sum2(qa, qb);
            const float ra = rsqrtf(qa * (1.0f / CC) + EPS), rb = rsqrtf(qb * (1.0f / CC) + EPS);
            v0 = v0 * ra * gc0 + bc0; v1 = v1 * ra * gc1 + bc1; z0 = z0 * rb * gc0 + bc0; z1 = z1 * rb * gc1 + bc1;
            u32x2 o0, o1, p0, p1;
            o0.x = cvt_pk_bf16(silu_f(v0[0]), silu_f(v0[1])); o0.y = cvt_pk_bf16(silu_f(v0[2]), silu_f(v0[3]));
            o1.x = cvt_pk_bf16(silu_f(v1[0]), silu_f(v1[1])); o1.y = cvt_pk_bf16(silu_f(v1[2]), silu_f(v1[3]));
            p0.x = cvt_pk_bf16(silu_f(z0[0]), silu_f(z0[1])); p0.y = cvt_pk_bf16(silu_f(z0[2]), silu_f(z0[3]));
            p1.x = cvt_pk_bf16(silu_f(z1[0]), silu_f(z1[1])); p1.y = cvt_pk_bf16(silu_f(z1[2]), silu_f(z1[3]));
            *(u32x2*)(MIX + (size_t)tok * D + 4 * lane) = o0; *(u32x2*)(MIX + (size_t)tok * D + 256 + 4 * lane) = o1;
            *(u32x2*)(MIX + (size_t)(tok + 1) * D + 4 * lane) = p0; *(u32x2*)(MIX + (size_t)(tok + 1) * D + 256 + 4 * lane) = p1;
        }
    }
    __syncthreads();
}

#define XB_TMO      128
#define XB_XCNT(j)  (256  + 64 * (j))
#define XB_XSUB(j)  (1280 + 64 * (j))
#define XB_XGEN(j)  (2304 + 64 * (j))
#define XB_TOP      3328
#define XB_TOPGEN   3392
#define XCD_BAR_WORDS 3456
#define XB_SPIN_CAP (1u << 18)
__device__ __forceinline__ unsigned xb_ld(unsigned* p)              { return __hip_atomic_load(p, __ATOMIC_RELAXED, __HIP_MEMORY_SCOPE_AGENT); }
__device__ __forceinline__ unsigned xb_add(unsigned* p, unsigned v) { return __hip_atomic_fetch_add(p, v, __ATOMIC_RELAXED, __HIP_MEMORY_SCOPE_AGENT); }
__device__ __forceinline__ unsigned xb_xcc_id() { return (unsigned)__builtin_amdgcn_s_getreg((3 << 11) | 20) & 0xFu; }
#define XB_SPIN(cond, bar) do { unsigned _sp = 0; while (cond) { __builtin_amdgcn_s_sleep(1); \
    if ((++_sp & 255u) == 0u) { if (xb_ld(&(bar)[XB_TMO])) break; if (_sp > XB_SPIN_CAP) { atomicAdd(&(bar)[XB_TMO], 1u); break; } } } } while (0)
struct XcdBarrier { unsigned* bar; unsigned x; volatile LAS unsigned* st; };
__device__ __forceinline__ XcdBarrier xcd_barrier_post(unsigned* bar, volatile LAS unsigned* st, int wave_) {
    XcdBarrier b; b.bar = bar; b.x = (unsigned)__builtin_amdgcn_readfirstlane((int)xb_xcc_id()); b.st = st;
    if (wave_ == 0 && lane_now() == 0) (void)xb_add(&bar[XB_XCNT(b.x)], 1u);
    return b;
}
__device__ __forceinline__ void xcd_barrier_complete(unsigned* bar, unsigned x, unsigned& nloc, unsigned& nx) {
    const unsigned G = gridDim.x * gridDim.y * gridDim.z;
    unsigned sum, cnt, mine, sp = 0u;
    for (;;) {
        sum = 0u; cnt = 0u; mine = 0u;
#pragma unroll
        for (unsigned j = 0; j < 16; ++j) { const unsigned c = xb_ld(&bar[XB_XCNT(j)]); sum += c; cnt += (c > 0u) ? 1u : 0u; mine = (j == x) ? c : mine; }
        if (sum == G) break;
        __builtin_amdgcn_s_sleep(1);
        if ((++sp & 255u) == 0u) { if (xb_ld(&bar[XB_TMO])) break; if (sp > XB_SPIN_CAP) { atomicAdd(&bar[XB_TMO], 1u); break; } }
    }
    nloc = mine > 0u ? mine : 1u; nx = cnt > 0u ? cnt : 1u;
}
__device__ __forceinline__ void xcd_barrier(const XcdBarrier& b, int wave_) {
    asm volatile("s_waitcnt vmcnt(0)" ::: "memory");
    __syncthreads();
    if (wave_ == 0 && lane_now() == 0) {
        unsigned* bar = b.bar; unsigned bx = b.x; asm volatile("" : "+s"(bx));
        __builtin_amdgcn_s_waitcnt(0);
        unsigned nloc = b.st[0], nx = b.st[1];
        if (nloc == 0u) { xcd_barrier_complete(bar, bx, nloc, nx); b.st[0] = nloc; b.st[1] = nx; }
        const unsigned old = xb_add(&bar[XB_XSUB(bx)], 1u);
        const unsigned gen = old / nloc;
        if (old + 1u == (gen + 1u) * nloc) {
            __builtin_amdgcn_fence(__ATOMIC_RELEASE, "agent");
            asm volatile("s_waitcnt vmcnt(0)" ::: "memory");
            const unsigned og = xb_add(&bar[XB_TOP], 1u);
            const unsigned tg = og / nx;
            if (og + 1u == (tg + 1u) * nx) xb_add(&bar[XB_TOPGEN], 1u);
            else XB_SPIN(xb_ld(&bar[XB_TOPGEN]) == tg, bar);
            __builtin_amdgcn_fence(__ATOMIC_ACQUIRE, "agent");
            xb_add(&bar[XB_XGEN(bx)], 1u);
            asm volatile("s_waitcnt vmcnt(0)" ::: "memory");
        } else {
            XB_SPIN(xb_ld(&bar[XB_XGEN(bx)]) == gen, bar);
            __builtin_amdgcn_fence(__ATOMIC_ACQUIRE, "agent");
            asm volatile("s_waitcnt vmcnt(0)" ::: "memory");
        }
    }
    __syncthreads();
}
constexpr int MISC_OFF = 151552;
constexpr size_t CTL_ZERO_BYTES = 65536;
constexpr int CW_BAR = 4096;

__global__ void __launch_bounds__(512, 2) hymba_fwd(Args a_) {
    extern __shared__ __attribute__((aligned(16))) unsigned char lds_raw[];
    LAS unsigned char* lds = (LAS unsigned char*)lds_raw;
    unsigned char* ws = a_.ws;
    const int wave = __builtin_amdgcn_readfirstlane((int)threadIdx.x >> 6);
#define lane lane_now()
#define tid (wave * 64 + lane_now())
    const int G = gridDim.x, bid = blockIdx.x;
    for (int u = wave * 64 + lane_now(); u < (LDS_BYTES - MISC_OFF) / 4; u += 512) ((LAS unsigned*)(lds + MISC_OFF))[u] = 0u;
    __syncthreads();
    const XcdBarrier bar = xcd_barrier_post((unsigned*)ws + CW_BAR, (volatile LAS unsigned*)(lds + MISC_OFF) + 8, wave);
#define GRID_BAR() xcd_barrier(bar, wave)

    bf16_t* AB = (bf16_t*)(ws + WS_AB); bf16_t* ACT = (bf16_t*)(ws + WS_ACT);
    float* ssq0 = (float*)(ws + WS_SSQ0); float* ssq1 = (float*)(ws + WS_SSQ1); float* ssq2 = (float*)(ws + WS_SSQ2);

#ifndef PROBE_DUP
#define PROBE_DUP -1
#endif
#ifndef PHASE_MASK
#define PHASE_MASK 0xff
#endif
#define REPS(k) if (PHASE_MASK & (1 << (k))) for (int rep_ = 0; rep_ < ((PROBE_DUP == (k)) ? 2 : 1); ++rep_)
#define ARGS_HERE() ArgsRef a = *args_now()
    REPS(0) { ARGS_HERE(); p0_prologue(a, lds, wave); GRID_BAR(); }
    REPS(1) {
    { int bs_ = bid, gs_ = G; asm volatile("" : "+s"(bs_), "+s"(gs_));
      pg8::Gemm g{(const bf16_t*)(ws + WS_A8), (const bf16_t*)(ws + WS_W1Q), MP, NUP, D / 2}; pg8::StaticOrder S; S.init(MP, NUP, gs_, bs_, 16);
      EpiSwigluI8 E{ACT, (const float*)(ws + WS_RS), (const float*)(ws + WS_CS1), lds};
      for (int pass = 0; pass < 2; ++pass) { if (((pass ^ (bs_ >> 6)) & 1) == 0) { pg8::gemm_phase<EpiSwigluI8, pg8::StaticOrder, true, true, true>(lds, g, S, E, wave); } else { small_gemm<1, 4, true>((const bf16_t*)(ws + WS_A8), (const bf16_t*)(ws + WS_W1Q), NUP, D / 2, E, lds, bs_, gs_, wave, lane); } } }
    GRID_BAR(); }
    REPS(2) {
    { int bs_ = bid, gs_ = G; asm volatile("" : "+s"(bs_), "+s"(gs_));
      pg8::Gemm g{ACT, (const bf16_t*)(ws + WS_W2T), MP, D, FF}; pg8::StaticOrder S; S.init(MP, D, gs_, bs_);
      ARGS_HERE(); EpiResid<0> E{a.in[0], a.in[1], nullptr, AB, ssq1, 0.5f};
      for (int pass = 0; pass < 2; ++pass) { if (((pass ^ (bs_ >> 6)) & 1) == 0) { pg8::gemm_phase<EpiResid<0>, pg8::StaticOrder, true, true>(lds, g, S, E, wave); } else { small_gemm<8, 2, false>(ACT, (const bf16_t*)(ws + WS_W2T), D, FF, E, lds, bs_, gs_, wave, lane); } } }
    GRID_BAR(); }
    REPS(3) {
    { int bs_ = bid, gs_ = G; asm volatile("" : "+s"(bs_), "+s"(gs_));
      pg8::Gemm g{AB, (const bf16_t*)(ws + WS_WINT), MP, NIN, D}; pg8::StaticOrder S; S.init(MP, NIN, gs_, bs_);
      ARGS_HERE(); EpiInProj E{ws, a.in[10], a.in[11], a.out, lds};
      pg8::gemm_phase<EpiInProj, pg8::StaticOrder, true, true>(lds, g, S, E, wave);
      const bool side = (rep_ == 0) && (bid >= G / 2);
      if (side) { int ln = lane; asm volatile("" : "+v"(ln));
        for (int nb = bid - G / 2; nb < NUP / 32; nb += G - G / 2) w8_strip(a.in[19], a.in[18], (signed char*)(ws + WS_W3Q), (float*)(ws + WS_CS3), nb, lds, wave, ln); }
      small_gemm<1, 4, false>(AB, (const bf16_t*)(ws + WS_WINT), NIN, D, E, lds, gs_ - 1 - bs_, gs_, wave, lane, 2);
      if (side) { int ln = lane; asm volatile("" : "+v"(ln));
        const int idx = bid - G / 2, nsm = G - 112 - G / 2;
        const int nconv = nsm * 8 + (G - G / 2 - nsm) * 6;
        const int rank = idx < nsm ? idx * 8 + wave : (wave >= 2 ? nsm * 8 + (idx - nsm) * 6 + (wave - 2) : (1 << 28));
        weights_convert(a, lds, NITEMS_EARLY + I_UP, NITEMS, rank, nconv, wave, ln); } }
    GRID_BAR(); }
    REPS(4) {
#ifndef PROBE_P4SUB
#define PROBE_P4SUB 0
#endif
    ARGS_HERE();
    if (!(rep_ == 1 && PROBE_P4SUB == 1)) conv_phase(a, lds, tid, G - 1 - bid, G);
    if (!(rep_ == 1 && PROBE_P4SUB == 2)) attn_phase(a, lds, tid, bid, G);
    GRID_BAR(); }
    REPS(5) {
    { int bs_ = bid, gs_ = G; asm volatile("" : "+s"(bs_), "+s"(gs_));
      pg8::Gemm g{(const bf16_t*)(ws + WS_MIX), (const bf16_t*)(ws + WS_WOT), MP, D, D}; pg8::StaticOrder S; S.init(MP, D, gs_, bs_);
      EpiResid<1> E{nullptr, nullptr, nullptr, AB, ssq2, 1.0f};
      for (int pass = 0; pass < 2; ++pass) { if (((pass ^ (bs_ >> 6)) & 1) == 0) { pg8::gemm_phase<EpiResid<1>, pg8::StaticOrder, true, true>(lds, g, S, E, wave); } else { small_gemm<8, 2, false>((const bf16_t*)(ws + WS_MIX), (const bf16_t*)(ws + WS_WOT), D, D, E, lds, bs_, gs_, wave, lane); } } }
    GRID_BAR(); }
    { const int gw = bid * 8 + wave, NGW = G * 8; int ln = lane; asm volatile("" : "+v"(ln));
      for (int m0 = gw * 4; m0 < M; m0 += NGW * 4) q8_rows<4>(ws, ssq2, m0, ln);
      GRID_BAR(); }
    REPS(6) {
    { int bs_ = bid, gs_ = G; asm volatile("" : "+s"(bs_), "+s"(gs_));
      pg8::Gemm g{(const bf16_t*)(ws + WS_A8), (const bf16_t*)(ws + WS_W3Q), MP, NUP, D / 2}; pg8::StaticOrder S; S.init(MP, NUP, gs_, bs_, 16);
      EpiSwigluI8 E{ACT, (const float*)(ws + WS_RS), (const float*)(ws + WS_CS3), lds};
      for (int pass = 0; pass < 2; ++pass) { if (((pass ^ (bs_ >> 6)) & 1) == 0) { pg8::gemm_phase<EpiSwigluI8, pg8::StaticOrder, true, true, true>(lds, g, S, E, wave); } else { small_gemm<1, 4, true>((const bf16_t*)(ws + WS_A8), (const bf16_t*)(ws + WS_W3Q), NUP, D / 2, E, lds, bs_, gs_, wave, lane); } } }
    GRID_BAR(); }
    REPS(7) { int bs_ = bid, gs_ = G; asm volatile("" : "+s"(bs_), "+s"(gs_));
      pg8::Gemm g{ACT, (const bf16_t*)(ws + WS_W4T), MP, D, FF}; pg8::StaticOrder S; S.init(MP, D, gs_, bs_);
      ARGS_HERE(); EpiResid<2> E{nullptr, nullptr, a.out, AB, nullptr, 0.5f};
      for (int pass = 0; pass < 2; ++pass) { if (((pass ^ (bs_ >> 6)) & 1) == 0) { pg8::gemm_phase<EpiResid<2>, pg8::StaticOrder, true, true>(lds, g, S, E, wave); } else { small_gemm<8, 2, false>(ACT, (const bf16_t*)(ws + WS_W4T), D, FF, E, lds, bs_, gs_, wave, lane); } } }
}
#undef lane
#undef tid

extern "C" void kernel_launch(void* const* d_in, const int* in_sizes, int n_in, void* d_out, int out_size, void* d_ws, size_t ws_size, hipStream_t stream) {
    static int grid = 0;
    if (grid == 0) {
        if (n_in != 21 || (size_t)out_size != O_END || ws_size < WS_END) { fprintf(stderr, "kernel_launch: unexpected shapes: n_in %d out %d ws %zu (need %zu)\n", n_in, out_size, ws_size, (size_t)WS_END); grid = -1; return; }
        int dev = 0, cus = 0, per_cu = 0;
        (void)hipGetDevice(&dev);
        (void)hipDeviceGetAttribute(&cus, hipDeviceAttributeMultiprocessorCount, dev);
        if (cus != 256) fprintf(stderr, "kernel_launch: note: built for a 256-CU device (one workgroup per CU), this device reports %d\n", cus);
        if (hipFuncSetAttribute((const void*)hymba_fwd, hipFuncAttributeMaxDynamicSharedMemorySize, LDS_BYTES) != hipSuccess) { fprintf(stderr, "kernel_launch: hipFuncSetAttribute failed\n"); grid = -1; return; }
        if (hipOccupancyMaxActiveBlocksPerMultiprocessor(&per_cu, (const void*)hymba_fwd, 512, LDS_BYTES) != hipSuccess || per_cu < 1) { fprintf(stderr, "kernel_launch: occupancy query failed (%d)\n", per_cu); grid = -1; (void)hipGetLastError(); return; }
        grid = cus;
    }
    if (grid < 0) return;
    Args a{};
    for (int i = 0; i < 21; ++i) a.in[i] = (const float*)d_in[i];
    a.out = (float*)d_out; a.ws = (unsigned char*)d_ws;
    for (int i = 0; i < 8; ++i) a.inv[i] = powf(500000.0f, -(float)i / 8.0f);
    if (hipMemsetAsync(d_ws, 0, CTL_ZERO_BYTES, stream) != hipSuccess) { fprintf(stderr, "kernel_launch: memset failed\n"); return; }
    hipLaunchKernelGGL(hymba_fwd, dim3(grid), dim3(512), LDS_BYTES, stream, a);
    const hipError_t e = hipPeekAtLastError();
    if (e != hipSuccess) fprintf(stderr, "kernel_launch: launch failed: %s (grid %d)\n", hipGetErrorString(e), grid);
}
```

```cpp
#include <hip/hip_runtime.h>
#include <cstdio>
#include <cstdint>
#include <cmath>

#define LAS __attribute__((address_space(3)))
typedef unsigned short bf16_t;
typedef short bf16x8 __attribute__((ext_vector_type(8)));
typedef float f32x4 __attribute__((ext_vector_type(4)));
typedef float f32x2 __attribute__((ext_vector_type(2)));
typedef unsigned u32x4 __attribute__((ext_vector_type(4)));
typedef unsigned u32x2 __attribute__((ext_vector_type(2)));
typedef int i32x4 __attribute__((ext_vector_type(4)));

constexpr int D = 1024, TP = 8192, NBP = 4, NBS = 32, TS = 16, MP = NBP * TP, MS = NBS * TS, M = MP + MS;
constexpr int FF = 2816, NUP = 2 * FF, NIN = 1792, CC = 512, HD = 64, PAST = 4096;
constexpr int CW = 31, HIST = CW - 1, WIN = 128;
constexpr int KSROWS = 160;
constexpr int USROWS = HIST + TS;
constexpr float EPS = 1e-6f;
constexpr float LOG2E = 1.4426950408889634f;
constexpr float QSCALE = 0.125f * LOG2E;

constexpr size_t O_YP = 0, O_YS = (size_t)MP * D, O_CSP = O_YS + (size_t)MS * D, O_KWP = O_CSP + (size_t)NBP * HIST * CC,
                 O_VWP = O_KWP + (size_t)NBP * WIN * 128, O_CSS = O_VWP + (size_t)NBP * WIN * 128, O_KWS = O_CSS + (size_t)NBS * HIST * CC,
                 O_VWS = O_KWS + (size_t)NBS * WIN * 128, O_END = O_VWS + (size_t)NBS * WIN * 128;

constexpr size_t al(size_t x) { return (x + 4095) & ~(size_t)4095; }
constexpr size_t WS_CTL = 0;
constexpr size_t WS_W1T = 1u << 20;
constexpr size_t WS_W2T = WS_W1T + al((size_t)NUP * D * 2);
constexpr size_t WS_WINT = WS_W2T + al((size_t)D * FF * 2);
constexpr size_t WS_WOT = WS_WINT + al((size_t)NIN * D * 2);
constexpr size_t WS_W3T = WS_WOT + al((size_t)D * D * 2);
constexpr size_t WS_W4T = WS_W3T + al((size_t)NUP * D * 2);
constexpr size_t WS_ROPE = WS_W4T + al((size_t)D * FF * 2);
constexpr size_t WS_SSQ0 = WS_ROPE + al((size_t)TP * 8 * 8);
constexpr size_t WS_SSQ1 = WS_SSQ0 + al((size_t)M * 16 * 4);
constexpr size_t WS_SSQ2 = WS_SSQ1 + al((size_t)M * 16 * 4);
constexpr size_t WS_KS = WS_SSQ2 + al((size_t)M * 16 * 4);
constexpr size_t WS_VTS = WS_KS + al((size_t)NBS * KSROWS * 128 * 2);
constexpr size_t WS_US = WS_VTS + al((size_t)NBS * 128 * KSROWS * 2);
constexpr size_t WS_AB = WS_US + al((size_t)NBS * USROWS * CC * 2);
constexpr size_t WS_X1 = WS_AB + al((size_t)M * D * 2);
constexpr size_t WS_ACT = WS_X1 + al((size_t)M * D * 4);
constexpr size_t WS_A8 = WS_X1;
constexpr size_t WS_W3Q = WS_A8 + al((size_t)M * D);
constexpr size_t WS_W1Q = WS_W3Q + al((size_t)NUP * D);
constexpr size_t WS_RS = WS_W1Q + al((size_t)NUP * D);
constexpr size_t WS_CS3 = WS_RS + al((size_t)M * 4);
constexpr size_t WS_CS1 = WS_CS3 + al((size_t)NUP * 4);
static_assert(WS_CS1 + (size_t)NUP * 4 <= WS_ACT, "int8 operands fit in the f32 scratch");
constexpr size_t WS_END = WS_ACT + al((size_t)M * FF * 2);
constexpr size_t WS_UP = WS_ACT;
constexpr size_t WS_Q = WS_UP + al((size_t)MP * CC * 2);
constexpr size_t WS_KP = WS_Q + al((size_t)M * 512 * 2);
constexpr size_t WS_VTP = WS_KP + al((size_t)MP * 128 * 2);
constexpr size_t WS_MIX = WS_VTP + al((size_t)MP * 128 * 2);
static_assert(WS_MIX + (size_t)M * D * 2 <= WS_END, "overlay fits");

constexpr int LDS_BYTES = 155648;
constexpr int SSQ_LDS_OFF = 131072;

__device__ __forceinline__ unsigned cvt_pk_bf16(float lo, float hi) { unsigned r; asm volatile("v_cvt_pk_bf16_f32 %0, %1, %2" : "=v"(r) : "v"(lo), "v"(hi)); return r; }
__device__ __forceinline__ float bf2f(bf16_t h) { return __uint_as_float((unsigned)h << 16); }
__device__ __forceinline__ bf16_t f2bf(float f) { return (bf16_t)(cvt_pk_bf16(f, 0.f) & 0xffffu); }
__device__ __forceinline__ float silu_f(float a) { return a * __builtin_amdgcn_rcpf(1.0f + __builtin_amdgcn_exp2f(-a * LOG2E)); }
__device__ __forceinline__ float sigmoid_f(float a) { return __builtin_amdgcn_rcpf(1.0f + __builtin_amdgcn_exp2f(-a * LOG2E)); }
__device__ __forceinline__ float sum_rows4(float x) {
    float a = x, b = x;
    asm volatile("s_nop 1\n\tv_permlane16_swap_b32 %0, %1" : "+v"(a), "+v"(b));
    float t = a + b; a = t; b = t;
    asm volatile("s_nop 1\n\tv_permlane32_swap_b32 %0, %1" : "+v"(a), "+v"(b));
    return a + b;
}
__device__ __forceinline__ float max_rows4(float x) {
    float a = x, b = x;
    asm volatile("s_nop 1\n\tv_permlane16_swap_b32 %0, %1" : "+v"(a), "+v"(b));
    float t = fmaxf(a, b); a = t; b = t;
    asm volatile("s_nop 1\n\tv_permlane32_swap_b32 %0, %1" : "+v"(a), "+v"(b));
    return fmaxf(a, b);
}
__device__ __forceinline__ float dpp_max8(float v) {
    v = fmaxf(v, __builtin_bit_cast(float, __builtin_amdgcn_update_dpp(0, __builtin_bit_cast(int, v), 0xB1, 0xF, 0xF, true)));
    v = fmaxf(v, __builtin_bit_cast(float, __builtin_amdgcn_update_dpp(0, __builtin_bit_cast(int, v), 0x4E, 0xF, 0xF, true)));
    v = fmaxf(v, __builtin_bit_cast(float, __builtin_amdgcn_update_dpp(0, __builtin_bit_cast(int, v), 0x141, 0xF, 0xF, true)));
    return v;
}
__device__ __forceinline__ float dpp_max16(float v) {
    v = dpp_max8(v);
    return fmaxf(v, __builtin_bit_cast(float, __builtin_amdgcn_update_dpp(0, __builtin_bit_cast(int, v), 0x140, 0xF, 0xF, true)));
}
__device__ __forceinline__ float dpp_row_sum(float v) {
    v += __builtin_bit_cast(float, __builtin_amdgcn_update_dpp(0, __builtin_bit_cast(int, v), 0xB1, 0xF, 0xF, true));
    v += __builtin_bit_cast(float, __builtin_amdgcn_update_dpp(0, __builtin_bit_cast(int, v), 0x4E, 0xF, 0xF, true));
    v += __builtin_bit_cast(float, __builtin_amdgcn_update_dpp(0, __builtin_bit_cast(int, v), 0x124, 0xF, 0xF, true));
    v += __builtin_bit_cast(float, __builtin_amdgcn_update_dpp(0, __builtin_bit_cast(int, v), 0x128, 0xF, 0xF, true));
    return v;
}
__device__ __forceinline__ void wave_sum2(float& a, float& b) {
    a = dpp_row_sum(a); b = dpp_row_sum(b);
    a = sum_rows4(a); b = sum_rows4(b);
}
__device__ __forceinline__ float row_rstd(const float* ssq, int r) {
    const f32x4* p = (const f32x4*)(ssq + (size_t)r * 16);
    const f32x4 a = p[0], b = p[1], c = p[2], d = p[3];
    const f32x4 s = (a + b) + (c + d);
    return rsqrtf(((s.x + s.y) + (s.z + s.w)) * (1.0f / D) + EPS);
}

__device__ __forceinline__ int lane_now() { int l; asm volatile("v_mbcnt_lo_u32_b32 %0, -1, 0\n\tv_mbcnt_hi_u32_b32 %0, -1, %0" : "=v"(l)); return l; }
namespace pg8 {
constexpr int BM = 256, BK = 64, HALF = 128, HTB = HALF * BK * 2, STAGE_BYTES = 8 * HTB, NXCD = 8, WGM = 8;
__host__ __device__ __forceinline__ int lds_byte(int r, int c) { const int st = (r >> 4) * 2 + (c >> 5), rr = r & 15, cc = c & 31, ob = rr * 64 + cc * 2; return st * 1024 + (ob ^ (((ob >> 9) & 1) << 5)); }
__host__ __device__ __forceinline__ void stage_rc(int b, int& R, int& C) { const int st = b / 1024, sb = b % 1024, swz = sb ^ (((sb >> 9) & 1) << 5); R = (st >> 1) * 16 + swz / 64; C = (st & 1) * 32 + (swz % 64) / 2; }
__host__ __device__ __forceinline__ int perm32(int rho) { const int n = rho >> 4, i = rho & 15; return 8 * (i >> 2) + 4 * n + (i & 3); }

struct Unit { int pm, pn; };
struct Gemm { const bf16_t* A; const bf16_t* Bt; int M, N, K; };

struct StaticOrder {
    int nM, nN, nwg, G, c, wgm;
    __host__ __device__ void init(int M_, int N_, int G_, int c_, int wgm_ = WGM) { nM = M_ / BM; nN = N_ / BM; nwg = nM * nN; G = G_; c = c_; wgm = wgm_; }
    __host__ __device__ bool next(int i, Unit& u) const {
        const long L = (long)i * G + c; if (L >= nwg) return false;
        int wgid = (int)L; { const int q = nwg / NXCD, r = nwg % NXCD, xcd = wgid % NXCD, off = wgid / NXCD; wgid = (xcd < r ? xcd * (q + 1) : r * (q + 1) + (xcd - r) * q) + off; }
        const int nig = wgm * nN, gid = wgid / nig, fm = gid * wgm, gsz = (nM - fm) < wgm ? (nM - fm) : wgm;
        u.pm = fm + ((wgid % nig) % gsz); u.pn = (wgid % nig) / gsz; return true;
    }
    __device__ __forceinline__ void a_ready(const Unit&) const {}
    __device__ __forceinline__ void done(const Unit&) const {}
};

__device__ __forceinline__ f32x4 mma16(bf16x8 b, bf16x8 a, f32x4 c) { return __builtin_amdgcn_mfma_f32_16x16x32_bf16(b, a, c, 0, 0, 0); }
__device__ __forceinline__ i32x4 mma16(bf16x8 b, bf16x8 a, i32x4 c) { return __builtin_amdgcn_mfma_i32_16x16x64_i8(__builtin_bit_cast(i32x4, b), __builtin_bit_cast(i32x4, a), c, 0, 0, 0); }
template <bool I8> struct AccT { typedef f32x4 type; };
template <> struct AccT<true> { typedef i32x4 type; };
template <class Epi, class Sched, bool ALIGN_EPI, bool SP2, bool I8 = false>
__device__ __forceinline__ void gemm_phase(LAS unsigned char* lds, const Gemm g, const Sched& S, const Epi& E, int wave_) {
    static_assert(ALIGN_EPI && SP2, "only the aligned-epilogue, two-MFMA-cluster schedule is kept");
    const int tid = wave_ * 64 + lane_now();
    const int wid = wave_, lane = tid & 63, wr = wid >> 2, wc = wid & 3, fr = lane & 15, fq = lane >> 4;
    const int K = g.K, nt = K / BK;
    unsigned voffA, voffB;
    { int R, C; stage_rc(tid * 16, R, C); const int Rb = Epi::PERM ? ((R & ~31) + perm32(R & 31)) : R; voffA = (unsigned)(R * K + C) * 2u; voffB = (unsigned)(Rb * K + C) * 2u; }
    const __amdgpu_buffer_rsrc_t srdA = __builtin_amdgcn_make_buffer_rsrc((void*)g.A, (short)0, -1, 0x00020000);
    const __amdgpu_buffer_rsrc_t srdB = __builtin_amdgcn_make_buffer_rsrc((void*)g.Bt, (short)0, -1, 0x00020000);
    const unsigned kstep = BK * 2u, hstep = (unsigned)HALF * (unsigned)K * 2u, tstep = 2u * hstep, pstep = 64u * (unsigned)K * 2u;
    const unsigned ldsb = (unsigned)(size_t)lds + (unsigned)wid * 1024u;
    const int aoff = lds_byte(wr * 64 + fr, fq * 8), boff = lds_byte(wc * 32 + fr, fq * 8);
#define PG8_SA(b, h) (((b) * 2 + (h)) * HTB)
#define PG8_SB(b, h) ((4 + (b) * 2 + (h)) * HTB)
#define PG8_STAGE(bufoff, srd, soff, voff) do { _Pragma("unroll") for (int _i = 0; _i < 2; ++_i) \
        asm volatile("s_add_u32 m0, %0, %4\n\ts_nop 0\n\tbuffer_load_dwordx4 %1, %2, %3 offen lds" :: "s"(ldsb), "v"(voff), "s"(srd), "s"((soff) + _i * pstep), "n"((bufoff) + _i * 8192) : "m0", "scc", "memory"); } while (0)
#define PG8_STA(b, h, soff) PG8_STAGE(PG8_SA(b, h), srdA, soff, voffA)
#define PG8_STB(b, h, soff) PG8_STAGE(PG8_SB(b, h), srdB, soff, voffB)
#define PG8_LDA(dst, b, h) do { _Pragma("unroll") for (int m = 0; m < 4; ++m) _Pragma("unroll") for (int k = 0; k < 2; ++k) dst[m][k] = *(const LAS bf16x8*)(lds + PG8_SA(b, h) + aoff + m * 2048 + k * 1024); } while (0)
#define PG8_LDB(dst, b, h) do { _Pragma("unroll") for (int n = 0; n < 2; ++n) _Pragma("unroll") for (int k = 0; k < 2; ++k) dst[n][k] = *(const LAS bf16x8*)(lds + PG8_SB(b, h) + boff + n * 2048 + k * 1024); } while (0)
#define PG8_MMA(ai, bj, At, Bt) do { __builtin_amdgcn_s_setprio(1); _Pragma("unroll") for (int m = 0; m < 4; ++m) _Pragma("unroll") for (int n = 0; n < 2; ++n) _Pragma("unroll") for (int k = 0; k < 2; ++k) \
        acc[ai][bj][m][n] = mma16(Bt[n][k], At[m][k], acc[ai][bj][m][n]); __builtin_amdgcn_s_setprio(0); } while (0)
#define PG8_MMAZ(ai, bj, At, Bt) do { __builtin_amdgcn_s_setprio(1); _Pragma("unroll") for (int m = 0; m < 4; ++m) _Pragma("unroll") for (int n = 0; n < 2; ++n) { \
        acc[ai][bj][m][n] = mma16(Bt[n][0], At[m][0], acc_t{}); acc[ai][bj][m][n] = mma16(Bt[n][1], At[m][1], acc[ai][bj][m][n]); } __builtin_amdgcn_s_setprio(0); } while (0)
#define PG8_WAIT_V(n) asm volatile("s_waitcnt vmcnt(%0)" :: "n"(n) : "memory")
#define PG8_WAIT_L(n) asm volatile("s_waitcnt lgkmcnt(" #n ")" ::: "memory")
#define PG8_BAR __builtin_amdgcn_s_barrier()
#define PG8_SCHED __builtin_amdgcn_sched_barrier(0)
#ifndef PG8_RELAX
#define PG8_RELAX 1
#endif
#define PG8_WAIT_R(relaxed, nst) do { if (relaxed) PG8_WAIT_V(8 + PG8_RELAX * (nst)); else PG8_WAIT_V(8); } while (0)
#define PG8_TRIP(first, relaxed, nst) do { \
            PG8_LDB(B0, 0, 0); PG8_LDB(B1, 0, 1); PG8_SCHED; PG8_LDA(At, 0, 0); if (!(first)) PG8_STA(1, 1, a1 + hstep); \
            PG8_WAIT_R(relaxed, nst); PG8_WAIT_L(0); PG8_BAR; PG8_MMA(0, 0, At, B0); PG8_MMA(0, 1, At, B1); PG8_BAR; PG8_SCHED; \
            PG8_LDA(At, 0, 1); PG8_STB(0, 0, b2); PG8_STB(0, 1, b2 + hstep); PG8_STA(0, 0, a2); \
            PG8_WAIT_R(relaxed, nst); PG8_WAIT_L(0); PG8_BAR; PG8_MMA(1, 0, At, B0); PG8_MMA(1, 1, At, B1); PG8_BAR; PG8_SCHED; \
            PG8_LDB(B0, 1, 0); PG8_LDB(B1, 1, 1); PG8_SCHED; PG8_LDA(At, 1, 0); PG8_STA(0, 1, a2 + hstep); \
            PG8_WAIT_R(relaxed, nst); PG8_WAIT_L(0); PG8_BAR; PG8_MMA(0, 0, At, B0); PG8_MMA(0, 1, At, B1); PG8_BAR; PG8_SCHED; \
            PG8_LDA(At, 1, 1); PG8_STB(1, 0, b3); PG8_STB(1, 1, b3 + hstep); PG8_STA(1, 0, a3); \
            PG8_WAIT_V(8); PG8_WAIT_L(0); PG8_BAR; PG8_MMA(1, 0, At, B0); PG8_MMA(1, 1, At, B1); PG8_BAR; PG8_SCHED; } while (0)
    constexpr bool EARLY = Epi::NST > 0;
    Unit cur, nxt; int ui = 0;
    if (!S.next(0, cur)) return;
    typedef typename AccT<I8>::type acc_t;
    acc_t acc[2][2][4][2];
    bf16x8 At[4][2], B0[2][2], B1[2][2];
    unsigned cA = (unsigned)cur.pm * tstep, cB = (unsigned)cur.pn * tstep;
    S.a_ready(cur);
    PG8_STB(0, 0, cB); PG8_STB(0, 1, cB + hstep); PG8_STA(0, 0, cA); PG8_STA(0, 1, cA + hstep);
    if (wr == 1) PG8_BAR;
    PG8_WAIT_V(2); PG8_BAR;
    PG8_STB(1, 0, cB + kstep); PG8_STA(1, 0, cA + kstep); PG8_STB(1, 1, cB + hstep + kstep);
    if constexpr (EARLY) { PG8_STA(1, 1, cA + hstep + kstep); PG8_WAIT_V(8); } else { PG8_WAIT_V(6); }
    PG8_BAR;
#pragma unroll
    for (int a = 0; a < 2; ++a)
#pragma unroll
        for (int b = 0; b < 2; ++b)
#pragma unroll
            for (int m = 0; m < 4; ++m)
#pragma unroll
                for (int n = 0; n < 2; ++n) acc[a][b][m][n] = acc_t{};
    for (;;) {
        const bool has_next = S.next(ui + 1, nxt);
        const unsigned nA = has_next ? (unsigned)nxt.pm * tstep : cA, nB = has_next ? (unsigned)nxt.pn * tstep : cB;
        for (int t = 0; t < nt; t += 2) {
            const bool last = (t == nt - 2), first = EARLY && (t == 0), relaxed = first && ui > 0;
            const unsigned a1 = cA + (unsigned)(t + 1) * kstep;
            const unsigned a2 = last ? nA : cA + (unsigned)(t + 2) * kstep, b2 = last ? nB : cB + (unsigned)(t + 2) * kstep;
            const unsigned a3 = a2 + kstep, b3 = b2 + kstep;
            if (last && has_next) S.a_ready(nxt);
            if (last) E.prefetch(cur, wid, lane, lds);
            PG8_TRIP(first, relaxed, Epi::NST);
        }
        if constexpr (EARLY) PG8_STA(1, 1, nA + kstep + hstep);
        if (wr == 0) PG8_BAR;
        E(acc, cur, wr, wc, fr, fq); S.done(cur);
        if (!has_next) break;
#pragma unroll
        for (int a = 0; a < 2; ++a)
#pragma unroll
            for (int b = 0; b < 2; ++b)
#pragma unroll
                for (int m = 0; m < 4; ++m)
#pragma unroll
                    for (int n = 0; n < 2; ++n) acc[a][b][m][n] = acc_t{};
        cur = nxt; cA = nA; cB = nB; ++ui;
        if (wr == 1) PG8_BAR;
    }
    PG8_WAIT_V(0);
    PG8_BAR;
#undef PG8_SA
#undef PG8_SB
#undef PG8_STAGE
#undef PG8_STA
#undef PG8_STB
#undef PG8_LDA
#undef PG8_LDB
#undef PG8_MMA
#undef PG8_MMAZ
#undef PG8_TRIP
#undef PG8_WAIT_R
#undef PG8_WAIT_V
#undef PG8_WAIT_L
#undef PG8_BAR
#undef PG8_SCHED
}
}

typedef const f32x4 (&AccRef)[2][2][4][2];
#define EPI_BIG_CALL() \
    __device__ __forceinline__ void operator()(AccRef acc, const pg8::Unit& u, int wr, int wc, int fr, int fq) const { \
        { const int l_ = lane_now(); fr = l_ & 15; fq = (l_ >> 4) & 3; }     \
        const int row0 = u.pm * 256 + wr * 64 + fr; \
        _Pragma("unroll") for (int gq = 0; gq < 8 / PF; ++gq) { \
            Pre p[PF]; \
            asm volatile("" ::: "memory"); \
            _Pragma("unroll") for (int i = 0; i < PF; ++i) { const int rg = gq * PF + i; p[i] = pre_big(row0 + (rg >> 2) * 128 + (rg & 3) * 16, u.pn, wc, fq); }     \
            asm volatile("" ::: "memory"); \
            _Pragma("unroll") for (int i = 0; i < PF; ++i) { const int rg = gq * PF + i; \
                rows(acc[rg >> 2][0][rg & 3][0], acc[rg >> 2][0][rg & 3][1], acc[rg >> 2][1][rg & 3][0], acc[rg >> 2][1][rg & 3][1], row0 + (rg >> 2) * 128 + (rg & 3) * 16, u.pn, wc, fq, p[i]); } } \
    }
#define EPI_BIG_CALL_PIPE() \
    __device__ __forceinline__ void operator()(AccRef acc, const pg8::Unit& u, int wr, int wc, int fr, int fq) const { \
        { const int l_ = lane_now(); fr = l_ & 15; fq = (l_ >> 4) & 3; } \
        const int row0 = u.pm * 256 + wr * 64 + fr; \
        constexpr int NG = 8 / PF; \
        Pre p[2][PF]; \
        asm volatile("" ::: "memory"); \
        _Pragma("unroll") for (int i = 0; i < PF; ++i) p[0][i] = pre_big(row0 + (i >> 2) * 128 + (i & 3) * 16, u.pn, wc, fq); \
        _Pragma("unroll") for (int gq = 0; gq < NG; ++gq) { \
            asm volatile("" ::: "memory"); \
            if (gq + 1 < NG) { _Pragma("unroll") for (int i = 0; i < PF; ++i) { const int rg = (gq + 1) * PF + i; p[(gq + 1) & 1][i] = pre_big(row0 + (rg >> 2) * 128 + (rg & 3) * 16, u.pn, wc, fq); } } \
            asm volatile("" ::: "memory"); \
            _Pragma("unroll") for (int i = 0; i < PF; ++i) { const int rg = gq * PF + i; \
                rows(acc[rg >> 2][0][rg & 3][0], acc[rg >> 2][0][rg & 3][1], acc[rg >> 2][1][rg & 3][0], acc[rg >> 2][1][rg & 3][1], row0 + (rg >> 2) * 128 + (rg & 3) * 16, u.pn, wc, fq, p[gq & 1][i]); } } \
    }
#define EPI_BIG_CALL_NAMED(NAME) \
    __device__ __forceinline__ void NAME(AccRef acc, const pg8::Unit& u, int wr, int wc, int fr, int fq) const { \
        { const int l_ = lane_now(); fr = l_ & 15; fq = (l_ >> 4) & 3; }     \
        const int row0 = u.pm * 256 + wr * 64 + fr; \
        _Pragma("unroll") for (int gq = 0; gq < 8 / PF; ++gq) { \
            Pre p[PF]; \
            asm volatile("" ::: "memory"); \
            _Pragma("unroll") for (int i = 0; i < PF; ++i) { const int rg = gq * PF + i; p[i] = pre_big(row0 + (rg >> 2) * 128 + (rg & 3) * 16, u.pn, wc, fq); }     \
            asm volatile("" ::: "memory"); \
            _Pragma("unroll") for (int i = 0; i < PF; ++i) { const int rg = gq * PF + i; \
                rows(acc[rg >> 2][0][rg & 3][0], acc[rg >> 2][0][rg & 3][1], acc[rg >> 2][1][rg & 3][0], acc[rg >> 2][1][rg & 3][1], row0 + (rg >> 2) * 128 + (rg & 3) * 16, u.pn, wc, fq, p[i]); } } \
    }
#define EPI_BIG_CALL_PIPE() \
    __device__ __forceinline__ void NAME(AccRef acc, const pg8::Unit& u, int wr, int wc, int fr, int fq) const { \
        { const int l_ = lane_now(); fr = l_ & 15; fq = (l_ >> 4) & 3; } \
        const int row0 = u.pm * 256 + wr * 64 + fr; \
        constexpr int NG = 8 / PF; \
        Pre p[2][PF]; \
        asm volatile("" ::: "memory"); \
        _Pragma("unroll") for (int i = 0; i < PF; ++i) p[0][i] = pre_big(row0 + (i >> 2) * 128 + (i & 3) * 16, u.pn, wc, fq); \
        _Pragma("unroll") for (int gq = 0; gq < NG; ++gq) { \
            asm volatile("" ::: "memory"); \
            if (gq + 1 < NG) { _Pragma("unroll") for (int i = 0; i < PF; ++i) { const int rg = (gq + 1) * PF + i; p[(gq + 1) & 1][i] = pre_big(row0 + (rg >> 2) * 128 + (rg & 3) * 16, u.pn, wc, fq); } } \
            asm volatile("" ::: "memory"); \
            _Pragma("unroll") for (int i = 0; i < PF; ++i) { const int rg = gq * PF + i; \
                rows(acc[rg >> 2][0][rg & 3][0], acc[rg >> 2][0][rg & 3][1], acc[rg >> 2][1][rg & 3][0], acc[rg >> 2][1][rg & 3][1], row0 + (rg >> 2) * 128 + (rg & 3) * 16, u.pn, wc, fq, p[gq & 1][i]); } } \
    }
#define EPI_BIG_CALL_PIPE_NAMED(NAME) \
    __device__ __forceinline__ void NAME(AccRef acc, const pg8::Unit& u, int wr, int wc, int fr, int fq) const { \
        { const int l_ = lane_now(); fr = l_ & 15; fq = (l_ >> 4) & 3; } \
        const int row0 = u.pm * 256 + wr * 64 + fr; \
        constexpr int NG = 8 / PF; \
        Pre p[2][PF]; \
        asm volatile("" ::: "memory"); \
        _Pragma("unroll") for (int i = 0; i < PF; ++i) p[0][i] = pre_big(row0 + (i >> 2) * 128 + (i & 3) * 16, u.pn, wc, fq); \
        _Pragma("unroll") for (int gq = 0; gq < NG; ++gq) { \
            asm volatile("" ::: "memory"); \
            if (gq + 1 < NG) { _Pragma("unroll") for (int i = 0; i < PF; ++i) { const int rg = (gq + 1) * PF + i; p[(gq + 1) & 1][i] = pre_big(row0 + (rg >> 2) * 128 + (rg & 3) * 16, u.pn, wc, fq); } } \
            asm volatile("" ::: "memory"); \
            _Pragma("unroll") for (int i = 0; i < PF; ++i) { const int rg = gq * PF + i; \
                rows(acc[rg >> 2][0][rg & 3][0], acc[rg >> 2][0][rg & 3][1], acc[rg >> 2][1][rg & 3][0], acc[rg >> 2][1][rg & 3][1], row0 + (rg >> 2) * 128 + (rg & 3) * 16, u.pn, wc, fq, p[gq & 1][i]); } } \
    }
#define EPI_BIG_CALL_SEL() \
    __device__ __forceinline__ void operator()(AccRef acc, const pg8::Unit& u, int wr, int wc, int fr, int fq) const { call_pipe(acc, u, wr, wc, fr, fq); }
__device__ __forceinline__ f32x4 ssq_quarter(const float* ssq, int r, int fq) { return *(const f32x4*)(ssq + (size_t)r * 16 + 4 * fq); }
__device__ __forceinline__ float rstd_from(const f32x4& q) {
    float s = (q.x + q.y) + (q.z + q.w);
    s = sum_rows4(s);
    return rsqrtf(s * (1.0f / D) + EPS);
}

__device__ __forceinline__ void ssq_prefetch(const float* ssq, int pm, int wid, int lane, LAS unsigned char* lds) {
    asm volatile("" : "+v"(lane));
#pragma unroll
    for (int i = 0; i < 2; ++i)
        __builtin_amdgcn_global_load_lds((const unsigned*)(ssq + ((size_t)pm * 256 + wid * 32 + i * 16) * 16 + lane * 4), (LAS unsigned*)(lds + SSQ_LDS_OFF + (wid * 32 + i * 16) * 64), 16, 0, 0);
}
struct EpiSwiglu {
    static constexpr bool PERM = true; static constexpr int PF = 8; static constexpr int NST = 8;
    bf16_t* O; const float* ssq; LAS unsigned char* lds;
    struct Pre { f32x4 q; };
    __device__ __forceinline__ Pre pre(int r, int pn, int wc, int fq) const { Pre p; p.q = ssq_quarter(ssq, r, fq); return p; }
    __device__ __forceinline__ Pre pre_big(int r, int pn, int wc, int fq) const { Pre p; p.q = *(const LAS f32x4*)(lds + SSQ_LDS_OFF + (r & 255) * 64 + fq * 16); return p; }
    __device__ __forceinline__ void prefetch(const pg8::Unit& u, int wid, int lane, LAS unsigned char* l) const { ssq_prefetch(ssq, u.pm, wid, lane, l); }
    __device__ __forceinline__ void rows(const f32x4& c00, const f32x4& c01, const f32x4& c10, const f32x4& c11, int r, int pn, int wc, int fq, const Pre& p) const {
        const float rs = rstd_from(p.q);
        float o[8];
#pragma unroll
        for (int j = 0; j < 4; ++j) { o[j] = silu_f(c00[j] * rs) * (c10[j] * rs); o[4 + j] = silu_f(c01[j] * rs) * (c11[j] * rs); }
        u32x4 w; w.x = cvt_pk_bf16(o[0], o[1]); w.y = cvt_pk_bf16(o[2], o[3]); w.z = cvt_pk_bf16(o[4], o[5]); w.w = cvt_pk_bf16(o[6], o[7]);
        { bf16_t* dst_ = O + (size_t)r * FF + pn * 128 + wc * 32 + 8 * fq;
          asm volatile("global_store_dwordx4 %0, %1, off sc1\n\ts_nop 1" :: "v"(dst_), "v"(w) : "memory"); }
    }
    EPI_BIG_CALL()
};

struct EpiSwigluI8 {
    static constexpr bool PERM = true; static constexpr int NST = 8;
    bf16_t* O; const float* rs; const float* cs; LAS unsigned char* lds;
    struct Pre { float sa; };
    __device__ __forceinline__ Pre pre(int r, int pn, int wc, int fq) const { Pre p; p.sa = rs[r]; return p; }
    __device__ __forceinline__ void prefetch(const pg8::Unit& u, int wid, int lane, LAS unsigned char* l) const {
        asm volatile("" : "+v"(lane));
        if (wid == 0) __builtin_amdgcn_global_load_lds((const unsigned*)(rs + (size_t)u.pm * 256 + lane * 4), (LAS unsigned*)(l + SSQ_LDS_OFF), 16, 0, 0);
        if (wid == 1) __builtin_amdgcn_global_load_lds((const unsigned*)(cs + (size_t)u.pn * 256 + lane * 4), (LAS unsigned*)(l + SSQ_LDS_OFF + 1024), 16, 0, 0);
    }
    __device__ __forceinline__ void emit(const f32x4& c00, const f32x4& c01, const f32x4& c10, const f32x4& c11, float sa, const f32x4& w00, const f32x4& w01, const f32x4& w10, const f32x4& w11,
                                         int r, int pn, int wc, int fq) const {
        float o[8];
#pragma unroll
        for (int j = 0; j < 4; ++j) { o[j] = silu_f(c00[j] * (sa * w00[j])) * (c10[j] * (sa * w10[j])); o[4 + j] = silu_f(c01[j] * (sa * w01[j])) * (c11[j] * (sa * w11[j])); }
        u32x4 w; w.x = cvt_pk_bf16(o[0], o[1]); w.y = cvt_pk_bf16(o[2], o[3]); w.z = cvt_pk_bf16(o[4], o[5]); w.w = cvt_pk_bf16(o[6], o[7]);
        { bf16_t* dst_ = O + (size_t)r * FF + pn * 128 + wc * 32 + 8 * fq;
          asm volatile("global_store_dwordx4 %0, %1, off sc1\n\ts_nop 1" :: "v"(dst_), "v"(w) : "memory"); }
    }
    __device__ __forceinline__ void rows(const f32x4& c00, const f32x4& c01, const f32x4& c10, const f32x4& c11, int r, int pn, int wc, int fq, const Pre& p) const {
        const float* cp = cs + (size_t)pn * 256 + wc * 32 + 8 * fq;
        emit(c00, c01, c10, c11, p.sa, *(const f32x4*)cp, *(const f32x4*)(cp + 4), *(const f32x4*)(cp + 128), *(const f32x4*)(cp + 132), r, pn, wc, fq);
    }
    template <class AccTy> __device__ __forceinline__ void operator()(const AccTy (&acc)[2][2][4][2], const pg8::Unit& u, int wr, int wc, int fr, int fq) const {
        { const int l_ = lane_now(); fr = l_ & 15; fq = (l_ >> 4) & 3; }
        const int row0 = u.pm * 256 + wr * 64 + fr;
        LAS const float* lr = (LAS const float*)(lds + SSQ_LDS_OFF); LAS const float* lc = lr + 256 + wc * 32 + 8 * fq;
        const f32x4 w00 = *(LAS const f32x4*)lc, w01 = *(LAS const f32x4*)(lc + 4), w10 = *(LAS const f32x4*)(lc + 128), w11 = *(LAS const f32x4*)(lc + 132);
        f32x2 NW[4], WW[4];
        NW[0] = (f32x2){w00[0], w00[1]} * (-LOG2E); NW[1] = (f32x2){w00[2], w00[3]} * (-LOG2E); NW[2] = (f32x2){w01[0], w01[1]} * (-LOG2E); NW[3] = (f32x2){w01[2], w01[3]} * (-LOG2E);
        WW[0] = (f32x2){w00[0], w00[1]} * (f32x2){w10[0], w10[1]}; WW[1] = (f32x2){w00[2], w00[3]} * (f32x2){w10[2], w10[3]};
        WW[2] = (f32x2){w01[0], w01[1]} * (f32x2){w11[0], w11[1]}; WW[3] = (f32x2){w01[2], w01[3]} * (f32x2){w11[2], w11[3]};
#pragma unroll
        for (int rg = 0; rg < 8; ++rg) {
            const int ai = rg >> 2, m = rg & 3, r = row0 + ai * 128 + m * 16;
            const float sa = lr[r & 255], inv = __builtin_amdgcn_rcpf(sa);
            unsigned pk[4];
#pragma unroll
            for (int p = 0; p < 4; ++p) {
                const AccTy& cg = acc[ai][0][m][p >> 1]; const AccTy& cu = acc[ai][1][m][p >> 1]; const int j = (p & 1) * 2;
                const f32x2 G = (f32x2){(float)cg[j], (float)cg[j + 1]} * sa, U = (f32x2){(float)cu[j], (float)cu[j + 1]};
                const f32x2 T = G * NW[p];
                f32x2 E; E.x = __builtin_amdgcn_exp2f(T.x); E.y = __builtin_amdgcn_exp2f(T.y);
                const f32x2 Dn = E * inv + inv;
                f32x2 R; R.x = __builtin_amdgcn_rcpf(Dn.x); R.y = __builtin_amdgcn_rcpf(Dn.y);
                const f32x2 O = ((G * U) * WW[p]) * R;
                pk[p] = cvt_pk_bf16(O.x, O.y);
            }
            u32x4 w; w.x = pk[0]; w.y = pk[1]; w.z = pk[2]; w.w = pk[3];
            { bf16_t* dst_ = O_at(r, u.pn, wc, fq);
              asm volatile("global_store_dwordx4 %0, %1, off sc1\n\ts_nop 1" :: "v"(dst_), "v"(w) : "memory"); }
        }
    }
    __device__ __forceinline__ bf16_t* O_at(int r, int pn, int wc, int fq) const { return O + (size_t)r * FF + pn * 128 + wc * 32 + 8 * fq; }
};

template <int MODE> struct EpiResid {
    static constexpr bool PERM = true; static constexpr int PF = (MODE == 0) ? 1 : 2;
    static constexpr int NST = (MODE == 2) ? 16 : (MODE == 1) ? 12 : 6;
    const float* resP; const float* resS;
    float* out; bf16_t* xb; float* ssq; float scale;
    struct Pre { f32x4 r00, r01, r10, r11; u32x4 a, b; };
    __device__ __forceinline__ Pre pre(int r, int pn, int wc, int fq) const {
        Pre p; const size_t off = (size_t)r * D + pn * 256 + wc * 32 + 8 * fq;
        if (MODE == 0) { const float* rbase = (r >= MP) ? resS - (size_t)MP * D : resP;
            p.r00 = *(const f32x4*)(rbase + off); p.r01 = *(const f32x4*)(rbase + off + 4); p.r10 = *(const f32x4*)(rbase + off + 128); p.r11 = *(const f32x4*)(rbase + off + 132); }
        else { p.a = *(const u32x4*)(xb + off); p.b = *(const u32x4*)(xb + off + 128); }
        return p;
    }
    __device__ __forceinline__ Pre pre_big(int r, int pn, int wc, int fq) const { return pre(r, pn, wc, fq); }
    __device__ __forceinline__ void prefetch(const pg8::Unit&, int, int, LAS unsigned char*) const {}
    __device__ __forceinline__ void rows(const f32x4& c00, const f32x4& c01, const f32x4& c10, const f32x4& c11, int r, int pn, int wc, int fq, const Pre& p) const {
        const size_t off = (size_t)r * D + pn * 256 + wc * 32 + 8 * fq;
        f32x4 r00, r01, r10, r11;
        if (MODE == 0) { r00 = p.r00; r01 = p.r01; r10 = p.r10; r11 = p.r11; }
        else {
            const u32x4 a = p.a, b = p.b;
            r00 = (f32x4){__uint_as_float(a.x << 16), __uint_as_float(a.x & 0xffff0000u), __uint_as_float(a.y << 16), __uint_as_float(a.y & 0xffff0000u)};
            r01 = (f32x4){__uint_as_float(a.z << 16), __uint_as_float(a.z & 0xffff0000u), __uint_as_float(a.w << 16), __uint_as_float(a.w & 0xffff0000u)};
            r10 = (f32x4){__uint_as_float(b.x << 16), __uint_as_float(b.x & 0xffff0000u), __uint_as_float(b.y << 16), __uint_as_float(b.y & 0xffff0000u)};
            r11 = (f32x4){__uint_as_float(b.z << 16), __uint_as_float(b.z & 0xffff0000u), __uint_as_float(b.w << 16), __uint_as_float(b.w & 0xffff0000u)};
        }
        const f32x4 y00 = r00 + c00 * scale, y01 = r01 + c01 * scale, y10 = r10 + c10 * scale, y11 = r11 + c11 * scale;
        if (MODE == 2) {
            __builtin_nontemporal_store(y00, (f32x4*)(out + off)); __builtin_nontemporal_store(y01, (f32x4*)(out + off + 4)); __builtin_nontemporal_store(y10, (f32x4*)(out + off + 128)); __builtin_nontemporal_store(y11, (f32x4*)(out + off + 132));
        } else {
            u32x4 w0, w1;
            w0.x = cvt_pk_bf16(y00[0], y00[1]); w0.y = cvt_pk_bf16(y00[2], y00[3]); w0.z = cvt_pk_bf16(y01[0], y01[1]); w0.w = cvt_pk_bf16(y01[2], y01[3]);
            w1.x = cvt_pk_bf16(y10[0], y10[1]); w1.y = cvt_pk_bf16(y10[2], y10[3]); w1.z = cvt_pk_bf16(y11[0], y11[1]); w1.w = cvt_pk_bf16(y11[2], y11[3]);
            *(u32x4*)(xb + off) = w0; *(u32x4*)(xb + off + 128) = w1;
            float ss = (y00[0] * y00[0] + y00[1] * y00[1]) + (y00[2] * y00[2] + y00[3] * y00[3]) + (y01[0] * y01[0] + y01[1] * y01[1]) + (y01[2] * y01[2] + y01[3] * y01[3])
                     + (y10[0] * y10[0] + y10[1] * y10[1]) + (y10[2] * y10[2] + y10[3] * y10[3]) + (y11[0] * y11[0] + y11[1] * y11[1]) + (y11[2] * y11[2] + y11[3] * y11[3]);
            ss = sum_rows4(ss);
            if (fq == 0) ssq[(size_t)r * 16 + pn * 4 + wc] = ss;
        }
    }
    EPI_BIG_CALL_NAMED(call_plain)
    EPI_BIG_CALL_PIPE_NAMED(call_pipe)
    EPI_BIG_CALL_SEL()
};

constexpr int GAIN_LDS_OFF = 151552 + 1024;
struct EpiInProj {
    static constexpr bool PERM = true; static constexpr int PF = 1; static constexpr int NST = 0;
    unsigned char* ws; const float* gq; const float* gk; float* out; LAS unsigned char* lds;
    struct Pre { f32x4 q; };
    __device__ __forceinline__ Pre pre(int r, int pn, int wc, int fq) const { Pre p; p.q = ssq_quarter((const float*)(ws + WS_SSQ1), r, fq); return p; }
    __device__ __forceinline__ Pre pre_big(int r, int pn, int wc, int fq) const { Pre p; p.q = *(const LAS f32x4*)(lds + SSQ_LDS_OFF + (r & 255) * 64 + fq * 16); return p; }
    __device__ __forceinline__ void prefetch(const pg8::Unit& u, int wid, int lane, LAS unsigned char* l) const { ssq_prefetch((const float*)(ws + WS_SSQ1), u.pm, wid, lane, l); }
    __device__ __forceinline__ void rows(const f32x4& c00, const f32x4& c01, const f32x4& c10, const f32x4& c11, int r, int pn, int wc, int fq, const Pre& p) const {
        const bool sample = r >= MP;
        int b, t, pos;
        if (sample) { const int rr = r - MP; b = rr >> 4; t = rr & 15; pos = PAST + t; } else { b = r >> 13; t = r & (TP - 1); pos = t; }
        const float rs = rstd_from(p.q);
        if (pn < 4) {
            const int ch0 = pn * 128 + wc * 32 + 8 * fq;
            float o[8];
            { const float nrs = -LOG2E * rs, irs = __builtin_amdgcn_rcpf(rs);
#pragma unroll
              for (int p = 0; p < 4; ++p) {
                  const f32x4& cv = (p < 2) ? c00 : c01; const f32x4& cg = (p < 2) ? c10 : c11; const int j = (p & 1) * 2;
                  const f32x2 T = (f32x2){cg[j], cg[j + 1]} * nrs;
                  f32x2 E; E.x = __builtin_amdgcn_exp2f(T.x); E.y = __builtin_amdgcn_exp2f(T.y);
                  const f32x2 Dn = E * irs + irs;
                  f32x2 R; R.x = __builtin_amdgcn_rcpf(Dn.x); R.y = __builtin_amdgcn_rcpf(Dn.y);
                  const f32x2 O = (f32x2){cv[j], cv[j + 1]} * R;
                  o[2 * p] = O.x; o[2 * p + 1] = O.y; } }
            u32x4 w; w.x = cvt_pk_bf16(o[0], o[1]); w.y = cvt_pk_bf16(o[2], o[3]); w.z = cvt_pk_bf16(o[4], o[5]); w.w = cvt_pk_bf16(o[6], o[7]);
            bf16_t* ud = sample ? (bf16_t*)(ws + WS_US) + ((size_t)(b * USROWS + HIST + t)) * CC + ch0 : (bf16_t*)(ws + WS_UP) + (size_t)r * CC + ch0;
            *(u32x4*)ud = w;
            float* dst = nullptr;
            if (sample) dst = out + O_CSS + ((size_t)(b * HIST + (HIST - TS) + t)) * CC + ch0;
            else if (t >= TP - HIST) dst = out + O_CSP + ((size_t)(b * HIST + (t - (TP - HIST)))) * CC + ch0;
            if (dst) { *(f32x4*)dst = (f32x4){o[0], o[1], o[2], o[3]}; *(f32x4*)(dst + 4) = (f32x4){o[4], o[5], o[6], o[7]}; }
        } else if (pn < 6 || wc < 2) {
            const bool isq = pn < 6;
            const int h = isq ? (pn - 4) * 4 + wc : wc;
            LAS const float* gg = (LAS const float*)(lds + GAIN_LDS_OFF) + (isq ? 0 : 64);
            const f32x4 g00 = *(LAS const f32x4*)(gg + 8 * fq), g01 = *(LAS const f32x4*)(gg + 8 * fq + 4), g10 = *(LAS const f32x4*)(gg + 32 + 8 * fq), g11 = *(LAS const f32x4*)(gg + 32 + 8 * fq + 4);
            const float osc = isq ? QSCALE : 1.0f;
            f32x4 v00 = c00 * rs, v01 = c01 * rs, v10 = c10 * rs, v11 = c11 * rs;
            float ss = (v00[0] * v00[0] + v00[1] * v00[1]) + (v00[2] * v00[2] + v00[3] * v00[3]) + (v01[0] * v01[0] + v01[1] * v01[1]) + (v01[2] * v01[2] + v01[3] * v01[3])
                     + (v10[0] * v10[0] + v10[1] * v10[1]) + (v10[2] * v10[2] + v10[3] * v10[3]) + (v11[0] * v11[0] + v11[1] * v11[1]) + (v11[2] * v11[2] + v11[3] * v11[3]);
            ss = sum_rows4(ss);
            const float hn = rsqrtf(ss * (1.0f / HD) + EPS);
            v00 = v00 * hn * g00; v01 = v01 * hn * g01; v10 = v10 * hn * g10; v11 = v11 * hn * g11;
            f32x4 p0, p1;
#pragma unroll
            for (int j = 0; j < 4; ++j) { p0[j] = __shfl_xor(v00[j], 16); p1[j] = __shfl_xor(v01[j], 16);     }
            if (fq < 2) {
                constexpr float INVR[8] = {1.591549431e-01f, 3.086376340e-02f, 5.985185713e-03f, 1.160663641e-03f, 2.250790790e-04f, 4.364795279e-05f, 8.464330808e-06f, 1.641426263e-06f};
                const float sg = (fq == 0) ? -1.0f : 1.0f, fpos = (float)pos;
#pragma unroll
                for (int j = 0; j < 4; ++j) {
                    const float f0 = __builtin_amdgcn_fractf(fpos * INVR[j]), f1 = __builtin_amdgcn_fractf(fpos * INVR[4 + j]);
                    const float c0 = __builtin_amdgcn_cosf(f0), s0 = __builtin_amdgcn_sinf(f0), c1 = __builtin_amdgcn_cosf(f1), s1 = __builtin_amdgcn_sinf(f1);
                    v00[j] = v00[j] * c0 + sg * p0[j] * s0;
                    v01[j] = v01[j] * c1 + sg * p1[j] * s1;
                }
            }
            u32x4 w0, w1;
            w0.x = cvt_pk_bf16(v00[0] * osc, v00[1] * osc); w0.y = cvt_pk_bf16(v00[2] * osc, v00[3] * osc); w0.z = cvt_pk_bf16(v01[0] * osc, v01[1] * osc); w0.w = cvt_pk_bf16(v01[2] * osc, v01[3] * osc);
            w1.x = cvt_pk_bf16(v10[0] * osc, v10[1] * osc); w1.y = cvt_pk_bf16(v10[2] * osc, v10[3] * osc); w1.z = cvt_pk_bf16(v11[0] * osc, v11[1] * osc); w1.w = cvt_pk_bf16(v11[2] * osc, v11[3] * osc);
            if (isq) {
                bf16_t* dst = (bf16_t*)(ws + WS_Q) + (size_t)r * 512 + h * 64 + 8 * fq;
                *(u32x4*)dst = w0; *(u32x4*)(dst + 32) = w1;
            } else {
                bf16_t* dst = sample ? (bf16_t*)(ws + WS_KS) + ((size_t)(b * KSROWS + WIN + t)) * 128 + h * 64 + 8 * fq : (bf16_t*)(ws + WS_KP) + (size_t)r * 128 + h * 64 + 8 * fq;
                *(u32x4*)dst = w0; *(u32x4*)(dst + 32) = w1;
                float* od = nullptr;
                if (sample) od = out + O_KWS + ((size_t)((b * WIN + (WIN - TS) + t) * 2 + h)) * 64 + 8 * fq;
                else if (t >= TP - WIN) od = out + O_KWP + ((size_t)((b * WIN + (t - (TP - WIN))) * 2 + h)) * 64 + 8 * fq;
                if (od) { *(f32x4*)od = v00; *(f32x4*)(od + 4) = v01; *(f32x4*)(od + 32) = v10; *(f32x4*)(od + 36) = v11; }
            }
        } else {
            const int kh = wc - 2;
            const f32x4 v00 = c00 * rs, v01 = c01 * rs, v10 = c10 * rs, v11 = c11 * rs;
            bf16_t* vt; size_t vs;
            if (sample) { vt = (bf16_t*)(ws + WS_VTS) + ((size_t)((b * 2 + kh) * 64)) * KSROWS + WIN + t; vs = KSROWS; }
            else { vt = (bf16_t*)(ws + WS_VTP) + ((size_t)((b * 2 + kh) * (TP / 64) + (t >> 6))) * 4096 + (t & 63); vs = 64; }
#pragma unroll
            for (int j = 0; j < 4; ++j) {
                vt[(size_t)(8 * fq + j) * vs] = f2bf(v00[j]); vt[(size_t)(8 * fq + 4 + j) * vs] = f2bf(v01[j]);
                vt[(size_t)(32 + 8 * fq + j) * vs] = f2bf(v10[j]); vt[(size_t)(32 + 8 * fq + 4 + j) * vs] = f2bf(v11[j]);
            }
            float* od = nullptr;
            if (sample) od = out + O_VWS + ((size_t)((b * WIN + (WIN - TS) + t) * 2 + kh)) * 64 + 8 * fq;
            else if (t >= TP - WIN) od = out + O_VWP + ((size_t)((b * WIN + (t - (TP - WIN))) * 2 + kh)) * 64 + 8 * fq;
            if (od) { *(f32x4*)od = v00; *(f32x4*)(od + 4) = v01; *(f32x4*)(od + 32) = v10; *(f32x4*)(od + 36) = v11; }
        }
    }
    EPI_BIG_CALL()
};

template <int KS, int MT, bool I8, class Epi>
__device__ __forceinline__ void small_gemm(const bf16_t* A, const bf16_t* Bt, int N, int K, const Epi& E, LAS unsigned char* lds, int bid, int G, int wave, int lane, int wpc_in = 0) {
    constexpr int MTN = MS / (16 * MT);
    const int NT = MTN * (N / 256) * 4, NI = NT * KS, wpc = wpc_in ? wpc_in : (NI + G - 1) / G, nb = K / 64;
    asm volatile("" : "+v"(lane));
    const int fr = lane & 15, g = lane >> 4;
    for (int i0 = 0; i0 < wpc; i0 += 8) {
        const int i = i0 + wave, item = bid * wpc + i;
        const bool active = (i < wpc) && (item < NI);
        const int t = active ? item / KS : 0, ksl = item % KS;
        const int mt = t % MTN, nq = t / MTN, pn = nq >> 2, wc = nq & 3;
        const int r = MP + mt * (16 * MT) + fr;
        typedef typename pg8::AccT<I8>::type acc_t;
        acc_t acc[MT][2][2];
#pragma unroll
        for (int mi = 0; mi < MT; ++mi)
#pragma unroll
            for (int bj = 0; bj < 2; ++bj)
#pragma unroll
                for (int n = 0; n < 2; ++n) acc[mi][bj][n] = acc_t{};
        if (active) {
            const int b0 = (nb * ksl) / KS, b1 = (nb * (ksl + 1)) / KS;
            const bf16_t* ap = A + (size_t)r * K + g * 8;
            const bf16_t* bp = Bt + (size_t)(pn * 256 + wc * 32 + 8 * (fr >> 2) + (fr & 3)) * K + g * 8;
            bf16x8 afA[2][MT], bfA[2][2][2], afB[2][MT], bfB[2][2][2];
#define SG_LOAD(af, bf, kb) do { const int k0_ = (kb) * 64; _Pragma("unroll") for (int s_ = 0; s_ < 2; ++s_) { \
            _Pragma("unroll") for (int mi = 0; mi < MT; ++mi) af[s_][mi] = *(const bf16x8*)(ap + (size_t)(16 * mi) * K + k0_ + s_ * 32); \
            _Pragma("unroll") for (int bj = 0; bj < 2; ++bj) _Pragma("unroll") for (int n = 0; n < 2; ++n) bf[s_][bj][n] = *(const bf16x8*)(bp + (size_t)(4 * n + 128 * bj) * K + k0_ + s_ * 32); } } while (0)
#define SG_MMA(af, bf) do { _Pragma("unroll") for (int s_ = 0; s_ < 2; ++s_) _Pragma("unroll") for (int bj = 0; bj < 2; ++bj) _Pragma("unroll") for (int n = 0; n < 2; ++n) { \
            _Pragma("unroll") for (int mi = 0; mi < MT; ++mi) acc[mi][bj][n] = pg8::mma16(bf[s_][bj][n], af[s_][mi], acc[mi][bj][n]); } } while (0)
            SG_LOAD(afA, bfA, b0);
            int kb = b0;
            for (; kb + 2 < b1; kb += 2) {
                __builtin_amdgcn_sched_barrier(0);
                SG_LOAD(afB, bfB, kb + 1);
                __builtin_amdgcn_sched_barrier(0);
                SG_MMA(afA, bfA);
                __builtin_amdgcn_sched_barrier(0);
                SG_LOAD(afA, bfA, kb + 2);
                __builtin_amdgcn_sched_barrier(0);
                SG_MMA(afB, bfB);
            }
            __builtin_amdgcn_sched_barrier(0);
            if (kb + 1 < b1) { SG_LOAD(afB, bfB, kb + 1); __builtin_amdgcn_sched_barrier(0); SG_MMA(afA, bfA); SG_MMA(afB, bfB); }
            else { SG_MMA(afA, bfA); }
#undef SG_LOAD
#undef SG_MMA
        }
        if constexpr (KS > 1) {
            static_assert(KS == 1 || KS == 8, "KS: 1 or 8 (all eight waves of the workgroup on one tile)");
            LAS acc_t* red = (LAS acc_t*)lds;
            if (ksl != 0) {
#pragma unroll
                for (int mi = 0; mi < MT; ++mi)
#pragma unroll
                    for (int bj = 0; bj < 2; ++bj)
#pragma unroll
                        for (int n = 0; n < 2; ++n) red[(ksl - 1) * (MT * 256) + ((mi * 2 + bj) * 2 + n) * 64 + lane] = acc[mi][bj][n];
            }
            __syncthreads();
            if (ksl == 0) {
#pragma unroll
                for (int q = 0; q < KS - 1; ++q)
#pragma unroll
                    for (int mi = 0; mi < MT; ++mi)
#pragma unroll
                        for (int bj = 0; bj < 2; ++bj)
#pragma unroll
                            for (int n = 0; n < 2; ++n) acc[mi][bj][n] += red[q * (MT * 256) + ((mi * 2 + bj) * 2 + n) * 64 + lane];
            }
            __syncthreads();
        }
        if (active && ksl == 0) {
#pragma unroll
            for (int mi = 0; mi < MT; ++mi) { const typename Epi::Pre p = E.pre(r + 16 * mi, pn, wc, g);
                E.rows(__builtin_convertvector(acc[mi][0][0], f32x4), __builtin_convertvector(acc[mi][0][1], f32x4), __builtin_convertvector(acc[mi][1][0], f32x4), __builtin_convertvector(acc[mi][1][1], f32x4), r + 16 * mi, pn, wc, g, p); }
        }
    }
}

struct TItem { const float* W; const float* g; bf16_t* WT; int Nsrc, srccol0, K, destrow0, k0; };
__device__ __forceinline__ void p0_tload(const TItem& t, float (&v)[32], int lane) {
#pragma unroll
    for (int i = 0; i < 32; ++i) { const int kk = 2 * i + (lane >> 5); v[i] = t.W[(size_t)(t.k0 + kk) * t.Nsrc + t.srccol0 + (lane & 31)]; }
}
__device__ __forceinline__ void p0_tfinish(const TItem& t, const float (&v)[32], LAS float* scr, int lane) {
#pragma unroll
    for (int i = 0; i < 32; ++i) { const int kk = 2 * i + (lane >> 5); scr[kk * 33 + (lane & 31)] = v[i]; }
    asm volatile("s_waitcnt lgkmcnt(0)" ::: "memory");
    const int c = lane & 7;
    f32x4 g0 = (f32x4){1.f, 1.f, 1.f, 1.f}, g1 = g0;
    if (t.g) { g0 = *(const f32x4*)(t.g + t.k0 + 8 * c); g1 = *(const f32x4*)(t.g + t.k0 + 8 * c + 4); }
#pragma unroll
    for (int j = 0; j < 4; ++j) { const int n = (lane >> 3) + 8 * j; const LAS float* sp = scr + (8 * c) * 33 + n;
        u32x4 o; o.x = cvt_pk_bf16(sp[0 * 33] * g0.x, sp[1 * 33] * g0.y); o.y = cvt_pk_bf16(sp[2 * 33] * g0.z, sp[3 * 33] * g0.w); o.z = cvt_pk_bf16(sp[4 * 33] * g1.x, sp[5 * 33] * g1.y); o.w = cvt_pk_bf16(sp[6 * 33] * g1.z, sp[7 * 33] * g1.w);
        *(u32x4*)(t.WT + (size_t)(t.destrow0 + n) * t.K + t.k0 + 8 * c) = o; }
    asm volatile("s_waitcnt lgkmcnt(0)" ::: "memory");
}
__device__ __forceinline__ int src_up(int nb) { const int pn = nb >> 3, p0 = (nb & 7) * 32, bj = p0 >> 7; return bj * FF + pn * 128 + (p0 & 127); }
__device__ __forceinline__ int src_in(int nb) {
    const int pn = nb >> 3, p0 = (nb & 7) * 32, bj = p0 >> 7, wc = (p0 & 127) >> 5;
    if (pn < 4) return bj * CC + pn * 128 + wc * 32;
    if (pn < 6) return 1024 + ((pn - 4) * 4 + wc) * 64 + bj * 32;
    return (wc < 2) ? 1536 + wc * 64 + bj * 32 : 1664 + (wc - 2) * 64 + bj * 32;
}

struct Args { const float* in[21]; float* out; unsigned char* ws; float inv[8]; };
typedef const __attribute__((address_space(4))) Args& ArgsRef;
__device__ __forceinline__ const __attribute__((address_space(4))) Args* args_now() {
#if defined(__HIP_DEVICE_COMPILE__)
    auto p = (const __attribute__((address_space(4))) Args*)__builtin_amdgcn_kernarg_segment_ptr(); asm volatile("" : "+s"(p)); return p;
#else
    return nullptr;
#endif
}

constexpr int I_UP = (D / 64) * (NUP / 32), I_DN = (FF / 64) * (D / 32), I_IN = (D / 64) * (NIN / 32), I_O = (D / 64) * (D / 32);
constexpr int NITEMS = 2 * I_UP + 2 * I_DN + I_IN + I_O;
constexpr int NITEMS_EARLY = I_UP + I_DN + I_IN + I_O;
__device__ __forceinline__ TItem p0_decode(ArgsRef a, int it) {
    unsigned char* ws = a.ws; int r = it < NITEMS ? it : NITEMS - 1; TItem t;
    if (r < I_UP) { const int nblk = NUP / 32, kb = r / nblk, nb = r % nblk; t = TItem{a.in[6], a.in[5], (bf16_t*)(ws + WS_W1T), NUP, src_up(nb), D, nb * 32, kb * 64}; return t; } r -= I_UP;
    if (r < I_DN) { const int nblk = D / 32, kb = r / nblk, nb = r % nblk; t = TItem{a.in[7], nullptr, (bf16_t*)(ws + WS_W2T), D, nb * 32, FF, nb * 32, kb * 64}; return t; } r -= I_DN;
    if (r < I_IN) { const int nblk = NIN / 32, kb = r / nblk, nb = r % nblk; t = TItem{a.in[9], a.in[8], (bf16_t*)(ws + WS_WINT), NIN, src_in(nb), D, nb * 32, kb * 64}; return t; } r -= I_IN;
    if (r < I_O) { const int nblk = D / 32, kb = r / nblk, nb = r % nblk; t = TItem{a.in[17], nullptr, (bf16_t*)(ws + WS_WOT), D, nb * 32, D, nb * 32, kb * 64}; return t; } r -= I_O;
    if (r < I_UP) { const int nblk = NUP / 32, kb = r / nblk, nb = r % nblk; t = TItem{a.in[19], a.in[18], (bf16_t*)(ws + WS_W3T), NUP, src_up(nb), D, nb * 32, kb * 64}; return t; } r -= I_UP;
    { const int nblk = D / 32, kb = r / nblk, nb = r % nblk; t = TItem{a.in[20], nullptr, (bf16_t*)(ws + WS_W4T), D, nb * 32, FF, nb * 32, kb * 64}; return t; }
}
__device__ __forceinline__ void weights_convert(ArgsRef a, LAS unsigned char* lds, int it0, int it1, int gw, int NGW, int wave, int lane) {
    LAS float* scr = (LAS float*)(lds + wave * 16896);
    for (int it = it0 + gw; it < it1; it += 2 * NGW) {
        const TItem t0 = p0_decode(a, it), t1 = p0_decode(a, it + NGW < it1 ? it + NGW : it);
        float v0[32], v1[32];
        p0_tload(t0, v0, lane); p0_tload(t1, v1, lane);
        p0_tfinish(t0, v0, scr, lane);
        if (it + NGW < it1) p0_tfinish(t1, v1, scr + 64 * 33, lane);
    }
}


__device__ __forceinline__ unsigned q8_pack4(float a, float b, float c, float d, float inv) {
    const f32x2 M = (f32x2){12582912.0f, 12582912.0f};
    const f32x2 t01 = (f32x2){a, b} * inv + M, t23 = (f32x2){c, d} * inv + M;
    const unsigned p01 = __builtin_amdgcn_perm(__float_as_uint(t01.y), __float_as_uint(t01.x), 0x0c0c0400u);
    const unsigned p23 = __builtin_amdgcn_perm(__float_as_uint(t23.y), __float_as_uint(t23.x), 0x04000c0cu);
    return p01 | p23;
}
__device__ __forceinline__ void w8_strip(const float* W, const float* g, signed char* Wq, float* cs, int nb, LAS unsigned char* lds, int wave, int lane) {
    LAS float* scr = (LAS float*)(lds + wave * 16896);
    LAS float* red = (LAS float*)(lds + 139264);
    const int src0 = src_up(nb), k0 = 128 * wave, c = lane & 7;
    TItem t0{W, nullptr, nullptr, NUP, src0, D, 0, k0}, t1{W, nullptr, nullptr, NUP, src0, D, 0, k0 + 64};
    float v0[32], v1[32];
    p0_tload(t0, v0, lane); p0_tload(t1, v1, lane);
#pragma unroll
    for (int i = 0; i < 32; ++i) { const int kk = 2 * i + (lane >> 5); scr[kk * 33 + (lane & 31)] = v0[i]; scr[64 * 33 + kk * 33 + (lane & 31)] = v1[i]; }
    asm volatile("s_waitcnt lgkmcnt(0)" ::: "memory");
    float val[2][4][8]; float mx[4];
#pragma unroll
    for (int h = 0; h < 2; ++h) { const f32x4 ga = *(const f32x4*)(g + k0 + 64 * h + 8 * c), gb = *(const f32x4*)(g + k0 + 64 * h + 8 * c + 4);
#pragma unroll
        for (int j = 0; j < 4; ++j) { const LAS float* sp = scr + h * (64 * 33) + (8 * c) * 33 + (lane >> 3) + 8 * j;
#pragma unroll
            for (int i = 0; i < 8; ++i) val[h][j][i] = sp[i * 33] * (i < 4 ? ga[i] : gb[i - 4]); } }
#pragma unroll
    for (int j = 0; j < 4; ++j) { float m = 0.f;
#pragma unroll
        for (int h = 0; h < 2; ++h)
#pragma unroll
            for (int i = 0; i < 8; ++i) m = fmaxf(m, fabsf(val[h][j][i]));
        m = dpp_max8(m);
        mx[j] = m; }
    if (c == 0) {
#pragma unroll
        for (int j = 0; j < 4; ++j) red[wave * 32 + (lane >> 3) + 8 * j] = mx[j]; }
    __syncthreads();
#pragma unroll
    for (int j = 0; j < 4; ++j) { float m = 0.f;
#pragma unroll
        for (int w = 0; w < 8; ++w) m = fmaxf(m, red[w * 32 + (lane >> 3) + 8 * j]);
        mx[j] = m; }
#pragma unroll
    for (int j = 0; j < 4; ++j) { const int n = (lane >> 3) + 8 * j; const float inv = mx[j] > 0.f ? 127.0f / mx[j] : 0.f;
        if (wave == 0 && c == 0) cs[nb * 32 + n] = mx[j] > 0.f ? mx[j] * (1.0f / 127.0f) : 1.0f;
#pragma unroll
        for (int h = 0; h < 2; ++h) { const unsigned lo = q8_pack4(val[h][j][0], val[h][j][1], val[h][j][2], val[h][j][3], inv), hi = q8_pack4(val[h][j][4], val[h][j][5], val[h][j][6], val[h][j][7], inv);
            *(u32x2*)(Wq + (size_t)(nb * 32 + n) * D + k0 + 64 * h + 8 * c) = (u32x2){lo, hi}; } }
    __syncthreads();
}
template <int NR> __device__ __forceinline__ void q8_rows(unsigned char* ws, const float* ssq, int m0, int lane) {
    const bf16_t* AB = (const bf16_t*)(ws + WS_AB); signed char* A8 = (signed char*)(ws + WS_A8); float* RS = (float*)(ws + WS_RS);
    u32x4 xa[NR], xb[NR]; float sq[NR];
#pragma unroll
    for (int q = 0; q < NR; ++q) { const bf16_t* row = AB + (size_t)(m0 + q) * D; xa[q] = *(const u32x4*)(row + 8 * lane); xb[q] = *(const u32x4*)(row + 512 + 8 * lane); sq[q] = lane < 16 ? ssq[(size_t)(m0 + q) * 16 + lane] : 0.f; }
#pragma unroll
    for (int q = 0; q < NR; ++q) {
        float s = dpp_row_sum(sq[q]); s = __builtin_bit_cast(float, __builtin_amdgcn_readfirstlane(__builtin_bit_cast(int, s)));
        const float rstd = rsqrtf(s * (1.0f / D) + EPS);
        float v[16];
#pragma unroll
        for (int i = 0; i < 4; ++i) { const unsigned a = xa[q][i], b = xb[q][i];
            v[2 * i] = __uint_as_float(a << 16); v[2 * i + 1] = __uint_as_float(a & 0xffff0000u); v[8 + 2 * i] = __uint_as_float(b << 16); v[8 + 2 * i + 1] = __uint_as_float(b & 0xffff0000u); }
        float m = 0.f;
#pragma unroll
        for (int i = 0; i < 16; ++i) m = fmaxf(m, fabsf(v[i]));
        m = dpp_max16(m); m = max_rows4(m);
        const float inv = m > 0.f ? 127.0f / m : 0.f;
        signed char* orow = A8 + (size_t)(m0 + q) * D;
        *(u32x2*)(orow + 8 * lane) = (u32x2){q8_pack4(v[0], v[1], v[2], v[3], inv), q8_pack4(v[4], v[5], v[6], v[7], inv)};
        *(u32x2*)(orow + 512 + 8 * lane) = (u32x2){q8_pack4(v[8], v[9], v[10], v[11], inv), q8_pack4(v[12], v[13], v[14], v[15], inv)};
        if (lane == 0) RS[m0 + q] = m > 0.f ? m * rstd * (1.0f / 127.0f) : 1.0f;
    }
}
template <int NR> __device__ __forceinline__ void x_rows(ArgsRef a, int m0, int lane) {
    bf16_t* AB = (bf16_t*)(a.ws + WS_AB); float* ssq0 = (float*)(a.ws + WS_SSQ0);
    f32x4 v[NR][4];
#pragma unroll
    for (int q = 0; q < NR; ++q) { const int m = m0 + q;
        const float* xrow = (m < MP) ? a.in[0] + (size_t)m * D : a.in[1] + (size_t)(m - MP) * D;
        const f32x4* xr = (const f32x4*)xrow + lane;
#pragma unroll
        for (int j = 0; j < 4; ++j) v[q][j] = xr[64 * j]; }
    float t[NR + 1];
#pragma unroll
    for (int q = 0; q < NR; ++q) { float s = 0.f;
#pragma unroll
        for (int j = 0; j < 4; ++j) s += (v[q][j].x * v[q][j].x + v[q][j].y * v[q][j].y) + (v[q][j].z * v[q][j].z + v[q][j].w * v[q][j].w);
        t[q] = s; }
    t[NR] = 0.f;
#pragma unroll
    for (int q = 0; q < NR; q += 2) wave_sum2(t[q], t[q + 1]);
#pragma unroll
    for (int q = 0; q < NR; ++q) { const int m = m0 + q;
        u32x2* o8 = (u32x2*)(AB + (size_t)m * D) + lane;
#pragma unroll
        for (int j = 0; j < 4; ++j) { u32x2 w; w.x = cvt_pk_bf16(v[q][j].x, v[q][j].y); w.y = cvt_pk_bf16(v[q][j].z, v[q][j].w); o8[64 * j] = w; }
        if (lane < 16) ssq0[(size_t)m * 16 + lane] = (lane == 0) ? t[q] : 0.f; }
}

template <int NR> __device__ __forceinline__ void xq8_rows(ArgsRef a, int m0, int lane) {
    signed char* A8 = (signed char*)(a.ws + WS_A8); float* RS = (float*)(a.ws + WS_RS);
    f32x4 v[NR][4];
#pragma unroll
    for (int q = 0; q < NR; ++q) { const int m = m0 + q;
        const float* xrow = (m < MP) ? a.in[0] + (size_t)m * D : a.in[1] + (size_t)(m - MP) * D;
        const f32x4* xr = (const f32x4*)xrow + lane;
#pragma unroll
        for (int j = 0; j < 4; ++j) v[q][j] = xr[64 * j]; }
    float t[NR + 1], mxv[NR + 1];
#pragma unroll
    for (int q = 0; q < NR; ++q) { float s = 0.f, m = 0.f;
#pragma unroll
        for (int j = 0; j < 4; ++j) { s += (v[q][j].x * v[q][j].x + v[q][j].y * v[q][j].y) + (v[q][j].z * v[q][j].z + v[q][j].w * v[q][j].w);
            m = fmaxf(fmaxf(m, fmaxf(fabsf(v[q][j].x), fabsf(v[q][j].y))), fmaxf(fabsf(v[q][j].z), fabsf(v[q][j].w))); }
        t[q] = s; mxv[q] = m; }
    t[NR] = 0.f;
#pragma unroll
    for (int q = 0; q < NR; q += 2) wave_sum2(t[q], t[q + 1]);
#pragma unroll
    for (int q = 0; q < NR; ++q) { const int m = m0 + q;
        float mx = mxv[q]; mx = dpp_max16(mx); mx = max_rows4(mx);
        const float rstd = rsqrtf(t[q] * (1.0f / D) + EPS), inv = mx > 0.f ? 127.0f / mx : 0.f;
        unsigned* o4 = (unsigned*)(A8 + (size_t)m * D) + lane;
#pragma unroll
        for (int j = 0; j < 4; ++j) { const f32x4 x4 = v[q][j];
            o4[64 * j] = q8_pack4(x4.x, x4.y, x4.z, x4.w, inv); }
        if (lane == 0) RS[m] = mx > 0.f ? mx * rstd * (1.0f / 127.0f) : 1.0f; }
}

__device__ __forceinline__ void p0_xpart(ArgsRef a, int wave_) {
    const int lane = lane_now();
    const int gw = blockIdx.x * 8 + wave_, NGW = gridDim.x * 8;
    for (int m0 = gw * 8; m0 < MP; m0 += NGW * 8) xq8_rows<8>(a, m0, lane);
    for (int m = MP + gw; m < M; m += NGW) xq8_rows<1>(a, m, lane);
}
__device__ __forceinline__ void p0_wpart(ArgsRef a, LAS unsigned char* lds, int wave_) {
    const int tid = wave_ * 64 + lane_now();
    const int lane = tid & 63, wave = tid >> 6;
    const int gw = blockIdx.x * 8 + wave, NGW = gridDim.x * 8;
    unsigned char* ws = a.ws;
    for (int nb = blockIdx.x; nb < NUP / 32; nb += gridDim.x) w8_strip(a.in[6], a.in[5], (signed char*)(ws + WS_W1Q), (float*)(ws + WS_CS1), nb, lds, wave, lane);
    const int gt = blockIdx.x * 512 + tid, NGT = gridDim.x * 512;
    bf16_t* KS = (bf16_t*)(ws + WS_KS); bf16_t* VTS = (bf16_t*)(ws + WS_VTS); bf16_t* US = (bf16_t*)(ws + WS_US);
    for (int i = gt; i < NBS * WIN * 128; i += NGT) {
        const int c = i & 127, row = (i >> 7) & (WIN - 1), b = i >> 14;
        const float kv = a.in[3][i], vv = a.in[4][i];
        KS[((size_t)(b * KSROWS + row)) * 128 + c] = f2bf(kv);
        VTS[((size_t)(b * 128 + c)) * KSROWS + row] = f2bf(vv);
        if (row >= TS) { a.out[O_KWS + ((size_t)(b * WIN + row - TS)) * 128 + c] = kv; a.out[O_VWS + ((size_t)(b * WIN + row - TS)) * 128 + c] = vv; }
    }
    for (int i = gt; i < NBS * 128 * 16; i += NGT) { const int k = i & 15, rowd = i >> 4; VTS[(size_t)rowd * KSROWS + WIN + TS + k] = 0; }
    for (int i = gt; i < NBS * HIST * CC; i += NGT) {
        const int c = i & (CC - 1), row = (i >> 9) % HIST, b = (i >> 9) / HIST;
        const float uv = a.in[2][i];
        US[((size_t)(b * USROWS + row)) * CC + c] = f2bf(uv);
        if (row >= TS) a.out[O_CSS + ((size_t)(b * HIST + row - TS)) * CC + c] = uv;
    }
}
__device__ __forceinline__ void p0_prologue(ArgsRef a, LAS unsigned char* lds, int wave_) {
    if (blockIdx.x & 1) { p0_xpart(a, wave_); p0_wpart(a, lds, wave_); } else { p0_wpart(a, lds, wave_); p0_xpart(a, wave_); }
}

constexpr int ATT_VT_OFF = 192 * 128, ATT_VT_STRIDE = 400, ATT_BUF = ATT_VT_OFF + 64 * ATT_VT_STRIDE;
constexpr int ATT_UNITS_P = NBP * (TP / 64) * 2, ATT_UNITS = ATT_UNITS_P + NBS * 2;
constexpr int CONV_UNITS = MP / 16 + NBS;

struct AttUnit { const bf16_t* kb; const bf16_t* vt; int nkt; bool sample; };
__device__ __forceinline__ AttUnit att_decode(unsigned char* ws, int unit) {
    AttUnit u;
    if (unit < ATT_UNITS_P) { const int kh = unit & 1, c = (unit >> 1) & 127, b = unit >> 8, cs = c >= 2 ? c - 2 : 0;
        u.nkt = (c - cs + 1) * 4; u.sample = false;
        u.kb = (const bf16_t*)(ws + WS_KP) + ((size_t)(b * TP + cs * 64)) * 128 + kh * 64;
        u.vt = (const bf16_t*)(ws + WS_VTP) + ((size_t)((b * 2 + kh) * (TP / 64) + cs)) * 4096; }
    else { const int p = unit - ATT_UNITS_P, b = p >> 1, kh = p & 1;
        u.nkt = 9; u.sample = true;
        u.kb = (const bf16_t*)(ws + WS_KS) + ((size_t)(b * KSROWS)) * 128 + kh * 64;
        u.vt = (const bf16_t*)(ws + WS_VTS) + ((size_t)((b * 2 + kh) * 64)) * KSROWS; }
    return u;
}
__device__ __forceinline__ void att_stage_load(const AttUnit& u, int tid, u32x4 (&kp)[3], u32x4 (&vp)[3]) {
    const int nk = u.nkt * 16;
#pragma unroll
    for (int i = 0; i < 3; ++i) {
        const int p = tid + 512 * i; int row = p >> 3; const int ch = p & 7; row = row < nk ? row : nk - 1;
        kp[i] = *(const u32x4*)(u.kb + (size_t)row * 128 + ch * 8);
        if (u.sample) { int pp = p < 1280 ? p : 1279; const int d = pp / 20, q = pp - d * 20; vp[i] = *(const u32x4*)(u.vt + (size_t)d * KSROWS + q * 8); }
        else { const int jmax = (u.nkt >> 2) - 1, j = i < jmax ? i : jmax; vp[i] = *(const u32x4*)(u.vt + (size_t)j * 4096 + (p & 511) * 8); }
    }
}
__device__ __forceinline__ void att_stage_write(const AttUnit& u, int tid, LAS unsigned char* buf, const u32x4 (&kp)[3], const u32x4 (&vp)[3]) {
    const int nk = u.nkt * 16;
#pragma unroll
    for (int i = 0; i < 3; ++i) {
        const int p = tid + 512 * i; int row = p >> 3; const int ch = p & 7; row = row < nk ? row : nk - 1;
        *(LAS u32x4*)(buf + row * 128 + ((ch ^ ((row >> 1) & 7)) << 4)) = kp[i];
        if (u.sample) { int pp = p < 1280 ? p : 1279; const int d = pp / 20, q = pp - d * 20; *(LAS u32x4*)(buf + ATT_VT_OFF + d * ATT_VT_STRIDE + q * 16) = vp[i]; }
        else { const int jmax = (u.nkt >> 2) - 1, j = i < jmax ? i : jmax; const int d = (p & 511) >> 3, q = p & 7; *(LAS u32x4*)(buf + ATT_VT_OFF + d * ATT_VT_STRIDE + j * 128 + q * 16) = vp[i]; }
    }
}
__device__ __forceinline__ float max3f(float a, float b, float c) { float r; asm("v_max3_f32 %0, %1, %2, %3" : "=v"(r) : "v"(a), "v"(b), "v"(c)); return r; }
template <bool FULL>
__device__ __forceinline__ void attn_compute(const bf16x8 (&qf)[2][2], LAS const unsigned char* buf, int nkt, float sink0, float sink1, bf16_t* o0, bf16_t* o1, int lane) {
    const int fr = lane & 15, g = lane >> 4;
    f32x4 S[2][12];
    const float NEG = -INFINITY;
#pragma unroll
    for (int kt = 0; kt < 12; ++kt) {
        const int ktc = FULL ? kt : (kt < nkt ? kt : nkt - 1), row = ktc * 16 + fr, sw = (row >> 1) & 7;
        const bf16x8 k0 = *(LAS const bf16x8*)(buf + row * 128 + ((g ^ sw) << 4)), k1 = *(LAS const bf16x8*)(buf + row * 128 + (((g + 4) ^ sw) << 4));
        const bool ok = FULL || kt < nkt;
#pragma unroll
        for (int qt = 0; qt < 2; ++qt) {
            f32x4 c = (f32x4){0.f, 0.f, 0.f, 0.f};
            c = __builtin_amdgcn_mfma_f32_16x16x32_bf16(k0, qf[qt][0], c, 0, 0, 0);
            c = __builtin_amdgcn_mfma_f32_16x16x32_bf16(k1, qf[qt][1], c, 0, 0, 0);
            S[qt][kt] = ok ? c : (f32x4){NEG, NEG, NEG, NEG};
        }
    }
    bf16x8 pf[2][6]; float linv[2];
#pragma unroll
    for (int qt = 0; qt < 2; ++qt) {
        const float sink = qt ? sink1 : sink0;
        float mx = sink;
#pragma unroll
        for (int kt = 0; kt < 12; ++kt) mx = max3f(max3f(mx, S[qt][kt][0], S[qt][kt][1]), S[qt][kt][2], S[qt][kt][3]);
        mx = max_rows4(mx);
        f32x4 l4 = (f32x4){0.f, 0.f, 0.f, 0.f}; const float nm_ = -mx; const f32x4 nmx = (f32x4){nm_, nm_, nm_, nm_};
#pragma unroll
        for (int kt = 0; kt < 12; ++kt) {
            const f32x4 d = S[qt][kt] + nmx;
            f32x4 p; p.x = __builtin_amdgcn_exp2f(d.x); p.y = __builtin_amdgcn_exp2f(d.y); p.z = __builtin_amdgcn_exp2f(d.z); p.w = __builtin_amdgcn_exp2f(d.w);
            S[qt][kt] = p; l4 += p;
        }
        float l = (l4.x + l4.y) + (l4.z + l4.w);
        l = sum_rows4(l);
        l += __builtin_amdgcn_exp2f(sink - mx);
        linv[qt] = 1.0f / l;
#pragma unroll
        for (int kk = 0; kk < 6; ++kk) {
            u32x4 w; w.x = cvt_pk_bf16(S[qt][2 * kk][0], S[qt][2 * kk][1]); w.y = cvt_pk_bf16(S[qt][2 * kk][2], S[qt][2 * kk][3]);
            w.z = cvt_pk_bf16(S[qt][2 * kk + 1][0], S[qt][2 * kk + 1][1]); w.w = cvt_pk_bf16(S[qt][2 * kk + 1][2], S[qt][2 * kk + 1][3]);
            pf[qt][kk] = __builtin_bit_cast(bf16x8, w);
        }
    }
    f32x4 O[2][4];
    const int kkmax = (nkt - 1) >> 1;
    LAS const unsigned char* vb = buf + ATT_VT_OFF + fr * ATT_VT_STRIDE + g * 8;
#pragma unroll
    for (int dt = 0; dt < 4; ++dt) {
        O[0][dt] = (f32x4){0.f, 0.f, 0.f, 0.f}; O[1][dt] = (f32x4){0.f, 0.f, 0.f, 0.f};
#pragma unroll
        for (int kk = 0; kk < 6; ++kk) {
            const int kkc = kk < kkmax ? kk : kkmax;
            const u32x2 a0 = *(LAS const u32x2*)(vb + dt * 16 * ATT_VT_STRIDE + kkc * 64), a1 = *(LAS const u32x2*)(vb + dt * 16 * ATT_VT_STRIDE + kkc * 64 + 32);
            u32x4 aw; aw.x = a0.x; aw.y = a0.y; aw.z = a1.x; aw.w = a1.y;
            const bf16x8 af = __builtin_bit_cast(bf16x8, aw);
            O[0][dt] = __builtin_amdgcn_mfma_f32_16x16x32_bf16(af, pf[0][kk], O[0][dt], 0, 0, 0);
            O[1][dt] = __builtin_amdgcn_mfma_f32_16x16x32_bf16(af, pf[1][kk], O[1][dt], 0, 0, 0);
        }
    }
#pragma unroll
    for (int qt = 0; qt < 2; ++qt) {
        bf16_t* ob = (qt ? o1 : o0) + (size_t)fr * D + 4 * g;
#pragma unroll
        for (int dt = 0; dt < 4; ++dt) {
            const f32x4 v = O[qt][dt] * linv[qt];
            u32x2 w; w.x = cvt_pk_bf16(v[0], v[1]); w.y = cvt_pk_bf16(v[2], v[3]);
            *(u32x2*)(ob + dt * 16) = w;
        }
    }
}

__device__ __forceinline__ void attn_phase(ArgsRef a, LAS unsigned char* lds, int tid, int first, int G) {
    asm volatile("" : "+v"(tid));
    unsigned char* ws = a.ws;
    const int lane = tid & 63, wave = __builtin_amdgcn_readfirstlane(tid >> 6), fr = lane & 15, g = lane >> 4;
    const bf16_t* Q = (const bf16_t*)(ws + WS_Q); bf16_t* MIX = (bf16_t*)(ws + WS_MIX);
    const float* sinks = a.in[12];
    if (first >= ATT_UNITS) return;
    AttUnit cur = att_decode(ws, first);
    u32x4 kp[3], vp[3];
    att_stage_load(cur, tid, kp, vp);
    int par = 0;
    for (int unit = first; unit < ATT_UNITS; unit += G, par ^= 1) {
        LAS unsigned char* buf = lds + par * ATT_BUF;
        att_stage_write(cur, tid, buf, kp, vp);
        const bf16_t* q0; const bf16_t* q1; bf16_t* o0; bf16_t* o1; float sk0, sk1; bool work;
        if (!cur.sample) { const int kh = unit & 1, c = (unit >> 1) & 127, b = unit >> 8, h = kh * 4 + (wave >> 1), tok0 = c * 64 + (wave & 1) * 32;
            q0 = Q + ((size_t)(b * TP + tok0)) * 512 + h * 64; q1 = q0 + 16 * 512;
            o0 = MIX + ((size_t)(b * TP + tok0)) * D + 512 + h * 64; o1 = o0 + 16 * D; sk0 = sk1 = sinks[h] * LOG2E; work = true; }
        else { const int p = unit - ATT_UNITS_P, b = p >> 1, kh = p & 1, h0 = kh * 4 + (wave & 1) * 2;
            q0 = Q + ((size_t)(MP + b * TS)) * 512 + h0 * 64; q1 = q0 + 64;
            o0 = MIX + ((size_t)(MP + b * TS)) * D + 512 + h0 * 64; o1 = o0 + 64; sk0 = sinks[h0] * LOG2E; sk1 = sinks[h0 + 1] * LOG2E; work = wave < 2; }
        bf16x8 qf[2][2];
        qf[0][0] = *(const bf16x8*)(q0 + fr * 512 + g * 8); qf[0][1] = *(const bf16x8*)(q0 + fr * 512 + 32 + g * 8);
        qf[1][0] = *(const bf16x8*)(q1 + fr * 512 + g * 8); qf[1][1] = *(const bf16x8*)(q1 + fr * 512 + 32 + g * 8);
        const int nkt = cur.nkt;
        __syncthreads();
        const int nu = unit + G < ATT_UNITS ? unit + G : unit;
        cur = att_decode(ws, nu);
        att_stage_load(cur, tid, kp, vp);
        if (work) { if (nkt == 12) attn_compute<true>(qf, buf, nkt, sk0, sk1, o0, o1, lane); else attn_compute<false>(qf, buf, nkt, sk0, sk1, o0, o1, lane); }
    }
    __syncthreads();
}

struct ConvUnit { const bf16_t* ub; int jmin; size_t orow; };
__device__ __forceinline__ ConvUnit conv_decode(unsigned char* ws, int cu, int ch) {
    ConvUnit u;
    if (cu < MP / 16) { const int b = cu >> 9, t0 = (cu & 511) * 16; u.ub = (const bf16_t*)(ws + WS_UP) + ((size_t)(b * TP) + t0 - HIST) * CC + ch; u.jmin = HIST - t0; u.orow = (size_t)b * TP + t0; }
    else { const int b = cu - MP / 16; u.ub = (const bf16_t*)(ws + WS_US) + ((size_t)(b * USROWS)) * CC + ch; u.jmin = 0; u.orow = (size_t)MP + b * TS; }
    return u;
}
__device__ __forceinline__ void conv_phase(ArgsRef a, LAS unsigned char* lds, int tid, int first, int G) {
    asm volatile("" : "+v"(tid));
    unsigned char* ws = a.ws;
    const int ch = tid, wave = tid >> 6, lane = tid & 63;
    if (first >= CONV_UNITS) return;
    const float* wdw = a.in[13] + ch;
    f32x2 R[CW + 1];
    { float w[CW];
#pragma unroll
      for (int j = 0; j < CW; ++j) w[j] = wdw[j * CC];
      R[0] = (f32x2){w[0], 0.f};
#pragma unroll
      for (int k = 1; k < CW; ++k) R[k] = (f32x2){w[k], w[k - 1]};
      R[CW] = (f32x2){0.f, w[CW - 1]}; }
    const float bias = a.in[14][ch];
    const f32x4 gc0 = *(const f32x4*)(a.in[15] + 4 * lane), gc1 = *(const f32x4*)(a.in[15] + 256 + 4 * lane);
    const f32x4 bc0 = *(const f32x4*)(a.in[16] + 4 * lane), bc1 = *(const f32x4*)(a.in[16] + 256 + 4 * lane);
    ConvUnit cur = conv_decode(ws, first, ch);
    bf16_t xr[HIST + 16];
#pragma unroll
    for (int j = 0; j < HIST + 16; ++j) { const int jc = j > cur.jmin ? j : cur.jmin; xr[j] = cur.ub[(size_t)jc * CC]; }
    int par = 0;
    for (int cu = first; cu < CONV_UNITS; cu += G, par ^= 1) {
        const int jmin = cur.jmin; const size_t orow = cur.orow;
        f32x2 acc2[8];
#pragma unroll
        for (int p = 0; p < 8; ++p) acc2[p] = (f32x2){bias, bias};
#pragma unroll
        for (int j = 0; j < HIST + 16; ++j) {
            const float xv = (j >= jmin) ? bf2f(xr[j]) : 0.f;
            const f32x2 X = (f32x2){xv, xv};
#pragma unroll
            for (int p = 0; p < 8; ++p) { if (j - 2 * p >= 0 && j - 2 * p <= CW) acc2[p] = X * R[(j - 2 * p >= 0 && j - 2 * p <= CW) ? j - 2 * p : 0] + acc2[p]; }
        }
        __builtin_amdgcn_sched_barrier(0);
        { const int nu = cu + G < CONV_UNITS ? cu + G : cu;
          cur = conv_decode(ws, nu, ch);
#pragma unroll
          for (int j = 0; j < HIST + 16; ++j) { const int jc = j > cur.jmin ? j : cur.jmin; xr[j] = cur.ub[(size_t)jc * CC]; } }
        __builtin_amdgcn_sched_barrier(0);
        LAS float* yb = (LAS float*)lds + par * (16 * CC);
#pragma unroll
        for (int i = 0; i < 16; ++i) yb[i * CC + ch] = (i & 1) ? acc2[i >> 1].y : acc2[i >> 1].x;
        __syncthreads();
        bf16_t* MIX = (bf16_t*)(ws + WS_MIX) + orow * D;
        {
            const int tok = 2 * wave;
            f32x4 v0 = *(const LAS f32x4*)(yb + tok * CC + 4 * lane), v1 = *(const LAS f32x4*)(yb + tok * CC + 256 + 4 * lane);
            f32x4 z0 = *(const LAS f32x4*)(yb + (tok + 1) * CC + 4 * lane), z1 = *(const LAS f32x4*)(yb + (tok + 1) * CC + 256 + 4 * lane);
            float sa = (v0[0] + v0[1]) + (v0[2] + v0[3]) + (v1[0] + v1[1]) + (v1[2] + v1[3]);
            float sb = (z0[0] + z0[1]) + (z0[2] + z0[3]) + (z1[0] + z1[1]) + (z1[2] + z1[3]);
            wave_sum2(sa, sb);
            const float ma = sa * (1.0f / CC), mb = sb * (1.0f / CC);
            v0 = v0 - ma; v1 = v1 - ma; z0 = z0 - mb; z1 = z1 - mb;
            float qa = (v0[0] * v0[0] + v0[1] * v0[1]) + (v0[2] * v0[2] + v0[3] * v0[3]) + (v1[0] * v1[0] + v1[1] * v1[1]) + (v1[2] * v1[2] + v1[3] * v1[3]);
            float qb = (z0[0] * z0[0] + z0[1] * z0[1]) + (z0[2] * z0[2] + z0[3] * z0[3]) + (z1[0] * z1[0] + z1[1] * z1[1]) + (z1[2] * z1[2] + z1[3] * z1[3]);
            wave_sum2(qa, qb);
            const float ra = rsqrtf(qa * (1.0f / CC) + EPS), rb = rsqrtf(qb * (1.0f / CC) + EPS);
            v0 = v0 * ra * gc0 + bc0; v1 = v1 * ra * gc1 + bc1; z0 = z0 * rb * gc0 + bc0; z1 = z1 * rb * gc1 + bc1;
            u32x2 o0, o1, p0, p1;
            o0.x = cvt_pk_bf16(silu_f(v0[0]), silu_f(v0[1])); o0.y = cvt_pk_bf16(silu_f(v0[2]), silu_f(v0[3]));
            o1.x = cvt_pk_bf16(silu_f(v1[0]), silu_f(v1[1])); o1.y = cvt_pk_bf16(silu_f(v1[2]), silu_f(v1[3]));
            p0.x = cvt_pk_bf16(silu_f(z0[0]), silu_f(z0[1])); p0.y = cvt_pk_bf16(silu_f(z0[2]), silu_f(z0[3]));
            p1.x = cvt_pk_bf16(silu_f(z1[0]), silu_f(z1[1])); p1.y = cvt_pk_bf16(silu_f(z1[2]), silu_f(z1[3]));
            *(u32x2*)(MIX + (size_t)tok * D + 4 * lane) = o0; *(u32x2*)(MIX + (size_t)tok * D + 256 + 4 * lane) = o1;
            *(u32x2*)(MIX + (size_t)(tok + 1) * D + 4 * lane) = p0; *(u32x2*)(MIX + (size_t)(tok + 1) * D + 256 + 4 * lane) = p1;
        }
    }
    __syncthreads();
}

#define XB_TMO      128
#define XB_XCNT(j)  (256  + 64 * (j))
#define XB_XSUB(j)  (1280 + 64 * (j))
#define XB_XGEN(j)  (2304 + 64 * (j))
#define XB_TOP      3328
#define XB_TOPGEN   3392
#define XCD_BAR_WORDS 3456
#define XB_SPIN_CAP (1u << 18)
__device__ __forceinline__ unsigned xb_ld(unsigned* p)              { return __hip_atomic_load(p, __ATOMIC_RELAXED, __HIP_MEMORY_SCOPE_AGENT); }
__device__ __forceinline__ unsigned xb_add(unsigned* p, unsigned v) { return __hip_atomic_fetch_add(p, v, __ATOMIC_RELAXED, __HIP_MEMORY_SCOPE_AGENT); }
__device__ __forceinline__ unsigned xb_xcc_id() { return (unsigned)__builtin_amdgcn_s_getreg((3 << 11) | 20) & 0xFu; }
#define XB_SPIN(cond, bar) do { unsigned _sp = 0; while (cond) { __builtin_amdgcn_s_sleep(1); \
    if ((++_sp & 255u) == 0u) { if (xb_ld(&(bar)[XB_TMO])) break; if (_sp > XB_SPIN_CAP) { atomicAdd(&(bar)[XB_TMO], 1u); break; } } } } while (0)
struct XcdBarrier { unsigned* bar; unsigned x; volatile LAS unsigned* st; };
__device__ __forceinline__ XcdBarrier xcd_barrier_post(unsigned* bar, volatile LAS unsigned* st, int wave_) {
    XcdBarrier b; b.bar = bar; b.x = (unsigned)__builtin_amdgcn_readfirstlane((int)xb_xcc_id()); b.st = st;
    if (wave_ == 0 && lane_now() == 0) (void)xb_add(&bar[XB_XCNT(b.x)], 1u);
    return b;
}
__device__ __forceinline__ void xcd_barrier_complete(unsigned* bar, unsigned x, unsigned& nloc, unsigned& nx) {
    const unsigned G = gridDim.x * gridDim.y * gridDim.z;
    unsigned sum, cnt, mine, sp = 0u;
    for (;;) {
        sum = 0u; cnt = 0u; mine = 0u;
#pragma unroll
        for (unsigned j = 0; j < 16; ++j) { const unsigned c = xb_ld(&bar[XB_XCNT(j)]); sum += c; cnt += (c > 0u) ? 1u : 0u; mine = (j == x) ? c : mine; }
        if (sum == G) break;
        __builtin_amdgcn_s_sleep(1);
        if ((++sp & 255u) == 0u) { if (xb_ld(&bar[XB_TMO])) break; if (sp > XB_SPIN_CAP) { atomicAdd(&bar[XB_TMO], 1u); break; } }
    }
    nloc = mine > 0u ? mine : 1u; nx = cnt > 0u ? cnt : 1u;
}
__device__ __forceinline__ void xcd_barrier(const XcdBarrier& b, int wave_) {
    asm volatile("s_waitcnt vmcnt(0)" ::: "memory");
    __syncthreads();
    if (wave_ == 0 && lane_now() == 0) {
        unsigned* bar = b.bar; unsigned bx = b.x; asm volatile("" : "+s"(bx));
        __builtin_amdgcn_s_waitcnt(0);
        unsigned nloc = b.st[0], nx = b.st[1];
        if (nloc == 0u) { xcd_barrier_complete(bar, bx, nloc, nx); b.st[0] = nloc; b.st[1] = nx; }
        const unsigned old = xb_add(&bar[XB_XSUB(bx)], 1u);
        const unsigned gen = old / nloc;
        if (old + 1u == (gen + 1u) * nloc) {
            __builtin_amdgcn_fence(__ATOMIC_RELEASE, "agent");
            asm volatile("s_waitcnt vmcnt(0)" ::: "memory");
            const unsigned og = xb_add(&bar[XB_TOP], 1u);
            const unsigned tg = og / nx;
            if (og + 1u == (tg + 1u) * nx) xb_add(&bar[XB_TOPGEN], 1u);
            else XB_SPIN(xb_ld(&bar[XB_TOPGEN]) == tg, bar);
            __builtin_amdgcn_fence(__ATOMIC_ACQUIRE, "agent");
            xb_add(&bar[XB_XGEN(bx)], 1u);
            asm volatile("s_waitcnt vmcnt(0)" ::: "memory");
        } else {
            XB_SPIN(xb_ld(&bar[XB_XGEN(bx)]) == gen, bar);
            __builtin_amdgcn_fence(__ATOMIC_ACQUIRE, "agent");
            asm volatile("s_waitcnt vmcnt(0)" ::: "memory");
        }
    }
    __syncthreads();
}
constexpr int MISC_OFF = 151552;
constexpr size_t CTL_ZERO_BYTES = 65536;
constexpr int CW_BAR = 4096;

__global__ void __launch_bounds__(512, 2) hymba_fwd(Args a_) {
    extern __shared__ __attribute__((aligned(16))) unsigned char lds_raw[];
    LAS unsigned char* lds = (LAS unsigned char*)lds_raw;
    unsigned char* ws = a_.ws;
    const int wave = __builtin_amdgcn_readfirstlane((int)threadIdx.x >> 6);
#define lane lane_now()
#define tid (wave * 64 + lane_now())
    const int G = gridDim.x, bid = blockIdx.x;
    for (int u = wave * 64 + lane_now(); u < (LDS_BYTES - MISC_OFF) / 4; u += 512) ((LAS unsigned*)(lds + MISC_OFF))[u] = 0u;
    __syncthreads();
    const XcdBarrier bar = xcd_barrier_post((unsigned*)ws + CW_BAR, (volatile LAS unsigned*)(lds + MISC_OFF) + 8, wave);
#define GRID_BAR() xcd_barrier(bar, wave)

    bf16_t* AB = (bf16_t*)(ws + WS_AB); bf16_t* ACT = (bf16_t*)(ws + WS_ACT);
    float* ssq0 = (float*)(ws + WS_SSQ0); float* ssq1 = (float*)(ws + WS_SSQ1); float* ssq2 = (float*)(ws + WS_SSQ2);

#ifndef PROBE_DUP
#define PROBE_DUP -1
#endif
#ifndef PHASE_MASK
#define PHASE_MASK 0xff
#endif
#define REPS(k) if (PHASE_MASK & (1 << (k))) for (int rep_ = 0; rep_ < ((PROBE_DUP == (k)) ? 2 : 1); ++rep_)
#define ARGS_HERE() ArgsRef a = *args_now()
    REPS(0) { ARGS_HERE(); p0_prologue(a, lds, wave); GRID_BAR(); }
    REPS(1) {
    { int bs_ = bid, gs_ = G; asm volatile("" : "+s"(bs_), "+s"(gs_));
      pg8::Gemm g{(const bf16_t*)(ws + WS_A8), (const bf16_t*)(ws + WS_W1Q), MP, NUP, D / 2}; pg8::StaticOrder S; S.init(MP, NUP, gs_, bs_, 16);
      EpiSwigluI8 E{ACT, (const float*)(ws + WS_RS), (const float*)(ws + WS_CS1), lds};
      small_gemm<1, 4, true>((const bf16_t*)(ws + WS_A8), (const bf16_t*)(ws + WS_W1Q), NUP, D / 2, E, lds, bs_, gs_, wave, lane);
      if (rep_ == 0) { ARGS_HERE(); int ln = lane; asm volatile("" : "+v"(ln));
        weights_convert(a, lds, I_UP, NITEMS_EARLY, wave >= 3 ? bs_ * 5 + (wave - 3) : (1 << 28), gs_ * 5, wave, ln); }
      __syncthreads();
      pg8::gemm_phase<EpiSwigluI8, pg8::StaticOrder, true, true, true>(lds, g, S, E, wave); }
    GRID_BAR(); }
    REPS(2) {
    { int bs_ = bid, gs_ = G; asm volatile("" : "+s"(bs_), "+s"(gs_));
      pg8::Gemm g{ACT, (const bf16_t*)(ws + WS_W2T), MP, D, FF}; pg8::StaticOrder S; S.init(MP, D, gs_, bs_);
      ARGS_HERE(); EpiResid<0> E{a.in[0], a.in[1], nullptr, AB, ssq1, 0.5f};
      for (int pass = 0; pass < 2; ++pass) { if ((((pass ^ (bs_ >> 6)) & 1) == 0)) { pg8::gemm_phase<EpiResid<0>, pg8::StaticOrder, true, true>(lds, g, S, E, wave); } else { small_gemm<8, 2, false>(ACT, (const bf16_t*)(ws + WS_W2T), D, FF, E, lds, bs_, gs_, wave, lane); } } }
    GRID_BAR(); }
    REPS(3) {
    { int bs_ = bid, gs_ = G; asm volatile("" : "+s"(bs_), "+s"(gs_));
      pg8::Gemm g{AB, (const bf16_t*)(ws + WS_WINT), MP, NIN, D}; pg8::StaticOrder S; S.init(MP, NIN, gs_, bs_);
      ARGS_HERE(); EpiInProj E{ws, a.in[10], a.in[11], a.out, lds};
      { const int t_ = wave * 64 + lane_now(); if (t_ < 128) ((LAS float*)(lds + GAIN_LDS_OFF))[t_] = (t_ < 64) ? a.in[10][t_] : a.in[11][t_ - 64]; __syncthreads(); }
      pg8::gemm_phase<EpiInProj, pg8::StaticOrder, true, true>(lds, g, S, E, wave);
      const bool side = (rep_ == 0) && (bid >= G / 2);
      if (side) { int ln = lane; asm volatile("" : "+v"(ln));
        for (int nb = bid - G / 2; nb < NUP / 32; nb += G - G / 2) w8_strip(a.in[19], a.in[18], (signed char*)(ws + WS_W3Q), (float*)(ws + WS_CS3), nb, lds, wave, ln); }
      small_gemm<1, 4, false>(AB, (const bf16_t*)(ws + WS_WINT), NIN, D, E, lds, gs_ - 1 - bs_, gs_, wave, lane, 2);
 }
    GRID_BAR(); }
    REPS(4) {
#ifndef PROBE_P4SUB
#define PROBE_P4SUB 0
#endif
    ARGS_HERE();
    if (!(rep_ == 1 && PROBE_P4SUB == 1)) conv_phase(a, lds, tid, G - 1 - bid, G);
    if (!(rep_ == 1 && PROBE_P4SUB == 2)) attn_phase(a, lds, tid, bid, G);
    GRID_BAR(); }
    REPS(5) {
    { int bs_ = bid, gs_ = G; asm volatile("" : "+s"(bs_), "+s"(gs_));
      pg8::Gemm g{(const bf16_t*)(ws + WS_MIX), (const bf16_t*)(ws + WS_WOT), MP, D, D}; pg8::StaticOrder S; S.init(MP, D, gs_, bs_);
      EpiResid<1> E{nullptr, nullptr, nullptr, AB, ssq2, 1.0f};
      for (int pass = 0; pass < 2; ++pass) { if ((((pass ^ (bs_ >> 6)) & 1) == 0)) { pg8::gemm_phase<EpiResid<1>, pg8::StaticOrder, true, true>(lds, g, S, E, wave); } else { small_gemm<8, 2, false>((const bf16_t*)(ws + WS_MIX), (const bf16_t*)(ws + WS_WOT), D, D, E, lds, bs_, gs_, wave, lane); } } }
    GRID_BAR(); }
    { const int gw = bid * 8 + wave, NGW = G * 8; int ln = lane; asm volatile("" : "+v"(ln));
      if (G == 256) {
        const int base = (bid & 7) * 4096 + (bid >> 3) * 128 + wave * 16;
        q8_rows<8>(ws, ssq2, base, ln); q8_rows<8>(ws, ssq2, base + 8, ln);
        for (int m = MP + gw; m < M; m += NGW) q8_rows<1>(ws, ssq2, m, ln);
      } else { for (int m0 = gw * 8; m0 < M; m0 += NGW * 8) q8_rows<8>(ws, ssq2, m0, ln); }
      GRID_BAR(); }
    REPS(6) {
    { int bs_ = bid, gs_ = G; asm volatile("" : "+s"(bs_), "+s"(gs_));
      pg8::Gemm g{(const bf16_t*)(ws + WS_A8), (const bf16_t*)(ws + WS_W3Q), MP, NUP, D / 2}; pg8::StaticOrder S; S.init(MP, NUP, gs_, bs_, 16);
      EpiSwigluI8 E{ACT, (const float*)(ws + WS_RS), (const float*)(ws + WS_CS3), lds};
      small_gemm<1, 4, true>((const bf16_t*)(ws + WS_A8), (const bf16_t*)(ws + WS_W3Q), NUP, D / 2, E, lds, bs_, gs_, wave, lane);
      if (rep_ == 0) { ARGS_HERE(); int ln = lane; asm volatile("" : "+v"(ln));
        weights_convert(a, lds, NITEMS_EARLY + I_UP, NITEMS, wave >= 3 ? bs_ * 5 + (wave - 3) : (1 << 28), gs_ * 5, wave, ln); }
      __syncthreads();
      pg8::gemm_phase<EpiSwigluI8, pg8::StaticOrder, true, true, true>(lds, g, S, E, wave); }
    GRID_BAR(); }
    REPS(7) { int bs_ = bid, gs_ = G; asm volatile("" : "+s"(bs_), "+s"(gs_));
      pg8::Gemm g{ACT, (const bf16_t*)(ws + WS_W4T), MP, D, FF}; pg8::StaticOrder S; S.init(MP, D, gs_, bs_);
      ARGS_HERE(); EpiResid<2> E{nullptr, nullptr, a.out, AB, nullptr, 0.5f};
      for (int pass = 0; pass < 2; ++pass) { if ((((pass ^ (bs_ >> 6)) & 1) == 0)) { pg8::gemm_phase<EpiResid<2>, pg8::StaticOrder, true, true>(lds, g, S, E, wave); } else { small_gemm<8, 2, false>(ACT, (const bf16_t*)(ws + WS_W4T), D, FF, E, lds, bs_, gs_, wave, lane); } } }
}
#undef lane
#undef tid

extern "C" void kernel_launch(void* const* d_in, const int* in_sizes, int n_in, void* d_out, int out_size, void* d_ws, size_t ws_size, hipStream_t stream) {
    static int grid = 0;
    if (grid == 0) {
        if (n_in != 21 || (size_t)out_size != O_END || ws_size < WS_END) { fprintf(stderr, "kernel_launch: unexpected shapes: n_in %d out %d ws %zu (need %zu)\n", n_in, out_size, ws_size, (size_t)WS_END); grid = -1; return; }
        int dev = 0, cus = 0, per_cu = 0;
        (void)hipGetDevice(&dev);
        (void)hipDeviceGetAttribute(&cus, hipDeviceAttributeMultiprocessorCount, dev);
        if (cus != 256) fprintf(stderr, "kernel_launch: note: built for a 256-CU device (one workgroup per CU), this device reports %d\n", cus);
        if (hipFuncSetAttribute((const void*)hymba_fwd, hipFuncAttributeMaxDynamicSharedMemorySize, LDS_BYTES) != hipSuccess) { fprintf(stderr, "kernel_launch: hipFuncSetAttribute failed\n"); grid = -1; return; }
        if (hipOccupancyMaxActiveBlocksPerMultiprocessor(&per_cu, (const void*)hymba_fwd, 512, LDS_BYTES) != hipSuccess || per_cu < 1) { fprintf(stderr, "kernel_launch: occupancy query failed (%d)\n", per_cu); grid = -1; (void)hipGetLastError(); return; }
        grid = cus;
    }
    if (grid < 0) return;
    Args a{};
    for (int i = 0; i < 21; ++i) a.in[i] = (const float*)d_in[i];
    a.out = (float*)d_out; a.ws = (unsigned char*)d_ws;
    for (int i = 0; i < 8; ++i) a.inv[i] = powf(500000.0f, -(float)i / 8.0f);
    if (hipMemsetAsync(d_ws, 0, CTL_ZERO_BYTES, stream) != hipSuccess) { fprintf(stderr, "kernel_launch: memset failed\n"); return; }
    hipLaunchKernelGGL(hymba_fwd, dim3(grid), dim3(512), LDS_BYTES, stream, a);
    const hipError_t e = hipPeekAtLastError();
    if (e != hipSuccess) fprintf(stderr, "kernel_launch: launch failed: %s (grid %d)\n", hipGetErrorString(e), grid);
}
```
